# Optimizing an MI355X kernel written in HIP

```python
import jax, jax.numpy as jnp
from jax import lax
import numpy as np

D_MODEL = 2048
BATCH = 4
SEQ = 4096
DEPTH = 2

MEM_LEN = 256
HEAD_DIM = 128
MIX_W = D_MODEL
MEM_HEADS = 4
MEM_W = MEM_HEADS * HEAD_DIM
POOL_W = MIX_W - MEM_W
POOL_WINDOWS = (2, 4, 8, 16)
POOL_GROUPS = len(POOL_WINDOWS)
POOL_GC = POOL_W // POOL_GROUPS
NSA_W = MIX_W - MEM_W
NSA_HEADS = NSA_W // HEAD_DIM
NSA_KV_HEADS = 4
NSA_GROUP = NSA_HEADS // NSA_KV_HEADS
NSA_KV_W = NSA_KV_HEADS * HEAD_DIM
CMP_LEN = 32
CMP_STRIDE = 16
CMP_HID = 256
SEL_LEN = 64
SEL_TOPK = 16
WINDOW = 512
Q_CHUNK = 32
ROT_DIM = HEAD_DIM // 4
ROPE_THETA = 500000.0
NORM_EPS = 1e-6
FORCE_SCORE = 1e4
NEG_INF = -1e30

kernel_name = "yoco_pool_nsa_memory_hybrid"


def rmsnorm(x, g):
    xf = x.astype(jnp.float32)
    y = xf * lax.rsqrt(jnp.mean(xf * xf, axis=-1, keepdims=True) + NORM_EPS)
    return (y * g.astype(jnp.float32)).astype(x.dtype)


def rope(x, pos):
    half = ROT_DIM // 2
    inv = ROPE_THETA ** (-jnp.arange(half, dtype=jnp.float32) * 2.0 / ROT_DIM)
    ang = pos.astype(jnp.float32)[..., None] * inv
    cos = jnp.cos(ang)[:, :, None, :]
    sin = jnp.sin(ang)[:, :, None, :]
    xr = x[..., :ROT_DIM].astype(jnp.float32)
    x1, x2 = xr[..., :half], xr[..., half:]
    rot = jnp.concatenate([x1 * cos - x2 * sin, x2 * cos + x1 * sin], axis=-1)
    return jnp.concatenate([rot.astype(x.dtype), x[..., ROT_DIM:]], axis=-1)


def masked_softmax(s, mask):
    s = jnp.where(mask, s.astype(jnp.float32), NEG_INF)
    p = jax.nn.softmax(s, axis=-1)
    return jnp.where(mask, p, 0.0)


def memory_attention(q, mem, mem_g, w_mem_kv):
    b, m, _ = mem.shape
    mn = rmsnorm(mem, mem_g)
    kv = (mn @ w_mem_kv).reshape(b, m, 2, MEM_HEADS, HEAD_DIM)
    k, v = kv[:, :, 0], kv[:, :, 1]
    s = jnp.einsum('bshd,bmhd->bhsm', q, k).astype(jnp.float32)
    p = jax.nn.softmax(s, axis=-1).astype(v.dtype)
    o = jnp.einsum('bhsm,bmhd->bshd', p, v)
    return o.reshape(q.shape[0], q.shape[1], MEM_W)


def multiscale_pool(u, w_pool, scale):
    b, s, _ = u.shape
    ug = u.reshape(b, s, POOL_GROUPS, POOL_GC)
    t1 = jnp.arange(1, s + 1, dtype=jnp.float32)[None, :, None]
    outs = []
    for gi, win in enumerate(POOL_WINDOWS):
        v = ug[:, :, gi].astype(jnp.float32)
        c = jnp.cumsum(v, axis=1)
        c_lag = jnp.pad(c, ((0, 0), (win, 0), (0, 0)))[:, :s]
        outs.append((c - c_lag) / jnp.minimum(t1, float(win)) - v)
    pooled = jnp.stack(outs, axis=2).astype(u.dtype)
    mixed = jnp.einsum('bsgc,gcd->bsgd', pooled, w_pool).reshape(b, s, POOL_W)
    return mixed * scale


def nsa_shared_kv(h, kv_norm_g, w_kv, cmp_pe, cmp_w1, cmp_w2, positions):
    b, s, _ = h.shape
    hn = rmsnorm(h, kv_norm_g)
    kv = (hn @ w_kv).reshape(b, s, 6, NSA_KV_HEADS, HEAD_DIM)
    k_c, v_c, k_s, v_s, k_w, v_w = [kv[:, :, i] for i in range(6)]
    k_s = rope(k_s, positions)
    k_w = rope(k_w, positions)
    n_cmp = (s - CMP_LEN) // CMP_STRIDE + 1
    blk = jnp.arange(n_cmp)[:, None] * CMP_STRIDE + jnp.arange(CMP_LEN)[None, :]

    def compress(z, pe, w1, w2):
        zb = z[:, blk] + pe[None, None, :, None, :]
        zb = zb.transpose(0, 1, 3, 2, 4).reshape(b, n_cmp, NSA_KV_HEADS, CMP_LEN * HEAD_DIM)
        return jax.nn.silu(zb @ w1) @ w2

    k_cmp = compress(k_c, cmp_pe[0], cmp_w1[0], cmp_w2[0])
    v_cmp = compress(v_c, cmp_pe[1], cmp_w1[1], cmp_w2[1])
    k_cmp = rope(k_cmp, positions[:, blk[:, -1]])
    n_sel = s // SEL_LEN
    k_blk = k_s.reshape(b, n_sel, SEL_LEN, NSA_KV_HEADS, HEAD_DIM).transpose(0, 3, 1, 2, 4)
    v_blk = v_s.reshape(b, n_sel, SEL_LEN, NSA_KV_HEADS, HEAD_DIM).transpose(0, 3, 1, 2, 4)
    pad = ((0, 0), (WINDOW, 0), (0, 0), (0, 0))
    return (k_cmp, v_cmp, k_blk, v_blk, jnp.pad(k_w, pad), jnp.pad(v_w, pad))


def nsa_attention(q, gates, k_cmp, v_cmp, k_blk, v_blk, k_win, v_win):
    b, s, _, _ = q.shape
    n_cmp = k_cmp.shape[1]
    n_sel = k_blk.shape[2]
    n_top = min(SEL_TOPK, n_sel)
    G, R, L = NSA_KV_HEADS, NSA_GROUP, SEL_LEN
    cmp_start = jnp.arange(n_cmp) * CMP_STRIDE
    cmp_end = cmp_start + CMP_LEN - 1
    sel_start = jnp.arange(n_sel) * SEL_LEN
    ov = (jnp.minimum(cmp_end[:, None], sel_start[None, :] + L - 1)
          - jnp.maximum(cmp_start[:, None], sel_start[None, :]) + 1)
    overlap = jnp.maximum(ov, 0).astype(jnp.float32) / CMP_LEN
    bi = jnp.arange(b)[:, None, None, None]
    gi = jnp.arange(G)[None, :, None, None]
    jsel = jnp.arange(n_sel)

    def chunk(c):
        t0 = c * Q_CHUNK
        t = t0 + jnp.arange(Q_CHUNK)
        qc = lax.dynamic_slice_in_dim(q, t0, Q_CHUNK, axis=1).reshape(b, Q_CHUNK, G, R, HEAD_DIM)
        gc = lax.dynamic_slice_in_dim(gates, t0, Q_CHUNK, axis=1).reshape(b, Q_CHUNK, G, R, 3)
        sc = jnp.einsum('bqgrd,bngd->bgrqn', qc, k_cmp)
        p_cmp = masked_softmax(sc, cmp_end[None, :] <= t[:, None])
        o_cmp = jnp.einsum('bgrqn,bngd->bqgrd', p_cmp.astype(v_cmp.dtype), v_cmp)
        imp = jnp.einsum('bgrqn,nj->bgqj', p_cmp, overlap)
        cur = t // L
        forced = (jsel[None, :] == 0) | (jsel[None, :] == cur[:, None]) | (jsel[None, :] == cur[:, None] - 1)
        ok = sel_start[None, :] <= t[:, None]
        score = jnp.where(ok, jnp.where(forced, FORCE_SCORE, imp), NEG_INF)
        _, idx = lax.top_k(score, n_top)
        k_sel = k_blk[bi, gi, idx].reshape(b, G, Q_CHUNK, n_top * L, HEAD_DIM)
        v_sel = v_blk[bi, gi, idx].reshape(b, G, Q_CHUNK, n_top * L, HEAD_DIM)
        key_pos = (idx[..., None] * L + jnp.arange(L)).reshape(b, G, 1, Q_CHUNK, n_top * L)
        ss = jnp.einsum('bqgrd,bgqmd->bgrqm', qc, k_sel)
        p_sel = masked_softmax(ss, key_pos <= t[None, None, None, :, None])
        o_sel = jnp.einsum('bgrqm,bgqmd->bqgrd', p_sel.astype(v_sel.dtype), v_sel)
        kw = lax.dynamic_slice_in_dim(k_win, t0, WINDOW + Q_CHUNK, axis=1)
        vw = lax.dynamic_slice_in_dim(v_win, t0, WINDOW + Q_CHUNK, axis=1)
        spos = t0 - WINDOW + jnp.arange(WINDOW + Q_CHUNK)
        dist = t[:, None] - spos[None, :]
        win_ok = (dist >= 0) & (dist < WINDOW) & (spos[None, :] >= 0)
        sw = jnp.einsum('bqgrd,bsgd->bgrqs', qc, kw)
        p_w = masked_softmax(sw, win_ok)
        o_win = jnp.einsum('bgrqs,bsgd->bqgrd', p_w.astype(vw.dtype), vw)
        return gc[..., 0:1] * o_cmp + gc[..., 1:2] * o_sel + gc[..., 2:3] * o_win

    out = lax.map(chunk, jnp.arange(s // Q_CHUNK))
    return jnp.moveaxis(out, 0, 1).reshape(b, s, NSA_W)


def pool_layer(x, mem, norm_g, w_in, w_pool, pool_scale, mem_g, w_mem_kv, w_out):
    b, s, _ = x.shape
    h = rmsnorm(x, norm_g)
    proj = h @ w_in
    u, zu, qm, zm = jnp.split(proj, [POOL_W, 2 * POOL_W, 2 * POOL_W + MEM_W], axis=-1)
    y_pool = multiscale_pool(u, w_pool, pool_scale) * jax.nn.silu(zu)
    qm = qm.reshape(b, s, MEM_HEADS, HEAD_DIM) * (HEAD_DIM ** -0.5)
    y_mem = memory_attention(qm, mem, mem_g, w_mem_kv) * jax.nn.silu(zm)
    return x + jnp.concatenate([y_pool, y_mem], axis=-1) @ w_out


def nsa_layer(x, mem, positions, norm_g, w_in, mem_g, w_mem_kv, w_out, shared):
    b, s, _ = x.shape
    h = rmsnorm(x, norm_g)
    proj = h @ w_in
    o1 = NSA_W
    o2 = o1 + 3 * NSA_HEADS
    o3 = o2 + NSA_W
    o4 = o3 + MEM_W
    q, gl, zq, qm, zm = jnp.split(proj, [o1, o2, o3, o4], axis=-1)
    q = rope(q.reshape(b, s, NSA_HEADS, HEAD_DIM), positions) * (HEAD_DIM ** -0.5)
    gates = jax.nn.sigmoid(gl.reshape(b, s, NSA_HEADS, 3))
    y_nsa = nsa_attention(q, gates, *shared) * jax.nn.silu(zq)
    qm = qm.reshape(b, s, MEM_HEADS, HEAD_DIM) * (HEAD_DIM ** -0.5)
    y_mem = memory_attention(qm, mem, mem_g, w_mem_kv) * jax.nn.silu(zm)
    return x + jnp.concatenate([y_nsa, y_mem], axis=-1) @ w_out


def setup_inputs(seed: int = 0) -> dict:
    key = jax.random.key(seed)
    ks = jax.random.split(key, 20)
    n_a = DEPTH // 2
    n_b = DEPTH - n_a
    f32 = jnp.float32

    def w(k, shape, fan_in):
        return jax.random.normal(k, shape, f32) * (fan_in ** -0.5)

    def gain(k, shape):
        return 1.0 + 0.05 * jax.random.normal(k, shape, f32)

    x = jax.random.normal(ks[0], (BATCH, SEQ, D_MODEL), f32)
    mem = jax.random.normal(ks[1], (BATCH, MEM_LEN, D_MODEL), f32)
    offs = jax.random.randint(ks[2], (BATCH, 1), 0, 1024, dtype=jnp.int32)
    positions = (offs + jnp.arange(SEQ, dtype=jnp.int32)[None, :]).astype(jnp.int32)
    b_in_w = 2 * NSA_W + 3 * NSA_HEADS + 2 * MEM_W
    return {
        "x": x,
        "mem": mem,
        "positions": positions,
        "norm_g": gain(ks[3], (DEPTH, D_MODEL)),
        "mem_norm_g": gain(ks[4], (DEPTH, D_MODEL)),
        "w_mem_kv": w(ks[5], (DEPTH, D_MODEL, 2 * MEM_W), D_MODEL),
        "w_out": w(ks[6], (DEPTH, MIX_W, D_MODEL), MIX_W),
        "a_w_in": w(ks[7], (n_a, D_MODEL, 2 * POOL_W + 2 * MEM_W), D_MODEL),
        "a_w_pool": w(ks[8], (n_a, POOL_GROUPS, POOL_GC, POOL_GC), POOL_GC),
        "a_pool_scale": gain(ks[9], (n_a, POOL_W)),
        "b_w_in": w(ks[10], (n_b, D_MODEL, b_in_w), D_MODEL),
        "kv_norm_g": gain(ks[11], (D_MODEL,)),
        "w_kv": w(ks[12], (D_MODEL, 6 * NSA_KV_W), D_MODEL),
        "cmp_pe": 0.1 * jax.random.normal(ks[13], (2, CMP_LEN, HEAD_DIM), f32),
        "cmp_w1": w(ks[14], (2, CMP_LEN * HEAD_DIM, CMP_HID), CMP_LEN * HEAD_DIM),
        "cmp_w2": w(ks[15], (2, CMP_HID, HEAD_DIM), CMP_HID),
        "final_g": gain(ks[16], (D_MODEL,)),
    }


def reference(x, mem, positions, norm_g, mem_norm_g, w_mem_kv, w_out, a_w_in, a_w_pool,
              a_pool_scale, b_w_in, kv_norm_g, w_kv, cmp_pe, cmp_w1, cmp_w2, final_g):
    n_a = DEPTH // 2
    h = x
    shared = None
    for layer in range(DEPTH):
        if layer < n_a:
            h = pool_layer(h, mem, norm_g[layer], a_w_in[layer], a_w_pool[layer],
                           a_pool_scale[layer], mem_norm_g[layer], w_mem_kv[layer], w_out[layer])
        else:
            if layer == n_a:
                shared = nsa_shared_kv(h, kv_norm_g, w_kv, cmp_pe, cmp_w1, cmp_w2, positions)
            h = nsa_layer(h, mem, positions, norm_g[layer], b_w_in[layer - n_a],
                          mem_norm_g[layer], w_mem_kv[layer], w_out[layer], shared)
    return rmsnorm(h, final_g)
```

```cpp
#include <hip/hip_runtime.h>
#include <hip/hip_cooperative_groups.h>
#include <cstdio>
#include <cstdint>
namespace cg = cooperative_groups;

#define LAS __attribute__((address_space(3)))
typedef unsigned short bf16;
typedef unsigned v4u __attribute__((ext_vector_type(4)));
typedef unsigned v2u __attribute__((ext_vector_type(2)));
typedef float f32x4 __attribute__((ext_vector_type(4)));
typedef float f32x2 __attribute__((ext_vector_type(2)));
typedef float f32x16 __attribute__((ext_vector_type(16)));
typedef short bf16x8 __attribute__((ext_vector_type(8)));
typedef short s16x4 __attribute__((ext_vector_type(4)));

constexpr int NB = 4, SEQ = 4096, DM = 2048, MTOK = NB * SEQ;
constexpr int MEMLEN = 256, HD = 128;
constexpr int POOLW = 1536, MEMW = 512, NSAW = 1536, NHEAD = 12, NKVH = 4;
constexpr int N1 = 4096;
constexpr int NKV = 3072;
constexpr int N4 = 7424;
constexpr int NCMP = 255, CMPHID = 256;
constexpr float EPS = 1e-6f;
constexpr float LOG2E = 1.4426950408889634f;
constexpr float ATT_SCALE = 0.08838834764831845f;

constexpr size_t MiB = 1u << 20;
constexpr size_t WS_CTL = 0;
constexpr size_t WS_W1T = 1 * MiB;
constexpr size_t WS_WO0T = 17 * MiB;
constexpr size_t WS_W4T = 25 * MiB;
constexpr size_t WS_WO1T = 54 * MiB;
constexpr size_t WS_WMT = 62 * MiB;
constexpr size_t WS_WPT = 70 * MiB;
constexpr size_t WS_WC1T = 72 * MiB;
constexpr size_t WS_MEMN = 76 * MiB;
constexpr size_t WS_MKV = 80 * MiB;
constexpr size_t WS_ROPE = 84 * MiB;
constexpr size_t WS_ROPEC = 86 * MiB;
constexpr size_t WS_SS1 = 87 * MiB;
constexpr size_t WS_SS2 = 89 * MiB;
constexpr size_t WS_SEL = 91 * MiB;
constexpr size_t WS_KCMP = 92 * MiB;
constexpr size_t WS_VCMP = 93 * MiB;
constexpr size_t WS_GATES = 94 * MiB;
constexpr size_t WS_CBIAS = 97 * MiB;
constexpr size_t WS_A = 98 * MiB;
constexpr size_t WS_KVB = WS_A;
constexpr size_t WS_QM1 = WS_A + 97 * MiB;
constexpr size_t WS_ZM1 = WS_A + 113 * MiB;
constexpr size_t WS_B = 228 * MiB;
constexpr size_t WS_C = 292 * MiB;
constexpr size_t WS_D = 388 * MiB;
constexpr size_t WS_Q1 = WS_D, WS_ZQ = WS_D + 48 * MiB;
constexpr size_t WS_END = 484 * MiB;

#define LDS_WAIT() asm volatile("s_waitcnt lgkmcnt(0)" ::: "memory")
#define VM_WAIT() asm volatile("s_waitcnt vmcnt(0)" ::: "memory")
__device__ __forceinline__ unsigned f2bf(float f) { unsigned u = __builtin_bit_cast(unsigned, f); return (u + 0x7fffu + ((u >> 16) & 1u)) >> 16; }
__device__ __forceinline__ unsigned pk2(float lo, float hi) { return f2bf(lo) | (f2bf(hi) << 16); }
__device__ __forceinline__ float bf2f(unsigned short b) { return __builtin_bit_cast(float, (unsigned)b << 16); }
__device__ __forceinline__ float bflo(unsigned w) { return __builtin_bit_cast(float, w << 16); }
__device__ __forceinline__ float bfhi(unsigned w) { return __builtin_bit_cast(float, w & 0xffff0000u); }
__device__ __forceinline__ unsigned cvtpk(float lo, float hi) { unsigned r; asm volatile("v_cvt_pk_bf16_f32 %0, %1, %2" : "=v"(r) : "v"(lo), "v"(hi)); return r; }
__device__ __forceinline__ float silu_f(float x) { return x * __builtin_amdgcn_rcpf(1.f + __builtin_amdgcn_exp2f(-x * LOG2E)); }
__device__ __forceinline__ float sigmoid_f(float x) { return __builtin_amdgcn_rcpf(1.f + __builtin_amdgcn_exp2f(-x * LOG2E)); }
__device__ __forceinline__ float wave_sum(float v) {
#pragma unroll
    for (int o = 1; o < 64; o <<= 1) v += __shfl_xor(v, o);
    return v;
}

namespace pg8 {
#define PG8_LAS __attribute__((address_space(3)))
constexpr int BM = 256, BK = 64, HALF = 128, HTB = HALF * BK * 2, STAGE_BYTES = 8 * HTB, NXCD = 8, WGM = 8;
__host__ __device__ __forceinline__ int lds_byte(int r, int c) { const int st = (r >> 4) * 2 + (c >> 5), rr = r & 15, cc = c & 31, ob = rr * 64 + cc * 2; return st * 1024 + (ob ^ (((ob >> 9) & 1) << 5)); }
__host__ __device__ __forceinline__ int perm32(int rho) { const int n = rho >> 4, i = rho & 15; return 8 * (i >> 2) + 4 * n + (i & 3); }
__host__ __device__ __forceinline__ void stage_rc(int b, int& R, int& C) { const int st = b / 1024, sb = b % 1024, swz = sb ^ (((sb >> 9) & 1) << 5); R = (st >> 1) * 16 + swz / 64; C = (st & 1) * 32 + (swz % 64) / 2; }

struct Unit { int pm, pn, z, kind; const char* a; const char* b; };
__device__ __forceinline__ void tile_swz(int wgid, int nM, int nN, int wgm, int& pm, int& pn) {
    const int nwg = nM * nN;
    { const int q = nwg / NXCD, r = nwg % NXCD, xcd = wgid % NXCD, off = wgid / NXCD; wgid = (xcd < r ? xcd * (q + 1) : r * (q + 1) + (xcd - r) * q) + off; }
    const int nig = wgm * nN, gid = wgid / nig, fm = gid * wgm, gsz = (nM - fm) < wgm ? (nM - fm) : wgm;
    pm = fm + ((wgid % nig) % gsz); pn = (wgid % nig) / gsz;
}
struct Geo { int lda, ldb, nt; int kpairA; };

template <class Epi, class Sched, bool ALIGN_EPI, bool SP2>
__device__ __forceinline__ void gemm_phase(PG8_LAS unsigned char* lds, const int tid, const Geo g, const Sched& S, const Epi& E) {
    const int wid = __builtin_amdgcn_readfirstlane(tid >> 6), lane = tid & 63, wr = wid >> 2, wc = wid & 3, fr = lane & 15, fq = lane >> 4;
    const int nt = g.nt;
    unsigned voffA[2], voffB[2];
#pragma unroll
    for (int i = 0; i < 2; ++i) { int R, C; stage_rc(tid * 16 + i * 8192, R, C);
        const int Rb = Epi::PERM ? 64 * (R >> 5) + perm32(R & 31) : R;
        voffA[i] = (unsigned)(R * g.lda + C) * 2u; voffB[i] = (unsigned)(Rb * g.ldb + C) * 2u; }
    const size_t kstep = (size_t)(BK * 2);
    const size_t hstepA = (size_t)HALF * g.lda * 2, hstepB = (size_t)(Epi::PERM ? 32 : HALF) * g.ldb * 2;
    const size_t kpairA = (size_t)g.kpairA;
    const unsigned ldsw = (unsigned)wid * 1024u;
    const int aoff = lds_byte(wr * 64 + fr, fq * 8), boff = lds_byte(wc * 32 + fr, fq * 8);
#define PG8_SA(b, h) (((b) * 2 + (h)) * HTB)
#define PG8_SB(b, h) ((4 + (b) * 2 + (h)) * HTB)
#define PG8_STAGE(bufoff, gbase, voff) do { _Pragma("unroll") for (int _i = 0; _i < 2; ++_i) \
        __builtin_amdgcn_global_load_lds((const unsigned*)((const char*)(gbase) + (voff)[_i]), (PG8_LAS unsigned*)(lds + (bufoff) + ldsw + _i * 8192), 16, 0, 0); } while (0)
#define PG8_LDA(dst, b, h) do { _Pragma("unroll") for (int m = 0; m < 4; ++m) _Pragma("unroll") for (int k = 0; k < 2; ++k) dst[m][k] = *(const PG8_LAS bf16x8*)(lds + PG8_SA(b, h) + aoff + m * 2048 + k * 1024); } while (0)
#define PG8_LDB(dst, b, h) do { _Pragma("unroll") for (int n = 0; n < 2; ++n) _Pragma("unroll") for (int k = 0; k < 2; ++k) dst[n][k] = *(const PG8_LAS bf16x8*)(lds + PG8_SB(b, h) + boff + n * 2048 + k * 1024); } while (0)
#define PG8_MMA(ai, bj, At, Bt) do { __builtin_amdgcn_s_setprio(1); _Pragma("unroll") for (int m = 0; m < 4; ++m) _Pragma("unroll") for (int n = 0; n < 2; ++n) _Pragma("unroll") for (int k = 0; k < 2; ++k) \
        acc[ai][bj][m][n] = __builtin_amdgcn_mfma_f32_16x16x32_bf16(Bt[n][k], At[m][k], acc[ai][bj][m][n], 0, 0, 0); __builtin_amdgcn_s_setprio(0); } while (0)
#define PG8_WAIT_V(n) asm volatile("s_waitcnt vmcnt(" #n ")" ::: "memory")
#define PG8_WAIT_L(n) asm volatile("s_waitcnt lgkmcnt(" #n ")" ::: "memory")
#define PG8_BAR __builtin_amdgcn_s_barrier()
#define PG8_SCHED __builtin_amdgcn_sched_barrier(0)
    Unit cur, nxt; int ui = 0;
    if (!S.next(0, cur)) return;
    f32x4 acc[2][2][4][2];
    typename Epi::State est;
    E.begin(acc, est, cur, wr, wc, fr, fq);
    bf16x8 At[4][2], B0[2][2], B1[2][2];
    const char* cA = cur.a; const char* cB = cur.b;
    if constexpr (SP2) {
        PG8_STAGE(PG8_SB(0, 0), cB, voffB); PG8_STAGE(PG8_SB(0, 1), cB + hstepB, voffB); PG8_STAGE(PG8_SA(0, 0), cA, voffA); PG8_STAGE(PG8_SA(0, 1), cA + hstepA, voffA);
        if (wr == 1) PG8_BAR;
        PG8_WAIT_V(2); PG8_BAR;
        PG8_STAGE(PG8_SB(1, 0), cB + kstep, voffB); PG8_STAGE(PG8_SA(1, 0), cA + kstep, voffA); PG8_STAGE(PG8_SB(1, 1), cB + hstepB + kstep, voffB);
        PG8_WAIT_V(6); PG8_BAR;
    } else {
        PG8_STAGE(PG8_SB(0, 0), cB, voffB); PG8_STAGE(PG8_SA(0, 0), cA, voffA); PG8_STAGE(PG8_SB(0, 1), cB + hstepB, voffB); PG8_STAGE(PG8_SA(0, 1), cA + hstepA, voffA);
        if (wr == 1) PG8_BAR;
        PG8_WAIT_V(4); PG8_BAR;
        PG8_STAGE(PG8_SB(1, 0), cB + kstep, voffB); PG8_STAGE(PG8_SA(1, 0), cA + kstep, voffA); PG8_STAGE(PG8_SB(1, 1), cB + hstepB + kstep, voffB);
        PG8_WAIT_V(6); PG8_BAR;
    }
    for (;;) {
        const bool has_next = S.next(ui + 1, nxt);
        const char* nA = has_next ? nxt.a : cA; const char* nB = has_next ? nxt.b : cB;
        for (int t = 0; t < nt; t += 2) {
            const bool last = (t == nt - 2);
            const char* a0p = cA + (size_t)(t >> 1) * kpairA;
            const char* a1 = a0p + kstep;
            const char* a2 = last ? nA : a0p + kpairA; const char* b2 = last ? nB : cB + (size_t)(t + 2) * kstep;
            const char* a3 = a2 + kstep; const char* b3 = b2 + kstep;
            if constexpr (SP2) {
            PG8_LDB(B0, 0, 0); PG8_LDB(B1, 0, 1); PG8_SCHED; PG8_LDA(At, 0, 0); PG8_STAGE(PG8_SA(1, 1), a1 + hstepA, voffA);
            PG8_WAIT_V(8); PG8_WAIT_L(0); PG8_BAR; PG8_MMA(0, 0, At, B0); PG8_MMA(0, 1, At, B1); PG8_BAR; PG8_SCHED;
            PG8_LDA(At, 0, 1); PG8_STAGE(PG8_SB(0, 0), b2, voffB); PG8_STAGE(PG8_SB(0, 1), b2 + hstepB, voffB); PG8_STAGE(PG8_SA(0, 0), a2, voffA);
            PG8_WAIT_V(8); PG8_WAIT_L(0); PG8_BAR; PG8_MMA(1, 0, At, B0); PG8_MMA(1, 1, At, B1); PG8_BAR; PG8_SCHED;
            PG8_LDB(B0, 1, 0); PG8_LDB(B1, 1, 1); PG8_SCHED; PG8_LDA(At, 1, 0); PG8_STAGE(PG8_SA(0, 1), a2 + hstepA, voffA);
            PG8_WAIT_V(8); PG8_WAIT_L(0); PG8_BAR; PG8_MMA(0, 0, At, B0); PG8_MMA(0, 1, At, B1); PG8_BAR; PG8_SCHED;
            PG8_LDA(At, 1, 1); PG8_STAGE(PG8_SB(1, 0), b3, voffB); PG8_STAGE(PG8_SB(1, 1), b3 + hstepB, voffB); PG8_STAGE(PG8_SA(1, 0), a3, voffA);
            PG8_WAIT_V(8); PG8_WAIT_L(0); PG8_BAR; PG8_MMA(1, 0, At, B0); PG8_MMA(1, 1, At, B1); PG8_BAR; PG8_SCHED;
            } else {
            PG8_LDB(B0, 0, 0); PG8_SCHED; PG8_LDA(At, 0, 0); PG8_STAGE(PG8_SA(1, 1), a1 + hstepA, voffA);
            PG8_WAIT_L(8); PG8_BAR; PG8_WAIT_L(0); PG8_MMA(0, 0, At, B0); PG8_BAR; PG8_SCHED;
            PG8_LDB(B1, 0, 1); PG8_STAGE(PG8_SB(0, 0), b2, voffB);
            PG8_BAR; PG8_WAIT_L(0); PG8_MMA(0, 1, At, B1); PG8_BAR;
            PG8_LDA(At, 0, 1); PG8_STAGE(PG8_SA(0, 0), a2, voffA);
            PG8_BAR; PG8_WAIT_L(0); PG8_MMA(1, 0, At, B0); PG8_BAR; PG8_SCHED;
            PG8_STAGE(PG8_SB(0, 1), b2 + hstepB, voffB);
            PG8_WAIT_V(6); PG8_BAR; PG8_MMA(1, 1, At, B1); PG8_BAR;
            PG8_LDB(B0, 1, 0); PG8_SCHED; PG8_LDA(At, 1, 0); PG8_STAGE(PG8_SA(0, 1), a2 + hstepA, voffA);
            PG8_WAIT_L(8); PG8_BAR; PG8_WAIT_L(0); PG8_MMA(0, 0, At, B0); PG8_BAR; PG8_SCHED;
            PG8_LDB(B1, 1, 1); PG8_STAGE(PG8_SB(1, 0), b3, voffB);
            PG8_BAR; PG8_WAIT_L(0); PG8_MMA(0, 1, At, B1); PG8_BAR;
            PG8_LDA(At, 1, 1); PG8_STAGE(PG8_SA(1, 0), a3, voffA);
            PG8_BAR; PG8_WAIT_L(0); PG8_MMA(1, 0, At, B0); PG8_BAR; PG8_SCHED;
            PG8_STAGE(PG8_SB(1, 1), b3 + hstepB, voffB);
            PG8_WAIT_V(6); PG8_BAR; PG8_MMA(1, 1, At, B1); PG8_BAR;
            }
        }
        if constexpr (ALIGN_EPI) { if (wr == 0) PG8_BAR; }
        E(acc, est, cur, wr, wc, fr, fq);
        if (!has_next) break;
        cur = nxt; cA = nA; cB = nB; ++ui;
        E.begin(acc, est, cur, wr, wc, fr, fq);
        if constexpr (ALIGN_EPI) { if (wr == 1) PG8_BAR; }
    }
    PG8_WAIT_V(0);
    if constexpr (!ALIGN_EPI) { if (wr == 0) PG8_BAR; }
    PG8_BAR;
#undef PG8_SA
#undef PG8_SB
#undef PG8_STAGE
#undef PG8_LDA
#undef PG8_LDB
#undef PG8_MMA
#undef PG8_WAIT_V
#undef PG8_WAIT_L
#undef PG8_BAR
#undef PG8_SCHED
}
}

namespace att {
#ifndef AT_SELMASK
#define AT_SELMASK 1
#endif
constexpr int D = 128, NW = 8, QBLK = 32, KVBLK = 64, QB = NW * QBLK;
constexpr int SHM_V = KVBLK * D * 2, SHM_K = KVBLK * D * 2;
constexpr int LDS_BYTES = 2 * SHM_V + 2 * SHM_K + NW * 64 * 4;
constexpr float THR = 8.f;
#define KSWZ(row, colB) ((row) * 256 + ((colB) ^ (((row) & 7) << 4)))
#define SBAR() __builtin_amdgcn_sched_barrier(0)
__device__ __forceinline__ int v_st(int k, int c) { const int kk = (k & ~0xC) | ((k & 4) << 1) | ((k & 8) >> 1); return ((kk >> 3) * 4 + (c >> 5)) * 512 + ((kk & 7) * 32 + (c & 31)) * 2; }
__device__ __forceinline__ int v_rd_base(int lane) { return ((lane & 3) << 3) | (((lane >> 2) & 3) << 6) | (((lane >> 4) & 1) << 5) | (((lane >> 5) & 1) << 8); }
constexpr int v_rd_off(int d0, int ks, int half) { return d0 * 512 + ks * 4096 + half * 2048; }
__device__ __forceinline__ int crow(int r, int hi) { return (r & 3) + 8 * (r >> 2) + 4 * hi; }
__device__ __forceinline__ bf16x8 load8(const bf16* p) { return *reinterpret_cast<const bf16x8*>(p); }

__device__ __forceinline__ void mask_tile(f32x16& p0, f32x16& p1, int dq, unsigned W) {
    const float NEG = -__builtin_inff();
#pragma unroll
    for (int r = 0; r < 16; ++r) {
        const int c = (r & 3) + 8 * (r >> 2);
        if ((unsigned)(dq - c) >= W) p0[r] = NEG;
        if ((unsigned)(dq - c - 32) >= W) p1[r] = NEG;
    }
}
__device__ __forceinline__ void partialSM(f32x16& p0, f32x16& p1, float& m_reg, float& mn, float& alpha) {
    float pmax = p0[0];
#pragma unroll
    for (int r = 1; r < 16; ++r) pmax = fmaxf(pmax, p0[r]);
#pragma unroll
    for (int r = 0; r < 16; ++r) pmax = fmaxf(pmax, p1[r]);
    { auto rr = __builtin_amdgcn_permlane32_swap(__float_as_uint(pmax), __float_as_uint(pmax), false, false);
      pmax = fmaxf(__uint_as_float(rr[0]), __uint_as_float(rr[1])); }
    constexpr float C2 = LOG2E * ATT_SCALE;
    if (__builtin_expect(__all((pmax - m_reg) * ATT_SCALE <= THR), 1)) { mn = m_reg; alpha = 1.f; }
    else { mn = fmaxf(m_reg, pmax); alpha = __builtin_amdgcn_exp2f((m_reg - mn) * C2); m_reg = mn; }
    const float mnL = -mn * C2;
#pragma unroll
    for (int r = 0; r < 16; ++r) p0[r] = fmaf(p0[r], C2, mnL);
#pragma unroll
    for (int r = 0; r < 16; ++r) p1[r] = fmaf(p1[r], C2, mnL);
#pragma unroll
    for (int r = 0; r < 16; ++r) p0[r] = __builtin_amdgcn_exp2f(p0[r]);
}
__device__ __forceinline__ void finishSM(f32x16& p0, f32x16& p1, float alpha, float& l_reg, bf16x8& pa0, bf16x8& pa1, bf16x8& pa2, bf16x8& pa3, int keep) {
#pragma unroll
    for (int r = 0; r < 16; ++r) p1[r] = __builtin_amdgcn_exp2f(p1[r]);
    float ps = 0;
#pragma unroll
    for (int r = 0; r < 16; ++r) ps += p0[r];
#pragma unroll
    for (int r = 0; r < 16; ++r) ps += p1[r];
    { auto rr = __builtin_amdgcn_permlane32_swap(__float_as_uint(ps), __float_as_uint(ps), false, false);
      ps = __uint_as_float(rr[0]) + __uint_as_float(rr[1]); }
    l_reg = l_reg * alpha + (keep ? ps : 0.f);
#define PK4(P, B_, OUT) do { unsigned a0 = cvtpk(P[B_+0], P[B_+1]), a1 = cvtpk(P[B_+2], P[B_+3]);                          \
        unsigned b0 = cvtpk(P[B_+4], P[B_+5]), b1 = cvtpk(P[B_+6], P[B_+7]);                                             \
        auto r0 = __builtin_amdgcn_permlane32_swap(a0, b0, false, false); auto r1 = __builtin_amdgcn_permlane32_swap(a1, b1, false, false); \
        v4u w = {keep ? r0[0] : 0u, keep ? r1[0] : 0u, keep ? r0[1] : 0u, keep ? r1[1] : 0u}; OUT = *reinterpret_cast<bf16x8*>(&w); } while (0)
    PK4(p0, 0, pa0); PK4(p0, 8, pa1); PK4(p1, 0, pa2); PK4(p1, 8, pa3);
#undef PK4
}
template <int KB>
__device__ __forceinline__ void qkt(f32x16& p0, f32x16& p1, const char* K_lds, int r32, int hi, const bf16x8* qr) {
    p0 = f32x16{}; p1 = f32x16{};
    const char* kb[4];
#pragma unroll
    for (int dd = 0; dd < 4; ++dd) kb[dd] = K_lds + KB * SHM_K + KSWZ(r32, (dd * 16 + hi * 8) * 2);
#pragma unroll
    for (int d0 = 0; d0 < 8; ++d0) { const char* a = kb[d0 & 3] + (d0 >> 2) * 128;
        bf16x8 b0 = *reinterpret_cast<const bf16x8*>(a);
        bf16x8 b1 = *reinterpret_cast<const bf16x8*>(a + 32 * 256);
        p0 = __builtin_amdgcn_mfma_f32_32x32x16_bf16(b0, qr[d0], p0, 0, 0, 0);
        p1 = __builtin_amdgcn_mfma_f32_32x32x16_bf16(b1, qr[d0], p1, 0, 0, 0); }
}
template <int VB>
__device__ __forceinline__ void pv_tile(f32x16* o, int vb0, bf16x8 pa0, bf16x8 pa1, bf16x8 pa2, bf16x8 pa3) {
#define TRRD(dst, off) asm volatile("ds_read_b64_tr_b16 %0, %1 offset:%2" : "=&v"(dst) : "v"(vb0), "i"(off) : "memory")
#define PV_D0(d0) do { s16x4 l0, l1, l2, l3, h0, h1, h2, h3; constexpr int b_ = VB * SHM_V + v_rd_off(d0, 0, 0);   \
        TRRD(l0, b_); TRRD(h0, b_ + 2048); TRRD(l1, b_ + 4096); TRRD(h1, b_ + 6144); TRRD(l2, b_ + 8192); TRRD(h2, b_ + 10240); TRRD(l3, b_ + 12288); TRRD(h3, b_ + 14336); \
        asm volatile("s_waitcnt lgkmcnt(0)" ::: "memory"); SBAR();   \
        o[d0] = __builtin_amdgcn_mfma_f32_32x32x16_bf16(pa0, (bf16x8){l0[0], l0[1], l0[2], l0[3], h0[0], h0[1], h0[2], h0[3]}, o[d0], 0, 0, 0);   \
        o[d0] = __builtin_amdgcn_mfma_f32_32x32x16_bf16(pa1, (bf16x8){l1[0], l1[1], l1[2], l1[3], h1[0], h1[1], h1[2], h1[3]}, o[d0], 0, 0, 0);   \
        o[d0] = __builtin_amdgcn_mfma_f32_32x32x16_bf16(pa2, (bf16x8){l2[0], l2[1], l2[2], l2[3], h2[0], h2[1], h2[2], h2[3]}, o[d0], 0, 0, 0);   \
        o[d0] = __builtin_amdgcn_mfma_f32_32x32x16_bf16(pa3, (bf16x8){l3[0], l3[1], l3[2], l3[3], h3[0], h3[1], h3[2], h3[3]}, o[d0], 0, 0, 0); } while (0)
    PV_D0(0); PV_D0(1); PV_D0(2); PV_D0(3);
#undef PV_D0
#undef TRRD
}

enum { MODE_NONE = 0, MODE_SEL = 1, MODE_WIN = 2, MODE_CMP = 3 };
enum { EPI_MEM = 0, EPI_ACC0 = 1, EPI_ACC1 = 2, EPI_FIN = 3 };
struct Ctx { const bf16 *KV, *KC, *VC, *Q1, *ZQ, *QM, *ZM, *MKV; const float* gates; const unsigned long long* SEL; float* YACC; bf16* Y; int qm_ld, zm_ld, qm_c0, zm_c0; };
struct Blk {
    const bf16* Q; const bf16* K; int voff;
    int ldq, ldk;
    int j_lo, j_hi;
    int t0;
    int mode, epi;
    int row0, hcol, gcol, bg;
};
constexpr int LDS_WS = 2 * SHM_V + 2 * SHM_K;
constexpr int LDS_SEL = LDS_WS + NW * 64 * 4;
constexpr int LDS_STG = LDS_SEL + NW * 32 * 8;
constexpr int LDS_BYTES2 = LDS_STG + NW * 32 * 68 * 4;
struct Seam { bf16x8 qr[8]; bf16x8 st_v0, st_v1, st_k0, st_k1; };
#define AROW(p, k0, rr) ((p) + (size_t)((k0) + (rr)) * ldk + sc)
#define VMWN(n) asm volatile("s_waitcnt vmcnt(%0)" :: "i"(n) : "memory")
#define SLOAD_H(Kp, Vp, k0) do { S.st_v0 = load8(AROW(Vp, k0, sr)); S.st_v1 = load8(AROW(Vp, k0, 32 + sr));              \
                         S.st_k0 = load8(AROW(Kp, k0, sr)); S.st_k1 = load8(AROW(Kp, k0, 32 + sr)); } while (0)
#define SWRITE_HK(bf) do { *(bf16x8*)(K_lds + (bf) * SHM_K + kws) = S.st_k0; *(bf16x8*)(K_lds + (bf) * SHM_K + kws + 32 * 256) = S.st_k1; } while (0)
#define SWRITE_HV(bf) do { *(bf16x8*)(V_lds + (bf) * SHM_V + vst0) = S.st_v0; *(bf16x8*)(V_lds + (bf) * SHM_V + vst1) = S.st_v1; } while (0)
#define SWRITE_H(bf) do { SWRITE_HV(bf); SWRITE_HK(bf); } while (0)

__device__ __forceinline__ void attn_prime(const int tid, const Blk& cur, char* lds, Seam& S) {
    const int wid = __builtin_amdgcn_readfirstlane(tid >> 6), lane = tid & 63, r32 = lane & 31, hi = lane >> 5;
    const int sr = tid >> 4, sc = (tid & 15) * 8, kws = KSWZ(sr, sc * 2); char* K_lds = lds + 2 * SHM_V;
    const int ldk = cur.ldk; const int kb0 = cur.j_lo * KVBLK;
#pragma unroll
    for (int i = 0; i < 8; ++i) S.qr[i] = load8(cur.Q + (size_t)(wid * QBLK + (lane >> 4) + 4 * i) * cur.ldq + (lane & 15) * 8);
    SLOAD_H(cur.K, cur.K + cur.voff, kb0); VM_WAIT(); SWRITE_HK(0);
    __syncthreads();
}
__device__ __forceinline__ void attn_block(const int tid, const Ctx& C, const Blk& cur, const bf16* nQ, const bf16* nK, int nvoff, int nldq, int nldk, int nj_lo, char* lds, Seam& S) {
    const int wid = __builtin_amdgcn_readfirstlane(tid >> 6), lane = tid & 63, r32 = lane & 31, hi = lane >> 5;
#ifdef AT_TILE2X
    const int j_lo = cur.j_lo, NT0 = cur.j_hi - cur.j_lo, NT = (cur.mode == AT_TILE2X) ? 2 * NT0 : NT0;
#define TIX(t) ((t) >= NT0 ? (t) - NT0 : (t))
#else
    const int j_lo = cur.j_lo, NT = cur.j_hi - cur.j_lo;
#define TIX(t) (t)
#endif
    const int kbn = nj_lo * KVBLK;
    const int mode = cur.mode;
    const int trow = cur.t0 + wid * QBLK;
    int pos, pmin, pmax; unsigned W;
    if (mode == MODE_CMP) { pos = (trow + r32 - 31) >> 4; pmin = (trow - 31) >> 4; pmax = trow >> 4; W = 0x7fffffffu; }
    else if (mode == MODE_NONE) { pos = 1 << 29; pmin = 1 << 29; pmax = 1 << 29; W = 0x7fffffffu; }
    else { pos = trow + r32; pmin = trow; pmax = trow + QBLK - 1; W = (mode == MODE_WIN) ? 512u : 0x7fffffffu; }
    const int qm = pos - 4 * hi;
    char* V_lds = lds; char* K_lds = lds + 2 * SHM_V;
    float* ws = (float*)(lds + LDS_WS) + wid * 64; float* li_l = ws, * al_l = ws + 32;
    unsigned long long* sel_l = (unsigned long long*)(lds + LDS_SEL) + wid * 32;
    if (mode == MODE_SEL && hi == 0) sel_l[r32] = C.SEL[(size_t)cur.bg * SEQ + trow + r32];
    float m_reg = -1e30f, l_reg = 0; f32x16 o[4] = {};
    const int sr = tid >> 4, sc = (tid & 15) * 8, vst0 = v_st(sr, sc), vst1 = v_st(32 + sr, sc), kws = KSWZ(sr, sc * 2);
    const int vb0 = (int)(uintptr_t)V_lds + v_rd_base(lane);
    const bf16* Kh = cur.K; const bf16* Vh = cur.K + cur.voff; const int ldk = cur.ldk;
#define RESC(a) do { if (__any((a) < 1.f)) { if (hi == 0) al_l[r32] = (a); asm volatile("s_waitcnt lgkmcnt(0)" ::: "memory");              \
                     for (int d_ = 0; d_ < 4; ++d_) for (int r = 0; r < 16; ++r) o[d_][r] *= al_l[crow(r, hi)]; } } while (0)
#define KBASE(t) ((j_lo + TIX(t)) * KVBLK)
#define MASKT(P0_, P1_, t, KP_) do { const int kb_ = KBASE(t); KP_ = 1; \
        if (mode == MODE_SEL) { const int bit_ = (int)((sel_l[r32] >> (j_lo + TIX(t))) & 1ull); \
            if (kb_ + KVBLK - 1 > pmin) mask_tile(P0_, P1_, bit_ ? qm - kb_ : -(1 << 30), W);       \
            else KP_ = bit_; }                                                                         \
        else if (kb_ + KVBLK - 1 > pmin || kb_ <= pmax - (int)W) mask_tile(P0_, P1_, qm - kb_, W); } while (0)
    constexpr int NQL = 8;
#define SEAM_K0() do { VMWN(NQL); SWRITE_HK(0); SBAR(); } while (0)
    f32x16 pA0, pA1, pB0, pB1; float mnA, mnB, alA, alB; int kpA = 1, kpB = 1; bf16x8 pa0, pa1, pa2, pa3;
    {
        char* stq = lds + LDS_STG + wid * (32 * 272);
#pragma unroll
        for (int i = 0; i < 8; ++i) *(bf16x8*)(stq + ((lane >> 4) + 4 * i) * 272 + (lane & 15) * 16) = S.qr[i];
        asm volatile("s_waitcnt lgkmcnt(0)" ::: "memory");
#pragma unroll
        for (int d0 = 0; d0 < 8; ++d0) S.qr[d0] = *(const bf16x8*)(stq + r32 * 272 + (2 * d0 + hi) * 16);
        asm volatile("s_waitcnt lgkmcnt(0)" ::: "memory");
    }
    SWRITE_HV(0); SBAR();
    if (NT > 1) { SLOAD_H(Kh, Vh, KBASE(1)); }
    SBAR(); qkt<0>(pA0, pA1, K_lds, r32, hi, S.qr);
    MASKT(pA0, pA1, 0, kpA); partialSM(pA0, pA1, m_reg, mnA, alA);
    if (NT > 1) { VM_WAIT(); SWRITE_H(1); }
    __syncthreads();
#define HALF_STEP(PX0, PX1, mnX, alX, kpX, PY0, PY1, alY, kpY, t, KB, VB, SB) do {                                                      \
        SBAR(); if ((t) + 1 < NT) { SLOAD_H(Kh, Vh, KBASE((t) + 1)); SBAR(); }         \
        qkt<KB>(PX0, PX1, K_lds, r32, hi, S.qr);                                             \
        finishSM(PY0, PY1, alY, l_reg, pa0, pa1, pa2, pa3, kpY); SBAR();                                                      \
        pv_tile<VB>(o, vb0, pa0, pa1, pa2, pa3); MASKT(PX0, PX1, (t), kpX); partialSM(PX0, PX1, m_reg, mnX, alX);                                        \
        __syncthreads();                                                                                                      \
        if ((t) + 1 < NT) { VM_WAIT(); SWRITE_H(SB); }                                                                          \
        RESC(alX); __syncthreads(); } while (0)
    for (int t = 1; t + 1 < NT; t += 2) {
        HALF_STEP(pB0, pB1, mnB, alB, kpB, pA0, pA1, alA, kpA, t, 1, 0, 0);
        HALF_STEP(pA0, pA1, mnA, alA, kpA, pB0, pB1, alB, kpB, t + 1, 0, 1, 1);
    }
    const bool even = (NT & 1) == 0;
    if (even) { SBAR(); qkt<1>(pB0, pB1, K_lds, r32, hi, S.qr); SBAR(); }
    { const int ldk = nldk; SLOAD_H(nK, nK + nvoff, kbn); SBAR(); }
#pragma unroll
    for (int i = 0; i < 8; ++i) S.qr[i] = load8(nQ + (size_t)(wid * QBLK + (lane >> 4) + 4 * i) * nldq + (lane & 15) * 8);
    SBAR();
    finishSM(pA0, pA1, alA, l_reg, pa0, pa1, pa2, pa3, kpA); SBAR();
    pv_tile<0>(o, vb0, pa0, pa1, pa2, pa3);
    if (even) { MASKT(pB0, pB1, NT - 1, kpB); partialSM(pB0, pB1, m_reg, mnB, alB); __syncthreads(); RESC(alB);
        finishSM(pB0, pB1, alB, l_reg, pa0, pa1, pa2, pa3, kpB); SBAR(); pv_tile<1>(o, vb0, pa0, pa1, pa2, pa3); }
    SBAR(); SEAM_K0();
    {
        const int epi = cur.epi;
        float fac = l_reg > 0.f ? __builtin_amdgcn_rcpf(l_reg) : 0.f;
        if (epi != EPI_MEM) fac *= C.gates[(size_t)(cur.row0 + wid * QBLK + r32) * 36 + cur.gcol];
        if (hi == 0) li_l[r32] = fac;
        asm volatile("s_waitcnt lgkmcnt(0)" ::: "memory");
        float* stg = (float*)(lds + LDS_STG) + wid * (32 * 68);
        const int rrow = lane >> 4, c4 = (lane & 15) * 4;
        const size_t grow = (size_t)cur.row0 + wid * QBLK + rrow;
        const bool fin = (epi == EPI_FIN);
        float* accb = C.YACC + grow * NSAW + cur.hcol + c4;
        const bf16* zb = fin ? C.ZQ + grow * NSAW + cur.hcol + c4 : C.ZM + grow * C.zm_ld + C.zm_c0 + cur.hcol + c4;
        const int ldz = fin ? NSAW : C.zm_ld;
        bf16* yb = C.Y + grow * DM + (fin ? 0 : POOLW) + cur.hcol + c4;
#pragma unroll
        for (int half = 0; half < 2; ++half) {
#pragma unroll
            for (int r = 0; r < 16; ++r) { const float f = li_l[crow(r, hi)]; float* w = stg + crow(r, hi) * 68 + r32; w[0] = o[2 * half][r] * f; w[32] = o[2 * half + 1][r] * f; }
            asm volatile("s_waitcnt lgkmcnt(0)" ::: "memory");
            f32x4 v[8];
#pragma unroll
            for (int i = 0; i < 8; ++i) v[i] = *(const f32x4*)(stg + (rrow + 4 * i) * 68 + c4);
            const int co = half * 64;
            if (epi == EPI_ACC0) {
#pragma unroll
                for (int i = 0; i < 8; ++i) *(f32x4*)(accb + (size_t)(4 * i) * NSAW + co) = v[i];
            } else if (epi == EPI_ACC1) {
                f32x4 a[8];
#pragma unroll
                for (int i = 0; i < 8; ++i) a[i] = *(const f32x4*)(accb + (size_t)(4 * i) * NSAW + co);
#pragma unroll
                for (int i = 0; i < 8; ++i) *(f32x4*)(accb + (size_t)(4 * i) * NSAW + co) = a[i] + v[i];
            } else {
                v2u z[8];
#pragma unroll
                for (int i = 0; i < 8; ++i) z[i] = *(const v2u*)(zb + (size_t)(4 * i) * ldz + co);
                if (fin) { f32x4 a[8];
#pragma unroll
                    for (int i = 0; i < 8; ++i) a[i] = *(const f32x4*)(accb + (size_t)(4 * i) * NSAW + co);
#pragma unroll
                    for (int i = 0; i < 8; ++i) v[i] = v[i] + a[i]; }
#pragma unroll
                for (int i = 0; i < 8; ++i) { v2u w; w.x = pk2(v[i][0] * bflo(z[i].x), v[i][1] * bfhi(z[i].x)); w.y = pk2(v[i][2] * bflo(z[i].y), v[i][3] * bfhi(z[i].y));
                    *(v2u*)(yb + (size_t)(4 * i) * DM + co) = w; }
            }
            asm volatile("s_waitcnt lgkmcnt(0)" ::: "memory");
        }
    }
    __syncthreads();
#undef RESC
#undef TIX
#undef KBASE
#undef MASKT
#undef SEAM_K0
#undef HALF_STEP
}
#undef AROW
#undef VMWN
#undef SLOAD_H
#undef SWRITE_HK
#undef SWRITE_HV
#undef SWRITE_H
}
__device__ const unsigned short NSA_TAB[256 * 4] = {
    0, 384, 674, 65535,
    1, 385, 675, 65535,
    144, 480, 484, 65535,
    145, 481, 485, 65535,
    96, 482, 528, 65535,
    97, 483, 529, 65535,
    48, 388, 676, 65535,
    49, 389, 677, 65535,
    148, 432, 530, 65535,
    149, 433, 531, 65535,
    192, 386, 532, 65535,
    193, 387, 533, 65535,
    4, 288, 722, 65535,
    5, 289, 723, 65535,
    98, 436, 576, 65535,
    99, 437, 577, 65535,
    100, 434, 578, 65535,
    101, 435, 579, 65535,
    2, 292, 724, 65535,
    3, 293, 725, 65535,
    146, 336, 628, 65535,
    147, 337, 629, 65535,
    50, 338, 672, 65535,
    51, 339, 673, 65535,
    52, 244, 720, 65535,
    53, 245, 721, 65535,
    194, 340, 580, 65535,
    195, 341, 581, 65535,
    196, 290, 624, 65535,
    197, 291, 625, 65535,
    240, 242, 626, 65535,
    241, 243, 627, 65535,
    6, 390, 680, 65535,
    7, 391, 681, 65535,
    150, 486, 490, 65535,
    151, 487, 491, 65535,
    102, 488, 534, 65535,
    103, 489, 535, 65535,
    54, 394, 682, 65535,
    55, 395, 683, 65535,
    154, 438, 536, 65535,
    155, 439, 537, 65535,
    198, 392, 538, 65535,
    199, 393, 539, 65535,
    10, 294, 728, 65535,
    11, 295, 729, 65535,
    104, 442, 582, 65535,
    105, 443, 583, 65535,
    106, 440, 584, 65535,
    107, 441, 585, 65535,
    8, 298, 730, 65535,
    9, 299, 731, 65535,
    152, 342, 634, 65535,
    153, 343, 635, 65535,
    56, 344, 678, 65535,
    57, 345, 679, 65535,
    58, 250, 726, 65535,
    59, 251, 727, 65535,
    200, 346, 586, 65535,
    201, 347, 587, 65535,
    202, 296, 630, 65535,
    203, 297, 631, 65535,
    246, 248, 632, 65535,
    247, 249, 633, 65535,
    12, 396, 686, 65535,
    13, 397, 687, 65535,
    156, 492, 496, 65535,
    157, 493, 497, 65535,
    108, 494, 540, 65535,
    109, 495, 541, 65535,
    60, 400, 688, 65535,
    61, 401, 689, 65535,
    160, 444, 542, 65535,
    161, 445, 543, 65535,
    204, 398, 544, 65535,
    205, 399, 545, 65535,
    16, 300, 734, 65535,
    17, 301, 735, 65535,
    110, 448, 588, 65535,
    111, 449, 589, 65535,
    112, 446, 590, 65535,
    113, 447, 591, 65535,
    14, 304, 736, 65535,
    15, 305, 737, 65535,
    158, 348, 640, 65535,
    159, 349, 641, 65535,
    62, 350, 684, 65535,
    63, 351, 685, 65535,
    64, 256, 732, 65535,
    65, 257, 733, 65535,
    206, 352, 592, 65535,
    207, 353, 593, 65535,
    208, 302, 636, 65535,
    209, 303, 637, 65535,
    252, 254, 638, 65535,
    253, 255, 639, 65535,
    18, 402, 692, 65535,
    19, 403, 693, 65535,
    162, 498, 502, 65535,
    163, 499, 503, 65535,
    114, 500, 546, 65535,
    115, 501, 547, 65535,
    66, 406, 694, 65535,
    67, 407, 695, 65535,
    166, 450, 548, 65535,
    167, 451, 549, 65535,
    210, 404, 550, 65535,
    211, 405, 551, 65535,
    22, 306, 740, 65535,
    23, 307, 741, 65535,
    116, 454, 594, 65535,
    117, 455, 595, 65535,
    118, 452, 596, 65535,
    119, 453, 597, 65535,
    20, 310, 742, 65535,
    21, 311, 743, 65535,
    164, 354, 646, 65535,
    165, 355, 647, 65535,
    68, 356, 690, 65535,
    69, 357, 691, 65535,
    70, 262, 738, 65535,
    71, 263, 739, 65535,
    212, 358, 598, 65535,
    213, 359, 599, 65535,
    214, 308, 642, 65535,
    215, 309, 643, 65535,
    258, 260, 644, 65535,
    259, 261, 645, 65535,
    24, 408, 698, 65535,
    25, 409, 699, 65535,
    168, 504, 508, 65535,
    169, 505, 509, 65535,
    120, 506, 552, 65535,
    121, 507, 553, 65535,
    72, 412, 700, 65535,
    73, 413, 701, 65535,
    172, 456, 554, 65535,
    173, 457, 555, 65535,
    216, 410, 556, 65535,
    217, 411, 557, 65535,
    28, 312, 746, 65535,
    29, 313, 747, 65535,
    122, 460, 600, 65535,
    123, 461, 601, 65535,
    124, 458, 602, 65535,
    125, 459, 603, 65535,
    26, 316, 748, 65535,
    27, 317, 749, 65535,
    170, 360, 652, 65535,
    171, 361, 653, 65535,
    74, 362, 696, 65535,
    75, 363, 697, 65535,
    76, 268, 744, 65535,
    77, 269, 745, 65535,
    218, 364, 604, 65535,
    219, 365, 605, 65535,
    220, 314, 648, 65535,
    221, 315, 649, 65535,
    264, 266, 650, 65535,
    265, 267, 651, 65535,
    30, 414, 704, 65535,
    31, 415, 705, 65535,
    174, 510, 514, 65535,
    175, 511, 515, 65535,
    126, 512, 558, 65535,
    127, 513, 559, 65535,
    78, 418, 706, 65535,
    79, 419, 707, 65535,
    178, 462, 560, 65535,
    179, 463, 561, 65535,
    222, 416, 562, 65535,
    223, 417, 563, 65535,
    34, 318, 752, 65535,
    35, 319, 753, 65535,
    128, 466, 606, 65535,
    129, 467, 607, 65535,
    130, 464, 608, 65535,
    131, 465, 609, 65535,
    32, 322, 754, 65535,
    33, 323, 755, 65535,
    176, 366, 658, 65535,
    177, 367, 659, 65535,
    80, 368, 702, 65535,
    81, 369, 703, 65535,
    82, 274, 750, 65535,
    83, 275, 751, 65535,
    224, 370, 610, 65535,
    225, 371, 611, 65535,
    226, 320, 654, 65535,
    227, 321, 655, 65535,
    270, 272, 656, 65535,
    271, 273, 657, 65535,
    36, 420, 710, 65535,
    37, 421, 711, 65535,
    180, 516, 520, 65535,
    181, 517, 521, 65535,
    132, 518, 564, 65535,
    133, 519, 565, 65535,
    84, 424, 712, 65535,
    85, 425, 713, 65535,
    184, 468, 566, 65535,
    185, 469, 567, 65535,
    228, 422, 568, 65535,
    229, 423, 569, 65535,
    40, 324, 758, 65535,
    41, 325, 759, 65535,
    134, 472, 612, 65535,
    135, 473, 613, 65535,
    136, 470, 614, 65535,
    137, 471, 615, 65535,
    38, 328, 760, 65535,
    39, 329, 761, 65535,
    182, 372, 664, 65535,
    183, 373, 665, 65535,
    86, 374, 708, 65535,
    87, 375, 709, 65535,
    88, 280, 756, 65535,
    89, 281, 757, 65535,
    230, 376, 616, 65535,
    231, 377, 617, 65535,
    232, 326, 660, 65535,
    233, 327, 661, 65535,
    276, 278, 662, 65535,
    277, 279, 663, 65535,
    42, 426, 716, 65535,
    43, 427, 717, 65535,
    186, 522, 526, 65535,
    187, 523, 527, 65535,
    138, 524, 570, 65535,
    139, 525, 571, 65535,
    90, 430, 718, 65535,
    91, 431, 719, 65535,
    190, 474, 572, 65535,
    191, 475, 573, 65535,
    234, 428, 574, 65535,
    235, 429, 575, 65535,
    46, 330, 764, 65535,
    47, 331, 765, 65535,
    140, 478, 618, 65535,
    141, 479, 619, 65535,
    142, 476, 620, 65535,
    143, 477, 621, 65535,
    44, 334, 766, 65535,
    45, 335, 767, 65535,
    188, 378, 670, 65535,
    189, 379, 671, 65535,
    92, 380, 714, 65535,
    93, 381, 715, 65535,
    94, 286, 762, 65535,
    95, 287, 763, 65535,
    236, 382, 622, 65535,
    237, 383, 623, 65535,
    238, 332, 666, 65535,
    239, 333, 667, 65535,
    282, 284, 668, 65535,
    283, 285, 669, 65535,
};

constexpr int NWAVES = 8, NTHREADS = 512;
constexpr int LDS_BYTES = 147456;
constexpr int NPHASE = 12;
#ifndef MK_PER_PHASE
#define MK_PER_PHASE 0
#endif

struct Args { const void* in[17]; float* out; unsigned char* ws; int ph_lo, ph_hi; };

constexpr int TAB_OFF = LDS_BYTES - 1024;
enum { IX_X = 0, IX_MEM, IX_POS, IX_NORM_G, IX_MEM_NORM_G, IX_W_MEM_KV, IX_W_OUT, IX_A_W_IN, IX_A_W_POOL, IX_A_POOL_SCALE, IX_B_W_IN, IX_KV_NORM_G, IX_W_KV, IX_CMP_PE, IX_CMP_W1, IX_CMP_W2, IX_FINAL_G, IX_OUT, IX_WS };
__device__ __forceinline__ int lane_fresh() { int l; asm volatile("v_mbcnt_lo_u32_b32 %0, -1, 0\n\tv_mbcnt_hi_u32_b32 %0, -1, %0" : "=v"(l)); return l; }
struct Frame {
    LAS unsigned char* lds; char* ldsg;
    int wave, vcu, G;
    __device__ __forceinline__ int tid() const { return wave * 64 + lane_fresh(); }
    __device__ __forceinline__ unsigned char* ptr(int k) const {
        volatile LAS unsigned* t = (volatile LAS unsigned*)(lds + TAB_OFF);
        const unsigned lo = t[2 * k], hi = t[2 * k + 1];
        typedef __attribute__((address_space(1))) unsigned char gchar;
        return (unsigned char*)(gchar*)(((unsigned long long)(unsigned)__builtin_amdgcn_readfirstlane(hi) << 32) | (unsigned)__builtin_amdgcn_readfirstlane(lo));
    }
    __device__ __forceinline__ const float* fin(int k) const { return (const float*)ptr(k); }
};
#define WSP(T, off) ((T*)(ws + (off)))

#define XB_TMO      128
#define XB_XCNT(j)  (256  + 64 * (j))
#define XB_XSUB(j)  (1280 + 64 * (j))
#define XB_XGEN(j)  (2304 + 64 * (j))
#define XB_TOP      3328
#define XB_TOPGEN   3392
#define XCD_BAR_WORDS 3456
#define XB_SPIN_CAP (1u << 20)
constexpr int MISC_OFF = LDS_BYTES - 512;
__device__ __forceinline__ unsigned xb_ld(unsigned* p)              { return __hip_atomic_load(p, __ATOMIC_RELAXED, __HIP_MEMORY_SCOPE_AGENT); }
__device__ __forceinline__ unsigned xb_add(unsigned* p, unsigned v) { return __hip_atomic_fetch_add(p, v, __ATOMIC_RELAXED, __HIP_MEMORY_SCOPE_AGENT); }
__device__ __forceinline__ unsigned xb_xcc_id() { return (unsigned)__builtin_amdgcn_s_getreg((3 << 11) | 20) & 0xFu; }
#define XB_SPIN(cond, bar) do { unsigned _sp = 0; while (cond) { __builtin_amdgcn_s_sleep(1); \
    if ((++_sp & 255u) == 0u) { if (xb_ld(&(bar)[XB_TMO])) break; if (_sp > XB_SPIN_CAP) { atomicAdd(&(bar)[XB_TMO], 1u); break; } } } } while (0)
__device__ __forceinline__ void xcd_barrier_complete(unsigned* bar, unsigned x, unsigned G, unsigned& nloc, unsigned& nx) {
    unsigned sum, cnt, mine, sp = 0u;
    for (;;) {
        sum = 0u; cnt = 0u; mine = 0u;
#pragma unroll
        for (unsigned j = 0; j < 16; ++j) { const unsigned c = xb_ld(&bar[XB_XCNT(j)]); sum += c; cnt += (c > 0u) ? 1u : 0u; mine = (j == x) ? c : mine; }
        if (sum == G) break;
        __builtin_amdgcn_s_sleep(1);
        if ((++sp & 255u) == 0u) { if (xb_ld(&bar[XB_TMO])) break; if (sp > XB_SPIN_CAP) { atomicAdd(&bar[XB_TMO], 1u); break; } }
    }
    nloc = mine > 0u ? mine : 1u; nx = cnt > 0u ? cnt : 1u;
}
__device__ __forceinline__ void xcd_barrier(unsigned* bar, volatile LAS unsigned* st, unsigned G, int tid) {
    asm volatile("s_waitcnt vmcnt(0)" ::: "memory");
    __syncthreads();
    if (tid == 0) {
        const unsigned x = xb_xcc_id();
        __builtin_amdgcn_s_waitcnt(0);
        unsigned nloc = st[0], nx = st[1];
        if (nloc == 0u) { xcd_barrier_complete(bar, x, G, nloc, nx); st[0] = nloc; st[1] = nx; }
        const unsigned old = xb_add(&bar[XB_XSUB(x)], 1u);
        const unsigned gen = old / nloc;
        if (old + 1u == (gen + 1u) * nloc) {
            __builtin_amdgcn_fence(__ATOMIC_RELEASE, "agent");
            asm volatile("s_waitcnt vmcnt(0)" ::: "memory");
            const unsigned og = xb_add(&bar[XB_TOP], 1u);
            const unsigned tg = og / nx;
            if (og + 1u == (tg + 1u) * nx) xb_add(&bar[XB_TOPGEN], 1u);
            else XB_SPIN(xb_ld(&bar[XB_TOPGEN]) == tg, bar);
            __builtin_amdgcn_fence(__ATOMIC_ACQUIRE, "agent");
            xb_add(&bar[XB_XGEN(x)], 1u);
            asm volatile("s_waitcnt vmcnt(0)" ::: "memory");
        } else {
            XB_SPIN(xb_ld(&bar[XB_XGEN(x)]) == gen, bar);
            __builtin_amdgcn_fence(__ATOMIC_ACQUIRE, "agent");
            asm volatile("s_waitcnt vmcnt(0)" ::: "memory");
        }
    }
    __syncthreads();
}

struct TDesc { const float* W; const float* gain; bf16* WT; int ldw, c0, nv, ldt, row0, k0; };
__device__ __forceinline__ void tload(const TDesc& d, f32x4 (&v)[16], int lane) {
    const int n4 = (lane & 15) * 4, kr = lane >> 4;
    const float* src = d.W + (size_t)(d.k0 + kr) * d.ldw + d.c0 + n4;
    if (n4 < d.nv) {
#pragma unroll
        for (int i = 0; i < 16; ++i) v[i] = __builtin_nontemporal_load((const f32x4*)(src + (size_t)(4 * i) * d.ldw));
    } else {
#pragma unroll
        for (int i = 0; i < 16; ++i) v[i] = (f32x4){0.f, 0.f, 0.f, 0.f};
    }
}
__device__ __forceinline__ void tproc(const TDesc& d, f32x4 (&v)[16], LAS float* scr, int lane) {
    const int n4 = (lane & 15) * 4, kr = lane >> 4;
    if (d.gain) {
#pragma unroll
        for (int i = 0; i < 16; ++i) v[i] = v[i] * d.gain[d.k0 + kr + 4 * i];
    }
#pragma unroll
    for (int i = 0; i < 16; ++i) { LAS float* q = scr + (kr + 4 * i) * 65 + n4; q[0] = v[i][0]; q[1] = v[i][1]; q[2] = v[i][2]; q[3] = v[i][3]; }
    LDS_WAIT(); asm volatile("" ::: "memory");
    const int ch = lane & 7;
#pragma unroll
    for (int j = 0; j < 8; ++j) { const int n = (lane >> 3) + 8 * j; const LAS float* s = scr + (8 * ch) * 65 + n;
        v4u o; o.x = pk2(s[0 * 65], s[1 * 65]); o.y = pk2(s[2 * 65], s[3 * 65]); o.z = pk2(s[4 * 65], s[5 * 65]); o.w = pk2(s[6 * 65], s[7 * 65]);
        if (n < d.nv) *(v4u*)(d.WT + (size_t)(d.row0 + n) * d.ldt + d.k0 + 8 * ch) = o; }
    LDS_WAIT(); asm volatile("" ::: "memory");
}
__device__ __forceinline__ void rms_load(const float* xrow, f32x4 (&v)[8], int lane) {
    const f32x4* xr = (const f32x4*)xrow + lane;
#pragma unroll
    for (int j = 0; j < 8; ++j) v[j] = __builtin_nontemporal_load(xr + 64 * j);
}
__device__ __forceinline__ void rms_finish(f32x4 (&v)[8], const float* g, bf16* orow, int lane) {
    float s = 0.f;
#pragma unroll
    for (int j = 0; j < 8; ++j) s += (v[j].x * v[j].x + v[j].y * v[j].y) + (v[j].z * v[j].z + v[j].w * v[j].w);
    const float rinv = 1.0f / sqrtf(wave_sum(s) * (1.f / DM) + EPS);
    unsigned long long* o8 = (unsigned long long*)orow + lane;
#pragma unroll
    for (int j = 0; j < 8; ++j) { f32x4 gg = g ? ((const f32x4*)g)[64 * j + lane] : (f32x4){1.f, 1.f, 1.f, 1.f};
        o8[64 * j] = (unsigned long long)pk2(v[j].x * rinv * gg.x, v[j].y * rinv * gg.y) | ((unsigned long long)pk2(v[j].z * rinv * gg.z, v[j].w * rinv * gg.w) << 32); }
}
__device__ __forceinline__ void sincos_acc(float angf, float& c, float& s) {
    const double a = (double)angf;
    const double kq = rint(a * 0.63661977236758134308);
    const double r = fma(-kq, 6.123233995736766e-17, fma(-kq, 1.5707963267948966, a));
    const double r2 = r * r;
    double sp = -2.5052108385441718775e-08; sp = fma(sp, r2, 2.7557319223985890653e-06); sp = fma(sp, r2, -1.9841269841269841270e-04); sp = fma(sp, r2, 8.3333333333333332177e-03); sp = fma(sp, r2, -1.6666666666666665741e-01);
    const double sn = fma(sp * r2, r, r) + r2 * r2 * r2 * r2 * r2 * r2 * r * 1.6059043836821614599e-10;
    double cp = 2.0876756987868098979e-09; cp = fma(cp, r2, -2.7557319223985890653e-07); cp = fma(cp, r2, 2.4801587301587301566e-05); cp = fma(cp, r2, -1.3888888888888889419e-03); cp = fma(cp, r2, 4.1666666666666664354e-02); cp = fma(cp, r2, -0.5);
    const double cs = fma(cp, r2, 1.0);
    const int q = ((int)kq) & 3;
    const double sv = (q & 1) ? cs : sn, cv = (q & 1) ? sn : cs;
    s = (float)((q & 2) ? -sv : sv);
    c = (float)(((q + 1) & 2) ? -cv : cv);
}
__device__ __forceinline__ float rope_inv(int i) {
    return (float)exp2(-(double)i * (18.931568569324174 / 16.0));
}

template <int WHICH>
__device__ __forceinline__ void transposes(Frame& F, int gw, int NGW, int lane) {
    unsigned char* ws = F.ptr(IX_WS);
    LAS float* scr = (LAS float*)(F.lds + F.wave * 16640);
    const float* a_w_in = F.fin(IX_A_W_IN); const float* w_out = F.fin(IX_W_OUT); const float* w_kv = F.fin(IX_W_KV); const float* b_w_in = F.fin(IX_B_W_IN);
    const float* norm_g = F.fin(IX_NORM_G); const float* kv_norm_g = F.fin(IX_KV_NORM_G); const float* mem_norm_g = F.fin(IX_MEM_NORM_G); const float* w_mem_kv = F.fin(IX_W_MEM_KV);
    const float* a_w_pool = F.fin(IX_A_W_POOL); const float* cmp_w1 = F.fin(IX_CMP_W1);
    bf16* W1T = WSP(bf16, WS_W1T); bf16* WO0T = WSP(bf16, WS_WO0T); bf16* W4T = WSP(bf16, WS_W4T); bf16* WO1T = WSP(bf16, WS_WO1T);
    bf16* WMT = WSP(bf16, WS_WMT); bf16* WPT = WSP(bf16, WS_WPT); bf16* WC1T = WSP(bf16, WS_WC1T);
#define SEG(W_, ldw_, K_, c0_, nc_, WT_, row0_, gain_) if (!done_) { const int nb_ = ((nc_) + 63) / 64, ni_ = ((K_) / 64) * nb_; \
        if (r < ni_) { const int kb = r / nb_, nb = r % nb_; int nv = (nc_) - nb * 64; nv = nv > 64 ? 64 : nv; \
            d.W = W_; d.gain = gain_; d.WT = WT_; d.ldw = ldw_; d.c0 = (c0_) + nb * 64; d.nv = nv; d.ldt = K_; d.row0 = (row0_) + nb * 64; d.k0 = kb * 64; done_ = true; } else r -= ni_; }
#define TDECODE(it_, dd_) do { TDesc& d = (dd_); int r = (it_); bool done_ = false; \
      if constexpr (WHICH == 0) { \
        SEG(a_w_in, N1, DM, 0, N1, W1T, 0, nullptr) \
        SEG(w_mem_kv, 1024, DM, 0, 1024, WMT, 0, mem_norm_g) \
      } else { \
        SEG(w_out, DM, DM, 0, DM, WO0T, 0, nullptr) \
        SEG(w_out + (size_t)DM * DM, DM, DM, 0, DM, WO1T, 0, nullptr) \
        SEG(w_kv, NKV, DM, 0, NKV, W4T, 0, kv_norm_g) \
        SEG(b_w_in, 4132, DM, 0, 1536, W4T, 3072, norm_g + DM)            \
        SEG(b_w_in, 4132, DM, 1572, 1536, W4T, 4608, norm_g + DM)         \
        SEG(b_w_in, 4132, DM, 3108, 512, W4T, 6144, norm_g + DM)          \
        SEG(b_w_in, 4132, DM, 3620, 512, W4T, 6656, norm_g + DM)          \
        SEG(b_w_in, 4132, DM, 1536, 36, W4T, 7168, norm_g + DM)           \
        SEG(w_mem_kv + (size_t)DM * 1024, 1024, DM, 0, 1024, WMT + (size_t)1024 * DM, 0, mem_norm_g + DM) \
        SEG(a_w_pool + 0 * 384 * 384, 384, 384, 0, 384, WPT + 0 * 512 * 384, 0, nullptr) \
        SEG(a_w_pool + 1 * 384 * 384, 384, 384, 0, 384, WPT + 1 * 512 * 384, 0, nullptr) \
        SEG(a_w_pool + 2 * 384 * 384, 384, 384, 0, 384, WPT + 2 * 512 * 384, 0, nullptr) \
        SEG(a_w_pool + 3 * 384 * 384, 384, 384, 0, 384, WPT + 3 * 512 * 384, 0, nullptr) \
        SEG(cmp_w1, 256, 4096, 0, 256, WC1T, 0, nullptr) \
        SEG(cmp_w1 + (size_t)4096 * 256, 256, 4096, 0, 256, WC1T + (size_t)256 * 4096, 0, nullptr) \
      } \
    } while (0)
    constexpr int NITEMS = WHICH == 0 ? 32 * 64 + 32 * 16 : 2 * 32 * 32 + 32 * 48 + 32 * (24 + 24 + 8 + 8 + 1) + 32 * 16 + 4 * 6 * 6 + 2 * 64 * 4;
    {
        TDesc da{}, db{}; f32x4 va[16], vb[16];
        if (gw < NITEMS) { TDECODE(gw, da); tload(da, va, lane); }
        for (int it = gw; it < NITEMS; it += 2 * NGW) {
            const bool hb = it + NGW < NITEMS;
            if (hb) { TDECODE(it + NGW, db); tload(db, vb, lane); }
            tproc(da, va, scr, lane);
            if (it + 2 * NGW < NITEMS) { TDECODE(it + 2 * NGW, da); tload(da, va, lane); }
            if (hb) tproc(db, vb, scr, lane);
        }
    }
#undef TDECODE
#undef SEG
}

__device__ __forceinline__ void p0_prologue(Frame& F) {
    const int tid = F.tid(), lane = tid & 63; unsigned char* ws = F.ptr(IX_WS);
    const int gw = F.vcu * NWAVES + F.wave, NGW = F.G * NWAVES;
    const float* norm_g = F.fin(IX_NORM_G); const float* cmp_w1 = F.fin(IX_CMP_W1);
    bf16* W4T = WSP(bf16, WS_W4T); bf16* WPT = WSP(bf16, WS_WPT);
    transposes<0>(F, gw, NGW, lane);
    transposes<1>(F, gw, NGW, lane);
    bf16* XN = WSP(bf16, WS_B); bf16* MEMN = WSP(bf16, WS_MEMN);
    { const float* xin = F.fin(IX_X); const float* memin = F.fin(IX_MEM);
      constexpr int NROWS = MTOK + NB * MEMLEN;
      for (int m = gw; m < NROWS; m += 4 * NGW) {
          f32x4 a[8], b[8], c[8], d[8];
          const int m1 = m + NGW, m2 = m + 2 * NGW, m3 = m + 3 * NGW;
#define RSRC(mm) ((mm) < MTOK ? xin + (size_t)(mm) * DM : memin + (size_t)((mm) - MTOK) * DM)
#define RFIN(mm, v) do { if ((mm) < MTOK) rms_finish(v, norm_g, XN + (size_t)(mm) * DM, lane); else rms_finish(v, nullptr, MEMN + (size_t)((mm) - MTOK) * DM, lane); } while (0)
          rms_load(RSRC(m), a, lane);
          if (m1 < NROWS) rms_load(RSRC(m1), b, lane);
          if (m2 < NROWS) rms_load(RSRC(m2), c, lane);
          if (m3 < NROWS) rms_load(RSRC(m3), d, lane);
          RFIN(m, a);
          if (m1 < NROWS) RFIN(m1, b);
          if (m2 < NROWS) RFIN(m2, c);
          if (m3 < NROWS) RFIN(m3, d);
#undef RSRC
#undef RFIN
      } }
    const int gt = F.vcu * NTHREADS + tid, NGT = F.G * NTHREADS; const int* positions = (const int*)F.ptr(IX_POS);
    float* ROPE = WSP(float, WS_ROPE); float* ROPEC = WSP(float, WS_ROPEC);
    {
    for (int i = gt; i < MTOK * 16; i += NGT) { const int tok = i >> 4, fi = i & 15;
        const float ang = (float)positions[tok] * rope_inv(fi); float c, s; sincos_acc(ang, c, s);
        ROPE[tok * 32 + fi] = c; ROPE[tok * 32 + 16 + fi] = s; }
    for (int i = gt; i < NB * 256 * 16; i += NGT) { const int bn = i >> 4, fi = i & 15, b = bn >> 8, n = bn & 255;
        float c = 1.f, s = 0.f;
        if (n < NCMP) { const float ang = (float)positions[b * SEQ + 16 * n + 31] * rope_inv(fi); sincos_acc(ang, c, s); }
        ROPEC[bn * 32 + fi] = c; ROPEC[bn * 32 + 16 + fi] = s; }
    }
    { v4u z = {0u, 0u, 0u, 0u};
      v4u* p = (v4u*)(W4T + (size_t)7204 * DM); for (int i = gt; i < 220 * DM / 8; i += NGT) p[i] = z;
      for (int g = 0; g < 4; ++g) { v4u* q = (v4u*)(WPT + (size_t)g * 512 * 384 + 384 * 384); for (int i = gt; i < 128 * 384 / 8; i += NGT) q[i] = z; }
      v4u* kvp = (v4u*)(WSP(bf16, WS_KVB) + (size_t)MTOK * NKV); for (int i = gt; i < 32 * NKV / 8; i += NGT) kvp[i] = z;
      for (int b = 0; b < NB; ++b) { v4u* k = (v4u*)(WSP(bf16, WS_KCMP) + (size_t)(b * 256 + 255) * 512); v4u* v = (v4u*)(WSP(bf16, WS_VCMP) + (size_t)(b * 256 + 255) * 512);
          for (int i = gt; i < 512 / 8; i += NGT) { k[i] = z; v[i] = z; } } }
    __syncthreads();
    for (int item = F.vcu; item < 64; item += F.G) {
        const int ks = item & 7, kv = (item >> 3) & 1, j = (item >> 4) * 64 + lane; const float* pe = F.fin(IX_CMP_PE) + kv * 4096; const float* w1 = cmp_w1 + (size_t)kv * 4096 * 256;
        float a = 0.f; const int kb = ks * 512 + F.wave * 64;
#pragma unroll 8
        for (int k = kb; k < kb + 64; ++k) a = fmaf(pe[k], w1[(size_t)k * 256 + j], a);
        LAS float* red = (LAS float*)F.lds;
        red[F.wave * 64 + lane] = a; __syncthreads();
        if (F.wave == 0) { float t = 0.f; for (int w = 0; w < 8; ++w) t += red[w * 64 + lane]; WSP(float, WS_CBIAS)[(ks * 2 + kv) * 256 + j] = t; }
        __syncthreads();
    }
}

__device__ __forceinline__ void st_bf4(bf16* p, f32x4 v) { v2u w; w.x = cvtpk(v[0], v[1]); w.y = cvtpk(v[2], v[3]); *(v2u*)p = w; }
__device__ __forceinline__ f32x4 silu4(f32x4 v) { return (f32x4){silu_f(v[0]), silu_f(v[1]), silu_f(v[2]), silu_f(v[3])}; }
__device__ __forceinline__ void p2_pool(Frame& F) {
    unsigned char* ws = F.ptr(IX_WS);
    {
        const float* SL = (const float*)(ws + WS_D); bf16* MKV0 = WSP(bf16, WS_MKV);
        const int gt0 = F.vcu * NTHREADS + F.tid(), NGT0 = F.G * NTHREADS;
        for (int i = gt0; i < 2 * 1024 * 1024 / 4; i += NGT0) { const float* s0 = SL + (size_t)(i >> 18) * 8 * 1024 * 1024 + (size_t)(i & 262143) * 4; f32x4 a = *(const f32x4*)s0;
#pragma unroll
            for (int z = 1; z < 8; ++z) a += *(const f32x4*)(s0 + (size_t)z * 1024 * 1024);
            st_bf4(MKV0 + (size_t)i * 4, a); }
    }
    const bf16* PROJ = WSP(bf16, WS_A); bf16* POOLED = WSP(bf16, WS_C);
    const int gt = F.vcu * NTHREADS + F.tid(), NGT = F.G * NTHREADS;
    constexpr int NV = POOLW / 8;
    for (int idx = gt; idx < (MTOK / 32) * NV; idx += NGT) {
        const int vec = idx % NV, chunk = idx / NV, g = vec / 48, win = 2 << g;
        const int row0 = chunk * 32, tb0 = row0 & (SEQ - 1);
        const bf16* up = PROJ + (size_t)row0 * N1 + vec * 8;
        float S[8];
#pragma unroll
        for (int e = 0; e < 8; ++e) S[e] = 0.f;
        for (int i = 1; i < win; ++i) if (tb0 - i >= 0) { const v4u w = *(const v4u*)(up - (size_t)i * N1);
            S[0] += bflo(w.x); S[1] += bfhi(w.x); S[2] += bflo(w.y); S[3] += bfhi(w.y); S[4] += bflo(w.z); S[5] += bfhi(w.z); S[6] += bflo(w.w); S[7] += bfhi(w.w); }
        for (int t = 0; t < 32; ++t) {
            const v4u w = *(const v4u*)(up + (size_t)t * N1);
            float u[8] = {bflo(w.x), bfhi(w.x), bflo(w.y), bfhi(w.y), bflo(w.z), bfhi(w.z), bflo(w.w), bfhi(w.w)};
            const int tb = tb0 + t; const float inv = 1.0f / (float)(tb + 1 < win ? tb + 1 : win);
            float o[8];
#pragma unroll
            for (int e = 0; e < 8; ++e) { S[e] += u[e]; o[e] = S[e] * inv - u[e]; }
            v4u ow; ow.x = pk2(o[0], o[1]); ow.y = pk2(o[2], o[3]); ow.z = pk2(o[4], o[5]); ow.w = pk2(o[6], o[7]);
            *(v4u*)(POOLED + (size_t)(row0 + t) * POOLW + vec * 8) = ow;
            if (tb - win + 1 >= 0) { const v4u x = *(const v4u*)(up + (ptrdiff_t)(t - win + 1) * N1);
                S[0] -= bflo(x.x); S[1] -= bfhi(x.x); S[2] -= bflo(x.y); S[3] -= bfhi(x.y); S[4] -= bflo(x.z); S[5] -= bfhi(x.z); S[6] -= bflo(x.w); S[7] -= bfhi(x.w); }
        }
    }
}

struct SchedLin {
    int nM, nN, nz, G, c, wgm;
    const char* A; const char* B; size_t a_pm, a_z, b_pn, b_z;
    int xM, xN; const char* XA; const char* XB; size_t xa_pm, xb_pn;
    __device__ __forceinline__ bool next(int i, pg8::Unit& u) const {
        const long L = (long)i * G + c; const int per = nM * nN; const long tot = (long)per * nz;
        if (L < tot) { const int z = (int)(L / per); int pm, pn; pg8::tile_swz((int)(L % per), nM, nN, wgm, pm, pn);
            u.pm = pm; u.pn = pn; u.z = z; u.kind = 0; u.a = A + pm * a_pm + z * a_z; u.b = B + pn * b_pn + z * b_z; return true; }
        const long X = L - tot; if (X >= (long)xM * xN) return false;
        u.pm = (int)(X / xN); u.pn = (int)(X % xN); u.z = 0; u.kind = 1; u.a = XA + u.pm * xa_pm; u.b = XB + u.pn * xb_pn; return true;
    }
};
struct SchedCmp {
    int G, c; const char* KV; const char* W;
    __device__ __forceinline__ bool next(int i, pg8::Unit& u) const {
        const int L = i * G + c; if (L >= 256) return false;
        const int pm = L & 15, kv = (L >> 4) & 1, ks = L >> 5, b = pm >> 2, g = pm & 3;
        u.pm = pm; u.pn = 0; u.z = ks * 2 + kv; u.kind = 0;
        u.a = KV + ((size_t)((kv * 4 + b) * 4 + g) * SEQ * 128 + ks * 512) * 2;
        u.b = W + ((size_t)kv * 256 * 4096 + ks * 512) * 2;
        return true;
    }
};

struct SchedMem {
    int G, c; const char* A; const char* B;
    __device__ __forceinline__ bool next(int i, pg8::Unit& u) const {
        const int L = i * G + c; if (L >= 256) return false;
        const int pm = L & 3, pn = (L >> 2) & 3, ks = (L >> 4) & 7, layer = L >> 7;
        u.pm = pm; u.pn = pn; u.z = layer * 8 + ks; u.kind = 0;
        u.a = A + (size_t)pm * 256 * DM * 2 + ks * 512;
        u.b = B + ((size_t)layer * 1024 + pn * 256) * DM * 2 + ks * 512;
        return true;
    }
};
struct SchedGate {
    int G, c; const char* A; const char* B;
    __device__ __forceinline__ bool next(int i, pg8::Unit& u) const {
        const int L = i * G + c; if (L >= 256) return false;
        const int pm = L >> 2, ks = L & 3;
        u.pm = pm; u.pn = 0; u.z = ks; u.kind = 0;
        u.a = A + (size_t)pm * 256 * DM * 2 + ks * 1024;
        u.b = B + ks * 1024;
        return true;
    }
};

#define EPI_ROWS(ai, m) (u.pm * 256 + (ai) * 128 + wr * 64 + (m) * 16 + fr)
#define EPI_COL(bj, n) ((bj) * 128 + wc * 32 + (n) * 16 + fq * 4)
typedef f32x4 acc_t[2][2][4][2];

#define EPI_C8(bj) (64 * wc + 32 * (bj) + 8 * fq)
__device__ __forceinline__ void st_bf8(bf16* p, f32x4 a, f32x4 b) { v4u w; w.x = cvtpk(a[0], a[1]); w.y = cvtpk(a[2], a[3]); w.z = cvtpk(b[0], b[1]); w.w = cvtpk(b[2], b[3]); *(v4u*)p = w; }
struct Epi1 {
    static constexpr bool PERM = true;
    bf16* proj;
    struct State {};
    __device__ __forceinline__ void begin(acc_t& acc, State&, const pg8::Unit&, int, int, int, int) const {
#pragma unroll
        for (int a = 0; a < 2; ++a)
#pragma unroll
            for (int b = 0; b < 2; ++b)
#pragma unroll
                for (int m = 0; m < 4; ++m)
#pragma unroll
                    for (int n = 0; n < 2; ++n) acc[a][b][m][n] = (f32x4){0.f, 0.f, 0.f, 0.f};
    }
    __device__ __forceinline__ void operator()(const acc_t& acc, State&, const pg8::Unit& u, int wr, int wc, int fr, int fq) const {
        const bool act = (u.pn >= 6 && u.pn < 12) || u.pn >= 14;
#pragma unroll
        for (int ai = 0; ai < 2; ++ai)
#pragma unroll
            for (int m = 0; m < 4; ++m) { bf16* rowp = proj + (size_t)EPI_ROWS(ai, m) * N1 + u.pn * 256;
#pragma unroll
                for (int bj = 0; bj < 2; ++bj) { f32x4 v0 = acc[ai][bj][m][0], v1 = acc[ai][bj][m][1]; if (act) { v0 = silu4(v0); v1 = silu4(v1); } st_bf8(rowp + EPI_C8(bj), v0, v1); } }
    }
};
struct Epi3 {
    static constexpr bool PERM = true;
    const float* scale; const bf16* proj; bf16* y0;
    struct State {};
    __device__ __forceinline__ void begin(acc_t& acc, State&, const pg8::Unit&, int, int, int, int) const {
#pragma unroll
        for (int a = 0; a < 2; ++a)
#pragma unroll
            for (int b = 0; b < 2; ++b)
#pragma unroll
                for (int m = 0; m < 4; ++m)
#pragma unroll
                    for (int n = 0; n < 2; ++n) acc[a][b][m][n] = (f32x4){0.f, 0.f, 0.f, 0.f};
    }
    __device__ __forceinline__ void operator()(const acc_t& acc, State&, const pg8::Unit& u, int wr, int wc, int fr, int fq) const {
        const int g = u.z;
#pragma unroll
        for (int ai = 0; ai < 2; ++ai)
#pragma unroll
            for (int m = 0; m < 4; ++m) { const size_t row = EPI_ROWS(ai, m);
#pragma unroll
                for (int bj = 0; bj < 2; ++bj) { const int d = u.pn * 256 + EPI_C8(bj);
                    if (d < 384) {
                        const f32x4 sc0 = *(const f32x4*)(scale + g * 384 + d), sc1 = *(const f32x4*)(scale + g * 384 + d + 4);
                        const v4u zw = *(const v4u*)(proj + row * N1 + POOLW + g * 384 + d);
                        f32x4 v0 = acc[ai][bj][m][0] * sc0, v1 = acc[ai][bj][m][1] * sc1;
                        v0[0] *= bflo(zw.x); v0[1] *= bfhi(zw.x); v0[2] *= bflo(zw.y); v0[3] *= bfhi(zw.y); v1[0] *= bflo(zw.z); v1[1] *= bfhi(zw.z); v1[2] *= bflo(zw.w); v1[3] *= bfhi(zw.w);
                        st_bf8(y0 + row * DM + g * 384 + d, v0, v1); } }
                asm volatile("" ::: "memory"); }
    }
};
template <bool RES_BF16>
struct EpiRes {
    static constexpr bool PERM = true;
    const void* res; bf16* hb; float* ss;
    struct State {};
    __device__ __forceinline__ void begin(acc_t& acc, State&, const pg8::Unit& u, int wr, int wc, int fr, int fq) const {
#pragma unroll
        for (int ai = 0; ai < 2; ++ai)
#pragma unroll
            for (int m = 0; m < 4; ++m) { const size_t row = EPI_ROWS(ai, m);
#pragma unroll
                for (int bj = 0; bj < 2; ++bj) { const size_t off = row * DM + u.pn * 256 + EPI_C8(bj);
                    if constexpr (RES_BF16) { const v4u w = *(const v4u*)((const bf16*)res + off);
                        acc[ai][bj][m][0] = (f32x4){bflo(w.x), bfhi(w.x), bflo(w.y), bfhi(w.y)}; acc[ai][bj][m][1] = (f32x4){bflo(w.z), bfhi(w.z), bflo(w.w), bfhi(w.w)}; }
                    else { acc[ai][bj][m][0] = __builtin_nontemporal_load((const f32x4*)((const float*)res + off)); acc[ai][bj][m][1] = __builtin_nontemporal_load((const f32x4*)((const float*)res + off + 4)); } } }
    }
    __device__ __forceinline__ void operator()(const acc_t& acc, State&, const pg8::Unit& u, int wr, int wc, int fr, int fq) const {
#pragma unroll
        for (int ai = 0; ai < 2; ++ai)
#pragma unroll
            for (int m = 0; m < 4; ++m) { const size_t row = EPI_ROWS(ai, m); float s = 0.f;
#pragma unroll
                for (int bj = 0; bj < 2; ++bj) { const f32x4 h0 = acc[ai][bj][m][0], h1 = acc[ai][bj][m][1];
                    st_bf8(hb + row * DM + u.pn * 256 + EPI_C8(bj), h0, h1);
                    s += (h0[0] * h0[0] + h0[1] * h0[1]) + (h0[2] * h0[2] + h0[3] * h0[3]) + (h1[0] * h1[0] + h1[1] * h1[1]) + (h1[2] * h1[2] + h1[3] * h1[3]); }
                s += __shfl_xor(s, 16); s += __shfl_xor(s, 32);
                if (fq == 0) ss[row * 32 + u.pn * 4 + wc] = s; }
    }
};
struct Epi5 {
    static constexpr bool PERM = true;
    const float* ss1; const float* rope; bf16 *kv, *q1, *zq, *qm1, *zm1;
    struct State { float rinv[2][4]; };
    __device__ __forceinline__ void begin(acc_t& acc, State& st, const pg8::Unit& u, int wr, int wc, int fr, int fq) const {
#pragma unroll
        for (int a = 0; a < 2; ++a)
#pragma unroll
            for (int b = 0; b < 2; ++b)
#pragma unroll
                for (int m = 0; m < 4; ++m)
#pragma unroll
                    for (int n = 0; n < 2; ++n) acc[a][b][m][n] = (f32x4){0.f, 0.f, 0.f, 0.f};
        {
#pragma unroll
            for (int ai = 0; ai < 2; ++ai)
#pragma unroll
                for (int m = 0; m < 4; ++m) { const size_t row = EPI_ROWS(ai, m);
                    const float* sp = ss1 + row * 32 + fq * 8; const f32x4 s0 = *(const f32x4*)sp, s1 = *(const f32x4*)(sp + 4);
                    float s = (s0[0] + s0[1]) + (s0[2] + s0[3]) + (s1[0] + s1[1]) + (s1[2] + s1[3]);
                    s += __shfl_xor(s, 16); s += __shfl_xor(s, 32);
                    st.rinv[ai][m] = 1.0f / sqrtf(s * (1.f / DM) + EPS); }
        }
    }
    __device__ __forceinline__ void operator()(const acc_t& acc, State& st, const pg8::Unit& u, int wr, int wc, int fr, int fq) const {
        const int pn = u.pn;
        bf16* base; int ld, c0; bool dorope = false, act = false;
        const bool kvt = pn < 12;
        if (kvt) { base = kv; ld = 128; c0 = 0; dorope = ((pn >> 1) == 2) || ((pn >> 1) == 4); }
        else if (pn < 18) { base = q1; ld = NSAW; c0 = (pn - 12) * 256; dorope = true; }
        else if (pn < 24) { base = zq; ld = NSAW; c0 = (pn - 18) * 256; act = true; }
        else if (pn < 26) { base = qm1; ld = MEMW; c0 = (pn - 24) * 256; }
        else { base = zm1; ld = MEMW; c0 = (pn - 26) * 256; act = true; }
        const bool rp = dorope && (wc & 1) == 0;
#pragma unroll
        for (int ai = 0; ai < 2; ++ai)
#pragma unroll
            for (int m = 0; m < 4; ++m) { const size_t row = EPI_ROWS(ai, m);
                const float rinv = st.rinv[ai][m];
#pragma unroll
                for (int bj = 0; bj < 2; ++bj) {
                    f32x4 v0 = acc[ai][bj][m][0] * rinv, v1 = acc[ai][bj][m][1] * rinv;
                    if (bj == 0 && rp) {
                        const int fi = 8 * (fq & 1);
                        const f32x4 c0v = *(const f32x4*)(rope + row * 32 + fi), c1v = *(const f32x4*)(rope + row * 32 + fi + 4);
                        const f32x4 s0v = *(const f32x4*)(rope + row * 32 + 16 + fi), s1v = *(const f32x4*)(rope + row * 32 + 16 + fi + 4);
                        f32x4 p0, p1;
#pragma unroll
                        for (int j = 0; j < 4; ++j) { p0[j] = __shfl_xor(v0[j], 32); p1[j] = __shfl_xor(v1[j], 32); }
                        if (fq < 2) { v0 = v0 * c0v - p0 * s0v; v1 = v1 * c1v - p1 * s1v; }
                        else { v0 = v0 * c0v + p0 * s0v; v1 = v1 * c1v + p1 * s1v; }
                    }
                    if (act) { v0 = silu4(v0); v1 = silu4(v1); }
                    if (kvt) { const int g = (pn & 1) * 2 + (wc >> 1), d = 64 * (wc & 1) + 32 * bj + 8 * fq; const size_t b = row >> 12, t = row & (SEQ - 1);
                        st_bf8(kv + ((((size_t)(pn >> 1) * 4 + b) * 4 + g) * SEQ + t) * 128 + d, v0, v1); }
                    else st_bf8(base + row * ld + c0 + EPI_C8(bj), v0, v1); } }
    }
};
struct Epi6 {
    static constexpr bool PERM = false;
    float* base; int ld; size_t plane;
    struct State {};
    __device__ __forceinline__ void begin(acc_t& acc, State&, const pg8::Unit&, int, int, int, int) const {
#pragma unroll
        for (int a = 0; a < 2; ++a)
#pragma unroll
            for (int b = 0; b < 2; ++b)
#pragma unroll
                for (int m = 0; m < 4; ++m)
#pragma unroll
                    for (int n = 0; n < 2; ++n) acc[a][b][m][n] = (f32x4){0.f, 0.f, 0.f, 0.f};
    }
    __device__ __forceinline__ void operator()(const acc_t& acc, State&, const pg8::Unit& u, int wr, int wc, int fr, int fq) const {
        float* b0 = base + (size_t)u.z * plane + u.pn * 256;
#pragma unroll
        for (int ai = 0; ai < 2; ++ai)
#pragma unroll
            for (int m = 0; m < 4; ++m) { float* rowp = b0 + (size_t)EPI_ROWS(ai, m) * ld;
#pragma unroll
                for (int bj = 0; bj < 2; ++bj)
#pragma unroll
                    for (int n = 0; n < 2; ++n) *(f32x4*)(rowp + EPI_COL(bj, n)) = acc[ai][bj][m][n]; }
    }
};
struct EpiG {
    static constexpr bool PERM = true;
    float* slab;
    struct State {};
    __device__ __forceinline__ void begin(acc_t& acc, State&, const pg8::Unit&, int, int, int, int) const {
#pragma unroll
        for (int a = 0; a < 2; ++a)
#pragma unroll
            for (int b = 0; b < 2; ++b)
#pragma unroll
                for (int m = 0; m < 4; ++m)
#pragma unroll
                    for (int n = 0; n < 2; ++n) acc[a][b][m][n] = (f32x4){0.f, 0.f, 0.f, 0.f};
    }
    __device__ __forceinline__ void operator()(const acc_t& acc, State&, const pg8::Unit& u, int wr, int wc, int fr, int fq) const {
        if (wc != 0) return;
        float* b0 = slab + (size_t)u.z * MTOK * 36;
#pragma unroll
        for (int ai = 0; ai < 2; ++ai)
#pragma unroll
            for (int m = 0; m < 4; ++m) { float* rowp = b0 + (size_t)EPI_ROWS(ai, m) * 36;
                *(f32x4*)(rowp + 8 * fq) = acc[ai][0][m][0]; *(f32x4*)(rowp + 8 * fq + 4) = acc[ai][0][m][1];
                if (fq == 0) *(f32x4*)(rowp + 32) = acc[ai][1][m][0]; }
    }
};

__device__ __forceinline__ void gates_finish(Frame& F) {
    unsigned char* ws = F.ptr(IX_WS); const float* SL = WSP(float, WS_C); const float* SS1 = WSP(float, WS_SS1); float* GATES = WSP(float, WS_GATES);
    const int gt = F.vcu * NTHREADS + F.tid(), NGT = F.G * NTHREADS;
    for (int i = gt; i < MTOK * 9; i += NGT) { const int row = i / 9, c4 = (i - row * 9) * 4;
        f32x4 s = {0.f, 0.f, 0.f, 0.f};
#pragma unroll
        for (int q = 0; q < 8; ++q) s += *(const f32x4*)(SS1 + (size_t)row * 32 + q * 4);
        const float rinv = 1.0f / sqrtf(((s[0] + s[1]) + (s[2] + s[3])) * (1.f / DM) + EPS);
        f32x4 a = *(const f32x4*)(SL + (size_t)row * 36 + c4);
#pragma unroll
        for (int z = 1; z < 4; ++z) a += *(const f32x4*)(SL + (size_t)z * MTOK * 36 + (size_t)row * 36 + c4);
        a = a * rinv;
        *(f32x4*)(GATES + (size_t)row * 36 + c4) = (f32x4){sigmoid_f(a[0]), sigmoid_f(a[1]), sigmoid_f(a[2]), sigmoid_f(a[3])}; }
}
__device__ __forceinline__ void p7_cmp2(Frame& F) {
    unsigned char* ws = F.ptr(IX_WS); const float* cmp_w2 = F.fin(IX_CMP_W2); bf16* KCo = WSP(bf16, WS_KCMP); bf16* VCo = WSP(bf16, WS_VCMP);
    const float* HID = WSP(float, WS_B); const float* CB = WSP(float, WS_CBIAS); const float* ROPEC = WSP(float, WS_ROPEC);
    LAS float* hs = (LAS float*)F.lds;
    LAS float* os = hs + 16 * 256;
    const int tid = F.tid();
    for (int unit = F.vcu; unit < 512; unit += F.G) {
        const int kv = unit >> 8, rg = unit & 255, row0 = rg * 16;
        { const int r = tid >> 5, c8 = (tid & 31) * 8; f32x4 a0 = {0.f, 0.f, 0.f, 0.f}, a1 = {0.f, 0.f, 0.f, 0.f};
          for (int ks = 0; ks < 8; ++ks) { const float* cb = CB + (ks * 2 + kv) * 256 + c8; a0 += *(const f32x4*)cb; a1 += *(const f32x4*)(cb + 4); }
          for (int ks = 0; ks < 8; ++ks) { const float* p = HID + ((size_t)(ks * 2 + kv) * 4096 + row0 + r) * 256 + c8; a0 += *(const f32x4*)p; a1 += *(const f32x4*)(p + 4); }
          LAS float* d = hs + r * 256 + c8;
          d[0] = silu_f(a0[0]); d[1] = silu_f(a0[1]); d[2] = silu_f(a0[2]); d[3] = silu_f(a0[3]); d[4] = silu_f(a1[0]); d[5] = silu_f(a1[1]); d[6] = silu_f(a1[2]); d[7] = silu_f(a1[3]); }
        __syncthreads();
        const int r = tid >> 5, dg = tid & 31; const float* w2 = cmp_w2 + (size_t)kv * 256 * 128 + dg * 4;
        f32x4 a = {0.f, 0.f, 0.f, 0.f};
#pragma unroll 8
        for (int j = 0; j < 256; ++j) { const float h = hs[r * 256 + j]; a += *(const f32x4*)(w2 + j * 128) * h; }
        LAS float* od = os + r * 128 + dg * 4; od[0] = a[0]; od[1] = a[1]; od[2] = a[2]; od[3] = a[3];
        __syncthreads();
        const int row = row0 + r, bg = row >> 8, n = row & 255, b = bg >> 2, g = bg & 3;
        if (n < NCMP) {
            float o[4];
#pragma unroll
            for (int e = 0; e < 4; ++e) { const int d = dg * 4 + e; float v = os[r * 128 + d];
                if (kv == 0 && d < 32) { const int fi = d & 15; const float c = ROPEC[(b * 256 + n) * 32 + fi], s = ROPEC[(b * 256 + n) * 32 + 16 + fi];
                    v = d < 16 ? v * c - os[r * 128 + d + 16] * s : v * c + os[r * 128 + d - 16] * s; }
                o[e] = v; }
            bf16* dst = (kv == 0 ? KCo : VCo) + (size_t)(b * 256 + n) * 512 + g * 128 + dg * 4;
            v2u w; w.x = pk2(o[0], o[1]); w.y = pk2(o[2], o[3]); *(v2u*)dst = w;
        }
        __syncthreads();
    }
}

__device__ __forceinline__ void p8_select(Frame& F) {
    using namespace att;
    char* lds = F.ldsg; unsigned char* ws = F.ptr(IX_WS);
    const bf16* KC = WSP(bf16, WS_KCMP); const bf16* Q1 = WSP(bf16, WS_Q1); unsigned long long* SEL = WSP(unsigned long long, WS_SEL);
    const int wid = F.wave;
    for (int unit = F.vcu; unit < NB * NKVH * 16; unit += F.G) {
        const int tid = F.tid(), lane = tid & 63, r32 = lane & 31, hi = lane >> 5;
        const int sr = tid >> 4, sc = (tid & 15) * 8;
        const int qt = unit & 15, g = (unit >> 4) & 3, b = unit >> 6;
#pragma unroll
        for (int tt = 0; tt < 4; ++tt)
#pragma unroll
            for (int hf = 0; hf < 2; ++hf) { const int key = tt * 64 + hf * 32 + sr;
                *(bf16x8*)(lds + tt * SHM_K + KSWZ(hf * 32 + sr, sc * 2)) = load8(KC + (size_t)(b * 256 + key) * 512 + g * 128 + sc); }
        __syncthreads();
        const int tw = ((wid < 4) ? qt : 31 - qt) * 128 + (wid & 3) * 32, t = tw + r32, lim = (t - 31) >> 4;
        const int limw = tw >> 4;
        float imp[32];
#pragma unroll
        for (int c = 0; c < 32; ++c) imp[c] = 0.f;
        for (int rr = 0; rr < 3; ++rr) {
            const int h = g * 3 + rr; bf16x8 qr[8];
#pragma unroll
            for (int d0 = 0; d0 < 8; ++d0) qr[d0] = load8(Q1 + (size_t)(b * SEQ + t) * NSAW + h * 128 + d0 * 16 + hi * 8);
            f32x16 s[8];
            SBAR(); qkt<0>(s[0], s[1], lds, r32, hi, qr); SBAR();
            if (limw >= 64) { qkt<1>(s[2], s[3], lds, r32, hi, qr); SBAR(); }
            if (limw >= 128) { qkt<2>(s[4], s[5], lds, r32, hi, qr); SBAR(); }
            if (limw >= 192) { qkt<3>(s[6], s[7], lds, r32, hi, qr); SBAR(); }
            constexpr float C2 = LOG2E * ATT_SCALE; const float NEG = -__builtin_inff();
            float mx = -1e30f;
            int lim2 = lim - 4 * hi; asm volatile("" : "+v"(lim2));
#pragma unroll
            for (int i = 0; i < 8; ++i) if (limw >= (i >> 1) * 64) {
#pragma unroll
                for (int r = 0; r < 16; ++r) { const int key0 = (i >> 1) * 64 + (i & 1) * 32 + (r & 3) + 8 * (r >> 2); const float v = key0 <= lim2 ? s[i][r] * C2 : NEG; s[i][r] = v; mx = fmaxf(mx, v); } }
            { auto q2 = __builtin_amdgcn_permlane32_swap(__float_as_uint(mx), __float_as_uint(mx), false, false); mx = fmaxf(__uint_as_float(q2[0]), __uint_as_float(q2[1])); }
            float sum = 0.f;
#pragma unroll
            for (int i = 0; i < 8; ++i) {
                if (limw >= (i >> 1) * 64) {
#pragma unroll
                    for (int r = 0; r < 16; ++r) { const float p = __builtin_amdgcn_exp2f(s[i][r] - mx); s[i][r] = p; sum += p; }
                } else {
#pragma unroll
                    for (int r = 0; r < 16; ++r) s[i][r] = 0.f; } }
            { auto q2 = __builtin_amdgcn_permlane32_swap(__float_as_uint(sum), __float_as_uint(sum), false, false); sum = __uint_as_float(q2[0]) + __uint_as_float(q2[1]); }
            const float inv = sum > 0.f ? 1.0f / sum : 0.f;
            float prev_pt = 0.f;
#pragma unroll
            for (int c = 0; c < 32; ++c) { const int i = c >> 2, a = c & 3; const float tl = 0.5f * s[i][4 * a + 3] * inv;
                auto q2 = __builtin_amdgcn_permlane32_swap(__float_as_uint(tl), __float_as_uint(tl), false, false);
                const float pt = __uint_as_float(hi ? q2[0] : q2[1]);
                imp[c] += (s[i][4 * a] + s[i][4 * a + 1] + s[i][4 * a + 2]) * inv + tl + (hi ? pt : prev_pt);
                prev_pt = pt; }
        }
        const int cur = t >> 6;
        int hi2 = hi; asm volatile("" : "+v"(hi2));
        unsigned key[32];
#pragma unroll
        for (int c = 0; c < 32; ++c) { const int j = 2 * c + hi2; const bool ok = j <= cur, forced = (j == 0) || (j == cur) || (j == cur - 1);
            const float sc_ = forced ? 1e4f : imp[c];
            key[c] = (ok ? (__float_as_uint(sc_) & ~63u) : 0u) | (unsigned)(63 - j); }
        unsigned T = 0u;
#pragma unroll 1
        for (int bit = 30; bit >= 0; --bit) { const unsigned Tc = T | (1u << bit); unsigned cn = 0u;
#pragma unroll
            for (int c = 0; c < 32; ++c) cn += (key[c] >= Tc) ? 1u : 0u;
            { auto q2 = __builtin_amdgcn_permlane32_swap(cn, cn, false, false); cn = q2[0] + q2[1]; }
            T = cn >= 16u ? Tc : T; }
        unsigned wlo = 0u, whi = 0u;
#pragma unroll
        for (int c = 0; c < 32; ++c) { const unsigned selbit = (key[c] >= T && (2 * c + hi2) <= cur) ? 1u : 0u;
            if (c < 16) wlo |= selbit << (2 * c); else whi |= selbit << (2 * (c - 16)); }
        wlo <<= hi; whi <<= hi;
        { auto q2 = __builtin_amdgcn_permlane32_swap(wlo, wlo, false, false); wlo = q2[0] | q2[1]; }
        { auto q2 = __builtin_amdgcn_permlane32_swap(whi, whi, false, false); whi = q2[0] | q2[1]; }
        if (hi == 0) SEL[(size_t)(b * NKVH + g) * SEQ + t] = ((unsigned long long)whi << 32) | wlo;
        __syncthreads();
    }
}

typedef att::Ctx AttnCtx;
__device__ __forceinline__ void nsa_blk(const AttnCtx& C, int L, int pass, att::Blk& k) {
    const int qt = 15 - L / 48, bh = L % 48, b = bh / 12, h = bh % 12, g = h / 3;
    const int row0 = b * SEQ + qt * 256;
    k.Q = C.Q1 + (size_t)row0 * NSAW + h * 128; k.ldq = NSAW; k.t0 = qt * 256; k.row0 = row0; k.hcol = h * 128; k.bg = b * NKVH + g;
    if (pass == 0) { k.K = C.KV + (size_t)((2 * 4 + b) * 4 + g) * SEQ * 128; k.voff = 16 * SEQ * 128; k.ldk = 128; k.j_lo = 0; k.j_hi = 4 * qt + 4; k.mode = att::MODE_SEL; k.epi = att::EPI_ACC0; k.gcol = h * 3 + 1; }
    else if (pass == 1) { k.K = C.KV + (size_t)((4 * 4 + b) * 4 + g) * SEQ * 128; k.voff = 16 * SEQ * 128; k.ldk = 128; k.j_lo = qt >= 2 ? 4 * qt - 8 : 0; k.j_hi = 4 * qt + 4; k.mode = att::MODE_WIN; k.epi = att::EPI_ACC1; k.gcol = h * 3 + 2; }
    else { k.K = C.KC + (size_t)b * 256 * 512 + g * 128; k.voff = (int)(C.VC - C.KC); k.ldk = 512; k.j_lo = 0; k.j_hi = (qt >> 2) + 1; k.mode = att::MODE_CMP; k.epi = att::EPI_FIN; k.gcol = h * 3 + 0; }
}
__device__ __forceinline__ void mem_blk(const AttnCtx& C, int X, att::Blk& k) {
    const int qt = X & 15, mh = (X >> 4) & 3, b = X >> 6;
    const int row0 = b * SEQ + qt * 256;
    k.Q = C.QM + (size_t)row0 * C.qm_ld + C.qm_c0 + mh * 128; k.ldq = C.qm_ld; k.t0 = qt * 256; k.row0 = row0; k.hcol = mh * 128; k.bg = 0; k.gcol = 0;
    k.K = C.MKV + (size_t)b * 256 * 1024 + mh * 128; k.voff = 512; k.ldk = 1024; k.j_lo = 0; k.j_hi = 4; k.mode = att::MODE_NONE; k.epi = att::EPI_MEM;
}
struct AttnStream {
    int G, c, n_nsa, n_mem, cnt_nsa, total; bool tab;
    __device__ __forceinline__ void init(int G_, int c_, int n_nsa_, int n_mem_) {
        G = G_; c = c_; n_nsa = n_nsa_; n_mem = n_mem_;
        tab = (G == 256 && n_nsa == 768);
        if (tab) { cnt_nsa = 0;
#pragma unroll
            for (int r = 0; r < 4; ++r) cnt_nsa += NSA_TAB[c * 4 + r] != 0xffff ? 1 : 0; }
        else { const int full = n_nsa / G, rem = n_nsa - full * G, pos = (full & 1) ? G - 1 - c : c; cnt_nsa = full + (pos < rem ? 1 : 0); }
        const int cnt_mem = c < n_mem ? (n_mem - c + G - 1) / G : 0;
        total = 3 * cnt_nsa + cnt_mem;
    }
    __device__ __forceinline__ void get(const AttnCtx& C, int s, att::Blk& k) const {
        if (s < 3 * cnt_nsa) { const int r = s / 3, pass = s - 3 * r; const int L = tab ? (int)NSA_TAB[c * 4 + r] : r * G + ((r & 1) ? G - 1 - c : c); nsa_blk(C, L, pass, k); }
        else { const int sm = s - 3 * cnt_nsa; mem_blk(C, sm * G + c, k); }
    }
};
__device__ __forceinline__ void attn_run(Frame& F, const AttnCtx& C, int n_nsa, int n_mem) {
    AttnStream S; S.init(F.G, F.vcu, n_nsa, n_mem);
    if (S.total > 0) {
        att::Blk cur, nxt; att::Seam seam;
        S.get(C, 0, cur);
        att::attn_prime(F.tid(), cur, F.ldsg, seam);
        for (int s = 0; s < S.total; ++s) {
            const int tid = F.tid();
            S.get(C, s, cur);
            S.get(C, s + 1 < S.total ? s + 1 : s, nxt);
            att::attn_block(tid, C, cur, nxt.Q, nxt.K, nxt.voff, nxt.ldq, nxt.ldk, nxt.j_lo, F.ldsg, seam);
        }
    }
    VM_WAIT(); __syncthreads();
}
__device__ __forceinline__ void attn_run_mem(Frame& F, const AttnCtx& C, int n_mem) {
    const int G = F.G, c = F.vcu, cnt = c < n_mem ? (n_mem - c + G - 1) / G : 0;
    if (cnt > 0) {
        att::Blk cur, nxt; att::Seam seam;
        mem_blk(C, c, cur);
        const int tid = F.tid();
        att::attn_prime(tid, cur, F.ldsg, seam);
        for (int s = 0; s < cnt; ++s) {
            mem_blk(C, s * G + c, cur);
            mem_blk(C, (s + 1 < cnt ? s + 1 : s) * G + c, nxt);
            att::attn_block(tid, C, cur, nxt.Q, nxt.K, nxt.voff, nxt.ldq, nxt.ldk, nxt.j_lo, F.ldsg, seam);
        }
    }
    VM_WAIT(); __syncthreads();
}

__device__ __forceinline__ void p11_final(Frame& F) {
    unsigned char* ws = F.ptr(IX_WS); float* out = (float*)F.ptr(IX_OUT); const float* final_g = F.fin(IX_FINAL_G);
    const float* SS2 = WSP(float, WS_SS2); const bf16* H2B = WSP(bf16, WS_C);
    const int gw = F.vcu * NWAVES + F.wave, NGW = F.G * NWAVES, lane = F.tid() & 63;
    f32x4 g[8];
#pragma unroll
    for (int j = 0; j < 8; ++j) g[j] = ((const f32x4*)final_g)[64 * j + lane];
    for (int m = gw; m < MTOK; m += 4 * NGW) {
        v2u a[4][8]; float rv[4];
#pragma unroll
        for (int q = 0; q < 4; ++q) { const int mm = m + q * NGW < MTOK ? m + q * NGW : m; const v2u* p = (const v2u*)(H2B + (size_t)mm * DM) + lane;
#pragma unroll
            for (int j = 0; j < 8; ++j) a[q][j] = __builtin_nontemporal_load(p + 64 * j);
            rv[q] = lane < 32 ? SS2[(size_t)mm * 32 + lane] : 0.f; }
#pragma unroll
        for (int q = 0; q < 4; ++q) { const int mm = m + q * NGW; if (mm < MTOK) {
            const float rinv = 1.0f / sqrtf(wave_sum(rv[q]) * (1.f / DM) + EPS);
            f32x4* o = (f32x4*)(out + (size_t)mm * DM) + lane;
#pragma unroll
            for (int j = 0; j < 8; ++j) __builtin_nontemporal_store((f32x4){bflo(a[q][j].x), bfhi(a[q][j].x), bflo(a[q][j].y), bfhi(a[q][j].y)} * rinv * g[j], o + 64 * j); } }
    }
}

#ifndef WGM_P1
#define WGM_P1 4
#endif
#ifndef WGM_P3
#define WGM_P3 4
#endif
#ifndef WGM_P4
#define WGM_P4 2
#endif
#ifndef WGM_P5
#define WGM_P5 2
#endif
#ifndef WGM_P10
#define WGM_P10 2
#endif
__global__ void __launch_bounds__(NTHREADS, 2) fwd_kernel(Args args) {
    extern __shared__ __attribute__((aligned(16))) unsigned char lds[];
    Frame F;
    F.lds = (LAS unsigned char*)lds; F.ldsg = (char*)lds;
    F.wave = __builtin_amdgcn_readfirstlane((int)threadIdx.x >> 6);
    F.G = gridDim.x; { const int bx = blockIdx.x; F.vcu = (F.G % 8 == 0) ? (bx % 8) * (F.G / 8) + bx / 8 : bx; }
    if (threadIdx.x < 19) { const unsigned long long v = threadIdx.x < 17 ? (unsigned long long)args.in[threadIdx.x < 17 ? threadIdx.x : 0] : (threadIdx.x == 17 ? (unsigned long long)args.out : (unsigned long long)args.ws);
        ((LAS unsigned long long*)(F.lds + TAB_OFF))[threadIdx.x] = v; }
    if (threadIdx.x == 32) { ((LAS unsigned*)(F.lds + MISC_OFF))[0] = 0u; ((LAS unsigned*)(F.lds + MISC_OFF))[1] = 0u; }
    if (!MK_PER_PHASE && threadIdx.x == 0) (void)xb_add((unsigned*)(args.ws + WS_CTL) + 1024 + XB_XCNT(xb_xcc_id()), 1u);
    __syncthreads();
    const int lo = args.ph_lo, hi = args.ph_hi;
#ifndef PH_MASK
#define PH_MASK 0xfff
#endif
#define IN(k) (((PH_MASK >> (k)) & 1) && lo <= (k) && (k) < hi)
#ifndef REPEAT_MASK
#define REPEAT_MASK 0
#endif
#define REPS(k) (1 + ((REPEAT_MASK >> (k)) & 1))
#define GBAR() xcd_barrier((unsigned*)(F.ptr(IX_WS) + WS_CTL) + 1024, (volatile LAS unsigned*)(F.lds + MISC_OFF), (unsigned)F.G, F.tid())
#define SEAM(k) do { if (IN(k) && IN((k) + 1)) xcd_barrier((unsigned*)(F.ptr(IX_WS) + WS_CTL) + 1024, (volatile LAS unsigned*)(F.lds + MISC_OFF), (unsigned)F.G, F.tid()); } while (0)
    const size_t TILE_B = (size_t)256 * DM * 2;

    if (IN(0)) for (int rep = 0; rep < REPS(0); ++rep) { if (rep) GBAR(); p0_prologue(F); } SEAM(0);
#ifdef DUP0
    GBAR(); p0_prologue(F); GBAR();
#endif

    if (IN(1)) for (int rep = 0; rep < REPS(1); ++rep) { if (rep) GBAR(); unsigned char* ws = F.ptr(IX_WS);
        pg8::Geo g{DM, DM, DM / 64, 256};
        SchedLin S{64, 16, 1, F.G, (int)blockIdx.x, WGM_P1, (const char*)WSP(bf16, WS_B), (const char*)WSP(bf16, WS_W1T), TILE_B, 0, TILE_B, 0, 0, 0, nullptr, nullptr, 0, 0};
        Epi1 E{WSP(bf16, WS_A)};
        pg8::gemm_phase<Epi1, SchedLin, true, true>(F.lds, F.tid(), g, S, E);
        {
            pg8::Geo g2{DM, DM, 4, 256};
            SchedMem S2{F.G, (int)blockIdx.x, (const char*)WSP(bf16, WS_MEMN), (const char*)WSP(bf16, WS_WMT)};
            Epi6 E2{(float*)(ws + WS_D), 1024, (size_t)1024 * 1024};
            pg8::gemm_phase<Epi6, SchedMem, true, true>(F.lds, F.tid(), g2, S2, E2);
        }
    } SEAM(1);

#ifdef DUPBAR
    for (int i = 0; i < 10; ++i) GBAR();
#endif
    if (IN(2)) for (int rep = 0; rep < REPS(2); ++rep) { if (rep) GBAR(); p2_pool(F); } SEAM(2);

    if (IN(3)) for (int rep = 0; rep < REPS(3); ++rep) { if (rep) GBAR(); unsigned char* ws = F.ptr(IX_WS);
        pg8::Geo g{POOLW, 384, 6, 256};
        SchedLin S{64, 2, 4, F.G, (int)blockIdx.x, WGM_P3, (const char*)WSP(bf16, WS_C), (const char*)WSP(bf16, WS_WPT), (size_t)256 * POOLW * 2, (size_t)384 * 2, (size_t)256 * 384 * 2, (size_t)512 * 384 * 2,
                   0, 0, nullptr, nullptr, 0, 0};
        Epi3 E{F.fin(IX_A_POOL_SCALE), WSP(bf16, WS_A), WSP(bf16, WS_B)};
        AttnCtx C{}; C.QM = WSP(bf16, WS_A); C.qm_ld = N1; C.qm_c0 = 2 * POOLW; C.ZM = WSP(bf16, WS_A); C.zm_ld = N1; C.zm_c0 = 2 * POOLW + MEMW;
        C.MKV = WSP(bf16, WS_MKV); C.Y = WSP(bf16, WS_B);
        const int att_first = (blockIdx.x >> 3) & 1;
#pragma unroll 1
        for (int s = 0; s < 2; ++s) {
            if ((s ^ att_first) == 0) pg8::gemm_phase<Epi3, SchedLin, true, true>(F.lds, F.tid(), g, S, E);
            else attn_run_mem(F, C, NB * 4 * 16);
        }
    } SEAM(3);

    if (IN(4)) for (int rep = 0; rep < REPS(4); ++rep) { if (rep) GBAR(); unsigned char* ws = F.ptr(IX_WS);
        pg8::Geo g{DM, DM, DM / 64, 256};
        SchedLin S{64, 8, 1, F.G, (int)blockIdx.x, WGM_P4, (const char*)WSP(bf16, WS_B), (const char*)WSP(bf16, WS_WO0T), TILE_B, 0, TILE_B, 0, 0, 0, nullptr, nullptr, 0, 0};
        bf16* h1b = (bf16*)F.ptr(IX_OUT);
        EpiRes<false> E{F.fin(IX_X), h1b, WSP(float, WS_SS1)};
        pg8::gemm_phase<EpiRes<false>, SchedLin, true, true>(F.lds, F.tid(), g, S, E);
    } SEAM(4);

    if (IN(5)) for (int rep = 0; rep < REPS(5); ++rep) { if (rep) GBAR(); unsigned char* ws = F.ptr(IX_WS);
        pg8::Geo g{DM, DM, DM / 64, 256};
        SchedLin S{64, 28, 1, F.G, (int)blockIdx.x, WGM_P5, (const char*)F.ptr(IX_OUT), (const char*)WSP(bf16, WS_W4T), TILE_B, 0, TILE_B, 0, 0, 0, nullptr, nullptr, 0, 0};
        Epi5 E{WSP(float, WS_SS1), WSP(float, WS_ROPE), WSP(bf16, WS_KVB), WSP(bf16, WS_Q1), WSP(bf16, WS_ZQ), WSP(bf16, WS_QM1), WSP(bf16, WS_ZM1)};
        pg8::gemm_phase<Epi5, SchedLin, true, true>(F.lds, F.tid(), g, S, E);
        {
            pg8::Geo g2{DM, DM, 8, 256};
            SchedGate S2{F.G, (int)blockIdx.x, (const char*)F.ptr(IX_OUT), (const char*)(WSP(bf16, WS_W4T) + (size_t)28 * 256 * DM)};
            EpiG E2{WSP(float, WS_C)};
            pg8::gemm_phase<EpiG, SchedGate, true, true>(F.lds, F.tid(), g2, S2, E2);
        }
    } SEAM(5);

    if (IN(6)) for (int rep = 0; rep < REPS(6); ++rep) { if (rep) GBAR(); unsigned char* ws = F.ptr(IX_WS);
        pg8::Geo g{16 * 128, 4096, 8, 256};
        SchedCmp S{F.G, (int)blockIdx.x, (const char*)WSP(bf16, WS_KVB), (const char*)WSP(bf16, WS_WC1T)};
        Epi6 E{WSP(float, WS_B), 256, (size_t)4096 * 256};
        pg8::gemm_phase<Epi6, SchedCmp, true, true>(F.lds, F.tid(), g, S, E);
        gates_finish(F);
    } SEAM(6);

    if (IN(7)) for (int rep = 0; rep < REPS(7); ++rep) { if (rep) GBAR(); p7_cmp2(F); } SEAM(7);

    if (IN(8)) for (int rep = 0; rep < REPS(8); ++rep) { if (rep) GBAR(); p8_select(F); }
#ifdef DUP8
    GBAR(); p8_select(F);
#endif
    SEAM(8);

    if (IN(9)) for (int rep = 0; rep < REPS(9); ++rep) { if (rep) GBAR(); unsigned char* ws = F.ptr(IX_WS);
        AttnCtx C{}; C.KV = WSP(bf16, WS_KVB); C.KC = WSP(bf16, WS_KCMP); C.VC = WSP(bf16, WS_VCMP); C.Q1 = WSP(bf16, WS_Q1); C.ZQ = WSP(bf16, WS_ZQ);
        C.QM = WSP(bf16, WS_QM1); C.qm_ld = MEMW; C.qm_c0 = 0; C.ZM = WSP(bf16, WS_ZM1); C.zm_ld = MEMW; C.zm_c0 = 0; C.MKV = WSP(bf16, WS_MKV) + (size_t)1024 * 1024;
        C.gates = WSP(float, WS_GATES); C.SEL = WSP(unsigned long long, WS_SEL); C.YACC = WSP(float, WS_C); C.Y = WSP(bf16, WS_B);
        attn_run(F, C, NB * NHEAD * 16, NB * 4 * 16);
    } SEAM(9);

    if (IN(10)) for (int rep = 0; rep < REPS(10); ++rep) { if (rep) GBAR(); unsigned char* ws = F.ptr(IX_WS);
        pg8::Geo g{DM, DM, DM / 64, 256};
        SchedLin S{64, 8, 1, F.G, (int)blockIdx.x, WGM_P10, (const char*)WSP(bf16, WS_B), (const char*)WSP(bf16, WS_WO1T), TILE_B, 0, TILE_B, 0, 0, 0, nullptr, nullptr, 0, 0};
        EpiRes<true> E{F.ptr(IX_OUT), WSP(bf16, WS_C), WSP(float, WS_SS2)};
        pg8::gemm_phase<EpiRes<true>, SchedLin, true, true>(F.lds, F.tid(), g, S, E);
    } SEAM(10);

    if (IN(11)) for (int rep = 0; rep < REPS(11); ++rep) { if (rep) GBAR(); p11_final(F); }
#undef IN
#undef SEAM
}

extern "C" void kernel_launch(void* const* d_in, const int* in_sizes, int n_in, void* d_out, int out_size, void* d_ws, size_t ws_size, hipStream_t stream) {
    static int grid = 0;
    if (grid == 0) {
        if (n_in != 17 || in_sizes[0] != MTOK * DM || out_size != MTOK * DM || ws_size < WS_END) {
            fprintf(stderr, "kernel_launch: unexpected shapes (n_in %d, in0 %d, out %d, ws %zu < %zu)\n", n_in, n_in > 0 ? in_sizes[0] : -1, out_size, ws_size, (size_t)WS_END); grid = -1; return; }
        int dev = 0, cus = 0, per_cu = 0;
        if (hipGetDevice(&dev) != hipSuccess || hipDeviceGetAttribute(&cus, hipDeviceAttributeMultiprocessorCount, dev) != hipSuccess) { fprintf(stderr, "kernel_launch: device query failed\n"); grid = -1; return; }
        if (hipFuncSetAttribute((const void*)fwd_kernel, hipFuncAttributeMaxDynamicSharedMemorySize, LDS_BYTES) != hipSuccess) { fprintf(stderr, "kernel_launch: hipFuncSetAttribute failed\n"); grid = -1; return; }
        if (hipOccupancyMaxActiveBlocksPerMultiprocessor(&per_cu, (const void*)fwd_kernel, NTHREADS, LDS_BYTES) != hipSuccess || per_cu < 1) {
            fprintf(stderr, "kernel_launch: occupancy query says %d blocks per CU\n", per_cu); (void)hipGetLastError(); per_cu = 1; }
        grid = cus * (per_cu > 1 ? 1 : per_cu);
    }
    if (grid < 0) return;
    (void)hipMemsetAsync((char*)d_ws + WS_CTL, 0, 65536, stream);
    Args a{};
    for (int i = 0; i < 17; ++i) a.in[i] = d_in[i];
    a.out = (float*)d_out; a.ws = (unsigned char*)d_ws;
#if MK_PER_PHASE
    for (int p = 0; p < NPHASE; ++p) { a.ph_lo = p; a.ph_hi = p + 1; hipLaunchKernelGGL(fwd_kernel, dim3(grid), dim3(NTHREADS), LDS_BYTES, stream, a); }
#else
    a.ph_lo = 0; a.ph_hi = NPHASE;
    void* kargs[] = {&a};
    hipError_t e = hipLaunchCooperativeKernel((const void*)fwd_kernel, dim3(grid), dim3(NTHREADS), kargs, LDS_BYTES, stream);
    if (e != hipSuccess) fprintf(stderr, "kernel_launch: cooperative launch failed: %s (grid %d)\n", hipGetErrorString(e), grid);
#endif
}
```

```cpp
#include <hip/hip_runtime.h>
#include <hip/hip_cooperative_groups.h>
#include <cstdio>
#include <cstdint>
namespace cg = cooperative_groups;

#define LAS __attribute__((address_space(3)))
typedef unsigned short bf16;
typedef unsigned v4u __attribute__((ext_vector_type(4)));
typedef unsigned v2u __attribute__((ext_vector_type(2)));
typedef float f32x4 __attribute__((ext_vector_type(4)));
typedef float f32x2 __attribute__((ext_vector_type(2)));
typedef float f32x16 __attribute__((ext_vector_type(16)));
typedef short bf16x8 __attribute__((ext_vector_type(8)));
typedef short s16x4 __attribute__((ext_vector_type(4)));

constexpr int NB = 4, SEQ = 4096, DM = 2048, MTOK = NB * SEQ;
constexpr int MEMLEN = 256, HD = 128;
constexpr int POOLW = 1536, MEMW = 512, NSAW = 1536, NHEAD = 12, NKVH = 4;
constexpr int N1 = 4096;
constexpr int NKV = 3072;
constexpr int N4 = 7424;
constexpr int NCMP = 255, CMPHID = 256;
constexpr float EPS = 1e-6f;
constexpr float LOG2E = 1.4426950408889634f;
constexpr float ATT_SCALE = 0.08838834764831845f;

constexpr size_t MiB = 1u << 20;
constexpr size_t WS_CTL = 0;
constexpr size_t WS_W1T = 1 * MiB;
constexpr size_t WS_WO0T = 17 * MiB;
constexpr size_t WS_W4T = 25 * MiB;
constexpr size_t WS_WO1T = 54 * MiB;
constexpr size_t WS_WMT = 62 * MiB;
constexpr size_t WS_WPT = 70 * MiB;
constexpr size_t WS_WC1T = 72 * MiB;
constexpr size_t WS_MEMN = 76 * MiB;
constexpr size_t WS_MKV = 80 * MiB;
constexpr size_t WS_ROPE = 84 * MiB;
constexpr size_t WS_ROPEC = 86 * MiB;
constexpr size_t WS_SS1 = 87 * MiB;
constexpr size_t WS_SS2 = 89 * MiB;
constexpr size_t WS_SEL = 91 * MiB;
constexpr size_t WS_KCMP = 92 * MiB;
constexpr size_t WS_VCMP = 93 * MiB;
constexpr size_t WS_GATES = 94 * MiB;
constexpr size_t WS_CBIAS = 97 * MiB;
constexpr size_t WS_A = 98 * MiB;
constexpr size_t WS_KVB = WS_A;
constexpr size_t WS_QM1 = WS_A + 97 * MiB;
constexpr size_t WS_ZM1 = WS_A + 113 * MiB;
constexpr size_t WS_B = 228 * MiB;
constexpr size_t WS_C = 292 * MiB;
constexpr size_t WS_D = 388 * MiB;
constexpr size_t WS_Q1 = WS_D, WS_ZQ = WS_D + 48 * MiB;
constexpr size_t WS_END = 484 * MiB;

#define LDS_WAIT() asm volatile("s_waitcnt lgkmcnt(0)" ::: "memory")
#define VM_WAIT() asm volatile("s_waitcnt vmcnt(0)" ::: "memory")
__device__ __forceinline__ unsigned f2bf(float f) { unsigned u = __builtin_bit_cast(unsigned, f); return (u + 0x7fffu + ((u >> 16) & 1u)) >> 16; }
__device__ __forceinline__ unsigned pk2(float lo, float hi) { return f2bf(lo) | (f2bf(hi) << 16); }
__device__ __forceinline__ float bf2f(unsigned short b) { return __builtin_bit_cast(float, (unsigned)b << 16); }
__device__ __forceinline__ float bflo(unsigned w) { return __builtin_bit_cast(float, w << 16); }
__device__ __forceinline__ float bfhi(unsigned w) { return __builtin_bit_cast(float, w & 0xffff0000u); }
__device__ __forceinline__ unsigned cvtpk(float lo, float hi) { unsigned r; asm volatile("v_cvt_pk_bf16_f32 %0, %1, %2" : "=v"(r) : "v"(lo), "v"(hi)); return r; }
__device__ __forceinline__ float silu_f(float x) { return x * __builtin_amdgcn_rcpf(1.f + __builtin_amdgcn_exp2f(-x * LOG2E)); }
__device__ __forceinline__ float sigmoid_f(float x) { return __builtin_amdgcn_rcpf(1.f + __builtin_amdgcn_exp2f(-x * LOG2E)); }
__device__ __forceinline__ float wave_sum(float v) {
#pragma unroll
    for (int o = 1; o < 64; o <<= 1) v += __shfl_xor(v, o);
    return v;
}

namespace pg8 {
#define PG8_LAS __attribute__((address_space(3)))
constexpr int BM = 256, BK = 64, HALF = 128, HTB = HALF * BK * 2, STAGE_BYTES = 8 * HTB, NXCD = 8, WGM = 8;
__host__ __device__ __forceinline__ int lds_byte(int r, int c) { const int st = (r >> 4) * 2 + (c >> 5), rr = r & 15, cc = c & 31, ob = rr * 64 + cc * 2; return st * 1024 + (ob ^ (((ob >> 9) & 1) << 5)); }
__host__ __device__ __forceinline__ int perm32(int rho) { const int n = rho >> 4, i = rho & 15; return 8 * (i >> 2) + 4 * n + (i & 3); }
__host__ __device__ __forceinline__ void stage_rc(int b, int& R, int& C) { const int st = b / 1024, sb = b % 1024, swz = sb ^ (((sb >> 9) & 1) << 5); R = (st >> 1) * 16 + swz / 64; C = (st & 1) * 32 + (swz % 64) / 2; }

struct Unit { int pm, pn, z, kind; const char* a; const char* b; };
__device__ __forceinline__ void tile_swz(int wgid, int nM, int nN, int wgm, int& pm, int& pn) {
    const int nwg = nM * nN;
    { const int q = nwg / NXCD, r = nwg % NXCD, xcd = wgid % NXCD, off = wgid / NXCD; wgid = (xcd < r ? xcd * (q + 1) : r * (q + 1) + (xcd - r) * q) + off; }
    const int nig = wgm * nN, gid = wgid / nig, fm = gid * wgm, gsz = (nM - fm) < wgm ? (nM - fm) : wgm;
    pm = fm + ((wgid % nig) % gsz); pn = (wgid % nig) / gsz;
}
struct Geo { int lda, ldb, nt; int kpairA; };

template <class Epi, class Sched, bool ALIGN_EPI, bool SP2>
__device__ __forceinline__ void gemm_phase(PG8_LAS unsigned char* lds, const int tid, const Geo g, const Sched& S, const Epi& E) {
    const int wid = __builtin_amdgcn_readfirstlane(tid >> 6), lane = tid & 63, wr = wid >> 2, wc = wid & 3, fr = lane & 15, fq = lane >> 4;
    const int nt = g.nt;
    unsigned voffA[2], voffB[2];
#pragma unroll
    for (int i = 0; i < 2; ++i) { int R, C; stage_rc(tid * 16 + i * 8192, R, C);
        const int Rb = Epi::PERM ? 64 * (R >> 5) + perm32(R & 31) : R;
        voffA[i] = (unsigned)(R * g.lda + C) * 2u; voffB[i] = (unsigned)(Rb * g.ldb + C) * 2u; }
    const size_t kstep = (size_t)(BK * 2);
    const size_t hstepA = (size_t)HALF * g.lda * 2, hstepB = (size_t)(Epi::PERM ? 32 : HALF) * g.ldb * 2;
    const size_t kpairA = (size_t)g.kpairA;
    const unsigned ldsw = (unsigned)wid * 1024u;
    const int aoff = lds_byte(wr * 64 + fr, fq * 8), boff = lds_byte(wc * 32 + fr, fq * 8);
#define PG8_SA(b, h) (((b) * 2 + (h)) * HTB)
#define PG8_SB(b, h) ((4 + (b) * 2 + (h)) * HTB)
#define PG8_STAGE(bufoff, gbase, voff) do { _Pragma("unroll") for (int _i = 0; _i < 2; ++_i) \
        __builtin_amdgcn_global_load_lds((const unsigned*)((const char*)(gbase) + (voff)[_i]), (PG8_LAS unsigned*)(lds + (bufoff) + ldsw + _i * 8192), 16, 0, 0); } while (0)
#define PG8_LDA(dst, b, h) do { _Pragma("unroll") for (int m = 0; m < 4; ++m) _Pragma("unroll") for (int k = 0; k < 2; ++k) dst[m][k] = *(const PG8_LAS bf16x8*)(lds + PG8_SA(b, h) + aoff + m * 2048 + k * 1024); } while (0)
#define PG8_LDB(dst, b, h) do { _Pragma("unroll") for (int n = 0; n < 2; ++n) _Pragma("unroll") for (int k = 0; k < 2; ++k) dst[n][k] = *(const PG8_LAS bf16x8*)(lds + PG8_SB(b, h) + boff + n * 2048 + k * 1024); } while (0)
#define PG8_MMA(ai, bj, At, Bt) do { __builtin_amdgcn_s_setprio(1); _Pragma("unroll") for (int m = 0; m < 4; ++m) _Pragma("unroll") for (int n = 0; n < 2; ++n) _Pragma("unroll") for (int k = 0; k < 2; ++k) \
        acc[ai][bj][m][n] = __builtin_amdgcn_mfma_f32_16x16x32_bf16(Bt[n][k], At[m][k], acc[ai][bj][m][n], 0, 0, 0); __builtin_amdgcn_s_setprio(0); } while (0)
#define PG8_WAIT_V(n) asm volatile("s_waitcnt vmcnt(" #n ")" ::: "memory")
#define PG8_WAIT_L(n) asm volatile("s_waitcnt lgkmcnt(" #n ")" ::: "memory")
#define PG8_BAR __builtin_amdgcn_s_barrier()
#define PG8_SCHED __builtin_amdgcn_sched_barrier(0)
    Unit cur, nxt; int ui = 0;
    if (!S.next(0, cur)) return;
    f32x4 acc[2][2][4][2];
    typename Epi::State est;
    E.begin(acc, est, cur, wr, wc, fr, fq);
    bf16x8 At[4][2], B0[2][2], B1[2][2];
    const char* cA = cur.a; const char* cB = cur.b;
    if constexpr (SP2) {
        PG8_STAGE(PG8_SB(0, 0), cB, voffB); PG8_STAGE(PG8_SB(0, 1), cB + hstepB, voffB); PG8_STAGE(PG8_SA(0, 0), cA, voffA); PG8_STAGE(PG8_SA(0, 1), cA + hstepA, voffA);
        if (wr == 1) PG8_BAR;
        PG8_WAIT_V(2); PG8_BAR;
        PG8_STAGE(PG8_SB(1, 0), cB + kstep, voffB); PG8_STAGE(PG8_SA(1, 0), cA + kstep, voffA); PG8_STAGE(PG8_SB(1, 1), cB + hstepB + kstep, voffB);
        PG8_WAIT_V(6); PG8_BAR;
    } else {
        PG8_STAGE(PG8_SB(0, 0), cB, voffB); PG8_STAGE(PG8_SA(0, 0), cA, voffA); PG8_STAGE(PG8_SB(0, 1), cB + hstepB, voffB); PG8_STAGE(PG8_SA(0, 1), cA + hstepA, voffA);
        if (wr == 1) PG8_BAR;
        PG8_WAIT_V(4); PG8_BAR;
        PG8_STAGE(PG8_SB(1, 0), cB + kstep, voffB); PG8_STAGE(PG8_SA(1, 0), cA + kstep, voffA); PG8_STAGE(PG8_SB(1, 1), cB + hstepB + kstep, voffB);
        PG8_WAIT_V(6); PG8_BAR;
    }
    for (;;) {
        const bool has_next = S.next(ui + 1, nxt);
        const char* nA = has_next ? nxt.a : cA; const char* nB = has_next ? nxt.b : cB;
        for (int t = 0; t < nt; t += 2) {
            const bool last = (t == nt - 2);
            const char* a0p = cA + (size_t)(t >> 1) * kpairA;
            const char* a1 = a0p + kstep;
            const char* a2 = last ? nA : a0p + kpairA; const char* b2 = last ? nB : cB + (size_t)(t + 2) * kstep;
            const char* a3 = a2 + kstep; const char* b3 = b2 + kstep;
            if constexpr (SP2) {
            PG8_LDB(B0, 0, 0); PG8_LDB(B1, 0, 1); PG8_SCHED; PG8_LDA(At, 0, 0); PG8_STAGE(PG8_SA(1, 1), a1 + hstepA, voffA);
            PG8_WAIT_V(8); PG8_WAIT_L(0); PG8_BAR; PG8_MMA(0, 0, At, B0); PG8_MMA(0, 1, At, B1); PG8_BAR; PG8_SCHED;
            PG8_LDA(At, 0, 1); PG8_STAGE(PG8_SB(0, 0), b2, voffB); PG8_STAGE(PG8_SB(0, 1), b2 + hstepB, voffB); PG8_STAGE(PG8_SA(0, 0), a2, voffA);
            PG8_WAIT_V(8); PG8_WAIT_L(0); PG8_BAR; PG8_MMA(1, 0, At, B0); PG8_MMA(1, 1, At, B1); PG8_BAR; PG8_SCHED;
            PG8_LDB(B0, 1, 0); PG8_LDB(B1, 1, 1); PG8_SCHED; PG8_LDA(At, 1, 0); PG8_STAGE(PG8_SA(0, 1), a2 + hstepA, voffA);
            PG8_WAIT_V(8); PG8_WAIT_L(0); PG8_BAR; PG8_MMA(0, 0, At, B0); PG8_MMA(0, 1, At, B1); PG8_BAR; PG8_SCHED;
            PG8_LDA(At, 1, 1); PG8_STAGE(PG8_SB(1, 0), b3, voffB); PG8_STAGE(PG8_SB(1, 1), b3 + hstepB, voffB); PG8_STAGE(PG8_SA(1, 0), a3, voffA);
            PG8_WAIT_V(8); PG8_WAIT_L(0); PG8_BAR; PG8_MMA(1, 0, At, B0); PG8_MMA(1, 1, At, B1); PG8_BAR; PG8_SCHED;
            } else {
            PG8_LDB(B0, 0, 0); PG8_SCHED; PG8_LDA(At, 0, 0); PG8_STAGE(PG8_SA(1, 1), a1 + hstepA, voffA);
            PG8_WAIT_L(8); PG8_BAR; PG8_WAIT_L(0); PG8_MMA(0, 0, At, B0); PG8_BAR; PG8_SCHED;
            PG8_LDB(B1, 0, 1); PG8_STAGE(PG8_SB(0, 0), b2, voffB);
            PG8_BAR; PG8_WAIT_L(0); PG8_MMA(0, 1, At, B1); PG8_BAR;
            PG8_LDA(At, 0, 1); PG8_STAGE(PG8_SA(0, 0), a2, voffA);
            PG8_BAR; PG8_WAIT_L(0); PG8_MMA(1, 0, At, B0); PG8_BAR; PG8_SCHED;
            PG8_STAGE(PG8_SB(0, 1), b2 + hstepB, voffB);
            PG8_WAIT_V(6); PG8_BAR; PG8_MMA(1, 1, At, B1); PG8_BAR;
            PG8_LDB(B0, 1, 0); PG8_SCHED; PG8_LDA(At, 1, 0); PG8_STAGE(PG8_SA(0, 1), a2 + hstepA, voffA);
            PG8_WAIT_L(8); PG8_BAR; PG8_WAIT_L(0); PG8_MMA(0, 0, At, B0); PG8_BAR; PG8_SCHED;
            PG8_LDB(B1, 1, 1); PG8_STAGE(PG8_SB(1, 0), b3, voffB);
            PG8_BAR; PG8_WAIT_L(0); PG8_MMA(0, 1, At, B1); PG8_BAR;
            PG8_LDA(At, 1, 1); PG8_STAGE(PG8_SA(1, 0), a3, voffA);
            PG8_BAR; PG8_WAIT_L(0); PG8_MMA(1, 0, At, B0); PG8_BAR; PG8_SCHED;
            PG8_STAGE(PG8_SB(1, 1), b3 + hstepB, voffB);
            PG8_WAIT_V(6); PG8_BAR; PG8_MMA(1, 1, At, B1); PG8_BAR;
            }
        }
        if constexpr (ALIGN_EPI) { if (wr == 0) PG8_BAR; }
        E(acc, est, cur, wr, wc, fr, fq);
        if (!has_next) break;
        cur = nxt; cA = nA; cB = nB; ++ui;
        E.begin(acc, est, cur, wr, wc, fr, fq);
        if constexpr (ALIGN_EPI) { if (wr == 1) PG8_BAR; }
    }
    PG8_WAIT_V(0);
    if constexpr (!ALIGN_EPI) { if (wr == 0) PG8_BAR; }
    PG8_BAR;
#undef PG8_SA
#undef PG8_SB
#undef PG8_STAGE
#undef PG8_LDA
#undef PG8_LDB
#undef PG8_MMA
#undef PG8_WAIT_V
#undef PG8_WAIT_L
#undef PG8_BAR
#undef PG8_SCHED
}
}

namespace att {
#ifndef AT_SELMASK
#define AT_SELMASK 1
#endif
constexpr int D = 128, NW = 8, QBLK = 32, KVBLK = 64, QB = NW * QBLK;
constexpr int SHM_V = KVBLK * D * 2, SHM_K = KVBLK * D * 2;
constexpr int LDS_BYTES = 2 * SHM_V + 2 * SHM_K + NW * 64 * 4;
constexpr float THR = 16.f;
#define KSWZ(row, colB) ((row) * 256 + ((colB) ^ (((row) & 7) << 4)))
#define SBAR() __builtin_amdgcn_sched_barrier(0)
__device__ __forceinline__ int v_st(int k, int c) { const int kk = (k & ~0xC) | ((k & 4) << 1) | ((k & 8) >> 1); return ((kk >> 3) * 4 + (c >> 5)) * 512 + ((kk & 7) * 32 + (c & 31)) * 2; }
__device__ __forceinline__ int v_rd_base(int lane) { return ((lane & 3) << 3) | (((lane >> 2) & 3) << 6) | (((lane >> 4) & 1) << 5) | (((lane >> 5) & 1) << 8); }
constexpr int v_rd_off(int d0, int ks, int half) { return d0 * 512 + ks * 4096 + half * 2048; }
__device__ __forceinline__ int crow(int r, int hi) { return (r & 3) + 8 * (r >> 2) + 4 * hi; }
__device__ __forceinline__ bf16x8 load8(const bf16* p) { return *reinterpret_cast<const bf16x8*>(p); }

__device__ __forceinline__ void mask_tile(f32x16& p0, f32x16& p1, int dq, unsigned W) {
    const float NEG = -__builtin_inff();
#pragma unroll
    for (int r = 0; r < 16; ++r) {
        const int c = (r & 3) + 8 * (r >> 2);
        if ((unsigned)(dq - c) >= W) p0[r] = NEG;
        if ((unsigned)(dq - c - 32) >= W) p1[r] = NEG;
    }
}
__device__ __forceinline__ void partialSM(f32x16& p0, f32x16& p1, float& m_reg, float& mn, float& alpha) {
    float pmax = p0[0];
#pragma unroll
    for (int r = 1; r < 16; ++r) pmax = fmaxf(pmax, p0[r]);
#pragma unroll
    for (int r = 0; r < 16; ++r) pmax = fmaxf(pmax, p1[r]);
    { auto rr = __builtin_amdgcn_permlane32_swap(__float_as_uint(pmax), __float_as_uint(pmax), false, false);
      pmax = fmaxf(__uint_as_float(rr[0]), __uint_as_float(rr[1])); }
    constexpr float C2 = LOG2E * ATT_SCALE;
    if (__builtin_expect(__all((pmax - m_reg) * ATT_SCALE <= THR), 1)) { mn = m_reg; alpha = 1.f; }
    else { mn = fmaxf(m_reg, pmax); alpha = __builtin_amdgcn_exp2f((m_reg - mn) * C2); m_reg = mn; }
    const float mnL = -mn * C2;
#pragma unroll
    for (int r = 0; r < 16; ++r) p0[r] = fmaf(p0[r], C2, mnL);
#pragma unroll
    for (int r = 0; r < 16; ++r) p1[r] = fmaf(p1[r], C2, mnL);
#pragma unroll
    for (int r = 0; r < 16; ++r) p0[r] = __builtin_amdgcn_exp2f(p0[r]);
}
__device__ __forceinline__ void finishSM(f32x16& p0, f32x16& p1, float alpha, float& l_reg, bf16x8& pa0, bf16x8& pa1, bf16x8& pa2, bf16x8& pa3, int keep) {
#pragma unroll
    for (int r = 0; r < 16; ++r) p1[r] = __builtin_amdgcn_exp2f(p1[r]);
    float ps = 0;
#pragma unroll
    for (int r = 0; r < 16; ++r) ps += p0[r];
#pragma unroll
    for (int r = 0; r < 16; ++r) ps += p1[r];
    { auto rr = __builtin_amdgcn_permlane32_swap(__float_as_uint(ps), __float_as_uint(ps), false, false);
      ps = __uint_as_float(rr[0]) + __uint_as_float(rr[1]); }
    l_reg = l_reg * alpha + (keep ? ps : 0.f);
#define PK4(P, B_, OUT) do { unsigned a0 = cvtpk(P[B_+0], P[B_+1]), a1 = cvtpk(P[B_+2], P[B_+3]);                          \
        unsigned b0 = cvtpk(P[B_+4], P[B_+5]), b1 = cvtpk(P[B_+6], P[B_+7]);                                             \
        auto r0 = __builtin_amdgcn_permlane32_swap(a0, b0, false, false); auto r1 = __builtin_amdgcn_permlane32_swap(a1, b1, false, false); \
        v4u w = {keep ? r0[0] : 0u, keep ? r1[0] : 0u, keep ? r0[1] : 0u, keep ? r1[1] : 0u}; OUT = *reinterpret_cast<bf16x8*>(&w); } while (0)
    PK4(p0, 0, pa0); PK4(p0, 8, pa1); PK4(p1, 0, pa2); PK4(p1, 8, pa3);
#undef PK4
}
template <int KB>
__device__ __forceinline__ void qkt(f32x16& p0, f32x16& p1, const char* K_lds, int r32, int hi, const bf16x8* qr) {
    p0 = f32x16{}; p1 = f32x16{};
    const char* kb[4];
#pragma unroll
    for (int dd = 0; dd < 4; ++dd) kb[dd] = K_lds + KB * SHM_K + KSWZ(r32, (dd * 16 + hi * 8) * 2);
#pragma unroll
    for (int d0 = 0; d0 < 8; ++d0) { const char* a = kb[d0 & 3] + (d0 >> 2) * 128;
        bf16x8 b0 = *reinterpret_cast<const bf16x8*>(a);
        bf16x8 b1 = *reinterpret_cast<const bf16x8*>(a + 32 * 256);
        p0 = __builtin_amdgcn_mfma_f32_32x32x16_bf16(b0, qr[d0], p0, 0, 0, 0);
        p1 = __builtin_amdgcn_mfma_f32_32x32x16_bf16(b1, qr[d0], p1, 0, 0, 0); }
}
template <int VB>
__device__ __forceinline__ void pv_tile(f32x16* o, int vb0, bf16x8 pa0, bf16x8 pa1, bf16x8 pa2, bf16x8 pa3) {
#define TRRD(dst, off) asm volatile("ds_read_b64_tr_b16 %0, %1 offset:%2" : "=&v"(dst) : "v"(vb0), "i"(off) : "memory")
#define PV_D0(d0) do { s16x4 l0, l1, l2, l3, h0, h1, h2, h3; constexpr int b_ = VB * SHM_V + v_rd_off(d0, 0, 0);   \
        TRRD(l0, b_); TRRD(h0, b_ + 2048); TRRD(l1, b_ + 4096); TRRD(h1, b_ + 6144); TRRD(l2, b_ + 8192); TRRD(h2, b_ + 10240); TRRD(l3, b_ + 12288); TRRD(h3, b_ + 14336); \
        asm volatile("s_waitcnt lgkmcnt(0)" ::: "memory"); SBAR();   \
        o[d0] = __builtin_amdgcn_mfma_f32_32x32x16_bf16(pa0, (bf16x8){l0[0], l0[1], l0[2], l0[3], h0[0], h0[1], h0[2], h0[3]}, o[d0], 0, 0, 0);   \
        o[d0] = __builtin_amdgcn_mfma_f32_32x32x16_bf16(pa1, (bf16x8){l1[0], l1[1], l1[2], l1[3], h1[0], h1[1], h1[2], h1[3]}, o[d0], 0, 0, 0);   \
        o[d0] = __builtin_amdgcn_mfma_f32_32x32x16_bf16(pa2, (bf16x8){l2[0], l2[1], l2[2], l2[3], h2[0], h2[1], h2[2], h2[3]}, o[d0], 0, 0, 0);   \
        o[d0] = __builtin_amdgcn_mfma_f32_32x32x16_bf16(pa3, (bf16x8){l3[0], l3[1], l3[2], l3[3], h3[0], h3[1], h3[2], h3[3]}, o[d0], 0, 0, 0); } while (0)
    PV_D0(0); PV_D0(1); PV_D0(2); PV_D0(3);
#undef PV_D0
#undef TRRD
}

enum { MODE_NONE = 0, MODE_SEL = 1, MODE_WIN = 2, MODE_CMP = 3 };
enum { EPI_MEM = 0, EPI_ACC0 = 1, EPI_ACC1 = 2, EPI_FIN = 3 };
struct Ctx { const bf16 *KV, *KC, *VC, *Q1, *ZQ, *QM, *ZM, *MKV; const float* gates; const unsigned long long* SEL; float* YACC; bf16* Y; int qm_ld, zm_ld, qm_c0, zm_c0; };
struct Blk {
    const bf16* Q; const bf16* K; int voff;
    int ldq, ldk;
    int j_lo, j_hi;
    int t0;
    int mode, epi;
    int row0, hcol, gcol, bg;
};
constexpr int LDS_WS = 2 * SHM_V + 2 * SHM_K;
constexpr int LDS_SEL = LDS_WS + NW * 64 * 4;
constexpr int LDS_STG = LDS_SEL + NW * 32 * 8;
constexpr int LDS_BYTES2 = LDS_STG + NW * 32 * 68 * 4;
struct Seam { bf16x8 qr[8]; bf16x8 st_v0, st_v1, st_k0, st_k1; };
#define AROW(p, k0, rr) ((p) + (size_t)((k0) + (rr)) * ldk + sc)
#define VMWN(n) asm volatile("s_waitcnt vmcnt(%0)" :: "i"(n) : "memory")
#define SLOAD_H(Kp, Vp, k0) do { S.st_v0 = load8(AROW(Vp, k0, sr)); S.st_v1 = load8(AROW(Vp, k0, 32 + sr));              \
                         S.st_k0 = load8(AROW(Kp, k0, sr)); S.st_k1 = load8(AROW(Kp, k0, 32 + sr)); } while (0)
#define SWRITE_HK(bf) do { *(bf16x8*)(K_lds + (bf) * SHM_K + kws) = S.st_k0; *(bf16x8*)(K_lds + (bf) * SHM_K + kws + 32 * 256) = S.st_k1; } while (0)
#define SWRITE_HV(bf) do { *(bf16x8*)(V_lds + (bf) * SHM_V + vst0) = S.st_v0; *(bf16x8*)(V_lds + (bf) * SHM_V + vst1) = S.st_v1; } while (0)
#define SWRITE_H(bf) do { SWRITE_HV(bf); SWRITE_HK(bf); } while (0)

__device__ __forceinline__ void attn_prime(const int tid, const Blk& cur, char* lds, Seam& S) {
    const int wid = __builtin_amdgcn_readfirstlane(tid >> 6), lane = tid & 63, r32 = lane & 31, hi = lane >> 5;
    const int sr = tid >> 4, sc = (tid & 15) * 8, kws = KSWZ(sr, sc * 2); char* K_lds = lds + 2 * SHM_V;
    const int ldk = cur.ldk; const int kb0 = cur.j_lo * KVBLK;
#pragma unroll
    for (int i = 0; i < 8; ++i) S.qr[i] = load8(cur.Q + (size_t)(wid * QBLK + (lane >> 4) + 4 * i) * cur.ldq + (lane & 15) * 8);
    SLOAD_H(cur.K, cur.K + cur.voff, kb0); VM_WAIT(); SWRITE_HK(0);
    __syncthreads();
}
__device__ __forceinline__ void attn_block(const int tid, const Ctx& C, const Blk& cur, const bf16* nQ, const bf16* nK, int nvoff, int nldq, int nldk, int nj_lo, char* lds, Seam& S) {
    const int wid = __builtin_amdgcn_readfirstlane(tid >> 6), lane = tid & 63, r32 = lane & 31, hi = lane >> 5;
#ifdef AT_TILE2X
    const int j_lo = cur.j_lo, NT0 = cur.j_hi - cur.j_lo, NT = (cur.mode == AT_TILE2X) ? 2 * NT0 : NT0;
#define TIX(t) ((t) >= NT0 ? (t) - NT0 : (t))
#else
    const int j_lo = cur.j_lo, NT = cur.j_hi - cur.j_lo;
#define TIX(t) (t)
#endif
    const int kbn = nj_lo * KVBLK;
    const int mode = cur.mode;
    const int trow = cur.t0 + wid * QBLK;
    int pos, pmin, pmax; unsigned W;
    if (mode == MODE_CMP) { pos = (trow + r32 - 31) >> 4; pmin = (trow - 31) >> 4; pmax = trow >> 4; W = 0x7fffffffu; }
    else if (mode == MODE_NONE) { pos = 1 << 29; pmin = 1 << 29; pmax = 1 << 29; W = 0x7fffffffu; }
    else { pos = trow + r32; pmin = trow; pmax = trow + QBLK - 1; W = (mode == MODE_WIN) ? 512u : 0x7fffffffu; }
    const int qm = pos - 4 * hi;
    char* V_lds = lds; char* K_lds = lds + 2 * SHM_V;
    float* ws = (float*)(lds + LDS_WS) + wid * 64; float* li_l = ws, * al_l = ws + 32;
    unsigned long long* sel_l = (unsigned long long*)(lds + LDS_SEL) + wid * 32;
    if (mode == MODE_SEL && hi == 0) sel_l[r32] = C.SEL[(size_t)cur.bg * SEQ + trow + r32];
    float m_reg = -1e30f, l_reg = 0; f32x16 o[4] = {};
    const int sr = tid >> 4, sc = (tid & 15) * 8, vst0 = v_st(sr, sc), vst1 = v_st(32 + sr, sc), kws = KSWZ(sr, sc * 2);
    const int vb0 = (int)(uintptr_t)V_lds + v_rd_base(lane);
    const bf16* Kh = cur.K; const bf16* Vh = cur.K + cur.voff; const int ldk = cur.ldk;
#define RESC(a) do { if (__any((a) < 1.f)) { if (hi == 0) al_l[r32] = (a); asm volatile("s_waitcnt lgkmcnt(0)" ::: "memory");              \
                     for (int d_ = 0; d_ < 4; ++d_) for (int r = 0; r < 16; ++r) o[d_][r] *= al_l[crow(r, hi)]; } } while (0)
#define KBASE(t) ((j_lo + TIX(t)) * KVBLK)
#define MASKT(P0_, P1_, t, KP_) do { const int kb_ = KBASE(t); KP_ = 1; \
        if (mode == MODE_SEL) { const int bit_ = (int)((sel_l[r32] >> (j_lo + TIX(t))) & 1ull); \
            if (kb_ + KVBLK - 1 > pmin) mask_tile(P0_, P1_, bit_ ? qm - kb_ : -(1 << 30), W);       \
            else KP_ = bit_; }                                                                         \
        else if (kb_ + KVBLK - 1 > pmin || kb_ <= pmax - (int)W) mask_tile(P0_, P1_, qm - kb_, W); } while (0)
    constexpr int NQL = 8;
#define SEAM_K0() do { VMWN(NQL); SWRITE_HK(0); SBAR(); } while (0)
    f32x16 pA0, pA1, pB0, pB1; float mnA, mnB, alA, alB; int kpA = 1, kpB = 1; bf16x8 pa0, pa1, pa2, pa3;
    {
        char* stq = lds + LDS_STG + wid * (32 * 272);
#pragma unroll
        for (int i = 0; i < 8; ++i) *(bf16x8*)(stq + ((lane >> 4) + 4 * i) * 272 + (lane & 15) * 16) = S.qr[i];
        asm volatile("s_waitcnt lgkmcnt(0)" ::: "memory");
#pragma unroll
        for (int d0 = 0; d0 < 8; ++d0) S.qr[d0] = *(const bf16x8*)(stq + r32 * 272 + (2 * d0 + hi) * 16);
        asm volatile("s_waitcnt lgkmcnt(0)" ::: "memory");
    }
    SWRITE_HV(0); SBAR();
    if (NT > 1) { SLOAD_H(Kh, Vh, KBASE(1)); }
    SBAR(); qkt<0>(pA0, pA1, K_lds, r32, hi, S.qr);
    MASKT(pA0, pA1, 0, kpA); partialSM(pA0, pA1, m_reg, mnA, alA);
    if (NT > 1) { VM_WAIT(); SWRITE_H(1); }
    __syncthreads();
#define HALF_STEP(PX0, PX1, mnX, alX, kpX, PY0, PY1, alY, kpY, t, KB, VB, SB) do {                                                      \
        SBAR(); if ((t) + 1 < NT) { SLOAD_H(Kh, Vh, KBASE((t) + 1)); SBAR(); }         \
        qkt<KB>(PX0, PX1, K_lds, r32, hi, S.qr);                                             \
        finishSM(PY0, PY1, alY, l_reg, pa0, pa1, pa2, pa3, kpY); SBAR();                                                      \
        pv_tile<VB>(o, vb0, pa0, pa1, pa2, pa3); MASKT(PX0, PX1, (t), kpX); partialSM(PX0, PX1, m_reg, mnX, alX);                                        \
        __syncthreads();                                                                                                      \
        if ((t) + 1 < NT) { VM_WAIT(); SWRITE_H(SB); }                                                                          \
        RESC(alX); __syncthreads(); } while (0)
    for (int t = 1; t + 1 < NT; t += 2) {
        HALF_STEP(pB0, pB1, mnB, alB, kpB, pA0, pA1, alA, kpA, t, 1, 0, 0);
        HALF_STEP(pA0, pA1, mnA, alA, kpA, pB0, pB1, alB, kpB, t + 1, 0, 1, 1);
    }
    const bool even = (NT & 1) == 0;
    if (even) { SBAR(); qkt<1>(pB0, pB1, K_lds, r32, hi, S.qr); SBAR(); }
    { const int ldk = nldk; SLOAD_H(nK, nK + nvoff, kbn); SBAR(); }
#pragma unroll
    for (int i = 0; i < 8; ++i) S.qr[i] = load8(nQ + (size_t)(wid * QBLK + (lane >> 4) + 4 * i) * nldq + (lane & 15) * 8);
    SBAR();
    finishSM(pA0, pA1, alA, l_reg, pa0, pa1, pa2, pa3, kpA); SBAR();
    pv_tile<0>(o, vb0, pa0, pa1, pa2, pa3);
    if (even) { MASKT(pB0, pB1, NT - 1, kpB); partialSM(pB0, pB1, m_reg, mnB, alB); __syncthreads(); RESC(alB);
        finishSM(pB0, pB1, alB, l_reg, pa0, pa1, pa2, pa3, kpB); SBAR(); pv_tile<1>(o, vb0, pa0, pa1, pa2, pa3); }
    SBAR(); SEAM_K0();
    {
        const int epi = cur.epi;
        float fac = l_reg > 0.f ? __builtin_amdgcn_rcpf(l_reg) : 0.f;
        if (epi != EPI_MEM) fac *= C.gates[(size_t)(cur.row0 + wid * QBLK + r32) * 36 + cur.gcol];
        if (hi == 0) li_l[r32] = fac;
        asm volatile("s_waitcnt lgkmcnt(0)" ::: "memory");
        float* stg = (float*)(lds + LDS_STG) + wid * (32 * 68);
        const int rrow = lane >> 4, c4 = (lane & 15) * 4;
        const size_t grow = (size_t)cur.row0 + wid * QBLK + rrow;
        const bool fin = (epi == EPI_FIN);
        float* accb = C.YACC + grow * NSAW + cur.hcol + c4;
        const bf16* zb = fin ? C.ZQ + grow * NSAW + cur.hcol + c4 : C.ZM + grow * C.zm_ld + C.zm_c0 + cur.hcol + c4;
        const int ldz = fin ? NSAW : C.zm_ld;
        bf16* yb = C.Y + grow * DM + (fin ? 0 : POOLW) + cur.hcol + c4;
#pragma unroll
        for (int half = 0; half < 2; ++half) {
#pragma unroll
            for (int r = 0; r < 16; ++r) { const float f = li_l[crow(r, hi)]; float* w = stg + crow(r, hi) * 68 + r32; w[0] = o[2 * half][r] * f; w[32] = o[2 * half + 1][r] * f; }
            asm volatile("s_waitcnt lgkmcnt(0)" ::: "memory");
            f32x4 v[8];
#pragma unroll
            for (int i = 0; i < 8; ++i) v[i] = *(const f32x4*)(stg + (rrow + 4 * i) * 68 + c4);
            const int co = half * 64;
            if (epi == EPI_ACC0) {
#pragma unroll
                for (int i = 0; i < 8; ++i) *(f32x4*)(accb + (size_t)(4 * i) * NSAW + co) = v[i];
            } else if (epi == EPI_ACC1) {
                f32x4 a[8];
#pragma unroll
                for (int i = 0; i < 8; ++i) a[i] = *(const f32x4*)(accb + (size_t)(4 * i) * NSAW + co);
#pragma unroll
                for (int i = 0; i < 8; ++i) *(f32x4*)(accb + (size_t)(4 * i) * NSAW + co) = a[i] + v[i];
            } else {
                v2u z[8];
#pragma unroll
                for (int i = 0; i < 8; ++i) z[i] = *(const v2u*)(zb + (size_t)(4 * i) * ldz + co);
                if (fin) { f32x4 a[8];
#pragma unroll
                    for (int i = 0; i < 8; ++i) a[i] = *(const f32x4*)(accb + (size_t)(4 * i) * NSAW + co);
#pragma unroll
                    for (int i = 0; i < 8; ++i) v[i] = v[i] + a[i]; }
#pragma unroll
                for (int i = 0; i < 8; ++i) { v2u w; w.x = pk2(v[i][0] * bflo(z[i].x), v[i][1] * bfhi(z[i].x)); w.y = pk2(v[i][2] * bflo(z[i].y), v[i][3] * bfhi(z[i].y));
                    *(v2u*)(yb + (size_t)(4 * i) * DM + co) = w; }
            }
            asm volatile("s_waitcnt lgkmcnt(0)" ::: "memory");
        }
    }
    __syncthreads();
#undef RESC
#undef TIX
#undef KBASE
#undef MASKT
#undef SEAM_K0
#undef HALF_STEP
}
#undef AROW
#undef VMWN
#undef SLOAD_H
#undef SWRITE_HK
#undef SWRITE_HV
#undef SWRITE_H
}
__device__ const unsigned short NSA_TAB[256 * 4] = {
    0, 384, 674, 65535,
    1, 385, 675, 65535,
    144, 480, 484, 65535,
    145, 481, 485, 65535,
    96, 482, 528, 65535,
    97, 483, 529, 65535,
    48, 388, 676, 65535,
    49, 389, 677, 65535,
    148, 432, 530, 65535,
    149, 433, 531, 65535,
    192, 386, 532, 65535,
    193, 387, 533, 65535,
    4, 288, 722, 65535,
    5, 289, 723, 65535,
    98, 436, 576, 65535,
    99, 437, 577, 65535,
    100, 434, 578, 65535,
    101, 435, 579, 65535,
    2, 292, 724, 65535,
    3, 293, 725, 65535,
    146, 336, 628, 65535,
    147, 337, 629, 65535,
    50, 338, 672, 65535,
    51, 339, 673, 65535,
    52, 244, 720, 65535,
    53, 245, 721, 65535,
    194, 340, 580, 65535,
    195, 341, 581, 65535,
    196, 290, 624, 65535,
    197, 291, 625, 65535,
    240, 242, 626, 65535,
    241, 243, 627, 65535,
    6, 390, 680, 65535,
    7, 391, 681, 65535,
    150, 486, 490, 65535,
    151, 487, 491, 65535,
    102, 488, 534, 65535,
    103, 489, 535, 65535,
    54, 394, 682, 65535,
    55, 395, 683, 65535,
    154, 438, 536, 65535,
    155, 439, 537, 65535,
    198, 392, 538, 65535,
    199, 393, 539, 65535,
    10, 294, 728, 65535,
    11, 295, 729, 65535,
    104, 442, 582, 65535,
    105, 443, 583, 65535,
    106, 440, 584, 65535,
    107, 441, 585, 65535,
    8, 298, 730, 65535,
    9, 299, 731, 65535,
    152, 342, 634, 65535,
    153, 343, 635, 65535,
    56, 344, 678, 65535,
    57, 345, 679, 65535,
    58, 250, 726, 65535,
    59, 251, 727, 65535,
    200, 346, 586, 65535,
    201, 347, 587, 65535,
    202, 296, 630, 65535,
    203, 297, 631, 65535,
    246, 248, 632, 65535,
    247, 249, 633, 65535,
    12, 396, 686, 65535,
    13, 397, 687, 65535,
    156, 492, 496, 65535,
    157, 493, 497, 65535,
    108, 494, 540, 65535,
    109, 495, 541, 65535,
    60, 400, 688, 65535,
    61, 401, 689, 65535,
    160, 444, 542, 65535,
    161, 445, 543, 65535,
    204, 398, 544, 65535,
    205, 399, 545, 65535,
    16, 300, 734, 65535,
    17, 301, 735, 65535,
    110, 448, 588, 65535,
    111, 449, 589, 65535,
    112, 446, 590, 65535,
    113, 447, 591, 65535,
    14, 304, 736, 65535,
    15, 305, 737, 65535,
    158, 348, 640, 65535,
    159, 349, 641, 65535,
    62, 350, 684, 65535,
    63, 351, 685, 65535,
    64, 256, 732, 65535,
    65, 257, 733, 65535,
    206, 352, 592, 65535,
    207, 353, 593, 65535,
    208, 302, 636, 65535,
    209, 303, 637, 65535,
    252, 254, 638, 65535,
    253, 255, 639, 65535,
    18, 402, 692, 65535,
    19, 403, 693, 65535,
    162, 498, 502, 65535,
    163, 499, 503, 65535,
    114, 500, 546, 65535,
    115, 501, 547, 65535,
    66, 406, 694, 65535,
    67, 407, 695, 65535,
    166, 450, 548, 65535,
    167, 451, 549, 65535,
    210, 404, 550, 65535,
    211, 405, 551, 65535,
    22, 306, 740, 65535,
    23, 307, 741, 65535,
    116, 454, 594, 65535,
    117, 455, 595, 65535,
    118, 452, 596, 65535,
    119, 453, 597, 65535,
    20, 310, 742, 65535,
    21, 311, 743, 65535,
    164, 354, 646, 65535,
    165, 355, 647, 65535,
    68, 356, 690, 65535,
    69, 357, 691, 65535,
    70, 262, 738, 65535,
    71, 263, 739, 65535,
    212, 358, 598, 65535,
    213, 359, 599, 65535,
    214, 308, 642, 65535,
    215, 309, 643, 65535,
    258, 260, 644, 65535,
    259, 261, 645, 65535,
    24, 408, 698, 65535,
    25, 409, 699, 65535,
    168, 504, 508, 65535,
    169, 505, 509, 65535,
    120, 506, 552, 65535,
    121, 507, 553, 65535,
    72, 412, 700, 65535,
    73, 413, 701, 65535,
    172, 456, 554, 65535,
    173, 457, 555, 65535,
    216, 410, 556, 65535,
    217, 411, 557, 65535,
    28, 312, 746, 65535,
    29, 313, 747, 65535,
    122, 460, 600, 65535,
    123, 461, 601, 65535,
    124, 458, 602, 65535,
    125, 459, 603, 65535,
    26, 316, 748, 65535,
    27, 317, 749, 65535,
    170, 360, 652, 65535,
    171, 361, 653, 65535,
    74, 362, 696, 65535,
    75, 363, 697, 65535,
    76, 268, 744, 65535,
    77, 269, 745, 65535,
    218, 364, 604, 65535,
    219, 365, 605, 65535,
    220, 314, 648, 65535,
    221, 315, 649, 65535,
    264, 266, 650, 65535,
    265, 267, 651, 65535,
    30, 414, 704, 65535,
    31, 415, 705, 65535,
    174, 510, 514, 65535,
    175, 511, 515, 65535,
    126, 512, 558, 65535,
    127, 513, 559, 65535,
    78, 418, 706, 65535,
    79, 419, 707, 65535,
    178, 462, 560, 65535,
    179, 463, 561, 65535,
    222, 416, 562, 65535,
    223, 417, 563, 65535,
    34, 318, 752, 65535,
    35, 319, 753, 65535,
    128, 466, 606, 65535,
    129, 467, 607, 65535,
    130, 464, 608, 65535,
    131, 465, 609, 65535,
    32, 322, 754, 65535,
    33, 323, 755, 65535,
    176, 366, 658, 65535,
    177, 367, 659, 65535,
    80, 368, 702, 65535,
    81, 369, 703, 65535,
    82, 274, 750, 65535,
    83, 275, 751, 65535,
    224, 370, 610, 65535,
    225, 371, 611, 65535,
    226, 320, 654, 65535,
    227, 321, 655, 65535,
    270, 272, 656, 65535,
    271, 273, 657, 65535,
    36, 420, 710, 65535,
    37, 421, 711, 65535,
    180, 516, 520, 65535,
    181, 517, 521, 65535,
    132, 518, 564, 65535,
    133, 519, 565, 65535,
    84, 424, 712, 65535,
    85, 425, 713, 65535,
    184, 468, 566, 65535,
    185, 469, 567, 65535,
    228, 422, 568, 65535,
    229, 423, 569, 65535,
    40, 324, 758, 65535,
    41, 325, 759, 65535,
    134, 472, 612, 65535,
    135, 473, 613, 65535,
    136, 470, 614, 65535,
    137, 471, 615, 65535,
    38, 328, 760, 65535,
    39, 329, 761, 65535,
    182, 372, 664, 65535,
    183, 373, 665, 65535,
    86, 374, 708, 65535,
    87, 375, 709, 65535,
    88, 280, 756, 65535,
    89, 281, 757, 65535,
    230, 376, 616, 65535,
    231, 377, 617, 65535,
    232, 326, 660, 65535,
    233, 327, 661, 65535,
    276, 278, 662, 65535,
    277, 279, 663, 65535,
    42, 426, 716, 65535,
    43, 427, 717, 65535,
    186, 522, 526, 65535,
    187, 523, 527, 65535,
    138, 524, 570, 65535,
    139, 525, 571, 65535,
    90, 430, 718, 65535,
    91, 431, 719, 65535,
    190, 474, 572, 65535,
    191, 475, 573, 65535,
    234, 428, 574, 65535,
    235, 429, 575, 65535,
    46, 330, 764, 65535,
    47, 331, 765, 65535,
    140, 478, 618, 65535,
    141, 479, 619, 65535,
    142, 476, 620, 65535,
    143, 477, 621, 65535,
    44, 334, 766, 65535,
    45, 335, 767, 65535,
    188, 378, 670, 65535,
    189, 379, 671, 65535,
    92, 380, 714, 65535,
    93, 381, 715, 65535,
    94, 286, 762, 65535,
    95, 287, 763, 65535,
    236, 382, 622, 65535,
    237, 383, 623, 65535,
    238, 332, 666, 65535,
    239, 333, 667, 65535,
    282, 284, 668, 65535,
    283, 285, 669, 65535,
};

constexpr int NWAVES = 8, NTHREADS = 512;
constexpr int LDS_BYTES = 147456;
constexpr int NPHASE = 12;
#ifndef MK_PER_PHASE
#define MK_PER_PHASE 0
#endif

struct Args { const void* in[17]; float* out; unsigned char* ws; int ph_lo, ph_hi; };

constexpr int TAB_OFF = LDS_BYTES - 1024;
enum { IX_X = 0, IX_MEM, IX_POS, IX_NORM_G, IX_MEM_NORM_G, IX_W_MEM_KV, IX_W_OUT, IX_A_W_IN, IX_A_W_POOL, IX_A_POOL_SCALE, IX_B_W_IN, IX_KV_NORM_G, IX_W_KV, IX_CMP_PE, IX_CMP_W1, IX_CMP_W2, IX_FINAL_G, IX_OUT, IX_WS };
__device__ __forceinline__ int lane_fresh() { int l; asm volatile("v_mbcnt_lo_u32_b32 %0, -1, 0\n\tv_mbcnt_hi_u32_b32 %0, -1, %0" : "=v"(l)); return l; }
struct Frame {
    LAS unsigned char* lds; char* ldsg;
    int wave, vcu, G;
    __device__ __forceinline__ int tid() const { return wave * 64 + lane_fresh(); }
    __device__ __forceinline__ unsigned char* ptr(int k) const {
        volatile LAS unsigned* t = (volatile LAS unsigned*)(lds + TAB_OFF);
        const unsigned lo = t[2 * k], hi = t[2 * k + 1];
        typedef __attribute__((address_space(1))) unsigned char gchar;
        return (unsigned char*)(gchar*)(((unsigned long long)(unsigned)__builtin_amdgcn_readfirstlane(hi) << 32) | (unsigned)__builtin_amdgcn_readfirstlane(lo));
    }
    __device__ __forceinline__ const float* fin(int k) const { return (const float*)ptr(k); }
};
#define WSP(T, off) ((T*)(ws + (off)))

#define XB_TMO      128
#define XB_XCNT(j)  (256  + 64 * (j))
#define XB_XSUB(j)  (1280 + 64 * (j))
#define XB_XGEN(j)  (2304 + 64 * (j))
#define XB_TOP      3328
#define XB_TOPGEN   3392
#define XCD_BAR_WORDS 3456
#define XB_SPIN_CAP (1u << 20)
constexpr int MISC_OFF = LDS_BYTES - 512;
__device__ __forceinline__ unsigned xb_ld(unsigned* p)              { return __hip_atomic_load(p, __ATOMIC_RELAXED, __HIP_MEMORY_SCOPE_AGENT); }
__device__ __forceinline__ unsigned xb_add(unsigned* p, unsigned v) { return __hip_atomic_fetch_add(p, v, __ATOMIC_RELAXED, __HIP_MEMORY_SCOPE_AGENT); }
__device__ __forceinline__ unsigned xb_xcc_id() { return (unsigned)__builtin_amdgcn_s_getreg((3 << 11) | 20) & 0xFu; }
#define XB_SPIN(cond, bar) do { unsigned _sp = 0; while (cond) { __builtin_amdgcn_s_sleep(1); \
    if ((++_sp & 255u) == 0u) { if (xb_ld(&(bar)[XB_TMO])) break; if (_sp > XB_SPIN_CAP) { atomicAdd(&(bar)[XB_TMO], 1u); break; } } } } while (0)
__device__ __forceinline__ void xcd_barrier_complete(unsigned* bar, unsigned x, unsigned G, unsigned& nloc, unsigned& nx) {
    unsigned sum, cnt, mine, sp = 0u;
    for (;;) {
        sum = 0u; cnt = 0u; mine = 0u;
#pragma unroll
        for (unsigned j = 0; j < 16; ++j) { const unsigned c = xb_ld(&bar[XB_XCNT(j)]); sum += c; cnt += (c > 0u) ? 1u : 0u; mine = (j == x) ? c : mine; }
        if (sum == G) break;
        __builtin_amdgcn_s_sleep(1);
        if ((++sp & 255u) == 0u) { if (xb_ld(&bar[XB_TMO])) break; if (sp > XB_SPIN_CAP) { atomicAdd(&bar[XB_TMO], 1u); break; } }
    }
    nloc = mine > 0u ? mine : 1u; nx = cnt > 0u ? cnt : 1u;
}
__device__ __forceinline__ void xcd_barrier(unsigned* bar, volatile LAS unsigned* st, unsigned G, int tid) {
    asm volatile("s_waitcnt vmcnt(0)" ::: "memory");
    __syncthreads();
    if (tid == 0) {
        const unsigned x = xb_xcc_id();
        __builtin_amdgcn_s_waitcnt(0);
        unsigned nloc = st[0], nx = st[1];
        if (nloc == 0u) { xcd_barrier_complete(bar, x, G, nloc, nx); st[0] = nloc; st[1] = nx; }
        const unsigned old = xb_add(&bar[XB_XSUB(x)], 1u);
        const unsigned gen = old / nloc;
        if (old + 1u == (gen + 1u) * nloc) {
            __builtin_amdgcn_fence(__ATOMIC_RELEASE, "agent");
            asm volatile("s_waitcnt vmcnt(0)" ::: "memory");
            const unsigned og = xb_add(&bar[XB_TOP], 1u);
            const unsigned tg = og / nx;
            if (og + 1u == (tg + 1u) * nx) xb_add(&bar[XB_TOPGEN], 1u);
            else XB_SPIN(xb_ld(&bar[XB_TOPGEN]) == tg, bar);
            __builtin_amdgcn_fence(__ATOMIC_ACQUIRE, "agent");
            xb_add(&bar[XB_XGEN(x)], 1u);
            asm volatile("s_waitcnt vmcnt(0)" ::: "memory");
        } else {
            XB_SPIN(xb_ld(&bar[XB_XGEN(x)]) == gen, bar);
            __builtin_amdgcn_fence(__ATOMIC_ACQUIRE, "agent");
            asm volatile("s_waitcnt vmcnt(0)" ::: "memory");
        }
    }
    __syncthreads();
}

struct TDesc { const float* W; const float* gain; bf16* WT; int ldw, c0, nv, ldt, row0, k0; };
__device__ __forceinline__ void tload(const TDesc& d, f32x4 (&v)[16], int lane) {
    const int n4 = (lane & 15) * 4, kr = lane >> 4;
    const float* src = d.W + (size_t)(d.k0 + kr) * d.ldw + d.c0 + n4;
    if (n4 < d.nv) {
#pragma unroll
        for (int i = 0; i < 16; ++i) v[i] = __builtin_nontemporal_load((const f32x4*)(src + (size_t)(4 * i) * d.ldw));
    } else {
#pragma unroll
        for (int i = 0; i < 16; ++i) v[i] = (f32x4){0.f, 0.f, 0.f, 0.f};
    }
}
__device__ __forceinline__ void tproc(const TDesc& d, f32x4 (&v)[16], LAS float* scr, int lane) {
    const int n4 = (lane & 15) * 4, kr = lane >> 4;
    if (d.gain) {
#pragma unroll
        for (int i = 0; i < 16; ++i) v[i] = v[i] * d.gain[d.k0 + kr + 4 * i];
    }
#pragma unroll
    for (int i = 0; i < 16; ++i) { LAS float* q = scr + (kr + 4 * i) * 65 + n4; q[0] = v[i][0]; q[1] = v[i][1]; q[2] = v[i][2]; q[3] = v[i][3]; }
    LDS_WAIT(); asm volatile("" ::: "memory");
    const int ch = lane & 7;
#pragma unroll
    for (int j = 0; j < 8; ++j) { const int n = (lane >> 3) + 8 * j; const LAS float* s = scr + (8 * ch) * 65 + n;
        v4u o; o.x = pk2(s[0 * 65], s[1 * 65]); o.y = pk2(s[2 * 65], s[3 * 65]); o.z = pk2(s[4 * 65], s[5 * 65]); o.w = pk2(s[6 * 65], s[7 * 65]);
        if (n < d.nv) *(v4u*)(d.WT + (size_t)(d.row0 + n) * d.ldt + d.k0 + 8 * ch) = o; }
    LDS_WAIT(); asm volatile("" ::: "memory");
}
__device__ __forceinline__ void rms_load(const float* xrow, f32x4 (&v)[8], int lane) {
    const f32x4* xr = (const f32x4*)xrow + lane;
#pragma unroll
    for (int j = 0; j < 8; ++j) v[j] = __builtin_nontemporal_load(xr + 64 * j);
}
__device__ __forceinline__ void rms_finish(f32x4 (&v)[8], const float* g, bf16* orow, int lane) {
    float s = 0.f;
#pragma unroll
    for (int j = 0; j < 8; ++j) s += (v[j].x * v[j].x + v[j].y * v[j].y) + (v[j].z * v[j].z + v[j].w * v[j].w);
    const float rinv = 1.0f / sqrtf(wave_sum(s) * (1.f / DM) + EPS);
    unsigned long long* o8 = (unsigned long long*)orow + lane;
#pragma unroll
    for (int j = 0; j < 8; ++j) { f32x4 gg = g ? ((const f32x4*)g)[64 * j + lane] : (f32x4){1.f, 1.f, 1.f, 1.f};
        o8[64 * j] = (unsigned long long)pk2(v[j].x * rinv * gg.x, v[j].y * rinv * gg.y) | ((unsigned long long)pk2(v[j].z * rinv * gg.z, v[j].w * rinv * gg.w) << 32); }
}
__device__ __forceinline__ void sincos_acc(float angf, float& c, float& s) {
    const double a = (double)angf;
    const double kq = rint(a * 0.63661977236758134308);
    const double r = fma(-kq, 6.123233995736766e-17, fma(-kq, 1.5707963267948966, a));
    const double r2 = r * r;
    double sp = -2.5052108385441718775e-08; sp = fma(sp, r2, 2.7557319223985890653e-06); sp = fma(sp, r2, -1.9841269841269841270e-04); sp = fma(sp, r2, 8.3333333333333332177e-03); sp = fma(sp, r2, -1.6666666666666665741e-01);
    const double sn = fma(sp * r2, r, r) + r2 * r2 * r2 * r2 * r2 * r2 * r * 1.6059043836821614599e-10;
    double cp = 2.0876756987868098979e-09; cp = fma(cp, r2, -2.7557319223985890653e-07); cp = fma(cp, r2, 2.4801587301587301566e-05); cp = fma(cp, r2, -1.3888888888888889419e-03); cp = fma(cp, r2, 4.1666666666666664354e-02); cp = fma(cp, r2, -0.5);
    const double cs = fma(cp, r2, 1.0);
    const int q = ((int)kq) & 3;
    const double sv = (q & 1) ? cs : sn, cv = (q & 1) ? sn : cs;
    s = (float)((q & 2) ? -sv : sv);
    c = (float)(((q + 1) & 2) ? -cv : cv);
}
__device__ __forceinline__ float rope_inv(int i) {
    return (float)exp2(-(double)i * (18.931568569324174 / 16.0));
}

template <int WHICH>
__device__ __forceinline__ void transposes(Frame& F, int gw, int NGW, int lane) {
    unsigned char* ws = F.ptr(IX_WS);
    LAS float* scr = (LAS float*)(F.lds + F.wave * 16640);
    const float* a_w_in = F.fin(IX_A_W_IN); const float* w_out = F.fin(IX_W_OUT); const float* w_kv = F.fin(IX_W_KV); const float* b_w_in = F.fin(IX_B_W_IN);
    const float* norm_g = F.fin(IX_NORM_G); const float* kv_norm_g = F.fin(IX_KV_NORM_G); const float* mem_norm_g = F.fin(IX_MEM_NORM_G); const float* w_mem_kv = F.fin(IX_W_MEM_KV);
    const float* a_w_pool = F.fin(IX_A_W_POOL); const float* cmp_w1 = F.fin(IX_CMP_W1);
    bf16* W1T = WSP(bf16, WS_W1T); bf16* WO0T = WSP(bf16, WS_WO0T); bf16* W4T = WSP(bf16, WS_W4T); bf16* WO1T = WSP(bf16, WS_WO1T);
    bf16* WMT = WSP(bf16, WS_WMT); bf16* WPT = WSP(bf16, WS_WPT); bf16* WC1T = WSP(bf16, WS_WC1T);
#define SEG(W_, ldw_, K_, c0_, nc_, WT_, row0_, gain_) if (!done_) { const int nb_ = ((nc_) + 63) / 64, ni_ = ((K_) / 64) * nb_; \
        if (r < ni_) { const int kb = r / nb_, nb = r % nb_; int nv = (nc_) - nb * 64; nv = nv > 64 ? 64 : nv; \
            d.W = W_; d.gain = gain_; d.WT = WT_; d.ldw = ldw_; d.c0 = (c0_) + nb * 64; d.nv = nv; d.ldt = K_; d.row0 = (row0_) + nb * 64; d.k0 = kb * 64; done_ = true; } else r -= ni_; }
#define TDECODE(it_, dd_) do { TDesc& d = (dd_); int r = (it_); bool done_ = false; \
      if constexpr (WHICH == 0) { \
        SEG(a_w_in, N1, DM, 0, N1, W1T, 0, nullptr) \
        SEG(w_mem_kv, 1024, DM, 0, 1024, WMT, 0, mem_norm_g) \
      } else { \
        SEG(w_out, DM, DM, 0, DM, WO0T, 0, nullptr) \
        SEG(w_out + (size_t)DM * DM, DM, DM, 0, DM, WO1T, 0, nullptr) \
        SEG(w_kv, NKV, DM, 0, NKV, W4T, 0, kv_norm_g) \
        SEG(b_w_in, 4132, DM, 0, 1536, W4T, 3072, norm_g + DM)            \
        SEG(b_w_in, 4132, DM, 1572, 1536, W4T, 4608, norm_g + DM)         \
        SEG(b_w_in, 4132, DM, 3108, 512, W4T, 6144, norm_g + DM)          \
        SEG(b_w_in, 4132, DM, 3620, 512, W4T, 6656, norm_g + DM)          \
        SEG(b_w_in, 4132, DM, 1536, 36, W4T, 7168, norm_g + DM)           \
        SEG(w_mem_kv + (size_t)DM * 1024, 1024, DM, 0, 1024, WMT + (size_t)1024 * DM, 0, mem_norm_g + DM) \
        SEG(a_w_pool + 0 * 384 * 384, 384, 384, 0, 384, WPT + 0 * 512 * 384, 0, nullptr) \
        SEG(a_w_pool + 1 * 384 * 384, 384, 384, 0, 384, WPT + 1 * 512 * 384, 0, nullptr) \
        SEG(a_w_pool + 2 * 384 * 384, 384, 384, 0, 384, WPT + 2 * 512 * 384, 0, nullptr) \
        SEG(a_w_pool + 3 * 384 * 384, 384, 384, 0, 384, WPT + 3 * 512 * 384, 0, nullptr) \
        SEG(cmp_w1, 256, 4096, 0, 256, WC1T, 0, nullptr) \
        SEG(cmp_w1 + (size_t)4096 * 256, 256, 4096, 0, 256, WC1T + (size_t)256 * 4096, 0, nullptr) \
      } \
    } while (0)
    constexpr int NITEMS = WHICH == 0 ? 32 * 64 + 32 * 16 : 2 * 32 * 32 + 32 * 48 + 32 * (24 + 24 + 8 + 8 + 1) + 32 * 16 + 4 * 6 * 6 + 2 * 64 * 4;
    {
        TDesc da{}, db{}; f32x4 va[16], vb[16];
        if (gw < NITEMS) { TDECODE(gw, da); tload(da, va, lane); }
        for (int it = gw; it < NITEMS; it += 2 * NGW) {
            const bool hb = it + NGW < NITEMS;
            if (hb) { TDECODE(it + NGW, db); tload(db, vb, lane); }
            tproc(da, va, scr, lane);
            if (it + 2 * NGW < NITEMS) { TDECODE(it + 2 * NGW, da); tload(da, va, lane); }
            if (hb) tproc(db, vb, scr, lane);
        }
    }
#undef TDECODE
#undef SEG
}

__device__ __forceinline__ void p0_prologue(Frame& F) {
    const int tid = F.tid(), lane = tid & 63; unsigned char* ws = F.ptr(IX_WS);
    const int gw = F.vcu * NWAVES + F.wave, NGW = F.G * NWAVES;
    const float* norm_g = F.fin(IX_NORM_G); const float* cmp_w1 = F.fin(IX_CMP_W1);
    bf16* W4T = WSP(bf16, WS_W4T); bf16* WPT = WSP(bf16, WS_WPT);
    transposes<0>(F, gw, NGW, lane);
    transposes<1>(F, gw, NGW, lane);
    bf16* XN = WSP(bf16, WS_B); bf16* MEMN = WSP(bf16, WS_MEMN);
    { const float* xin = F.fin(IX_X); const float* memin = F.fin(IX_MEM);
      constexpr int NROWS = MTOK + NB * MEMLEN;
      for (int m = gw; m < NROWS; m += 4 * NGW) {
          f32x4 a[8], b[8], c[8], d[8];
          const int m1 = m + NGW, m2 = m + 2 * NGW, m3 = m + 3 * NGW;
#define RSRC(mm) ((mm) < MTOK ? xin + (size_t)(mm) * DM : memin + (size_t)((mm) - MTOK) * DM)
#define RFIN(mm, v) do { if ((mm) < MTOK) rms_finish(v, norm_g, XN + (size_t)(mm) * DM, lane); else rms_finish(v, nullptr, MEMN + (size_t)((mm) - MTOK) * DM, lane); } while (0)
          rms_load(RSRC(m), a, lane);
          if (m1 < NROWS) rms_load(RSRC(m1), b, lane);
          if (m2 < NROWS) rms_load(RSRC(m2), c, lane);
          if (m3 < NROWS) rms_load(RSRC(m3), d, lane);
          RFIN(m, a);
          if (m1 < NROWS) RFIN(m1, b);
          if (m2 < NROWS) RFIN(m2, c);
          if (m3 < NROWS) RFIN(m3, d);
#undef RSRC
#undef RFIN
      } }
    const int gt = F.vcu * NTHREADS + tid, NGT = F.G * NTHREADS; const int* positions = (const int*)F.ptr(IX_POS);
    float* ROPE = WSP(float, WS_ROPE); float* ROPEC = WSP(float, WS_ROPEC);
    {
    for (int i = gt; i < MTOK * 16; i += NGT) { const int tok = i >> 4, fi = i & 15;
        const float ang = (float)positions[tok] * rope_inv(fi); float c, s; sincos_acc(ang, c, s);
        ROPE[tok * 32 + fi] = c; ROPE[tok * 32 + 16 + fi] = s; }
    for (int i = gt; i < NB * 256 * 16; i += NGT) { const int bn = i >> 4, fi = i & 15, b = bn >> 8, n = bn & 255;
        float c = 1.f, s = 0.f;
        if (n < NCMP) { const float ang = (float)positions[b * SEQ + 16 * n + 31] * rope_inv(fi); sincos_acc(ang, c, s); }
        ROPEC[bn * 32 + fi] = c; ROPEC[bn * 32 + 16 + fi] = s; }
    }
    { v4u z = {0u, 0u, 0u, 0u};
      v4u* p = (v4u*)(W4T + (size_t)7204 * DM); for (int i = gt; i < 220 * DM / 8; i += NGT) p[i] = z;
      for (int g = 0; g < 4; ++g) { v4u* q = (v4u*)(WPT + (size_t)g * 512 * 384 + 384 * 384); for (int i = gt; i < 128 * 384 / 8; i += NGT) q[i] = z; }
      v4u* kvp = (v4u*)(WSP(bf16, WS_KVB) + (size_t)MTOK * NKV); for (int i = gt; i < 32 * NKV / 8; i += NGT) kvp[i] = z;
      for (int b = 0; b < NB; ++b) { v4u* k = (v4u*)(WSP(bf16, WS_KCMP) + (size_t)(b * 256 + 255) * 512); v4u* v = (v4u*)(WSP(bf16, WS_VCMP) + (size_t)(b * 256 + 255) * 512);
          for (int i = gt; i < 512 / 8; i += NGT) { k[i] = z; v[i] = z; } } }
    __syncthreads();
    for (int item = F.vcu; item < 64; item += F.G) {
        const int ks = item & 7, kv = (item >> 3) & 1, j = (item >> 4) * 64 + lane; const float* pe = F.fin(IX_CMP_PE) + kv * 4096; const float* w1 = cmp_w1 + (size_t)kv * 4096 * 256;
        float a = 0.f; const int kb = ks * 512 + F.wave * 64;
#pragma unroll 8
        for (int k = kb; k < kb + 64; ++k) a = fmaf(pe[k], w1[(size_t)k * 256 + j], a);
        LAS float* red = (LAS float*)F.lds;
        red[F.wave * 64 + lane] = a; __syncthreads();
        if (F.wave == 0) { float t = 0.f; for (int w = 0; w < 8; ++w) t += red[w * 64 + lane]; WSP(float, WS_CBIAS)[(ks * 2 + kv) * 256 + j] = t; }
        __syncthreads();
    }
}

__device__ __forceinline__ void st_bf4(bf16* p, f32x4 v) { v2u w; w.x = cvtpk(v[0], v[1]); w.y = cvtpk(v[2], v[3]); *(v2u*)p = w; }
__device__ __forceinline__ f32x4 silu4(f32x4 v) { return (f32x4){silu_f(v[0]), silu_f(v[1]), silu_f(v[2]), silu_f(v[3])}; }
__device__ __forceinline__ void p2_pool(Frame& F) {
    unsigned char* ws = F.ptr(IX_WS);
    {
        const float* SL = (const float*)(ws + WS_D); bf16* MKV0 = WSP(bf16, WS_MKV);
        const int gt0 = F.vcu * NTHREADS + F.tid(), NGT0 = F.G * NTHREADS;
        for (int i = gt0; i < 2 * 1024 * 1024 / 4; i += NGT0) { const float* s0 = SL + (size_t)(i >> 18) * 8 * 1024 * 1024 + (size_t)(i & 262143) * 4; f32x4 a = *(const f32x4*)s0;
#pragma unroll
            for (int z = 1; z < 8; ++z) a += *(const f32x4*)(s0 + (size_t)z * 1024 * 1024);
            st_bf4(MKV0 + (size_t)i * 4, a); }
    }
    const bf16* PROJ = WSP(bf16, WS_A); bf16* POOLED = WSP(bf16, WS_C);
    const int gt = F.vcu * NTHREADS + F.tid(), NGT = F.G * NTHREADS;
    constexpr int NV = POOLW / 8;
    for (int idx = gt; idx < (MTOK / 32) * NV; idx += NGT) {
        const int vec = idx % NV, chunk = idx / NV, g = vec / 48, win = 2 << g;
        const int row0 = chunk * 32, tb0 = row0 & (SEQ - 1);
        const bf16* up = PROJ + (size_t)row0 * N1 + vec * 8;
        float S[8];
#pragma unroll
        for (int e = 0; e < 8; ++e) S[e] = 0.f;
        for (int i = 1; i < win; ++i) if (tb0 - i >= 0) { const v4u w = *(const v4u*)(up - (size_t)i * N1);
            S[0] += bflo(w.x); S[1] += bfhi(w.x); S[2] += bflo(w.y); S[3] += bfhi(w.y); S[4] += bflo(w.z); S[5] += bfhi(w.z); S[6] += bflo(w.w); S[7] += bfhi(w.w); }
        for (int t = 0; t < 32; ++t) {
            const v4u w = *(const v4u*)(up + (size_t)t * N1);
            float u[8] = {bflo(w.x), bfhi(w.x), bflo(w.y), bfhi(w.y), bflo(w.z), bfhi(w.z), bflo(w.w), bfhi(w.w)};
            const int tb = tb0 + t; const float inv = 1.0f / (float)(tb + 1 < win ? tb + 1 : win);
            float o[8];
#pragma unroll
            for (int e = 0; e < 8; ++e) { S[e] += u[e]; o[e] = S[e] * inv - u[e]; }
            v4u ow; ow.x = pk2(o[0], o[1]); ow.y = pk2(o[2], o[3]); ow.z = pk2(o[4], o[5]); ow.w = pk2(o[6], o[7]);
            *(v4u*)(POOLED + (size_t)(row0 + t) * POOLW + vec * 8) = ow;
            if (tb - win + 1 >= 0) { const v4u x = *(const v4u*)(up + (ptrdiff_t)(t - win + 1) * N1);
                S[0] -= bflo(x.x); S[1] -= bfhi(x.x); S[2] -= bflo(x.y); S[3] -= bfhi(x.y); S[4] -= bflo(x.z); S[5] -= bfhi(x.z); S[6] -= bflo(x.w); S[7] -= bfhi(x.w); }
        }
    }
}

struct SchedLin {
    int nM, nN, nz, G, c, wgm;
    const char* A; const char* B; size_t a_pm, a_z, b_pn, b_z;
    int xM, xN; const char* XA; const char* XB; size_t xa_pm, xb_pn;
    __device__ __forceinline__ bool next(int i, pg8::Unit& u) const {
        const long L = (long)i * G + c; const int per = nM * nN; const long tot = (long)per * nz;
        if (L < tot) { const int z = (int)(L / per); int pm, pn; pg8::tile_swz((int)(L % per), nM, nN, wgm, pm, pn);
            u.pm = pm; u.pn = pn; u.z = z; u.kind = 0; u.a = A + pm * a_pm + z * a_z; u.b = B + pn * b_pn + z * b_z; return true; }
        const long X = L - tot; if (X >= (long)xM * xN) return false;
        u.pm = (int)(X / xN); u.pn = (int)(X % xN); u.z = 0; u.kind = 1; u.a = XA + u.pm * xa_pm; u.b = XB + u.pn * xb_pn; return true;
    }
};
struct SchedCmp {
    int G, c; const char* KV; const char* W;
    __device__ __forceinline__ bool next(int i, pg8::Unit& u) const {
        const int L = i * G + c; if (L >= 256) return false;
        const int pm = L & 15, kv = (L >> 4) & 1, ks = L >> 5, b = pm >> 2, g = pm & 3;
        u.pm = pm; u.pn = 0; u.z = ks * 2 + kv; u.kind = 0;
        u.a = KV + ((size_t)((kv * 4 + b) * 4 + g) * SEQ * 128 + ks * 512) * 2;
        u.b = W + ((size_t)kv * 256 * 4096 + ks * 512) * 2;
        return true;
    }
};

struct SchedMem {
    int G, c; const char* A; const char* B;
    __device__ __forceinline__ bool next(int i, pg8::Unit& u) const {
        const int L = i * G + c; if (L >= 256) return false;
        const int pm = L & 3, pn = (L >> 2) & 3, ks = (L >> 4) & 7, layer = L >> 7;
        u.pm = pm; u.pn = pn; u.z = layer * 8 + ks; u.kind = 0;
        u.a = A + (size_t)pm * 256 * DM * 2 + ks * 512;
        u.b = B + ((size_t)layer * 1024 + pn * 256) * DM * 2 + ks * 512;
        return true;
    }
};
struct SchedGate {
    int G, c; const char* A; const char* B;
    __device__ __forceinline__ bool next(int i, pg8::Unit& u) const {
        const int L = i * G + c; if (L >= 256) return false;
        const int pm = L >> 2, ks = L & 3;
        u.pm = pm; u.pn = 0; u.z = ks; u.kind = 0;
        u.a = A + (size_t)pm * 256 * DM * 2 + ks * 1024;
        u.b = B + ks * 1024;
        return true;
    }
};

#define EPI_ROWS(ai, m) (u.pm * 256 + (ai) * 128 + wr * 64 + (m) * 16 + fr)
#define EPI_COL(bj, n) ((bj) * 128 + wc * 32 + (n) * 16 + fq * 4)
typedef f32x4 acc_t[2][2][4][2];

#define EPI_C8(bj) (64 * wc + 32 * (bj) + 8 * fq)
__device__ __forceinline__ void st_bf8(bf16* p, f32x4 a, f32x4 b) { v4u w; w.x = cvtpk(a[0], a[1]); w.y = cvtpk(a[2], a[3]); w.z = cvtpk(b[0], b[1]); w.w = cvtpk(b[2], b[3]); *(v4u*)p = w; }
struct Epi1 {
    static constexpr bool PERM = true;
    bf16* proj;
    struct State {};
    __device__ __forceinline__ void begin(acc_t& acc, State&, const pg8::Unit&, int, int, int, int) const {
#pragma unroll
        for (int a = 0; a < 2; ++a)
#pragma unroll
            for (int b = 0; b < 2; ++b)
#pragma unroll
                for (int m = 0; m < 4; ++m)
#pragma unroll
                    for (int n = 0; n < 2; ++n) acc[a][b][m][n] = (f32x4){0.f, 0.f, 0.f, 0.f};
    }
    __device__ __forceinline__ void operator()(const acc_t& acc, State&, const pg8::Unit& u, int wr, int wc, int fr, int fq) const {
        const bool act = (u.pn >= 6 && u.pn < 12) || u.pn >= 14;
#pragma unroll
        for (int ai = 0; ai < 2; ++ai)
#pragma unroll
            for (int m = 0; m < 4; ++m) { bf16* rowp = proj + (size_t)EPI_ROWS(ai, m) * N1 + u.pn * 256;
#pragma unroll
                for (int bj = 0; bj < 2; ++bj) { f32x4 v0 = acc[ai][bj][m][0], v1 = acc[ai][bj][m][1]; if (act) { v0 = silu4(v0); v1 = silu4(v1); } st_bf8(rowp + EPI_C8(bj), v0, v1); } }
    }
};
struct Epi3 {
    static constexpr bool PERM = true;
    const float* scale; const bf16* proj; bf16* y0;
    struct State {};
    __device__ __forceinline__ void begin(acc_t& acc, State&, const pg8::Unit&, int, int, int, int) const {
#pragma unroll
        for (int a = 0; a < 2; ++a)
#pragma unroll
            for (int b = 0; b < 2; ++b)
#pragma unroll
                for (int m = 0; m < 4; ++m)
#pragma unroll
                    for (int n = 0; n < 2; ++n) acc[a][b][m][n] = (f32x4){0.f, 0.f, 0.f, 0.f};
    }
    __device__ __forceinline__ void operator()(const acc_t& acc, State&, const pg8::Unit& u, int wr, int wc, int fr, int fq) const {
        const int g = u.z;
#pragma unroll
        for (int ai = 0; ai < 2; ++ai)
#pragma unroll
            for (int m = 0; m < 4; ++m) { const size_t row = EPI_ROWS(ai, m);
#pragma unroll
                for (int bj = 0; bj < 2; ++bj) { const int d = u.pn * 256 + EPI_C8(bj);
                    if (d < 384) {
                        const f32x4 sc0 = *(const f32x4*)(scale + g * 384 + d), sc1 = *(const f32x4*)(scale + g * 384 + d + 4);
                        const v4u zw = *(const v4u*)(proj + row * N1 + POOLW + g * 384 + d);
                        f32x4 v0 = acc[ai][bj][m][0] * sc0, v1 = acc[ai][bj][m][1] * sc1;
                        v0[0] *= bflo(zw.x); v0[1] *= bfhi(zw.x); v0[2] *= bflo(zw.y); v0[3] *= bfhi(zw.y); v1[0] *= bflo(zw.z); v1[1] *= bfhi(zw.z); v1[2] *= bflo(zw.w); v1[3] *= bfhi(zw.w);
                        st_bf8(y0 + row * DM + g * 384 + d, v0, v1); } }
                asm volatile("" ::: "memory"); }
    }
};
template <bool RES_BF16>
struct EpiRes {
    static constexpr bool PERM = true;
    const void* res; bf16* hb; float* ss;
    struct State {};
    __device__ __forceinline__ void begin(acc_t& acc, State&, const pg8::Unit& u, int wr, int wc, int fr, int fq) const {
#pragma unroll
        for (int ai = 0; ai < 2; ++ai)
#pragma unroll
            for (int m = 0; m < 4; ++m) { const size_t row = EPI_ROWS(ai, m);
#pragma unroll
                for (int bj = 0; bj < 2; ++bj) { const size_t off = row * DM + u.pn * 256 + EPI_C8(bj);
                    if constexpr (RES_BF16) { const v4u w = *(const v4u*)((const bf16*)res + off);
                        acc[ai][bj][m][0] = (f32x4){bflo(w.x), bfhi(w.x), bflo(w.y), bfhi(w.y)}; acc[ai][bj][m][1] = (f32x4){bflo(w.z), bfhi(w.z), bflo(w.w), bfhi(w.w)}; }
                    else { acc[ai][bj][m][0] = __builtin_nontemporal_load((const f32x4*)((const float*)res + off)); acc[ai][bj][m][1] = __builtin_nontemporal_load((const f32x4*)((const float*)res + off + 4)); } } }
    }
    __device__ __forceinline__ void operator()(const acc_t& acc, State&, const pg8::Unit& u, int wr, int wc, int fr, int fq) const {
#pragma unroll
        for (int ai = 0; ai < 2; ++ai)
#pragma unroll
            for (int m = 0; m < 4; ++m) { const size_t row = EPI_ROWS(ai, m); float s = 0.f;
#pragma unroll
                for (int bj = 0; bj < 2; ++bj) { const f32x4 h0 = acc[ai][bj][m][0], h1 = acc[ai][bj][m][1];
                    st_bf8(hb + row * DM + u.pn * 256 + EPI_C8(bj), h0, h1);
                    s += (h0[0] * h0[0] + h0[1] * h0[1]) + (h0[2] * h0[2] + h0[3] * h0[3]) + (h1[0] * h1[0] + h1[1] * h1[1]) + (h1[2] * h1[2] + h1[3] * h1[3]); }
                s += __shfl_xor(s, 16); s += __shfl_xor(s, 32);
                if (fq == 0) ss[row * 32 + u.pn * 4 + wc] = s; }
    }
};
struct Epi5 {
    static constexpr bool PERM = true;
    const float* ss1; const float* rope; bf16 *kv, *q1, *zq, *qm1, *zm1;
    struct State { float rinv[2][4]; };
    __device__ __forceinline__ void begin(acc_t& acc, State& st, const pg8::Unit& u, int wr, int wc, int fr, int fq) const {
#pragma unroll
        for (int a = 0; a < 2; ++a)
#pragma unroll
            for (int b = 0; b < 2; ++b)
#pragma unroll
                for (int m = 0; m < 4; ++m)
#pragma unroll
                    for (int n = 0; n < 2; ++n) acc[a][b][m][n] = (f32x4){0.f, 0.f, 0.f, 0.f};
        {
#pragma unroll
            for (int ai = 0; ai < 2; ++ai)
#pragma unroll
                for (int m = 0; m < 4; ++m) { const size_t row = EPI_ROWS(ai, m);
                    const float* sp = ss1 + row * 32 + fq * 8; const f32x4 s0 = *(const f32x4*)sp, s1 = *(const f32x4*)(sp + 4);
                    float s = (s0[0] + s0[1]) + (s0[2] + s0[3]) + (s1[0] + s1[1]) + (s1[2] + s1[3]);
                    s += __shfl_xor(s, 16); s += __shfl_xor(s, 32);
                    st.rinv[ai][m] = 1.0f / sqrtf(s * (1.f / DM) + EPS); }
        }
    }
    __device__ __forceinline__ void operator()(const acc_t& acc, State& st, const pg8::Unit& u, int wr, int wc, int fr, int fq) const {
        const int pn = u.pn;
        bf16* base; int ld, c0; bool dorope = false, act = false;
        const bool kvt = pn < 12;
        if (kvt) { base = kv; ld = 128; c0 = 0; dorope = ((pn >> 1) == 2) || ((pn >> 1) == 4); }
        else if (pn < 18) { base = q1; ld = NSAW; c0 = (pn - 12) * 256; dorope = true; }
        else if (pn < 24) { base = zq; ld = NSAW; c0 = (pn - 18) * 256; act = true; }
        else if (pn < 26) { base = qm1; ld = MEMW; c0 = (pn - 24) * 256; }
        else { base = zm1; ld = MEMW; c0 = (pn - 26) * 256; act = true; }
        const bool rp = dorope && (wc & 1) == 0;
#pragma unroll
        for (int ai = 0; ai < 2; ++ai)
#pragma unroll
            for (int m = 0; m < 4; ++m) { const size_t row = EPI_ROWS(ai, m);
                const float rinv = st.rinv[ai][m];
#pragma unroll
                for (int bj = 0; bj < 2; ++bj) {
                    f32x4 v0 = acc[ai][bj][m][0] * rinv, v1 = acc[ai][bj][m][1] * rinv;
                    if (bj == 0 && rp) {
                        const int fi = 8 * (fq & 1);
                        const f32x4 c0v = *(const f32x4*)(rope + row * 32 + fi), c1v = *(const f32x4*)(rope + row * 32 + fi + 4);
                        const f32x4 s0v = *(const f32x4*)(rope + row * 32 + 16 + fi), s1v = *(const f32x4*)(rope + row * 32 + 16 + fi + 4);
                        f32x4 p0, p1;
#pragma unroll
                        for (int j = 0; j < 4; ++j) { p0[j] = __shfl_xor(v0[j], 32); p1[j] = __shfl_xor(v1[j], 32); }
                        if (fq < 2) { v0 = v0 * c0v - p0 * s0v; v1 = v1 * c1v - p1 * s1v; }
                        else { v0 = v0 * c0v + p0 * s0v; v1 = v1 * c1v + p1 * s1v; }
                    }
                    if (act) { v0 = silu4(v0); v1 = silu4(v1); }
                    if (kvt) { const int g = (pn & 1) * 2 + (wc >> 1), d = 64 * (wc & 1) + 32 * bj + 8 * fq; const size_t b = row >> 12, t = row & (SEQ - 1);
                        st_bf8(kv + ((((size_t)(pn >> 1) * 4 + b) * 4 + g) * SEQ + t) * 128 + d, v0, v1); }
                    else st_bf8(base + row * ld + c0 + EPI_C8(bj), v0, v1); } }
    }
};
struct Epi6 {
    static constexpr bool PERM = false;
    float* base; int ld; size_t plane;
    struct State {};
    __device__ __forceinline__ void begin(acc_t& acc, State&, const pg8::Unit&, int, int, int, int) const {
#pragma unroll
        for (int a = 0; a < 2; ++a)
#pragma unroll
            for (int b = 0; b < 2; ++b)
#pragma unroll
                for (int m = 0; m < 4; ++m)
#pragma unroll
                    for (int n = 0; n < 2; ++n) acc[a][b][m][n] = (f32x4){0.f, 0.f, 0.f, 0.f};
    }
    __device__ __forceinline__ void operator()(const acc_t& acc, State&, const pg8::Unit& u, int wr, int wc, int fr, int fq) const {
        float* b0 = base + (size_t)u.z * plane + u.pn * 256;
#pragma unroll
        for (int ai = 0; ai < 2; ++ai)
#pragma unroll
            for (int m = 0; m < 4; ++m) { float* rowp = b0 + (size_t)EPI_ROWS(ai, m) * ld;
#pragma unroll
                for (int bj = 0; bj < 2; ++bj)
#pragma unroll
                    for (int n = 0; n < 2; ++n) *(f32x4*)(rowp + EPI_COL(bj, n)) = acc[ai][bj][m][n]; }
    }
};
struct EpiG {
    static constexpr bool PERM = true;
    float* slab;
    struct State {};
    __device__ __forceinline__ void begin(acc_t& acc, State&, const pg8::Unit&, int, int, int, int) const {
#pragma unroll
        for (int a = 0; a < 2; ++a)
#pragma unroll
            for (int b = 0; b < 2; ++b)
#pragma unroll
                for (int m = 0; m < 4; ++m)
#pragma unroll
                    for (int n = 0; n < 2; ++n) acc[a][b][m][n] = (f32x4){0.f, 0.f, 0.f, 0.f};
    }
    __device__ __forceinline__ void operator()(const acc_t& acc, State&, const pg8::Unit& u, int wr, int wc, int fr, int fq) const {
        if (wc != 0) return;
        float* b0 = slab + (size_t)u.z * MTOK * 36;
#pragma unroll
        for (int ai = 0; ai < 2; ++ai)
#pragma unroll
            for (int m = 0; m < 4; ++m) { float* rowp = b0 + (size_t)EPI_ROWS(ai, m) * 36;
                *(f32x4*)(rowp + 8 * fq) = acc[ai][0][m][0]; *(f32x4*)(rowp + 8 * fq + 4) = acc[ai][0][m][1];
                if (fq == 0) *(f32x4*)(rowp + 32) = acc[ai][1][m][0]; }
    }
};

__device__ __forceinline__ void gates_finish(Frame& F) {
    unsigned char* ws = F.ptr(IX_WS); const float* SL = WSP(float, WS_C); const float* SS1 = WSP(float, WS_SS1); float* GATES = WSP(float, WS_GATES);
    const int gt = F.vcu * NTHREADS + F.tid(), NGT = F.G * NTHREADS;
    for (int i = gt; i < MTOK * 9; i += NGT) { const int row = i / 9, c4 = (i - row * 9) * 4;
        f32x4 s = {0.f, 0.f, 0.f, 0.f};
#pragma unroll
        for (int q = 0; q < 8; ++q) s += *(const f32x4*)(SS1 + (size_t)row * 32 + q * 4);
        const float rinv = 1.0f / sqrtf(((s[0] + s[1]) + (s[2] + s[3])) * (1.f / DM) + EPS);
        f32x4 a = *(const f32x4*)(SL + (size_t)row * 36 + c4);
#pragma unroll
        for (int z = 1; z < 4; ++z) a += *(const f32x4*)(SL + (size_t)z * MTOK * 36 + (size_t)row * 36 + c4);
        a = a * rinv;
        *(f32x4*)(GATES + (size_t)row * 36 + c4) = (f32x4){sigmoid_f(a[0]), sigmoid_f(a[1]), sigmoid_f(a[2]), sigmoid_f(a[3])}; }
}
__device__ __forceinline__ void p7_cmp2(Frame& F) {
    unsigned char* ws = F.ptr(IX_WS); const float* cmp_w2 = F.fin(IX_CMP_W2); bf16* KCo = WSP(bf16, WS_KCMP); bf16* VCo = WSP(bf16, WS_VCMP);
    const float* HID = WSP(float, WS_B); const float* CB = WSP(float, WS_CBIAS); const float* ROPEC = WSP(float, WS_ROPEC);
    LAS float* hs = (LAS float*)F.lds;
    LAS float* os = hs + 16 * 256;
    const int tid = F.tid();
    for (int unit = F.vcu; unit < 512; unit += F.G) {
        const int kv = unit >> 8, rg = unit & 255, row0 = rg * 16;
        { const int r = tid >> 5, c8 = (tid & 31) * 8; f32x4 a0 = {0.f, 0.f, 0.f, 0.f}, a1 = {0.f, 0.f, 0.f, 0.f};
          for (int ks = 0; ks < 8; ++ks) { const float* cb = CB + (ks * 2 + kv) * 256 + c8; a0 += *(const f32x4*)cb; a1 += *(const f32x4*)(cb + 4); }
          for (int ks = 0; ks < 8; ++ks) { const float* p = HID + ((size_t)(ks * 2 + kv) * 4096 + row0 + r) * 256 + c8; a0 += *(const f32x4*)p; a1 += *(const f32x4*)(p + 4); }
          LAS float* d = hs + r * 256 + c8;
          d[0] = silu_f(a0[0]); d[1] = silu_f(a0[1]); d[2] = silu_f(a0[2]); d[3] = silu_f(a0[3]); d[4] = silu_f(a1[0]); d[5] = silu_f(a1[1]); d[6] = silu_f(a1[2]); d[7] = silu_f(a1[3]); }
        __syncthreads();
        const int r = tid >> 5, dg = tid & 31; const float* w2 = cmp_w2 + (size_t)kv * 256 * 128 + dg * 4;
        f32x4 a = {0.f, 0.f, 0.f, 0.f};
#pragma unroll 8
        for (int j = 0; j < 256; ++j) { const float h = hs[r * 256 + j]; a += *(const f32x4*)(w2 + j * 128) * h; }
        LAS float* od = os + r * 128 + dg * 4; od[0] = a[0]; od[1] = a[1]; od[2] = a[2]; od[3] = a[3];
        __syncthreads();
        const int row = row0 + r, bg = row >> 8, n = row & 255, b = bg >> 2, g = bg & 3;
        if (n < NCMP) {
            float o[4];
#pragma unroll
            for (int e = 0; e < 4; ++e) { const int d = dg * 4 + e; float v = os[r * 128 + d];
                if (kv == 0 && d < 32) { const int fi = d & 15; const float c = ROPEC[(b * 256 + n) * 32 + fi], s = ROPEC[(b * 256 + n) * 32 + 16 + fi];
                    v = d < 16 ? v * c - os[r * 128 + d + 16] * s : v * c + os[r * 128 + d - 16] * s; }
                o[e] = v; }
            bf16* dst = (kv == 0 ? KCo : VCo) + (size_t)(b * 256 + n) * 512 + g * 128 + dg * 4;
            v2u w; w.x = pk2(o[0], o[1]); w.y = pk2(o[2], o[3]); *(v2u*)dst = w;
        }
        __syncthreads();
    }
}

__device__ __forceinline__ void p8_select(Frame& F) {
    using namespace att;
    char* lds = F.ldsg; unsigned char* ws = F.ptr(IX_WS);
    const bf16* KC = WSP(bf16, WS_KCMP); const bf16* Q1 = WSP(bf16, WS_Q1); unsigned long long* SEL = WSP(unsigned long long, WS_SEL);
    const int wid = F.wave;
    for (int unit = F.vcu; unit < NB * NKVH * 16; unit += F.G) {
        const int tid = F.tid(), lane = tid & 63, r32 = lane & 31, hi = lane >> 5;
        const int sr = tid >> 4, sc = (tid & 15) * 8;
        const int qt = unit & 15, g = (unit >> 4) & 3, b = unit >> 6;
#pragma unroll
        for (int tt = 0; tt < 4; ++tt)
#pragma unroll
            for (int hf = 0; hf < 2; ++hf) { const int key = tt * 64 + hf * 32 + sr;
                *(bf16x8*)(lds + tt * SHM_K + KSWZ(hf * 32 + sr, sc * 2)) = load8(KC + (size_t)(b * 256 + key) * 512 + g * 128 + sc); }
        __syncthreads();
        const int tw = ((wid < 4) ? qt : 31 - qt) * 128 + (wid & 3) * 32, t = tw + r32, lim = (t - 31) >> 4;
        const int limw = tw >> 4;
        float imp[32];
#pragma unroll
        for (int c = 0; c < 32; ++c) imp[c] = 0.f;
        for (int rr = 0; rr < 3; ++rr) {
            const int h = g * 3 + rr; bf16x8 qr[8];
#pragma unroll
            for (int d0 = 0; d0 < 8; ++d0) qr[d0] = load8(Q1 + (size_t)(b * SEQ + t) * NSAW + h * 128 + d0 * 16 + hi * 8);
            f32x16 s[8];
            SBAR(); qkt<0>(s[0], s[1], lds, r32, hi, qr); SBAR();
            if (limw >= 64) { qkt<1>(s[2], s[3], lds, r32, hi, qr); SBAR(); }
            if (limw >= 128) { qkt<2>(s[4], s[5], lds, r32, hi, qr); SBAR(); }
            if (limw >= 192) { qkt<3>(s[6], s[7], lds, r32, hi, qr); SBAR(); }
            constexpr float C2 = LOG2E * ATT_SCALE; const float NEG = -__builtin_inff();
            float mx = -1e30f;
            int lim2 = lim - 4 * hi; asm volatile("" : "+v"(lim2));
#pragma unroll
            for (int i = 0; i < 8; ++i) if (limw >= (i >> 1) * 64) {
#pragma unroll
                for (int r = 0; r < 16; ++r) { const int key0 = (i >> 1) * 64 + (i & 1) * 32 + (r & 3) + 8 * (r >> 2); const float v = key0 <= lim2 ? s[i][r] * C2 : NEG; s[i][r] = v; mx = fmaxf(mx, v); } }
            { auto q2 = __builtin_amdgcn_permlane32_swap(__float_as_uint(mx), __float_as_uint(mx), false, false); mx = fmaxf(__uint_as_float(q2[0]), __uint_as_float(q2[1])); }
            float sum = 0.f;
#pragma unroll
            for (int i = 0; i < 8; ++i) {
                if (limw >= (i >> 1) * 64) {
#pragma unroll
                    for (int r = 0; r < 16; ++r) { const float p = __builtin_amdgcn_exp2f(s[i][r] - mx); s[i][r] = p; sum += p; }
                } else {
#pragma unroll
                    for (int r = 0; r < 16; ++r) s[i][r] = 0.f; } }
            { auto q2 = __builtin_amdgcn_permlane32_swap(__float_as_uint(sum), __float_as_uint(sum), false, false); sum = __uint_as_float(q2[0]) + __uint_as_float(q2[1]); }
            const float inv = sum > 0.f ? 1.0f / sum : 0.f;
            float prev_pt = 0.f;
#pragma unroll
            for (int c = 0; c < 32; ++c) { const int i = c >> 2, a = c & 3; const float tl = 0.5f * s[i][4 * a + 3] * inv;
                auto q2 = __builtin_amdgcn_permlane32_swap(__float_as_uint(tl), __float_as_uint(tl), false, false);
                const float pt = __uint_as_float(hi ? q2[0] : q2[1]);
                imp[c] += (s[i][4 * a] + s[i][4 * a + 1] + s[i][4 * a + 2]) * inv + tl + (hi ? pt : prev_pt);
                prev_pt = pt; }
        }
        const int cur = t >> 6;
        int hi2 = hi; asm volatile("" : "+v"(hi2));
        unsigned key[32];
#pragma unroll
        for (int c = 0; c < 32; ++c) { const int j = 2 * c + hi2; const bool ok = j <= cur, forced = (j == 0) || (j == cur) || (j == cur - 1);
            const float sc_ = forced ? 1e4f : imp[c];
            key[c] = (ok ? (__float_as_uint(sc_) & ~63u) : 0u) | (unsigned)(63 - j); }
        unsigned T = 0u;
#pragma unroll 1
        for (int bit = 30; bit >= 0; --bit) { const unsigned Tc = T | (1u << bit); unsigned cn = 0u;
#pragma unroll
            for (int c = 0; c < 32; ++c) cn += (key[c] >= Tc) ? 1u : 0u;
            { auto q2 = __builtin_amdgcn_permlane32_swap(cn, cn, false, false); cn = q2[0] + q2[1]; }
            T = cn >= 16u ? Tc : T; }
        unsigned wlo = 0u, whi = 0u;
#pragma unroll
        for (int c = 0; c < 32; ++c) { const unsigned selbit = (key[c] >= T && (2 * c + hi2) <= cur) ? 1u : 0u;
            if (c < 16) wlo |= selbit << (2 * c); else whi |= selbit << (2 * (c - 16)); }
        wlo <<= hi; whi <<= hi;
        { auto q2 = __builtin_amdgcn_permlane32_swap(wlo, wlo, false, false); wlo = q2[0] | q2[1]; }
        { auto q2 = __builtin_amdgcn_permlane32_swap(whi, whi, false, false); whi = q2[0] | q2[1]; }
        if (hi == 0) SEL[(size_t)(b * NKVH + g) * SEQ + t] = ((unsigned long long)whi << 32) | wlo;
        __syncthreads();
    }
}

typedef att::Ctx AttnCtx;
__device__ __forceinline__ void nsa_blk(const AttnCtx& C, int L, int pass, att::Blk& k) {
    const int qt = 15 - L / 48, bh = L % 48, b = bh / 12, h = bh % 12, g = h / 3;
    const int row0 = b * SEQ + qt * 256;
    k.Q = C.Q1 + (size_t)row0 * NSAW + h * 128; k.ldq = NSAW; k.t0 = qt * 256; k.row0 = row0; k.hcol = h * 128; k.bg = b * NKVH + g;
    if (pass == 0) { k.K = C.KV + (size_t)((2 * 4 + b) * 4 + g) * SEQ * 128; k.voff = 16 * SEQ * 128; k.ldk = 128; k.j_lo = 0; k.j_hi = 4 * qt + 4; k.mode = att::MODE_SEL; k.epi = att::EPI_ACC0; k.gcol = h * 3 + 1; }
    else if (pass == 1) { k.K = C.KV + (size_t)((4 * 4 + b) * 4 + g) * SEQ * 128; k.voff = 16 * SEQ * 128; k.ldk = 128; k.j_lo = qt >= 2 ? 4 * qt - 8 : 0; k.j_hi = 4 * qt + 4; k.mode = att::MODE_WIN; k.epi = att::EPI_ACC1; k.gcol = h * 3 + 2; }
    else { k.K = C.KC + (size_t)b * 256 * 512 + g * 128; k.voff = (int)(C.VC - C.KC); k.ldk = 512; k.j_lo = 0; k.j_hi = (qt >> 2) + 1; k.mode = att::MODE_CMP; k.epi = att::EPI_FIN; k.gcol = h * 3 + 0; }
}
__device__ __forceinline__ void mem_blk(const AttnCtx& C, int X, att::Blk& k) {
    const int qt = X & 15, mh = (X >> 4) & 3, b = X >> 6;
    const int row0 = b * SEQ + qt * 256;
    k.Q = C.QM + (size_t)row0 * C.qm_ld + C.qm_c0 + mh * 128; k.ldq = C.qm_ld; k.t0 = qt * 256; k.row0 = row0; k.hcol = mh * 128; k.bg = 0; k.gcol = 0;
    k.K = C.MKV + (size_t)b * 256 * 1024 + mh * 128; k.voff = 512; k.ldk = 1024; k.j_lo = 0; k.j_hi = 4; k.mode = att::MODE_NONE; k.epi = att::EPI_MEM;
}
struct AttnStream {
    int G, c, n_nsa, n_mem, cnt_nsa, total; bool tab;
    __device__ __forceinline__ void init(int G_, int c_, int n_nsa_, int n_mem_) {
        G = G_; c = c_; n_nsa = n_nsa_; n_mem = n_mem_;
        tab = (G == 256 && n_nsa == 768);
        if (tab) { cnt_nsa = 0;
#pragma unroll
            for (int r = 0; r < 4; ++r) cnt_nsa += NSA_TAB[c * 4 + r] != 0xffff ? 1 : 0; }
        else { const int full = n_nsa / G, rem = n_nsa - full * G, pos = (full & 1) ? G - 1 - c : c; cnt_nsa = full + (pos < rem ? 1 : 0); }
        const int cnt_mem = c < n_mem ? (n_mem - c + G - 1) / G : 0;
        total = 3 * cnt_nsa + cnt_mem;
    }
    __device__ __forceinline__ void get(const AttnCtx& C, int s, att::Blk& k) const {
        if (s < 3 * cnt_nsa) { const int r = s / 3, pass = s - 3 * r; const int L = tab ? (int)NSA_TAB[c * 4 + r] : r * G + ((r & 1) ? G - 1 - c : c); nsa_blk(C, L, pass, k); }
        else { const int sm = s - 3 * cnt_nsa; mem_blk(C, sm * G + c, k); }
    }
};
__device__ __forceinline__ void attn_run(Frame& F, const AttnCtx& C, int n_nsa, int n_mem) {
    AttnStream S; S.init(F.G, F.vcu, n_nsa, n_mem);
    if (S.total > 0) {
        att::Blk cur, nxt; att::Seam seam;
        S.get(C, 0, cur);
        att::attn_prime(F.tid(), cur, F.ldsg, seam);
        for (int s = 0; s < S.total; ++s) {
            const int tid = F.tid();
            S.get(C, s, cur);
            S.get(C, s + 1 < S.total ? s + 1 : s, nxt);
            att::attn_block(tid, C, cur, nxt.Q, nxt.K, nxt.voff, nxt.ldq, nxt.ldk, nxt.j_lo, F.ldsg, seam);
        }
    }
    VM_WAIT(); __syncthreads();
}
__device__ __forceinline__ void attn_run_mem(Frame& F, const AttnCtx& C, int n_mem) {
    const int G = F.G, c = F.vcu, cnt = c < n_mem ? (n_mem - c + G - 1) / G : 0;
    if (cnt > 0) {
        att::Blk cur, nxt; att::Seam seam;
        mem_blk(C, c, cur);
        const int tid = F.tid();
        att::attn_prime(tid, cur, F.ldsg, seam);
        for (int s = 0; s < cnt; ++s) {
            mem_blk(C, s * G + c, cur);
            mem_blk(C, (s + 1 < cnt ? s + 1 : s) * G + c, nxt);
            att::attn_block(tid, C, cur, nxt.Q, nxt.K, nxt.voff, nxt.ldq, nxt.ldk, nxt.j_lo, F.ldsg, seam);
        }
    }
    VM_WAIT(); __syncthreads();
}

__device__ __forceinline__ void p11_final(Frame& F) {
    unsigned char* ws = F.ptr(IX_WS); float* out = (float*)F.ptr(IX_OUT); const float* final_g = F.fin(IX_FINAL_G);
    const float* SS2 = WSP(float, WS_SS2); const bf16* H2B = WSP(bf16, WS_C);
    const int gw = F.vcu * NWAVES + F.wave, NGW = F.G * NWAVES, lane = F.tid() & 63;
    f32x4 g[8];
#pragma unroll
    for (int j = 0; j < 8; ++j) g[j] = ((const f32x4*)final_g)[64 * j + lane];
    for (int m = gw; m < MTOK; m += 4 * NGW) {
        v2u a[4][8]; float rv[4];
#pragma unroll
        for (int q = 0; q < 4; ++q) { const int mm = m + q * NGW < MTOK ? m + q * NGW : m; const v2u* p = (const v2u*)(H2B + (size_t)mm * DM) + lane;
#pragma unroll
            for (int j = 0; j < 8; ++j) a[q][j] = __builtin_nontemporal_load(p + 64 * j);
            rv[q] = lane < 32 ? SS2[(size_t)mm * 32 + lane] : 0.f; }
#pragma unroll
        for (int q = 0; q < 4; ++q) { const int mm = m + q * NGW; if (mm < MTOK) {
            const float rinv = 1.0f / sqrtf(wave_sum(rv[q]) * (1.f / DM) + EPS);
            f32x4* o = (f32x4*)(out + (size_t)mm * DM) + lane;
#pragma unroll
            for (int j = 0; j < 8; ++j) __builtin_nontemporal_store((f32x4){bflo(a[q][j].x), bfhi(a[q][j].x), bflo(a[q][j].y), bfhi(a[q][j].y)} * rinv * g[j], o + 64 * j); } }
    }
}

#ifndef WGM_P1
#define WGM_P1 4
#endif
#ifndef WGM_P3
#define WGM_P3 4
#endif
#ifndef WGM_P4
#define WGM_P4 2
#endif
#ifndef WGM_P5
#define WGM_P5 2
#endif
#ifndef WGM_P10
#define WGM_P10 2
#endif
__global__ void __launch_bounds__(NTHREADS, 2) fwd_kernel(Args args) {
    extern __shared__ __attribute__((aligned(16))) unsigned char lds[];
    Frame F;
    F.lds = (LAS unsigned char*)lds; F.ldsg = (char*)lds;
    F.wave = __builtin_amdgcn_readfirstlane((int)threadIdx.x >> 6);
    F.G = gridDim.x; { const int bx = blockIdx.x; F.vcu = (F.G % 8 == 0) ? (bx % 8) * (F.G / 8) + bx / 8 : bx; }
    if (threadIdx.x < 19) { const unsigned long long v = threadIdx.x < 17 ? (unsigned long long)args.in[threadIdx.x < 17 ? threadIdx.x : 0] : (threadIdx.x == 17 ? (unsigned long long)args.out : (unsigned long long)args.ws);
        ((LAS unsigned long long*)(F.lds + TAB_OFF))[threadIdx.x] = v; }
    if (threadIdx.x == 32) { ((LAS unsigned*)(F.lds + MISC_OFF))[0] = 0u; ((LAS unsigned*)(F.lds + MISC_OFF))[1] = 0u; }
    if (!MK_PER_PHASE && threadIdx.x == 0) (void)xb_add((unsigned*)(args.ws + WS_CTL) + 1024 + XB_XCNT(xb_xcc_id()), 1u);
    __syncthreads();
    const int lo = args.ph_lo, hi = args.ph_hi;
#ifndef PH_MASK
#define PH_MASK 0xfff
#endif
#define IN(k) (((PH_MASK >> (k)) & 1) && lo <= (k) && (k) < hi)
#ifndef REPEAT_MASK
#define REPEAT_MASK 0
#endif
#define REPS(k) (1 + ((REPEAT_MASK >> (k)) & 1))
#define GBAR() xcd_barrier((unsigned*)(F.ptr(IX_WS) + WS_CTL) + 1024, (volatile LAS unsigned*)(F.lds + MISC_OFF), (unsigned)F.G, F.tid())
#define SEAM(k) do { if (IN(k) && IN((k) + 1)) xcd_barrier((unsigned*)(F.ptr(IX_WS) + WS_CTL) + 1024, (volatile LAS unsigned*)(F.lds + MISC_OFF), (unsigned)F.G, F.tid()); } while (0)
    const size_t TILE_B = (size_t)256 * DM * 2;

    if (IN(0)) for (int rep = 0; rep < REPS(0); ++rep) { if (rep) GBAR(); p0_prologue(F); } SEAM(0);
#ifdef DUP0
    GBAR(); p0_prologue(F); GBAR();
#endif

    if (IN(1)) for (int rep = 0; rep < REPS(1); ++rep) { if (rep) GBAR(); unsigned char* ws = F.ptr(IX_WS);
        pg8::Geo g{DM, DM, DM / 64, 256};
        SchedLin S{64, 16, 1, F.G, (int)blockIdx.x, WGM_P1, (const char*)WSP(bf16, WS_B), (const char*)WSP(bf16, WS_W1T), TILE_B, 0, TILE_B, 0, 0, 0, nullptr, nullptr, 0, 0};
        Epi1 E{WSP(bf16, WS_A)};
        pg8::gemm_phase<Epi1, SchedLin, true, true>(F.lds, F.tid(), g, S, E);
        {
            pg8::Geo g2{DM, DM, 4, 256};
            SchedMem S2{F.G, (int)blockIdx.x, (const char*)WSP(bf16, WS_MEMN), (const char*)WSP(bf16, WS_WMT)};
            Epi6 E2{(float*)(ws + WS_D), 1024, (size_t)1024 * 1024};
            pg8::gemm_phase<Epi6, SchedMem, true, true>(F.lds, F.tid(), g2, S2, E2);
        }
    } SEAM(1);

#ifdef DUPBAR
    for (int i = 0; i < 10; ++i) GBAR();
#endif
    if (IN(2)) for (int rep = 0; rep < REPS(2); ++rep) { if (rep) GBAR(); p2_pool(F); } SEAM(2);

    if (IN(3)) for (int rep = 0; rep < REPS(3); ++rep) { if (rep) GBAR(); unsigned char* ws = F.ptr(IX_WS);
        pg8::Geo g{POOLW, 384, 6, 256};
        SchedLin S{64, 2, 4, F.G, (int)blockIdx.x, WGM_P3, (const char*)WSP(bf16, WS_C), (const char*)WSP(bf16, WS_WPT), (size_t)256 * POOLW * 2, (size_t)384 * 2, (size_t)256 * 384 * 2, (size_t)512 * 384 * 2,
                   0, 0, nullptr, nullptr, 0, 0};
        Epi3 E{F.fin(IX_A_POOL_SCALE), WSP(bf16, WS_A), WSP(bf16, WS_B)};
        pg8::gemm_phase<Epi3, SchedLin, true, true>(F.lds, F.tid(), g, S, E);
#ifdef DUP3G
        GBAR(); pg8::gemm_phase<Epi3, SchedLin, true, true>(F.lds, F.tid(), g, S, E);
#endif
        AttnCtx C{}; C.QM = WSP(bf16, WS_A); C.qm_ld = N1; C.qm_c0 = 2 * POOLW; C.ZM = WSP(bf16, WS_A); C.zm_ld = N1; C.zm_c0 = 2 * POOLW + MEMW;
        C.MKV = WSP(bf16, WS_MKV); C.Y = WSP(bf16, WS_B);
#ifndef NO_ATT3
        attn_run_mem(F, C, NB * 4 * 16);
#ifdef DUP3A
        GBAR(); attn_run_mem(F, C, NB * 4 * 16);
#endif
#endif
    } SEAM(3);

    if (IN(4)) for (int rep = 0; rep < REPS(4); ++rep) { if (rep) GBAR(); unsigned char* ws = F.ptr(IX_WS);
        pg8::Geo g{DM, DM, DM / 64, 256};
        SchedLin S{64, 8, 1, F.G, (int)blockIdx.x, WGM_P4, (const char*)WSP(bf16, WS_B), (const char*)WSP(bf16, WS_WO0T), TILE_B, 0, TILE_B, 0, 0, 0, nullptr, nullptr, 0, 0};
        bf16* h1b = (bf16*)F.ptr(IX_OUT);
        EpiRes<false> E{F.fin(IX_X), h1b, WSP(float, WS_SS1)};
        pg8::gemm_phase<EpiRes<false>, SchedLin, true, true>(F.lds, F.tid(), g, S, E);
    } SEAM(4);

    if (IN(5)) for (int rep = 0; rep < REPS(5); ++rep) { if (rep) GBAR(); unsigned char* ws = F.ptr(IX_WS);
        pg8::Geo g{DM, DM, DM / 64, 256};
        SchedLin S{64, 28, 1, F.G, (int)blockIdx.x, WGM_P5, (const char*)F.ptr(IX_OUT), (const char*)WSP(bf16, WS_W4T), TILE_B, 0, TILE_B, 0, 0, 0, nullptr, nullptr, 0, 0};
        Epi5 E{WSP(float, WS_SS1), WSP(float, WS_ROPE), WSP(bf16, WS_KVB), WSP(bf16, WS_Q1), WSP(bf16, WS_ZQ), WSP(bf16, WS_QM1), WSP(bf16, WS_ZM1)};
        pg8::gemm_phase<Epi5, SchedLin, true, true>(F.lds, F.tid(), g, S, E);
        {
            pg8::Geo g2{DM, DM, 8, 256};
            SchedGate S2{F.G, (int)blockIdx.x, (const char*)F.ptr(IX_OUT), (const char*)(WSP(bf16, WS_W4T) + (size_t)28 * 256 * DM)};
            EpiG E2{WSP(float, WS_C)};
            pg8::gemm_phase<EpiG, SchedGate, true, true>(F.lds, F.tid(), g2, S2, E2);
        }
    } SEAM(5);

    if (IN(6)) for (int rep = 0; rep < REPS(6); ++rep) { if (rep) GBAR(); unsigned char* ws = F.ptr(IX_WS);
        pg8::Geo g{16 * 128, 4096, 8, 256};
        SchedCmp S{F.G, (int)blockIdx.x, (const char*)WSP(bf16, WS_KVB), (const char*)WSP(bf16, WS_WC1T)};
        Epi6 E{WSP(float, WS_B), 256, (size_t)4096 * 256};
        pg8::gemm_phase<Epi6, SchedCmp, true, true>(F.lds, F.tid(), g, S, E);
        gates_finish(F);
    } SEAM(6);

    if (IN(7)) for (int rep = 0; rep < REPS(7); ++rep) { if (rep) GBAR(); p7_cmp2(F); } SEAM(7);

    if (IN(8)) for (int rep = 0; rep < REPS(8); ++rep) { if (rep) GBAR(); p8_select(F); }
#ifdef DUP8
    GBAR(); p8_select(F);
#endif
    SEAM(8);

    if (IN(9)) for (int rep = 0; rep < REPS(9); ++rep) { if (rep) GBAR(); unsigned char* ws = F.ptr(IX_WS);
        AttnCtx C{}; C.KV = WSP(bf16, WS_KVB); C.KC = WSP(bf16, WS_KCMP); C.VC = WSP(bf16, WS_VCMP); C.Q1 = WSP(bf16, WS_Q1); C.ZQ = WSP(bf16, WS_ZQ);
        C.QM = WSP(bf16, WS_QM1); C.qm_ld = MEMW; C.qm_c0 = 0; C.ZM = WSP(bf16, WS_ZM1); C.zm_ld = MEMW; C.zm_c0 = 0; C.MKV = WSP(bf16, WS_MKV) + (size_t)1024 * 1024;
        C.gates = WSP(float, WS_GATES); C.SEL = WSP(unsigned long long, WS_SEL); C.YACC = WSP(float, WS_C); C.Y = WSP(bf16, WS_B);
        attn_run(F, C, NB * NHEAD * 16, NB * 4 * 16);
    } SEAM(9);

    if (IN(10)) for (int rep = 0; rep < REPS(10); ++rep) { if (rep) GBAR(); unsigned char* ws = F.ptr(IX_WS);
        pg8::Geo g{DM, DM, DM / 64, 256};
        SchedLin S{64, 8, 1, F.G, (int)blockIdx.x, WGM_P10, (const char*)WSP(bf16, WS_B), (const char*)WSP(bf16, WS_WO1T), TILE_B, 0, TILE_B, 0, 0, 0, nullptr, nullptr, 0, 0};
        EpiRes<true> E{F.ptr(IX_OUT), WSP(bf16, WS_C), WSP(float, WS_SS2)};
        pg8::gemm_phase<EpiRes<true>, SchedLin, true, true>(F.lds, F.tid(), g, S, E);
    } SEAM(10);

    if (IN(11)) for (int rep = 0; rep < REPS(11); ++rep) { if (rep) GBAR(); p11_final(F); }
#undef IN
#undef SEAM
}

extern "C" void kernel_launch(void* const* d_in, const int* in_sizes, int n_in, void* d_out, int out_size, void* d_ws, size_t ws_size, hipStream_t stream) {
    static int grid = 0;
    if (grid == 0) {
        if (n_in != 17 || in_sizes[0] != MTOK * DM || out_size != MTOK * DM || ws_size < WS_END) {
            fprintf(stderr, "kernel_launch: unexpected shapes (n_in %d, in0 %d, out %d, ws %zu < %zu)\n", n_in, n_in > 0 ? in_sizes[0] : -1, out_size, ws_size, (size_t)WS_END); grid = -1; return; }
        int dev = 0, cus = 0, per_cu = 0;
        if (hipGetDevice(&dev) != hipSuccess || hipDeviceGetAttribute(&cus, hipDeviceAttributeMultiprocessorCount, dev) != hipSuccess) { fprintf(stderr, "kernel_launch: device query failed\n"); grid = -1; return; }
        if (hipFuncSetAttribute((const void*)fwd_kernel, hipFuncAttributeMaxDynamicSharedMemorySize, LDS_BYTES) != hipSuccess) { fprintf(stderr, "kernel_launch: hipFuncSetAttribute failed\n"); grid = -1; return; }
        if (hipOccupancyMaxActiveBlocksPerMultiprocessor(&per_cu, (const void*)fwd_kernel, NTHREADS, LDS_BYTES) != hipSuccess || per_cu < 1) {
            fprintf(stderr, "kernel_launch: occupancy query says %d blocks per CU\n", per_cu); (void)hipGetLastError(); per_cu = 1; }
        grid = cus * (per_cu > 1 ? 1 : per_cu);
    }
    if (grid < 0) return;
    (void)hipMemsetAsync((char*)d_ws + WS_CTL, 0, 65536, stream);
    Args a{};
    for (int i = 0; i < 17; ++i) a.in[i] = d_in[i];
    a.out = (float*)d_out; a.ws = (unsigned char*)d_ws;
#if MK_PER_PHASE
    for (int p = 0; p < NPHASE; ++p) { a.ph_lo = p; a.ph_hi = p + 1; hipLaunchKernelGGL(fwd_kernel, dim3(grid), dim3(NTHREADS), LDS_BYTES, stream, a); }
#else
    a.ph_lo = 0; a.ph_hi = NPHASE;
    void* kargs[] = {&a};
    hipError_t e = hipLaunchCooperativeKernel((const void*)fwd_kernel, dim3(grid), dim3(NTHREADS), kargs, LDS_BYTES, stream);
    if (e != hipSuccess) fprintf(stderr, "kernel_launch: cooperative launch failed: %s (grid %d)\n", hipGetErrorString(e), grid);
#endif
}
```

```cpp
#include <hip/hip_runtime.h>
#include <hip/hip_cooperative_groups.h>
#include <cstdio>
#include <cstdint>
namespace cg = cooperative_groups;

#define LAS __attribute__((address_space(3)))
typedef unsigned short bf16;
typedef unsigned v4u __attribute__((ext_vector_type(4)));
typedef unsigned v2u __attribute__((ext_vector_type(2)));
typedef float f32x4 __attribute__((ext_vector_type(4)));
typedef float f32x2 __attribute__((ext_vector_type(2)));
typedef float f32x16 __attribute__((ext_vector_type(16)));
typedef short bf16x8 __attribute__((ext_vector_type(8)));
typedef short s16x4 __attribute__((ext_vector_type(4)));

constexpr int NB = 4, SEQ = 4096, DM = 2048, MTOK = NB * SEQ;
constexpr int MEMLEN = 256, HD = 128;
constexpr int POOLW = 1536, MEMW = 512, NSAW = 1536, NHEAD = 12, NKVH = 4;
constexpr int N1 = 4096;
constexpr int NKV = 3072;
constexpr int N4 = 7424;
constexpr int NCMP = 255, CMPHID = 256;
constexpr float EPS = 1e-6f;
constexpr float LOG2E = 1.4426950408889634f;
constexpr float ATT_SCALE = 0.08838834764831845f;

constexpr size_t MiB = 1u << 20;
constexpr size_t WS_CTL = 0;
constexpr size_t WS_W1T = 1 * MiB;
constexpr size_t WS_WO0T = 17 * MiB;
constexpr size_t WS_W4T = 25 * MiB;
constexpr size_t WS_WO1T = 54 * MiB;
constexpr size_t WS_WMT = 62 * MiB;
constexpr size_t WS_WPT = 70 * MiB;
constexpr size_t WS_WC1T = 72 * MiB;
constexpr size_t WS_MEMN = 76 * MiB;
constexpr size_t WS_MKV = 80 * MiB;
constexpr size_t WS_ROPE = 84 * MiB;
constexpr size_t WS_ROPEC = 86 * MiB;
constexpr size_t WS_SS1 = 87 * MiB;
constexpr size_t WS_SS2 = 89 * MiB;
constexpr size_t WS_SEL = 91 * MiB;
constexpr size_t WS_KCMP = 92 * MiB;
constexpr size_t WS_VCMP = 93 * MiB;
constexpr size_t WS_GATES = 94 * MiB;
constexpr size_t WS_CBIAS = 97 * MiB;
constexpr size_t WS_RINV1 = 97 * MiB + 512 * 1024;
constexpr size_t WS_A = 98 * MiB;
constexpr size_t WS_KVB = WS_A;
constexpr size_t WS_QM1 = WS_A + 97 * MiB;
constexpr size_t WS_ZM1 = WS_A + 113 * MiB;
constexpr size_t WS_B = 228 * MiB;
constexpr size_t WS_C = 292 * MiB;
constexpr size_t WS_D = 388 * MiB;
constexpr size_t WS_Q1 = WS_D, WS_ZQ = WS_D + 48 * MiB;
constexpr size_t WS_END = 484 * MiB;

#define LDS_WAIT() asm volatile("s_waitcnt lgkmcnt(0)" ::: "memory")
#define VM_WAIT() asm volatile("s_waitcnt vmcnt(0)" ::: "memory")
__device__ __forceinline__ unsigned f2bf(float f) { unsigned u = __builtin_bit_cast(unsigned, f); return (u + 0x7fffu + ((u >> 16) & 1u)) >> 16; }
__device__ __forceinline__ unsigned pk2(float lo, float hi) { return f2bf(lo) | (f2bf(hi) << 16); }
__device__ __forceinline__ float bf2f(unsigned short b) { return __builtin_bit_cast(float, (unsigned)b << 16); }
__device__ __forceinline__ float bflo(unsigned w) { return __builtin_bit_cast(float, w << 16); }
__device__ __forceinline__ float bfhi(unsigned w) { return __builtin_bit_cast(float, w & 0xffff0000u); }
__device__ __forceinline__ unsigned cvtpk(float lo, float hi) { unsigned r; asm volatile("v_cvt_pk_bf16_f32 %0, %1, %2" : "=v"(r) : "v"(lo), "v"(hi)); return r; }
__device__ __forceinline__ float silu_f(float x) { return x * __builtin_amdgcn_rcpf(1.f + __builtin_amdgcn_exp2f(-x * LOG2E)); }
__device__ __forceinline__ float sigmoid_f(float x) { return __builtin_amdgcn_rcpf(1.f + __builtin_amdgcn_exp2f(-x * LOG2E)); }
__device__ __forceinline__ float wave_sum(float v) {
#pragma unroll
    for (int o = 1; o < 64; o <<= 1) v += __shfl_xor(v, o);
    return v;
}

namespace pg8 {
#define PG8_LAS __attribute__((address_space(3)))
constexpr int BM = 256, BK = 64, HALF = 128, HTB = HALF * BK * 2, STAGE_BYTES = 8 * HTB, NXCD = 8, WGM = 8;
__host__ __device__ __forceinline__ int lds_byte(int r, int c) { const int st = (r >> 4) * 2 + (c >> 5), rr = r & 15, cc = c & 31, ob = rr * 64 + cc * 2; return st * 1024 + (ob ^ (((ob >> 9) & 1) << 5)); }
__host__ __device__ __forceinline__ int perm32(int rho) { const int n = rho >> 4, i = rho & 15; return 8 * (i >> 2) + 4 * n + (i & 3); }
__host__ __device__ __forceinline__ void stage_rc(int b, int& R, int& C) { const int st = b / 1024, sb = b % 1024, swz = sb ^ (((sb >> 9) & 1) << 5); R = (st >> 1) * 16 + swz / 64; C = (st & 1) * 32 + (swz % 64) / 2; }

struct Unit { int pm, pn, z, kind; const char* a; const char* b; };
__device__ __forceinline__ void tile_swz(int wgid, int nM, int nN, int wgm, int& pm, int& pn) {
    const int nwg = nM * nN;
    { const int q = nwg / NXCD, r = nwg % NXCD, xcd = wgid % NXCD, off = wgid / NXCD; wgid = (xcd < r ? xcd * (q + 1) : r * (q + 1) + (xcd - r) * q) + off; }
    const int nig = wgm * nN, gid = wgid / nig, fm = gid * wgm, gsz = (nM - fm) < wgm ? (nM - fm) : wgm;
    pm = fm + ((wgid % nig) % gsz); pn = (wgid % nig) / gsz;
}
struct Geo { int lda, ldb, nt; int kpairA; };

template <class Epi, class Sched, bool ALIGN_EPI, bool SP2>
__device__ __forceinline__ void gemm_phase(PG8_LAS unsigned char* lds, const int tid, const Geo g, const Sched& S, const Epi& E) {
    const int wid = __builtin_amdgcn_readfirstlane(tid >> 6), lane = tid & 63, wr = wid >> 2, wc = wid & 3, fr = lane & 15, fq = lane >> 4;
    const int nt = g.nt;
    unsigned voffA[2], voffB[2];
#pragma unroll
    for (int i = 0; i < 2; ++i) { int R, C; stage_rc(tid * 16 + i * 8192, R, C);
        const int Rb = Epi::PERM ? 64 * (R >> 5) + perm32(R & 31) : R;
        voffA[i] = (unsigned)(R * g.lda + C) * 2u; voffB[i] = (unsigned)(Rb * g.ldb + C) * 2u; }
    const size_t kstep = (size_t)(BK * 2);
    const size_t hstepA = (size_t)HALF * g.lda * 2, hstepB = (size_t)(Epi::PERM ? 32 : HALF) * g.ldb * 2;
    const size_t kpairA = (size_t)g.kpairA;
    const unsigned ldsw = (unsigned)wid * 1024u;
    const int aoff = lds_byte(wr * 64 + fr, fq * 8), boff = lds_byte(wc * 32 + fr, fq * 8);
#define PG8_SA(b, h) (((b) * 2 + (h)) * HTB)
#define PG8_SB(b, h) ((4 + (b) * 2 + (h)) * HTB)
#define PG8_STAGE(bufoff, gbase, voff) do { _Pragma("unroll") for (int _i = 0; _i < 2; ++_i) \
        __builtin_amdgcn_global_load_lds((const unsigned*)((const char*)(gbase) + (voff)[_i]), (PG8_LAS unsigned*)(lds + (bufoff) + ldsw + _i * 8192), 16, 0, 0); } while (0)
#define PG8_LDA(dst, b, h) do { _Pragma("unroll") for (int m = 0; m < 4; ++m) _Pragma("unroll") for (int k = 0; k < 2; ++k) dst[m][k] = *(const PG8_LAS bf16x8*)(lds + PG8_SA(b, h) + aoff + m * 2048 + k * 1024); } while (0)
#define PG8_LDB(dst, b, h) do { _Pragma("unroll") for (int n = 0; n < 2; ++n) _Pragma("unroll") for (int k = 0; k < 2; ++k) dst[n][k] = *(const PG8_LAS bf16x8*)(lds + PG8_SB(b, h) + boff + n * 2048 + k * 1024); } while (0)
#define PG8_MMA(ai, bj, At, Bt) do { __builtin_amdgcn_s_setprio(1); _Pragma("unroll") for (int m = 0; m < 4; ++m) _Pragma("unroll") for (int n = 0; n < 2; ++n) _Pragma("unroll") for (int k = 0; k < 2; ++k) \
        acc[ai][bj][m][n] = __builtin_amdgcn_mfma_f32_16x16x32_bf16(Bt[n][k], At[m][k], acc[ai][bj][m][n], 0, 0, 0); __builtin_amdgcn_s_setprio(0); } while (0)
#define PG8_WAIT_V(n) asm volatile("s_waitcnt vmcnt(" #n ")" ::: "memory")
#define PG8_WAIT_L(n) asm volatile("s_waitcnt lgkmcnt(" #n ")" ::: "memory")
#define PG8_BAR __builtin_amdgcn_s_barrier()
#define PG8_SCHED __builtin_amdgcn_sched_barrier(0)
    Unit cur, nxt; int ui = 0;
    if (!S.next(0, cur)) return;
    f32x4 acc[2][2][4][2];
    typename Epi::State est;
    E.begin(acc, est, cur, wr, wc, fr, fq);
    bf16x8 At[4][2], B0[2][2], B1[2][2];
    const char* cA = cur.a; const char* cB = cur.b;
    if constexpr (SP2) {
        PG8_STAGE(PG8_SB(0, 0), cB, voffB); PG8_STAGE(PG8_SB(0, 1), cB + hstepB, voffB); PG8_STAGE(PG8_SA(0, 0), cA, voffA); PG8_STAGE(PG8_SA(0, 1), cA + hstepA, voffA);
        if (wr == 1) PG8_BAR;
        PG8_WAIT_V(2); PG8_BAR;
        PG8_STAGE(PG8_SB(1, 0), cB + kstep, voffB); PG8_STAGE(PG8_SA(1, 0), cA + kstep, voffA); PG8_STAGE(PG8_SB(1, 1), cB + hstepB + kstep, voffB);
        PG8_WAIT_V(6); PG8_BAR;
    } else {
        PG8_STAGE(PG8_SB(0, 0), cB, voffB); PG8_STAGE(PG8_SA(0, 0), cA, voffA); PG8_STAGE(PG8_SB(0, 1), cB + hstepB, voffB); PG8_STAGE(PG8_SA(0, 1), cA + hstepA, voffA);
        if (wr == 1) PG8_BAR;
        PG8_WAIT_V(4); PG8_BAR;
        PG8_STAGE(PG8_SB(1, 0), cB + kstep, voffB); PG8_STAGE(PG8_SA(1, 0), cA + kstep, voffA); PG8_STAGE(PG8_SB(1, 1), cB + hstepB + kstep, voffB);
        PG8_WAIT_V(6); PG8_BAR;
    }
    for (;;) {
        const bool has_next = S.next(ui + 1, nxt);
        const char* nA = has_next ? nxt.a : cA; const char* nB = has_next ? nxt.b : cB;
        for (int t = 0; t < nt; t += 2) {
            const bool last = (t == nt - 2);
            const char* a0p = cA + (size_t)(t >> 1) * kpairA;
            const char* a1 = a0p + kstep;
            const char* a2 = last ? nA : a0p + kpairA; const char* b2 = last ? nB : cB + (size_t)(t + 2) * kstep;
            const char* a3 = a2 + kstep; const char* b3 = b2 + kstep;
            if constexpr (SP2) {
            PG8_LDB(B0, 0, 0); PG8_LDB(B1, 0, 1); PG8_SCHED; PG8_LDA(At, 0, 0); PG8_STAGE(PG8_SA(1, 1), a1 + hstepA, voffA);
            PG8_WAIT_V(8); PG8_WAIT_L(0); PG8_BAR; PG8_MMA(0, 0, At, B0); PG8_MMA(0, 1, At, B1); PG8_BAR; PG8_SCHED;
            PG8_LDA(At, 0, 1); PG8_STAGE(PG8_SB(0, 0), b2, voffB); PG8_STAGE(PG8_SB(0, 1), b2 + hstepB, voffB); PG8_STAGE(PG8_SA(0, 0), a2, voffA);
            PG8_WAIT_V(8); PG8_WAIT_L(0); PG8_BAR; PG8_MMA(1, 0, At, B0); PG8_MMA(1, 1, At, B1); PG8_BAR; PG8_SCHED;
            PG8_LDB(B0, 1, 0); PG8_LDB(B1, 1, 1); PG8_SCHED; PG8_LDA(At, 1, 0); PG8_STAGE(PG8_SA(0, 1), a2 + hstepA, voffA);
            PG8_WAIT_V(8); PG8_WAIT_L(0); PG8_BAR; PG8_MMA(0, 0, At, B0); PG8_MMA(0, 1, At, B1); PG8_BAR; PG8_SCHED;
            PG8_LDA(At, 1, 1); PG8_STAGE(PG8_SB(1, 0), b3, voffB); PG8_STAGE(PG8_SB(1, 1), b3 + hstepB, voffB); PG8_STAGE(PG8_SA(1, 0), a3, voffA);
            PG8_WAIT_V(8); PG8_WAIT_L(0); PG8_BAR; PG8_MMA(1, 0, At, B0); PG8_MMA(1, 1, At, B1); PG8_BAR; PG8_SCHED;
            } else {
            PG8_LDB(B0, 0, 0); PG8_SCHED; PG8_LDA(At, 0, 0); PG8_STAGE(PG8_SA(1, 1), a1 + hstepA, voffA);
            PG8_WAIT_L(8); PG8_BAR; PG8_WAIT_L(0); PG8_MMA(0, 0, At, B0); PG8_BAR; PG8_SCHED;
            PG8_LDB(B1, 0, 1); PG8_STAGE(PG8_SB(0, 0), b2, voffB);
            PG8_BAR; PG8_WAIT_L(0); PG8_MMA(0, 1, At, B1); PG8_BAR;
            PG8_LDA(At, 0, 1); PG8_STAGE(PG8_SA(0, 0), a2, voffA);
            PG8_BAR; PG8_WAIT_L(0); PG8_MMA(1, 0, At, B0); PG8_BAR; PG8_SCHED;
            PG8_STAGE(PG8_SB(0, 1), b2 + hstepB, voffB);
            PG8_WAIT_V(6); PG8_BAR; PG8_MMA(1, 1, At, B1); PG8_BAR;
            PG8_LDB(B0, 1, 0); PG8_SCHED; PG8_LDA(At, 1, 0); PG8_STAGE(PG8_SA(0, 1), a2 + hstepA, voffA);
            PG8_WAIT_L(8); PG8_BAR; PG8_WAIT_L(0); PG8_MMA(0, 0, At, B0); PG8_BAR; PG8_SCHED;
            PG8_LDB(B1, 1, 1); PG8_STAGE(PG8_SB(1, 0), b3, voffB);
            PG8_BAR; PG8_WAIT_L(0); PG8_MMA(0, 1, At, B1); PG8_BAR;
            PG8_LDA(At, 1, 1); PG8_STAGE(PG8_SA(1, 0), a3, voffA);
            PG8_BAR; PG8_WAIT_L(0); PG8_MMA(1, 0, At, B0); PG8_BAR; PG8_SCHED;
            PG8_STAGE(PG8_SB(1, 1), b3 + hstepB, voffB);
            PG8_WAIT_V(6); PG8_BAR; PG8_MMA(1, 1, At, B1); PG8_BAR;
            }
        }
        if constexpr (ALIGN_EPI) { if (wr == 0) PG8_BAR; }
        E(acc, est, cur, wr, wc, fr, fq);
        if (!has_next) break;
        cur = nxt; cA = nA; cB = nB; ++ui;
        E.begin(acc, est, cur, wr, wc, fr, fq);
        if constexpr (ALIGN_EPI) { if (wr == 1) PG8_BAR; }
    }
    PG8_WAIT_V(0);
    if constexpr (!ALIGN_EPI) { if (wr == 0) PG8_BAR; }
    PG8_BAR;
#undef PG8_SA
#undef PG8_SB
#undef PG8_STAGE
#undef PG8_LDA
#undef PG8_LDB
#undef PG8_MMA
#undef PG8_WAIT_V
#undef PG8_WAIT_L
#undef PG8_BAR
#undef PG8_SCHED
}
}

namespace att {
#ifndef AT_SELMASK
#define AT_SELMASK 1
#endif
constexpr int D = 128, NW = 8, QBLK = 32, KVBLK = 64, QB = NW * QBLK;
constexpr int SHM_V = KVBLK * D * 2, SHM_K = KVBLK * D * 2;
constexpr int LDS_BYTES = 2 * SHM_V + 2 * SHM_K + NW * 64 * 4;
constexpr float THR = 8.f;
#define KSWZ(row, colB) ((row) * 256 + ((colB) ^ (((row) & 7) << 4)))
#define SBAR() __builtin_amdgcn_sched_barrier(0)
__device__ __forceinline__ int v_st(int k, int c) { const int kk = (k & ~0xC) | ((k & 4) << 1) | ((k & 8) >> 1); return ((kk >> 3) * 4 + (c >> 5)) * 512 + ((kk & 7) * 32 + (c & 31)) * 2; }
__device__ __forceinline__ int v_rd_base(int lane) { return ((lane & 3) << 3) | (((lane >> 2) & 3) << 6) | (((lane >> 4) & 1) << 5) | (((lane >> 5) & 1) << 8); }
constexpr int v_rd_off(int d0, int ks, int half) { return d0 * 512 + ks * 4096 + half * 2048; }
__device__ __forceinline__ int crow(int r, int hi) { return (r & 3) + 8 * (r >> 2) + 4 * hi; }
__device__ __forceinline__ bf16x8 load8(const bf16* p) { return *reinterpret_cast<const bf16x8*>(p); }

__device__ __forceinline__ void mask_tile(f32x16& p0, f32x16& p1, int dq, unsigned W) {
    const float NEG = -__builtin_inff();
#pragma unroll
    for (int r = 0; r < 16; ++r) {
        const int c = (r & 3) + 8 * (r >> 2);
        if ((unsigned)(dq - c) >= W) p0[r] = NEG;
        if ((unsigned)(dq - c - 32) >= W) p1[r] = NEG;
    }
}
__device__ __forceinline__ void partialSM(f32x16& p0, f32x16& p1, float& m_reg, float& mn, float& alpha) {
    float pmax = p0[0];
#pragma unroll
    for (int r = 1; r < 16; ++r) pmax = fmaxf(pmax, p0[r]);
#pragma unroll
    for (int r = 0; r < 16; ++r) pmax = fmaxf(pmax, p1[r]);
    { auto rr = __builtin_amdgcn_permlane32_swap(__float_as_uint(pmax), __float_as_uint(pmax), false, false);
      pmax = fmaxf(__uint_as_float(rr[0]), __uint_as_float(rr[1])); }
    constexpr float C2 = LOG2E * ATT_SCALE;
    if (__builtin_expect(__all((pmax - m_reg) * ATT_SCALE <= THR), 1)) { mn = m_reg; alpha = 1.f; }
    else { mn = fmaxf(m_reg, pmax); alpha = __builtin_amdgcn_exp2f((m_reg - mn) * C2); m_reg = mn; }
    const float mnL = -mn * C2;
#pragma unroll
    for (int r = 0; r < 16; ++r) p0[r] = fmaf(p0[r], C2, mnL);
#pragma unroll
    for (int r = 0; r < 16; ++r) p1[r] = fmaf(p1[r], C2, mnL);
#pragma unroll
    for (int r = 0; r < 16; ++r) p0[r] = __builtin_amdgcn_exp2f(p0[r]);
}
__device__ __forceinline__ void finishSM(f32x16& p0, f32x16& p1, float alpha, float& l_reg, bf16x8& pa0, bf16x8& pa1, bf16x8& pa2, bf16x8& pa3, int keep) {
#pragma unroll
    for (int r = 0; r < 16; ++r) p1[r] = __builtin_amdgcn_exp2f(p1[r]);
    float ps = 0;
#pragma unroll
    for (int r = 0; r < 16; ++r) ps += p0[r];
#pragma unroll
    for (int r = 0; r < 16; ++r) ps += p1[r];
    { auto rr = __builtin_amdgcn_permlane32_swap(__float_as_uint(ps), __float_as_uint(ps), false, false);
      ps = __uint_as_float(rr[0]) + __uint_as_float(rr[1]); }
    l_reg = l_reg * alpha + (keep ? ps : 0.f);
#define PK4(P, B_, OUT) do { unsigned a0 = cvtpk(P[B_+0], P[B_+1]), a1 = cvtpk(P[B_+2], P[B_+3]);                          \
        unsigned b0 = cvtpk(P[B_+4], P[B_+5]), b1 = cvtpk(P[B_+6], P[B_+7]);                                             \
        auto r0 = __builtin_amdgcn_permlane32_swap(a0, b0, false, false); auto r1 = __builtin_amdgcn_permlane32_swap(a1, b1, false, false); \
        v4u w = {keep ? r0[0] : 0u, keep ? r1[0] : 0u, keep ? r0[1] : 0u, keep ? r1[1] : 0u}; OUT = *reinterpret_cast<bf16x8*>(&w); } while (0)
    PK4(p0, 0, pa0); PK4(p0, 8, pa1); PK4(p1, 0, pa2); PK4(p1, 8, pa3);
#undef PK4
}
template <int KB>
__device__ __forceinline__ void qkt(f32x16& p0, f32x16& p1, const char* K_lds, int r32, int hi, const bf16x8* qr) {
    p0 = f32x16{}; p1 = f32x16{};
    const char* kb[4];
#pragma unroll
    for (int dd = 0; dd < 4; ++dd) kb[dd] = K_lds + KB * SHM_K + KSWZ(r32, (dd * 16 + hi * 8) * 2);
#pragma unroll
    for (int d0 = 0; d0 < 8; ++d0) { const char* a = kb[d0 & 3] + (d0 >> 2) * 128;
        bf16x8 b0 = *reinterpret_cast<const bf16x8*>(a);
        bf16x8 b1 = *reinterpret_cast<const bf16x8*>(a + 32 * 256);
        p0 = __builtin_amdgcn_mfma_f32_32x32x16_bf16(b0, qr[d0], p0, 0, 0, 0);
        p1 = __builtin_amdgcn_mfma_f32_32x32x16_bf16(b1, qr[d0], p1, 0, 0, 0); }
}
template <int VB>
__device__ __forceinline__ void pv_tile(f32x16* o, int vb0, bf16x8 pa0, bf16x8 pa1, bf16x8 pa2, bf16x8 pa3) {
#define TRRD(dst, off) asm volatile("ds_read_b64_tr_b16 %0, %1 offset:%2" : "=&v"(dst) : "v"(vb0), "i"(off) : "memory")
#define PV_D0(d0) do { s16x4 l0, l1, l2, l3, h0, h1, h2, h3; constexpr int b_ = VB * SHM_V + v_rd_off(d0, 0, 0);   \
        TRRD(l0, b_); TRRD(h0, b_ + 2048); TRRD(l1, b_ + 4096); TRRD(h1, b_ + 6144); TRRD(l2, b_ + 8192); TRRD(h2, b_ + 10240); TRRD(l3, b_ + 12288); TRRD(h3, b_ + 14336); \
        asm volatile("s_waitcnt lgkmcnt(0)" ::: "memory"); SBAR();   \
        o[d0] = __builtin_amdgcn_mfma_f32_32x32x16_bf16(pa0, (bf16x8){l0[0], l0[1], l0[2], l0[3], h0[0], h0[1], h0[2], h0[3]}, o[d0], 0, 0, 0);   \
        o[d0] = __builtin_amdgcn_mfma_f32_32x32x16_bf16(pa1, (bf16x8){l1[0], l1[1], l1[2], l1[3], h1[0], h1[1], h1[2], h1[3]}, o[d0], 0, 0, 0);   \
        o[d0] = __builtin_amdgcn_mfma_f32_32x32x16_bf16(pa2, (bf16x8){l2[0], l2[1], l2[2], l2[3], h2[0], h2[1], h2[2], h2[3]}, o[d0], 0, 0, 0);   \
        o[d0] = __builtin_amdgcn_mfma_f32_32x32x16_bf16(pa3, (bf16x8){l3[0], l3[1], l3[2], l3[3], h3[0], h3[1], h3[2], h3[3]}, o[d0], 0, 0, 0); } while (0)
    PV_D0(0); PV_D0(1); PV_D0(2); PV_D0(3);
#undef PV_D0
#undef TRRD
}

enum { MODE_NONE = 0, MODE_SEL = 1, MODE_WIN = 2, MODE_CMP = 3 };
enum { EPI_MEM = 0, EPI_ACC0 = 1, EPI_ACC1 = 2, EPI_FIN = 3 };
struct Ctx { const bf16 *KV, *KC, *VC, *Q1, *ZQ, *QM, *ZM, *MKV; const float* gates; const unsigned long long* SEL; float* YACC; bf16* Y; int qm_ld, zm_ld, qm_c0, zm_c0; };
struct Blk {
    const bf16* Q; const bf16* K; int voff;
    int ldq, ldk;
    int j_lo, j_hi;
    int t0;
    int mode, epi;
    int row0, hcol, gcol, bg;
};
constexpr int LDS_WS = 2 * SHM_V + 2 * SHM_K;
constexpr int LDS_SEL = LDS_WS + NW * 64 * 4;
constexpr int LDS_STG = LDS_SEL + NW * 32 * 8;
constexpr int LDS_BYTES2 = LDS_STG + NW * 32 * 68 * 4;
struct Seam { bf16x8 qr[8]; bf16x8 st_v0, st_v1, st_k0, st_k1; };
#define AROW(p, k0, rr) ((p) + (size_t)((k0) + (rr)) * ldk + sc)
#define VMWN(n) asm volatile("s_waitcnt vmcnt(%0)" :: "i"(n) : "memory")
#define SLOAD_H(Kp, Vp, k0) do { S.st_v0 = load8(AROW(Vp, k0, sr)); S.st_v1 = load8(AROW(Vp, k0, 32 + sr));              \
                         S.st_k0 = load8(AROW(Kp, k0, sr)); S.st_k1 = load8(AROW(Kp, k0, 32 + sr)); } while (0)
#define SWRITE_HK(bf) do { *(bf16x8*)(K_lds + (bf) * SHM_K + kws) = S.st_k0; *(bf16x8*)(K_lds + (bf) * SHM_K + kws + 32 * 256) = S.st_k1; } while (0)
#define SWRITE_HV(bf) do { *(bf16x8*)(V_lds + (bf) * SHM_V + vst0) = S.st_v0; *(bf16x8*)(V_lds + (bf) * SHM_V + vst1) = S.st_v1; } while (0)
#define SWRITE_H(bf) do { SWRITE_HV(bf); SWRITE_HK(bf); } while (0)

__device__ __forceinline__ void attn_prime(const int tid, const Blk& cur, char* lds, Seam& S) {
    const int wid = __builtin_amdgcn_readfirstlane(tid >> 6), lane = tid & 63, r32 = lane & 31, hi = lane >> 5;
    const int sr = tid >> 4, sc = (tid & 15) * 8, kws = KSWZ(sr, sc * 2); char* K_lds = lds + 2 * SHM_V;
    const int ldk = cur.ldk; const int kb0 = cur.j_lo * KVBLK;
#pragma unroll
    for (int i = 0; i < 8; ++i) S.qr[i] = load8(cur.Q + (size_t)(wid * QBLK + (lane >> 4) + 4 * i) * cur.ldq + (lane & 15) * 8);
    SLOAD_H(cur.K, cur.K + cur.voff, kb0); VM_WAIT(); SWRITE_HK(0);
    __syncthreads();
}
__device__ __forceinline__ void attn_block(const int tid, const Ctx& C, const Blk& cur, const bf16* nQ, const bf16* nK, int nvoff, int nldq, int nldk, int nj_lo, char* lds, Seam& S) {
    const int wid = __builtin_amdgcn_readfirstlane(tid >> 6), lane = tid & 63, r32 = lane & 31, hi = lane >> 5;
#ifdef AT_TILE2X
    const int j_lo = cur.j_lo, NT0 = cur.j_hi - cur.j_lo, NT = (cur.mode == AT_TILE2X) ? 2 * NT0 : NT0;
#define TIX(t) ((t) >= NT0 ? (t) - NT0 : (t))
#else
    const int j_lo = cur.j_lo, NT = cur.j_hi - cur.j_lo;
#define TIX(t) (t)
#endif
    const int kbn = nj_lo * KVBLK;
    const int mode = cur.mode;
    const int trow = cur.t0 + wid * QBLK;
    int pos, pmin, pmax; unsigned W;
    if (mode == MODE_CMP) { pos = (trow + r32 - 31) >> 4; pmin = (trow - 31) >> 4; pmax = trow >> 4; W = 0x7fffffffu; }
    else if (mode == MODE_NONE) { pos = 1 << 29; pmin = 1 << 29; pmax = 1 << 29; W = 0x7fffffffu; }
    else { pos = trow + r32; pmin = trow; pmax = trow + QBLK - 1; W = (mode == MODE_WIN) ? 512u : 0x7fffffffu; }
    const int qm = pos - 4 * hi;
    char* V_lds = lds; char* K_lds = lds + 2 * SHM_V;
    float* ws = (float*)(lds + LDS_WS) + wid * 64; float* li_l = ws, * al_l = ws + 32;
    unsigned long long* sel_l = (unsigned long long*)(lds + LDS_SEL) + wid * 32;
    if (mode == MODE_SEL && hi == 0) sel_l[r32] = C.SEL[(size_t)cur.bg * SEQ + trow + r32];
    float m_reg = -1e30f, l_reg = 0; f32x16 o[4] = {};
    const int sr = tid >> 4, sc = (tid & 15) * 8, vst0 = v_st(sr, sc), vst1 = v_st(32 + sr, sc), kws = KSWZ(sr, sc * 2);
    const int vb0 = (int)(uintptr_t)V_lds + v_rd_base(lane);
    const bf16* Kh = cur.K; const bf16* Vh = cur.K + cur.voff; const int ldk = cur.ldk;
#define RESC(a) do { if (__any((a) < 1.f)) { if (hi == 0) al_l[r32] = (a); asm volatile("s_waitcnt lgkmcnt(0)" ::: "memory");              \
                     for (int d_ = 0; d_ < 4; ++d_) for (int r = 0; r < 16; ++r) o[d_][r] *= al_l[crow(r, hi)]; } } while (0)
#define KBASE(t) ((j_lo + TIX(t)) * KVBLK)
#define MASKT(P0_, P1_, t, KP_) do { const int kb_ = KBASE(t); KP_ = 1; \
        if (mode == MODE_SEL) { const int bit_ = (int)((sel_l[r32] >> (j_lo + TIX(t))) & 1ull); \
            if (kb_ + KVBLK - 1 > pmin) mask_tile(P0_, P1_, bit_ ? qm - kb_ : -(1 << 30), W);       \
            else KP_ = bit_; }                                                                         \
        else if (kb_ + KVBLK - 1 > pmin || kb_ <= pmax - (int)W) mask_tile(P0_, P1_, qm - kb_, W); } while (0)
    constexpr int NQL = 8;
#define SEAM_K0() do { VMWN(NQL); SWRITE_HK(0); SBAR(); } while (0)
    f32x16 pA0, pA1, pB0, pB1; float mnA, mnB, alA, alB; int kpA = 1, kpB = 1; bf16x8 pa0, pa1, pa2, pa3;
    {
        char* stq = lds + LDS_STG + wid * (32 * 272);
#pragma unroll
        for (int i = 0; i < 8; ++i) *(bf16x8*)(stq + ((lane >> 4) + 4 * i) * 272 + (lane & 15) * 16) = S.qr[i];
        asm volatile("s_waitcnt lgkmcnt(0)" ::: "memory");
#pragma unroll
        for (int d0 = 0; d0 < 8; ++d0) S.qr[d0] = *(const bf16x8*)(stq + r32 * 272 + (2 * d0 + hi) * 16);
        asm volatile("s_waitcnt lgkmcnt(0)" ::: "memory");
    }
    SWRITE_HV(0); SBAR();
    if (NT > 1) { SLOAD_H(Kh, Vh, KBASE(1)); }
    SBAR(); qkt<0>(pA0, pA1, K_lds, r32, hi, S.qr);
    MASKT(pA0, pA1, 0, kpA); partialSM(pA0, pA1, m_reg, mnA, alA);
    if (NT > 1) { VM_WAIT(); SWRITE_H(1); }
    __syncthreads();
#define HALF_STEP(PX0, PX1, mnX, alX, kpX, PY0, PY1, alY, kpY, t, KB, VB, SB) do {                                                      \
        SBAR(); if ((t) + 1 < NT) { SLOAD_H(Kh, Vh, KBASE((t) + 1)); SBAR(); }         \
        qkt<KB>(PX0, PX1, K_lds, r32, hi, S.qr);                                             \
        finishSM(PY0, PY1, alY, l_reg, pa0, pa1, pa2, pa3, kpY); SBAR();                                                      \
        pv_tile<VB>(o, vb0, pa0, pa1, pa2, pa3); MASKT(PX0, PX1, (t), kpX); partialSM(PX0, PX1, m_reg, mnX, alX);                                        \
        __syncthreads();                                                                                                      \
        if ((t) + 1 < NT) { VM_WAIT(); SWRITE_H(SB); }                                                                          \
        RESC(alX); __syncthreads(); } while (0)
    for (int t = 1; t + 1 < NT; t += 2) {
        HALF_STEP(pB0, pB1, mnB, alB, kpB, pA0, pA1, alA, kpA, t, 1, 0, 0);
        HALF_STEP(pA0, pA1, mnA, alA, kpA, pB0, pB1, alB, kpB, t + 1, 0, 1, 1);
    }
    const bool even = (NT & 1) == 0;
    if (even) { SBAR(); qkt<1>(pB0, pB1, K_lds, r32, hi, S.qr); SBAR(); }
    { const int ldk = nldk; SLOAD_H(nK, nK + nvoff, kbn); SBAR(); }
#pragma unroll
    for (int i = 0; i < 8; ++i) S.qr[i] = load8(nQ + (size_t)(wid * QBLK + (lane >> 4) + 4 * i) * nldq + (lane & 15) * 8);
    SBAR();
    finishSM(pA0, pA1, alA, l_reg, pa0, pa1, pa2, pa3, kpA); SBAR();
    pv_tile<0>(o, vb0, pa0, pa1, pa2, pa3);
    if (even) { MASKT(pB0, pB1, NT - 1, kpB); partialSM(pB0, pB1, m_reg, mnB, alB); __syncthreads(); RESC(alB);
        finishSM(pB0, pB1, alB, l_reg, pa0, pa1, pa2, pa3, kpB); SBAR(); pv_tile<1>(o, vb0, pa0, pa1, pa2, pa3); }
    SBAR(); SEAM_K0();
    {
        const int epi = cur.epi;
        float fac = l_reg > 0.f ? __builtin_amdgcn_rcpf(l_reg) : 0.f;
        if (epi != EPI_MEM) fac *= C.gates[(size_t)(cur.row0 + wid * QBLK + r32) * 36 + cur.gcol];
        if (hi == 0) li_l[r32] = fac;
        asm volatile("s_waitcnt lgkmcnt(0)" ::: "memory");
        float* stg = (float*)(lds + LDS_STG) + wid * (32 * 68);
        const int rrow = lane >> 4, c4 = (lane & 15) * 4;
        const size_t grow = (size_t)cur.row0 + wid * QBLK + rrow;
        const bool fin = (epi == EPI_FIN);
        float* accb = C.YACC + grow * NSAW + cur.hcol + c4;
        const bf16* zb = fin ? C.ZQ + grow * NSAW + cur.hcol + c4 : C.ZM + grow * C.zm_ld + C.zm_c0 + cur.hcol + c4;
        const int ldz = fin ? NSAW : C.zm_ld;
        bf16* yb = C.Y + grow * DM + (fin ? 0 : POOLW) + cur.hcol + c4;
#pragma unroll
        for (int half = 0; half < 2; ++half) {
#pragma unroll
            for (int r = 0; r < 16; ++r) { const float f = li_l[crow(r, hi)]; float* w = stg + crow(r, hi) * 68 + r32; w[0] = o[2 * half][r] * f; w[32] = o[2 * half + 1][r] * f; }
            asm volatile("s_waitcnt lgkmcnt(0)" ::: "memory");
            f32x4 v[8];
#pragma unroll
            for (int i = 0; i < 8; ++i) v[i] = *(const f32x4*)(stg + (rrow + 4 * i) * 68 + c4);
            const int co = half * 64;
            if (epi == EPI_ACC0) {
#pragma unroll
                for (int i = 0; i < 8; ++i) *(f32x4*)(accb + (size_t)(4 * i) * NSAW + co) = v[i];
            } else if (epi == EPI_ACC1) {
                f32x4 a[8];
#pragma unroll
                for (int i = 0; i < 8; ++i) a[i] = *(const f32x4*)(accb + (size_t)(4 * i) * NSAW + co);
#pragma unroll
                for (int i = 0; i < 8; ++i) *(f32x4*)(accb + (size_t)(4 * i) * NSAW + co) = a[i] + v[i];
            } else {
                v2u z[8];
#pragma unroll
                for (int i = 0; i < 8; ++i) z[i] = *(const v2u*)(zb + (size_t)(4 * i) * ldz + co);
                if (fin) { f32x4 a[8];
#pragma unroll
                    for (int i = 0; i < 8; ++i) a[i] = *(const f32x4*)(accb + (size_t)(4 * i) * NSAW + co);
#pragma unroll
                    for (int i = 0; i < 8; ++i) v[i] = v[i] + a[i]; }
#pragma unroll
                for (int i = 0; i < 8; ++i) { v2u w; w.x = pk2(v[i][0] * bflo(z[i].x), v[i][1] * bfhi(z[i].x)); w.y = pk2(v[i][2] * bflo(z[i].y), v[i][3] * bfhi(z[i].y));
                    *(v2u*)(yb + (size_t)(4 * i) * DM + co) = w; }
            }
            asm volatile("s_waitcnt lgkmcnt(0)" ::: "memory");
        }
    }
    __syncthreads();
#undef RESC
#undef TIX
#undef KBASE
#undef MASKT
#undef SEAM_K0
#undef HALF_STEP
}
#undef AROW
#undef VMWN
#undef SLOAD_H
#undef SWRITE_HK
#undef SWRITE_HV
#undef SWRITE_H
}
__device__ const unsigned short NSA_TAB[256 * 4] = {
    0, 384, 674, 65535,
    1, 385, 675, 65535,
    144, 480, 484, 65535,
    145, 481, 485, 65535,
    96, 482, 528, 65535,
    97, 483, 529, 65535,
    48, 388, 676, 65535,
    49, 389, 677, 65535,
    148, 432, 530, 65535,
    149, 433, 531, 65535,
    192, 386, 532, 65535,
    193, 387, 533, 65535,
    4, 288, 722, 65535,
    5, 289, 723, 65535,
    98, 436, 576, 65535,
    99, 437, 577, 65535,
    100, 434, 578, 65535,
    101, 435, 579, 65535,
    2, 292, 724, 65535,
    3, 293, 725, 65535,
    146, 336, 628, 65535,
    147, 337, 629, 65535,
    50, 338, 672, 65535,
    51, 339, 673, 65535,
    52, 244, 720, 65535,
    53, 245, 721, 65535,
    194, 340, 580, 65535,
    195, 341, 581, 65535,
    196, 290, 624, 65535,
    197, 291, 625, 65535,
    240, 242, 626, 65535,
    241, 243, 627, 65535,
    6, 390, 680, 65535,
    7, 391, 681, 65535,
    150, 486, 490, 65535,
    151, 487, 491, 65535,
    102, 488, 534, 65535,
    103, 489, 535, 65535,
    54, 394, 682, 65535,
    55, 395, 683, 65535,
    154, 438, 536, 65535,
    155, 439, 537, 65535,
    198, 392, 538, 65535,
    199, 393, 539, 65535,
    10, 294, 728, 65535,
    11, 295, 729, 65535,
    104, 442, 582, 65535,
    105, 443, 583, 65535,
    106, 440, 584, 65535,
    107, 441, 585, 65535,
    8, 298, 730, 65535,
    9, 299, 731, 65535,
    152, 342, 634, 65535,
    153, 343, 635, 65535,
    56, 344, 678, 65535,
    57, 345, 679, 65535,
    58, 250, 726, 65535,
    59, 251, 727, 65535,
    200, 346, 586, 65535,
    201, 347, 587, 65535,
    202, 296, 630, 65535,
    203, 297, 631, 65535,
    246, 248, 632, 65535,
    247, 249, 633, 65535,
    12, 396, 686, 65535,
    13, 397, 687, 65535,
    156, 492, 496, 65535,
    157, 493, 497, 65535,
    108, 494, 540, 65535,
    109, 495, 541, 65535,
    60, 400, 688, 65535,
    61, 401, 689, 65535,
    160, 444, 542, 65535,
    161, 445, 543, 65535,
    204, 398, 544, 65535,
    205, 399, 545, 65535,
    16, 300, 734, 65535,
    17, 301, 735, 65535,
    110, 448, 588, 65535,
    111, 449, 589, 65535,
    112, 446, 590, 65535,
    113, 447, 591, 65535,
    14, 304, 736, 65535,
    15, 305, 737, 65535,
    158, 348, 640, 65535,
    159, 349, 641, 65535,
    62, 350, 684, 65535,
    63, 351, 685, 65535,
    64, 256, 732, 65535,
    65, 257, 733, 65535,
    206, 352, 592, 65535,
    207, 353, 593, 65535,
    208, 302, 636, 65535,
    209, 303, 637, 65535,
    252, 254, 638, 65535,
    253, 255, 639, 65535,
    18, 402, 692, 65535,
    19, 403, 693, 65535,
    162, 498, 502, 65535,
    163, 499, 503, 65535,
    114, 500, 546, 65535,
    115, 501, 547, 65535,
    66, 406, 694, 65535,
    67, 407, 695, 65535,
    166, 450, 548, 65535,
    167, 451, 549, 65535,
    210, 404, 550, 65535,
    211, 405, 551, 65535,
    22, 306, 740, 65535,
    23, 307, 741, 65535,
    116, 454, 594, 65535,
    117, 455, 595, 65535,
    118, 452, 596, 65535,
    119, 453, 597, 65535,
    20, 310, 742, 65535,
    21, 311, 743, 65535,
    164, 354, 646, 65535,
    165, 355, 647, 65535,
    68, 356, 690, 65535,
    69, 357, 691, 65535,
    70, 262, 738, 65535,
    71, 263, 739, 65535,
    212, 358, 598, 65535,
    213, 359, 599, 65535,
    214, 308, 642, 65535,
    215, 309, 643, 65535,
    258, 260, 644, 65535,
    259, 261, 645, 65535,
    24, 408, 698, 65535,
    25, 409, 699, 65535,
    168, 504, 508, 65535,
    169, 505, 509, 65535,
    120, 506, 552, 65535,
    121, 507, 553, 65535,
    72, 412, 700, 65535,
    73, 413, 701, 65535,
    172, 456, 554, 65535,
    173, 457, 555, 65535,
    216, 410, 556, 65535,
    217, 411, 557, 65535,
    28, 312, 746, 65535,
    29, 313, 747, 65535,
    122, 460, 600, 65535,
    123, 461, 601, 65535,
    124, 458, 602, 65535,
    125, 459, 603, 65535,
    26, 316, 748, 65535,
    27, 317, 749, 65535,
    170, 360, 652, 65535,
    171, 361, 653, 65535,
    74, 362, 696, 65535,
    75, 363, 697, 65535,
    76, 268, 744, 65535,
    77, 269, 745, 65535,
    218, 364, 604, 65535,
    219, 365, 605, 65535,
    220, 314, 648, 65535,
    221, 315, 649, 65535,
    264, 266, 650, 65535,
    265, 267, 651, 65535,
    30, 414, 704, 65535,
    31, 415, 705, 65535,
    174, 510, 514, 65535,
    175, 511, 515, 65535,
    126, 512, 558, 65535,
    127, 513, 559, 65535,
    78, 418, 706, 65535,
    79, 419, 707, 65535,
    178, 462, 560, 65535,
    179, 463, 561, 65535,
    222, 416, 562, 65535,
    223, 417, 563, 65535,
    34, 318, 752, 65535,
    35, 319, 753, 65535,
    128, 466, 606, 65535,
    129, 467, 607, 65535,
    130, 464, 608, 65535,
    131, 465, 609, 65535,
    32, 322, 754, 65535,
    33, 323, 755, 65535,
    176, 366, 658, 65535,
    177, 367, 659, 65535,
    80, 368, 702, 65535,
    81, 369, 703, 65535,
    82, 274, 750, 65535,
    83, 275, 751, 65535,
    224, 370, 610, 65535,
    225, 371, 611, 65535,
    226, 320, 654, 65535,
    227, 321, 655, 65535,
    270, 272, 656, 65535,
    271, 273, 657, 65535,
    36, 420, 710, 65535,
    37, 421, 711, 65535,
    180, 516, 520, 65535,
    181, 517, 521, 65535,
    132, 518, 564, 65535,
    133, 519, 565, 65535,
    84, 424, 712, 65535,
    85, 425, 713, 65535,
    184, 468, 566, 65535,
    185, 469, 567, 65535,
    228, 422, 568, 65535,
    229, 423, 569, 65535,
    40, 324, 758, 65535,
    41, 325, 759, 65535,
    134, 472, 612, 65535,
    135, 473, 613, 65535,
    136, 470, 614, 65535,
    137, 471, 615, 65535,
    38, 328, 760, 65535,
    39, 329, 761, 65535,
    182, 372, 664, 65535,
    183, 373, 665, 65535,
    86, 374, 708, 65535,
    87, 375, 709, 65535,
    88, 280, 756, 65535,
    89, 281, 757, 65535,
    230, 376, 616, 65535,
    231, 377, 617, 65535,
    232, 326, 660, 65535,
    233, 327, 661, 65535,
    276, 278, 662, 65535,
    277, 279, 663, 65535,
    42, 426, 716, 65535,
    43, 427, 717, 65535,
    186, 522, 526, 65535,
    187, 523, 527, 65535,
    138, 524, 570, 65535,
    139, 525, 571, 65535,
    90, 430, 718, 65535,
    91, 431, 719, 65535,
    190, 474, 572, 65535,
    191, 475, 573, 65535,
    234, 428, 574, 65535,
    235, 429, 575, 65535,
    46, 330, 764, 65535,
    47, 331, 765, 65535,
    140, 478, 618, 65535,
    141, 479, 619, 65535,
    142, 476, 620, 65535,
    143, 477, 621, 65535,
    44, 334, 766, 65535,
    45, 335, 767, 65535,
    188, 378, 670, 65535,
    189, 379, 671, 65535,
    92, 380, 714, 65535,
    93, 381, 715, 65535,
    94, 286, 762, 65535,
    95, 287, 763, 65535,
    236, 382, 622, 65535,
    237, 383, 623, 65535,
    238, 332, 666, 65535,
    239, 333, 667, 65535,
    282, 284, 668, 65535,
    283, 285, 669, 65535,
};

constexpr int NWAVES = 8, NTHREADS = 512;
constexpr int LDS_BYTES = 147456;
constexpr int NPHASE = 12;
#ifndef MK_PER_PHASE
#define MK_PER_PHASE 0
#endif

struct Args { const void* in[17]; float* out; unsigned char* ws; int ph_lo, ph_hi; };

constexpr int TAB_OFF = LDS_BYTES - 1024;
enum { IX_X = 0, IX_MEM, IX_POS, IX_NORM_G, IX_MEM_NORM_G, IX_W_MEM_KV, IX_W_OUT, IX_A_W_IN, IX_A_W_POOL, IX_A_POOL_SCALE, IX_B_W_IN, IX_KV_NORM_G, IX_W_KV, IX_CMP_PE, IX_CMP_W1, IX_CMP_W2, IX_FINAL_G, IX_OUT, IX_WS };
__device__ __forceinline__ int lane_fresh() { int l; asm volatile("v_mbcnt_lo_u32_b32 %0, -1, 0\n\tv_mbcnt_hi_u32_b32 %0, -1, %0" : "=v"(l)); return l; }
struct Frame {
    LAS unsigned char* lds; char* ldsg;
    int wave, vcu, G;
    __device__ __forceinline__ int tid() const { return wave * 64 + lane_fresh(); }
    __device__ __forceinline__ unsigned char* ptr(int k) const {
        volatile LAS unsigned* t = (volatile LAS unsigned*)(lds + TAB_OFF);
        const unsigned lo = t[2 * k], hi = t[2 * k + 1];
        typedef __attribute__((address_space(1))) unsigned char gchar;
        return (unsigned char*)(gchar*)(((unsigned long long)(unsigned)__builtin_amdgcn_readfirstlane(hi) << 32) | (unsigned)__builtin_amdgcn_readfirstlane(lo));
    }
    __device__ __forceinline__ const float* fin(int k) const { return (const float*)ptr(k); }
};
#define WSP(T, off) ((T*)(ws + (off)))

#define XB_TMO      128
#define XB_XCNT(j)  (256  + 64 * (j))
#define XB_XSUB(j)  (1280 + 64 * (j))
#define XB_XGEN(j)  (2304 + 64 * (j))
#define XB_TOP      3328
#define XB_TOPGEN   3392
#define XCD_BAR_WORDS 3456
#define XB_SPIN_CAP (1u << 20)
constexpr int MISC_OFF = LDS_BYTES - 512;
__device__ __forceinline__ unsigned xb_ld(unsigned* p)              { return __hip_atomic_load(p, __ATOMIC_RELAXED, __HIP_MEMORY_SCOPE_AGENT); }
__device__ __forceinline__ unsigned xb_add(unsigned* p, unsigned v) { return __hip_atomic_fetch_add(p, v, __ATOMIC_RELAXED, __HIP_MEMORY_SCOPE_AGENT); }
__device__ __forceinline__ unsigned xb_xcc_id() { return (unsigned)__builtin_amdgcn_s_getreg((3 << 11) | 20) & 0xFu; }
#define XB_SPIN(cond, bar) do { unsigned _sp = 0; while (cond) { __builtin_amdgcn_s_sleep(1); \
    if ((++_sp & 255u) == 0u) { if (xb_ld(&(bar)[XB_TMO])) break; if (_sp > XB_SPIN_CAP) { atomicAdd(&(bar)[XB_TMO], 1u); break; } } } } while (0)
__device__ __forceinline__ void xcd_barrier_complete(unsigned* bar, unsigned x, unsigned G, unsigned& nloc, unsigned& nx) {
    unsigned sum, cnt, mine, sp = 0u;
    for (;;) {
        sum = 0u; cnt = 0u; mine = 0u;
#pragma unroll
        for (unsigned j = 0; j < 16; ++j) { const unsigned c = xb_ld(&bar[XB_XCNT(j)]); sum += c; cnt += (c > 0u) ? 1u : 0u; mine = (j == x) ? c : mine; }
        if (sum == G) break;
        __builtin_amdgcn_s_sleep(1);
        if ((++sp & 255u) == 0u) { if (xb_ld(&bar[XB_TMO])) break; if (sp > XB_SPIN_CAP) { atomicAdd(&bar[XB_TMO], 1u); break; } }
    }
    nloc = mine > 0u ? mine : 1u; nx = cnt > 0u ? cnt : 1u;
}
__device__ __forceinline__ void xcd_barrier(unsigned* bar, volatile LAS unsigned* st, unsigned G, int tid) {
    asm volatile("s_waitcnt vmcnt(0)" ::: "memory");
    __syncthreads();
    if (tid == 0) {
        const unsigned x = xb_xcc_id();
        __builtin_amdgcn_s_waitcnt(0);
        unsigned nloc = st[0], nx = st[1];
        if (nloc == 0u) { xcd_barrier_complete(bar, x, G, nloc, nx); st[0] = nloc; st[1] = nx; }
        const unsigned old = xb_add(&bar[XB_XSUB(x)], 1u);
        const unsigned gen = old / nloc;
        if (old + 1u == (gen + 1u) * nloc) {
            __builtin_amdgcn_fence(__ATOMIC_RELEASE, "agent");
            asm volatile("s_waitcnt vmcnt(0)" ::: "memory");
            const unsigned og = xb_add(&bar[XB_TOP], 1u);
            const unsigned tg = og / nx;
            if (og + 1u == (tg + 1u) * nx) xb_add(&bar[XB_TOPGEN], 1u);
            else XB_SPIN(xb_ld(&bar[XB_TOPGEN]) == tg, bar);
            __builtin_amdgcn_fence(__ATOMIC_ACQUIRE, "agent");
            xb_add(&bar[XB_XGEN(x)], 1u);
            asm volatile("s_waitcnt vmcnt(0)" ::: "memory");
        } else {
            XB_SPIN(xb_ld(&bar[XB_XGEN(x)]) == gen, bar);
            __builtin_amdgcn_fence(__ATOMIC_ACQUIRE, "agent");
            asm volatile("s_waitcnt vmcnt(0)" ::: "memory");
        }
    }
    __syncthreads();
}

struct TDesc { const float* W; const float* gain; bf16* WT; int ldw, c0, nv, ldt, row0, k0; };
__device__ __forceinline__ void tload(const TDesc& d, f32x4 (&v)[16], int lane) {
    const int n4 = (lane & 15) * 4, kr = lane >> 4;
    const float* src = d.W + (size_t)(d.k0 + kr) * d.ldw + d.c0 + n4;
    if (n4 < d.nv) {
#pragma unroll
        for (int i = 0; i < 16; ++i) v[i] = __builtin_nontemporal_load((const f32x4*)(src + (size_t)(4 * i) * d.ldw));
    } else {
#pragma unroll
        for (int i = 0; i < 16; ++i) v[i] = (f32x4){0.f, 0.f, 0.f, 0.f};
    }
}
__device__ __forceinline__ void tproc(const TDesc& d, f32x4 (&v)[16], LAS float* scr, int lane) {
    const int n4 = (lane & 15) * 4, kr = lane >> 4;
    if (d.gain) {
#pragma unroll
        for (int i = 0; i < 16; ++i) v[i] = v[i] * d.gain[d.k0 + kr + 4 * i];
    }
#pragma unroll
    for (int i = 0; i < 16; ++i) { LAS float* q = scr + (kr + 4 * i) * 65 + n4; q[0] = v[i][0]; q[1] = v[i][1]; q[2] = v[i][2]; q[3] = v[i][3]; }
    LDS_WAIT(); asm volatile("" ::: "memory");
    const int ch = lane & 7;
#pragma unroll
    for (int j = 0; j < 8; ++j) { const int n = (lane >> 3) + 8 * j; const LAS float* s = scr + (8 * ch) * 65 + n;
        v4u o; o.x = pk2(s[0 * 65], s[1 * 65]); o.y = pk2(s[2 * 65], s[3 * 65]); o.z = pk2(s[4 * 65], s[5 * 65]); o.w = pk2(s[6 * 65], s[7 * 65]);
        if (n < d.nv) *(v4u*)(d.WT + (size_t)(d.row0 + n) * d.ldt + d.k0 + 8 * ch) = o; }
    LDS_WAIT(); asm volatile("" ::: "memory");
}
__device__ __forceinline__ void rms_load(const float* xrow, f32x4 (&v)[8], int lane) {
    const f32x4* xr = (const f32x4*)xrow + lane;
#pragma unroll
    for (int j = 0; j < 8; ++j) v[j] = __builtin_nontemporal_load(xr + 64 * j);
}
__device__ __forceinline__ void rms_finish(f32x4 (&v)[8], const float* g, bf16* orow, int lane) {
    float s = 0.f;
#pragma unroll
    for (int j = 0; j < 8; ++j) s += (v[j].x * v[j].x + v[j].y * v[j].y) + (v[j].z * v[j].z + v[j].w * v[j].w);
    const float rinv = 1.0f / sqrtf(wave_sum(s) * (1.f / DM) + EPS);
    unsigned long long* o8 = (unsigned long long*)orow + lane;
#pragma unroll
    for (int j = 0; j < 8; ++j) { f32x4 gg = g ? ((const f32x4*)g)[64 * j + lane] : (f32x4){1.f, 1.f, 1.f, 1.f};
        o8[64 * j] = (unsigned long long)pk2(v[j].x * rinv * gg.x, v[j].y * rinv * gg.y) | ((unsigned long long)pk2(v[j].z * rinv * gg.z, v[j].w * rinv * gg.w) << 32); }
}
__device__ __forceinline__ void sincos_acc(float angf, float& c, float& s) {
    const double a = (double)angf;
    const double kq = rint(a * 0.63661977236758134308);
    const double r = fma(-kq, 6.123233995736766e-17, fma(-kq, 1.5707963267948966, a));
    const double r2 = r * r;
    double sp = -2.5052108385441718775e-08; sp = fma(sp, r2, 2.7557319223985890653e-06); sp = fma(sp, r2, -1.9841269841269841270e-04); sp = fma(sp, r2, 8.3333333333333332177e-03); sp = fma(sp, r2, -1.6666666666666665741e-01);
    const double sn = fma(sp * r2, r, r) + r2 * r2 * r2 * r2 * r2 * r2 * r * 1.6059043836821614599e-10;
    double cp = 2.0876756987868098979e-09; cp = fma(cp, r2, -2.7557319223985890653e-07); cp = fma(cp, r2, 2.4801587301587301566e-05); cp = fma(cp, r2, -1.3888888888888889419e-03); cp = fma(cp, r2, 4.1666666666666664354e-02); cp = fma(cp, r2, -0.5);
    const double cs = fma(cp, r2, 1.0);
    const int q = ((int)kq) & 3;
    const double sv = (q & 1) ? cs : sn, cv = (q & 1) ? sn : cs;
    s = (float)((q & 2) ? -sv : sv);
    c = (float)(((q + 1) & 2) ? -cv : cv);
}
__device__ __forceinline__ float rope_inv(int i) {
    return (float)exp2(-(double)i * (18.931568569324174 / 16.0));
}

template <int WHICH>
__device__ __forceinline__ void transposes(Frame& F, int gw, int NGW, int lane) {
    unsigned char* ws = F.ptr(IX_WS);
    LAS float* scr = (LAS float*)(F.lds + F.wave * 16640);
    const float* a_w_in = F.fin(IX_A_W_IN); const float* w_out = F.fin(IX_W_OUT); const float* w_kv = F.fin(IX_W_KV); const float* b_w_in = F.fin(IX_B_W_IN);
    const float* norm_g = F.fin(IX_NORM_G); const float* kv_norm_g = F.fin(IX_KV_NORM_G); const float* mem_norm_g = F.fin(IX_MEM_NORM_G); const float* w_mem_kv = F.fin(IX_W_MEM_KV);
    const float* a_w_pool = F.fin(IX_A_W_POOL); const float* cmp_w1 = F.fin(IX_CMP_W1);
    bf16* W1T = WSP(bf16, WS_W1T); bf16* WO0T = WSP(bf16, WS_WO0T); bf16* W4T = WSP(bf16, WS_W4T); bf16* WO1T = WSP(bf16, WS_WO1T);
    bf16* WMT = WSP(bf16, WS_WMT); bf16* WPT = WSP(bf16, WS_WPT); bf16* WC1T = WSP(bf16, WS_WC1T);
#define SEG(W_, ldw_, K_, c0_, nc_, WT_, row0_, gain_) if (!done_) { const int nb_ = ((nc_) + 63) / 64, ni_ = ((K_) / 64) * nb_; \
        if (r < ni_) { const int kb = r / nb_, nb = r % nb_; int nv = (nc_) - nb * 64; nv = nv > 64 ? 64 : nv; \
            d.W = W_; d.gain = gain_; d.WT = WT_; d.ldw = ldw_; d.c0 = (c0_) + nb * 64; d.nv = nv; d.ldt = K_; d.row0 = (row0_) + nb * 64; d.k0 = kb * 64; done_ = true; } else r -= ni_; }
#define TDECODE(it_, dd_) do { TDesc& d = (dd_); int r = (it_); bool done_ = false; \
      if constexpr (WHICH == 0) { \
        SEG(a_w_in, N1, DM, 0, N1, W1T, 0, nullptr) \
        SEG(w_mem_kv, 1024, DM, 0, 1024, WMT, 0, mem_norm_g) \
      } else { \
        SEG(w_out, DM, DM, 0, DM, WO0T, 0, nullptr) \
        SEG(w_out + (size_t)DM * DM, DM, DM, 0, DM, WO1T, 0, nullptr) \
        SEG(w_kv, NKV, DM, 0, NKV, W4T, 0, kv_norm_g) \
        SEG(b_w_in, 4132, DM, 0, 1536, W4T, 3072, norm_g + DM)            \
        SEG(b_w_in, 4132, DM, 1572, 1536, W4T, 4608, norm_g + DM)         \
        SEG(b_w_in, 4132, DM, 3108, 512, W4T, 6144, norm_g + DM)          \
        SEG(b_w_in, 4132, DM, 3620, 512, W4T, 6656, norm_g + DM)          \
        SEG(b_w_in, 4132, DM, 1536, 36, W4T, 7168, norm_g + DM)           \
        SEG(w_mem_kv + (size_t)DM * 1024, 1024, DM, 0, 1024, WMT + (size_t)1024 * DM, 0, mem_norm_g + DM) \
        SEG(a_w_pool + 0 * 384 * 384, 384, 384, 0, 384, WPT + 0 * 512 * 384, 0, nullptr) \
        SEG(a_w_pool + 1 * 384 * 384, 384, 384, 0, 384, WPT + 1 * 512 * 384, 0, nullptr) \
        SEG(a_w_pool + 2 * 384 * 384, 384, 384, 0, 384, WPT + 2 * 512 * 384, 0, nullptr) \
        SEG(a_w_pool + 3 * 384 * 384, 384, 384, 0, 384, WPT + 3 * 512 * 384, 0, nullptr) \
        SEG(cmp_w1, 256, 4096, 0, 256, WC1T, 0, nullptr) \
        SEG(cmp_w1 + (size_t)4096 * 256, 256, 4096, 0, 256, WC1T + (size_t)256 * 4096, 0, nullptr) \
      } \
    } while (0)
    constexpr int NITEMS = WHICH == 0 ? 32 * 64 + 32 * 16 : 2 * 32 * 32 + 32 * 48 + 32 * (24 + 24 + 8 + 8 + 1) + 32 * 16 + 4 * 6 * 6 + 2 * 64 * 4;
    {
        TDesc da{}, db{}; f32x4 va[16], vb[16];
        if (gw < NITEMS) { TDECODE(gw, da); tload(da, va, lane); }
        for (int it = gw; it < NITEMS; it += 2 * NGW) {
            const bool hb = it + NGW < NITEMS;
            if (hb) { TDECODE(it + NGW, db); tload(db, vb, lane); }
            tproc(da, va, scr, lane);
            if (it + 2 * NGW < NITEMS) { TDECODE(it + 2 * NGW, da); tload(da, va, lane); }
            if (hb) tproc(db, vb, scr, lane);
        }
    }
#undef TDECODE
#undef SEG
}

__device__ __forceinline__ void p0_prologue(Frame& F) {
    const int tid = F.tid(), lane = tid & 63; unsigned char* ws = F.ptr(IX_WS);
    const int gw = F.vcu * NWAVES + F.wave, NGW = F.G * NWAVES;
    const float* norm_g = F.fin(IX_NORM_G); const float* cmp_w1 = F.fin(IX_CMP_W1);
    bf16* W4T = WSP(bf16, WS_W4T); bf16* WPT = WSP(bf16, WS_WPT);
    transposes<0>(F, gw, NGW, lane);
    transposes<1>(F, gw, NGW, lane);
    bf16* XN = WSP(bf16, WS_B); bf16* MEMN = WSP(bf16, WS_MEMN);
    { const float* xin = F.fin(IX_X); const float* memin = F.fin(IX_MEM);
      constexpr int NROWS = MTOK + NB * MEMLEN;
      for (int m = gw; m < NROWS; m += 4 * NGW) {
          f32x4 a[8], b[8], c[8], d[8];
          const int m1 = m + NGW, m2 = m + 2 * NGW, m3 = m + 3 * NGW;
#define RSRC(mm) ((mm) < MTOK ? xin + (size_t)(mm) * DM : memin + (size_t)((mm) - MTOK) * DM)
#define RFIN(mm, v) do { if ((mm) < MTOK) rms_finish(v, norm_g, XN + (size_t)(mm) * DM, lane); else rms_finish(v, nullptr, MEMN + (size_t)((mm) - MTOK) * DM, lane); } while (0)
          rms_load(RSRC(m), a, lane);
          if (m1 < NROWS) rms_load(RSRC(m1), b, lane);
          if (m2 < NROWS) rms_load(RSRC(m2), c, lane);
          if (m3 < NROWS) rms_load(RSRC(m3), d, lane);
          RFIN(m, a);
          if (m1 < NROWS) RFIN(m1, b);
          if (m2 < NROWS) RFIN(m2, c);
          if (m3 < NROWS) RFIN(m3, d);
#undef RSRC
#undef RFIN
      } }
    const int gt = F.vcu * NTHREADS + tid, NGT = F.G * NTHREADS; const int* positions = (const int*)F.ptr(IX_POS);
    float* ROPE = WSP(float, WS_ROPE); float* ROPEC = WSP(float, WS_ROPEC);
    {
    for (int i = gt; i < MTOK * 16; i += NGT) { const int tok = i >> 4, fi = i & 15;
        const float ang = (float)positions[tok] * rope_inv(fi); float c, s; sincos_acc(ang, c, s);
        ROPE[tok * 32 + fi] = c; ROPE[tok * 32 + 16 + fi] = s; }
    for (int i = gt; i < NB * 256 * 16; i += NGT) { const int bn = i >> 4, fi = i & 15, b = bn >> 8, n = bn & 255;
        float c = 1.f, s = 0.f;
        if (n < NCMP) { const float ang = (float)positions[b * SEQ + 16 * n + 31] * rope_inv(fi); sincos_acc(ang, c, s); }
        ROPEC[bn * 32 + fi] = c; ROPEC[bn * 32 + 16 + fi] = s; }
    }
    { v4u z = {0u, 0u, 0u, 0u};
      v4u* p = (v4u*)(W4T + (size_t)7204 * DM); for (int i = gt; i < 220 * DM / 8; i += NGT) p[i] = z;
      for (int g = 0; g < 4; ++g) { v4u* q = (v4u*)(WPT + (size_t)g * 512 * 384 + 384 * 384); for (int i = gt; i < 128 * 384 / 8; i += NGT) q[i] = z; }
      v4u* kvp = (v4u*)(WSP(bf16, WS_KVB) + (size_t)MTOK * NKV); for (int i = gt; i < 32 * NKV / 8; i += NGT) kvp[i] = z;
      for (int b = 0; b < NB; ++b) { v4u* k = (v4u*)(WSP(bf16, WS_KCMP) + (size_t)(b * 256 + 255) * 512); v4u* v = (v4u*)(WSP(bf16, WS_VCMP) + (size_t)(b * 256 + 255) * 512);
          for (int i = gt; i < 512 / 8; i += NGT) { k[i] = z; v[i] = z; } } }
    __syncthreads();
    for (int item = F.vcu; item < 64; item += F.G) {
        const int ks = item & 7, kv = (item >> 3) & 1, j = (item >> 4) * 64 + lane; const float* pe = F.fin(IX_CMP_PE) + kv * 4096; const float* w1 = cmp_w1 + (size_t)kv * 4096 * 256;
        float a = 0.f; const int kb = ks * 512 + F.wave * 64;
#pragma unroll 8
        for (int k = kb; k < kb + 64; ++k) a = fmaf(pe[k], w1[(size_t)k * 256 + j], a);
        LAS float* red = (LAS float*)F.lds;
        red[F.wave * 64 + lane] = a; __syncthreads();
        if (F.wave == 0) { float t = 0.f; for (int w = 0; w < 8; ++w) t += red[w * 64 + lane]; WSP(float, WS_CBIAS)[(ks * 2 + kv) * 256 + j] = t; }
        __syncthreads();
    }
}

__device__ __forceinline__ void st_bf4(bf16* p, f32x4 v) { v2u w; w.x = cvtpk(v[0], v[1]); w.y = cvtpk(v[2], v[3]); *(v2u*)p = w; }
__device__ __forceinline__ f32x4 silu4(f32x4 v) { return (f32x4){silu_f(v[0]), silu_f(v[1]), silu_f(v[2]), silu_f(v[3])}; }
__device__ __forceinline__ void p2_pool(Frame& F) {
    unsigned char* ws = F.ptr(IX_WS);
    {
        const float* SL = (const float*)(ws + WS_D); bf16* MKV0 = WSP(bf16, WS_MKV);
        const int gt0 = F.vcu * NTHREADS + F.tid(), NGT0 = F.G * NTHREADS;
        for (int i = gt0; i < 2 * 1024 * 1024 / 4; i += NGT0) { const float* s0 = SL + (size_t)(i >> 18) * 8 * 1024 * 1024 + (size_t)(i & 262143) * 4; f32x4 a = *(const f32x4*)s0;
#pragma unroll
            for (int z = 1; z < 8; ++z) a += *(const f32x4*)(s0 + (size_t)z * 1024 * 1024);
            st_bf4(MKV0 + (size_t)i * 4, a); }
    }
    const bf16* PROJ = WSP(bf16, WS_A); bf16* POOLED = WSP(bf16, WS_C);
    const int gt = F.vcu * NTHREADS + F.tid(), NGT = F.G * NTHREADS;
    constexpr int NV = POOLW / 8;
    for (int idx = gt; idx < (MTOK / 32) * NV; idx += NGT) {
        const int vec = idx % NV, chunk = idx / NV, g = vec / 48, win = 2 << g;
        const int row0 = chunk * 32, tb0 = row0 & (SEQ - 1);
        const bf16* up = PROJ + (size_t)row0 * N1 + vec * 8;
        float S[8];
#pragma unroll
        for (int e = 0; e < 8; ++e) S[e] = 0.f;
        for (int i = 1; i < win; ++i) if (tb0 - i >= 0) { const v4u w = *(const v4u*)(up - (size_t)i * N1);
            S[0] += bflo(w.x); S[1] += bfhi(w.x); S[2] += bflo(w.y); S[3] += bfhi(w.y); S[4] += bflo(w.z); S[5] += bfhi(w.z); S[6] += bflo(w.w); S[7] += bfhi(w.w); }
        for (int t = 0; t < 32; ++t) {
            const v4u w = *(const v4u*)(up + (size_t)t * N1);
            float u[8] = {bflo(w.x), bfhi(w.x), bflo(w.y), bfhi(w.y), bflo(w.z), bfhi(w.z), bflo(w.w), bfhi(w.w)};
            const int tb = tb0 + t; const float inv = 1.0f / (float)(tb + 1 < win ? tb + 1 : win);
            float o[8];
#pragma unroll
            for (int e = 0; e < 8; ++e) { S[e] += u[e]; o[e] = S[e] * inv - u[e]; }
            v4u ow; ow.x = pk2(o[0], o[1]); ow.y = pk2(o[2], o[3]); ow.z = pk2(o[4], o[5]); ow.w = pk2(o[6], o[7]);
            *(v4u*)(POOLED + (size_t)(row0 + t) * POOLW + vec * 8) = ow;
            if (tb - win + 1 >= 0) { const v4u x = *(const v4u*)(up + (ptrdiff_t)(t - win + 1) * N1);
                S[0] -= bflo(x.x); S[1] -= bfhi(x.x); S[2] -= bflo(x.y); S[3] -= bfhi(x.y); S[4] -= bflo(x.z); S[5] -= bfhi(x.z); S[6] -= bflo(x.w); S[7] -= bfhi(x.w); }
        }
    }
}

struct SchedLin {
    int nM, nN, nz, G, c, wgm;
    const char* A; const char* B; size_t a_pm, a_z, b_pn, b_z;
    int xM, xN; const char* XA; const char* XB; size_t xa_pm, xb_pn;
    __device__ __forceinline__ bool next(int i, pg8::Unit& u) const {
        const long L = (long)i * G + c; const int per = nM * nN; const long tot = (long)per * nz;
        if (L < tot) { const int z = (int)(L / per); int pm, pn; pg8::tile_swz((int)(L % per), nM, nN, wgm, pm, pn);
            u.pm = pm; u.pn = pn; u.z = z; u.kind = 0; u.a = A + pm * a_pm + z * a_z; u.b = B + pn * b_pn + z * b_z; return true; }
        const long X = L - tot; if (X >= (long)xM * xN) return false;
        u.pm = (int)(X / xN); u.pn = (int)(X % xN); u.z = 0; u.kind = 1; u.a = XA + u.pm * xa_pm; u.b = XB + u.pn * xb_pn; return true;
    }
};
struct SchedCmp {
    int G, c; const char* KV; const char* W;
    __device__ __forceinline__ bool next(int i, pg8::Unit& u) const {
        const int L = i * G + c; if (L >= 256) return false;
        const int pm = L & 15, kv = (L >> 4) & 1, ks = L >> 5, b = pm >> 2, g = pm & 3;
        u.pm = pm; u.pn = 0; u.z = ks * 2 + kv; u.kind = 0;
        u.a = KV + ((size_t)((kv * 4 + b) * 4 + g) * SEQ * 128 + ks * 512) * 2;
        u.b = W + ((size_t)kv * 256 * 4096 + ks * 512) * 2;
        return true;
    }
};

struct SchedMem {
    int G, c; const char* A; const char* B;
    __device__ __forceinline__ bool next(int i, pg8::Unit& u) const {
        const int L = i * G + c; if (L >= 256) return false;
        const int pm = L & 3, pn = (L >> 2) & 3, ks = (L >> 4) & 7, layer = L >> 7;
        u.pm = pm; u.pn = pn; u.z = layer * 8 + ks; u.kind = 0;
        u.a = A + (size_t)pm * 256 * DM * 2 + ks * 512;
        u.b = B + ((size_t)layer * 1024 + pn * 256) * DM * 2 + ks * 512;
        return true;
    }
};
struct SchedGate {
    int G, c; const char* A; const char* B;
    __device__ __forceinline__ bool next(int i, pg8::Unit& u) const {
        const int L = i * G + c; if (L >= 256) return false;
        const int pm = L >> 2, ks = L & 3;
        u.pm = pm; u.pn = 0; u.z = ks; u.kind = 0;
        u.a = A + (size_t)pm * 256 * DM * 2 + ks * 1024;
        u.b = B + ks * 1024;
        return true;
    }
};

#define EPI_ROWS(ai, m) (u.pm * 256 + (ai) * 128 + wr * 64 + (m) * 16 + fr)
#define EPI_COL(bj, n) ((bj) * 128 + wc * 32 + (n) * 16 + fq * 4)
typedef f32x4 acc_t[2][2][4][2];

#define EPI_C8(bj) (64 * wc + 32 * (bj) + 8 * fq)
__device__ __forceinline__ void st_bf8(bf16* p, f32x4 a, f32x4 b) { v4u w; w.x = cvtpk(a[0], a[1]); w.y = cvtpk(a[2], a[3]); w.z = cvtpk(b[0], b[1]); w.w = cvtpk(b[2], b[3]); *(v4u*)p = w; }
struct Epi1 {
    static constexpr bool PERM = true;
    bf16* proj;
    struct State {};
    __device__ __forceinline__ void begin(acc_t& acc, State&, const pg8::Unit&, int, int, int, int) const {
#pragma unroll
        for (int a = 0; a < 2; ++a)
#pragma unroll
            for (int b = 0; b < 2; ++b)
#pragma unroll
                for (int m = 0; m < 4; ++m)
#pragma unroll
                    for (int n = 0; n < 2; ++n) acc[a][b][m][n] = (f32x4){0.f, 0.f, 0.f, 0.f};
    }
    __device__ __forceinline__ void operator()(const acc_t& acc, State&, const pg8::Unit& u, int wr, int wc, int fr, int fq) const {
        const bool act = (u.pn >= 6 && u.pn < 12) || u.pn >= 14;
#pragma unroll
        for (int ai = 0; ai < 2; ++ai)
#pragma unroll
            for (int m = 0; m < 4; ++m) { bf16* rowp = proj + (size_t)EPI_ROWS(ai, m) * N1 + u.pn * 256;
#pragma unroll
                for (int bj = 0; bj < 2; ++bj) { f32x4 v0 = acc[ai][bj][m][0], v1 = acc[ai][bj][m][1]; if (act) { v0 = silu4(v0); v1 = silu4(v1); } st_bf8(rowp + EPI_C8(bj), v0, v1); } }
    }
};
struct Epi3 {
    static constexpr bool PERM = true;
    const float* scale; const bf16* proj; bf16* y0;
    struct State {};
    __device__ __forceinline__ void begin(acc_t& acc, State&, const pg8::Unit&, int, int, int, int) const {
#pragma unroll
        for (int a = 0; a < 2; ++a)
#pragma unroll
            for (int b = 0; b < 2; ++b)
#pragma unroll
                for (int m = 0; m < 4; ++m)
#pragma unroll
                    for (int n = 0; n < 2; ++n) acc[a][b][m][n] = (f32x4){0.f, 0.f, 0.f, 0.f};
    }
    __device__ __forceinline__ void operator()(const acc_t& acc, State&, const pg8::Unit& u, int wr, int wc, int fr, int fq) const {
        const int g = u.z;
#pragma unroll
        for (int ai = 0; ai < 2; ++ai)
#pragma unroll
            for (int m = 0; m < 4; ++m) { const size_t row = EPI_ROWS(ai, m);
#pragma unroll
                for (int bj = 0; bj < 2; ++bj) { const int d = u.pn * 256 + EPI_C8(bj);
                    if (d < 384) {
                        const f32x4 sc0 = *(const f32x4*)(scale + g * 384 + d), sc1 = *(const f32x4*)(scale + g * 384 + d + 4);
                        const v4u zw = *(const v4u*)(proj + row * N1 + POOLW + g * 384 + d);
                        f32x4 v0 = acc[ai][bj][m][0] * sc0, v1 = acc[ai][bj][m][1] * sc1;
                        v0[0] *= bflo(zw.x); v0[1] *= bfhi(zw.x); v0[2] *= bflo(zw.y); v0[3] *= bfhi(zw.y); v1[0] *= bflo(zw.z); v1[1] *= bfhi(zw.z); v1[2] *= bflo(zw.w); v1[3] *= bfhi(zw.w);
                        st_bf8(y0 + row * DM + g * 384 + d, v0, v1); } }
                asm volatile("" ::: "memory"); }
    }
};
template <bool RES_BF16>
struct EpiRes {
    static constexpr bool PERM = true;
    const void* res; bf16* hb; float* ss;
    struct State {};
    __device__ __forceinline__ void begin(acc_t& acc, State&, const pg8::Unit& u, int wr, int wc, int fr, int fq) const {
#pragma unroll
        for (int ai = 0; ai < 2; ++ai)
#pragma unroll
            for (int m = 0; m < 4; ++m) { const size_t row = EPI_ROWS(ai, m);
#pragma unroll
                for (int bj = 0; bj < 2; ++bj) { const size_t off = row * DM + u.pn * 256 + EPI_C8(bj);
                    if constexpr (RES_BF16) { const v4u w = *(const v4u*)((const bf16*)res + off);
                        acc[ai][bj][m][0] = (f32x4){bflo(w.x), bfhi(w.x), bflo(w.y), bfhi(w.y)}; acc[ai][bj][m][1] = (f32x4){bflo(w.z), bfhi(w.z), bflo(w.w), bfhi(w.w)}; }
                    else { acc[ai][bj][m][0] = __builtin_nontemporal_load((const f32x4*)((const float*)res + off)); acc[ai][bj][m][1] = __builtin_nontemporal_load((const f32x4*)((const float*)res + off + 4)); } } }
    }
    __device__ __forceinline__ void operator()(const acc_t& acc, State&, const pg8::Unit& u, int wr, int wc, int fr, int fq) const {
#pragma unroll
        for (int ai = 0; ai < 2; ++ai)
#pragma unroll
            for (int m = 0; m < 4; ++m) { const size_t row = EPI_ROWS(ai, m); float s = 0.f;
#pragma unroll
                for (int bj = 0; bj < 2; ++bj) { const f32x4 h0 = acc[ai][bj][m][0], h1 = acc[ai][bj][m][1];
                    st_bf8(hb + row * DM + u.pn * 256 + EPI_C8(bj), h0, h1);
                    s += (h0[0] * h0[0] + h0[1] * h0[1]) + (h0[2] * h0[2] + h0[3] * h0[3]) + (h1[0] * h1[0] + h1[1] * h1[1]) + (h1[2] * h1[2] + h1[3] * h1[3]); }
                s += __shfl_xor(s, 16); s += __shfl_xor(s, 32);
                if (fq == 0) ss[row * 32 + u.pn * 4 + wc] = s; }
    }
};
struct Epi5 {
    static constexpr bool PERM = true;
    const float* rinv1; bf16 *kv, *q1, *zq, *qm1, *zm1;
    struct State { float rinv[2][4]; };
    __device__ __forceinline__ void begin(acc_t& acc, State& st, const pg8::Unit& u, int wr, int wc, int fr, int fq) const {
#pragma unroll
        for (int a = 0; a < 2; ++a)
#pragma unroll
            for (int b = 0; b < 2; ++b)
#pragma unroll
                for (int m = 0; m < 4; ++m)
#pragma unroll
                    for (int n = 0; n < 2; ++n) acc[a][b][m][n] = (f32x4){0.f, 0.f, 0.f, 0.f};
#pragma unroll
        for (int ai = 0; ai < 2; ++ai)
#pragma unroll
            for (int m = 0; m < 4; ++m) st.rinv[ai][m] = rinv1[EPI_ROWS(ai, m)];
    }
    __device__ __forceinline__ void operator()(const acc_t& acc, State& st, const pg8::Unit& u, int wr, int wc, int fr, int fq) const {
        const int pn = u.pn;
        bf16* base; int ld, c0; bool act = false;
        const bool kvt = pn < 12;
        if (kvt) { base = kv; ld = 128; c0 = 0; }
        else if (pn < 18) { base = q1; ld = NSAW; c0 = (pn - 12) * 256; }
        else if (pn < 24) { base = zq; ld = NSAW; c0 = (pn - 18) * 256; act = true; }
        else if (pn < 26) { base = qm1; ld = MEMW; c0 = (pn - 24) * 256; }
        else { base = zm1; ld = MEMW; c0 = (pn - 26) * 256; act = true; }
#pragma unroll
        for (int ai = 0; ai < 2; ++ai)
#pragma unroll
            for (int m = 0; m < 4; ++m) { const size_t row = EPI_ROWS(ai, m);
                const float rinv = st.rinv[ai][m];
#pragma unroll
                for (int bj = 0; bj < 2; ++bj) {
                    f32x4 v0 = acc[ai][bj][m][0] * rinv, v1 = acc[ai][bj][m][1] * rinv;
                    if (act) { v0 = silu4(v0); v1 = silu4(v1); }
                    if (kvt) { const int g = (pn & 1) * 2 + (wc >> 1), d = 64 * (wc & 1) + 32 * bj + 8 * fq; const size_t b = row >> 12, t = row & (SEQ - 1);
                        st_bf8(kv + ((((size_t)(pn >> 1) * 4 + b) * 4 + g) * SEQ + t) * 128 + d, v0, v1); }
                    else st_bf8(base + row * ld + c0 + EPI_C8(bj), v0, v1); } }
    }
};
struct Epi6 {
    static constexpr bool PERM = false;
    float* base; int ld; size_t plane;
    struct State {};
    __device__ __forceinline__ void begin(acc_t& acc, State&, const pg8::Unit&, int, int, int, int) const {
#pragma unroll
        for (int a = 0; a < 2; ++a)
#pragma unroll
            for (int b = 0; b < 2; ++b)
#pragma unroll
                for (int m = 0; m < 4; ++m)
#pragma unroll
                    for (int n = 0; n < 2; ++n) acc[a][b][m][n] = (f32x4){0.f, 0.f, 0.f, 0.f};
    }
    __device__ __forceinline__ void operator()(const acc_t& acc, State&, const pg8::Unit& u, int wr, int wc, int fr, int fq) const {
        float* b0 = base + (size_t)u.z * plane + u.pn * 256;
#pragma unroll
        for (int ai = 0; ai < 2; ++ai)
#pragma unroll
            for (int m = 0; m < 4; ++m) { float* rowp = b0 + (size_t)EPI_ROWS(ai, m) * ld;
#pragma unroll
                for (int bj = 0; bj < 2; ++bj)
#pragma unroll
                    for (int n = 0; n < 2; ++n) *(f32x4*)(rowp + EPI_COL(bj, n)) = acc[ai][bj][m][n]; }
    }
};
struct EpiG {
    static constexpr bool PERM = true;
    float* slab;
    struct State {};
    __device__ __forceinline__ void begin(acc_t& acc, State&, const pg8::Unit&, int, int, int, int) const {
#pragma unroll
        for (int a = 0; a < 2; ++a)
#pragma unroll
            for (int b = 0; b < 2; ++b)
#pragma unroll
                for (int m = 0; m < 4; ++m)
#pragma unroll
                    for (int n = 0; n < 2; ++n) acc[a][b][m][n] = (f32x4){0.f, 0.f, 0.f, 0.f};
    }
    __device__ __forceinline__ void operator()(const acc_t& acc, State&, const pg8::Unit& u, int wr, int wc, int fr, int fq) const {
        if (wc != 0) return;
        float* b0 = slab + (size_t)u.z * MTOK * 36;
#pragma unroll
        for (int ai = 0; ai < 2; ++ai)
#pragma unroll
            for (int m = 0; m < 4; ++m) { float* rowp = b0 + (size_t)EPI_ROWS(ai, m) * 36;
                *(f32x4*)(rowp + 8 * fq) = acc[ai][0][m][0]; *(f32x4*)(rowp + 8 * fq + 4) = acc[ai][0][m][1];
                if (fq == 0) *(f32x4*)(rowp + 32) = acc[ai][1][m][0]; }
    }
};

__device__ __forceinline__ void rinv_pass(Frame& F) {
    unsigned char* ws = F.ptr(IX_WS); const float* SS1 = WSP(float, WS_SS1); float* RINV = WSP(float, WS_RINV1);
    const int gt = F.vcu * NTHREADS + F.tid(), NGT = F.G * NTHREADS;
    for (int i = gt; i < MTOK * 4; i += NGT) { const int row = i >> 2, q = i & 3;
        const f32x4 a = *(const f32x4*)(SS1 + (size_t)row * 32 + q * 8), b = *(const f32x4*)(SS1 + (size_t)row * 32 + q * 8 + 4);
        float s = ((a[0] + a[1]) + (a[2] + a[3])) + ((b[0] + b[1]) + (b[2] + b[3]));
        s += __shfl_xor(s, 1); s += __shfl_xor(s, 2);
        if (q == 0) RINV[row] = 1.0f / sqrtf(s * (1.f / DM) + EPS); }
}
__device__ __forceinline__ void gates_finish(Frame& F) {
    unsigned char* ws = F.ptr(IX_WS); const float* SL = WSP(float, WS_C); const float* RINV = WSP(float, WS_RINV1); float* GATES = WSP(float, WS_GATES);
    const int gt = F.vcu * NTHREADS + F.tid(), NGT = F.G * NTHREADS;
    for (int i = gt; i < MTOK * 9; i += NGT) { const int row = i / 9, c4 = (i - row * 9) * 4;
        const float rinv = RINV[row];
        f32x4 a = *(const f32x4*)(SL + (size_t)row * 36 + c4);
#pragma unroll
        for (int z = 1; z < 4; ++z) a += *(const f32x4*)(SL + (size_t)z * MTOK * 36 + (size_t)row * 36 + c4);
        a = a * rinv;
        *(f32x4*)(GATES + (size_t)row * 36 + c4) = (f32x4){sigmoid_f(a[0]), sigmoid_f(a[1]), sigmoid_f(a[2]), sigmoid_f(a[3])}; }
}
__device__ __forceinline__ void rope_pass(Frame& F) {
    unsigned char* ws = F.ptr(IX_WS); bf16* Q1 = WSP(bf16, WS_Q1); bf16* KV = WSP(bf16, WS_KVB); const float* ROPE = WSP(float, WS_ROPE);
    const int gt = F.vcu * NTHREADS + F.tid(), NGT = F.G * NTHREADS;
    constexpr int NQI = MTOK * NHEAD * 2, NKI = 2 * MTOK * NKVH * 2, NI = NQI + NKI;
    for (int i0 = gt; i0 < NI; i0 += 5 * NGT) {
        bf16* pp[5]; v4u x1[5], x2[5]; f32x4 c0[5], c1[5], s0[5], s1[5];
#pragma unroll
        for (int e = 0; e < 5; ++e) { const int i = i0 + e * NGT; pp[e] = nullptr;
            if (i < NI) { const int q = i & 1; int row; bf16* p;
                if (i < NQI) { const int rh = i >> 1; row = rh / NHEAD; p = Q1 + (size_t)row * NSAW + (rh - row * NHEAD) * 128; }
                else { const int k = (i - NQI) >> 1, t = k & (SEQ - 1), sg = k >> 12, kind = 2 + 2 * (sg >> 4), bg = sg & 15;
                    row = (bg >> 2) * SEQ + t; p = KV + (((size_t)kind * 16 + bg) * SEQ + t) * 128; }
                p += 8 * q; pp[e] = p; const float* rp = ROPE + (size_t)row * 32 + 8 * q;
                x1[e] = *(const v4u*)p; x2[e] = *(const v4u*)(p + 16);
                c0[e] = *(const f32x4*)rp; c1[e] = *(const f32x4*)(rp + 4); s0[e] = *(const f32x4*)(rp + 16); s1[e] = *(const f32x4*)(rp + 20); } }
#pragma unroll
        for (int e = 0; e < 5; ++e) if (pp[e]) {
            const f32x4 a0 = {bflo(x1[e].x), bfhi(x1[e].x), bflo(x1[e].y), bfhi(x1[e].y)}, a1 = {bflo(x1[e].z), bfhi(x1[e].z), bflo(x1[e].w), bfhi(x1[e].w)};
            const f32x4 b0 = {bflo(x2[e].x), bfhi(x2[e].x), bflo(x2[e].y), bfhi(x2[e].y)}, b1 = {bflo(x2[e].z), bfhi(x2[e].z), bflo(x2[e].w), bfhi(x2[e].w)};
            st_bf8(pp[e], a0 * c0[e] - b0 * s0[e], a1 * c1[e] - b1 * s1[e]);
            st_bf8(pp[e] + 16, b0 * c0[e] + a0 * s0[e], b1 * c1[e] + a1 * s1[e]); }
    }
}
__device__ __forceinline__ void p7_cmp2(Frame& F) {
    unsigned char* ws = F.ptr(IX_WS); const float* cmp_w2 = F.fin(IX_CMP_W2); bf16* KCo = WSP(bf16, WS_KCMP); bf16* VCo = WSP(bf16, WS_VCMP);
    const float* HID = WSP(float, WS_B); const float* CB = WSP(float, WS_CBIAS); const float* ROPEC = WSP(float, WS_ROPEC);
    LAS float* hs = (LAS float*)F.lds;
    LAS float* os = hs + 16 * 256;
    const int tid = F.tid();
    for (int unit = F.vcu; unit < 512; unit += F.G) {
        const int kv = unit >> 8, rg = unit & 255, row0 = rg * 16;
        { const int r = tid >> 5, c8 = (tid & 31) * 8; f32x4 a0 = {0.f, 0.f, 0.f, 0.f}, a1 = {0.f, 0.f, 0.f, 0.f};
          for (int ks = 0; ks < 8; ++ks) { const float* cb = CB + (ks * 2 + kv) * 256 + c8; a0 += *(const f32x4*)cb; a1 += *(const f32x4*)(cb + 4); }
          for (int ks = 0; ks < 8; ++ks) { const float* p = HID + ((size_t)(ks * 2 + kv) * 4096 + row0 + r) * 256 + c8; a0 += *(const f32x4*)p; a1 += *(const f32x4*)(p + 4); }
          LAS float* d = hs + r * 256 + c8;
          d[0] = silu_f(a0[0]); d[1] = silu_f(a0[1]); d[2] = silu_f(a0[2]); d[3] = silu_f(a0[3]); d[4] = silu_f(a1[0]); d[5] = silu_f(a1[1]); d[6] = silu_f(a1[2]); d[7] = silu_f(a1[3]); }
        __syncthreads();
        const int r = tid >> 5, dg = tid & 31; const float* w2 = cmp_w2 + (size_t)kv * 256 * 128 + dg * 4;
        f32x4 a = {0.f, 0.f, 0.f, 0.f};
#pragma unroll 8
        for (int j = 0; j < 256; ++j) { const float h = hs[r * 256 + j]; a += *(const f32x4*)(w2 + j * 128) * h; }
        LAS float* od = os + r * 128 + dg * 4; od[0] = a[0]; od[1] = a[1]; od[2] = a[2]; od[3] = a[3];
        __syncthreads();
        const int row = row0 + r, bg = row >> 8, n = row & 255, b = bg >> 2, g = bg & 3;
        if (n < NCMP) {
            float o[4];
#pragma unroll
            for (int e = 0; e < 4; ++e) { const int d = dg * 4 + e; float v = os[r * 128 + d];
                if (kv == 0 && d < 32) { const int fi = d & 15; const float c = ROPEC[(b * 256 + n) * 32 + fi], s = ROPEC[(b * 256 + n) * 32 + 16 + fi];
                    v = d < 16 ? v * c - os[r * 128 + d + 16] * s : v * c + os[r * 128 + d - 16] * s; }
                o[e] = v; }
            bf16* dst = (kv == 0 ? KCo : VCo) + (size_t)(b * 256 + n) * 512 + g * 128 + dg * 4;
            v2u w; w.x = pk2(o[0], o[1]); w.y = pk2(o[2], o[3]); *(v2u*)dst = w;
        }
        __syncthreads();
    }
}

__device__ __forceinline__ void p8_select(Frame& F) {
    using namespace att;
    char* lds = F.ldsg; unsigned char* ws = F.ptr(IX_WS);
    const bf16* KC = WSP(bf16, WS_KCMP); const bf16* Q1 = WSP(bf16, WS_Q1); unsigned long long* SEL = WSP(unsigned long long, WS_SEL);
    const int wid = F.wave;
    for (int unit = F.vcu; unit < NB * NKVH * 16; unit += F.G) {
        const int tid = F.tid(), lane = tid & 63, r32 = lane & 31, hi = lane >> 5;
        const int sr = tid >> 4, sc = (tid & 15) * 8;
        const int qt = unit & 15, g = (unit >> 4) & 3, b = unit >> 6;
#pragma unroll
        for (int tt = 0; tt < 4; ++tt)
#pragma unroll
            for (int hf = 0; hf < 2; ++hf) { const int key = tt * 64 + hf * 32 + sr;
                *(bf16x8*)(lds + tt * SHM_K + KSWZ(hf * 32 + sr, sc * 2)) = load8(KC + (size_t)(b * 256 + key) * 512 + g * 128 + sc); }
        __syncthreads();
        const int tw = ((wid < 4) ? qt : 31 - qt) * 128 + (wid & 3) * 32, t = tw + r32, lim = (t - 31) >> 4;
        const int limw = tw >> 4;
        float imp[32];
#pragma unroll
        for (int c = 0; c < 32; ++c) imp[c] = 0.f;
        for (int rr = 0; rr < 3; ++rr) {
            const int h = g * 3 + rr; bf16x8 qr[8];
#pragma unroll
            for (int d0 = 0; d0 < 8; ++d0) qr[d0] = load8(Q1 + (size_t)(b * SEQ + t) * NSAW + h * 128 + d0 * 16 + hi * 8);
            f32x16 s[8];
            SBAR(); qkt<0>(s[0], s[1], lds, r32, hi, qr); SBAR();
            if (limw >= 64) { qkt<1>(s[2], s[3], lds, r32, hi, qr); SBAR(); }
            if (limw >= 128) { qkt<2>(s[4], s[5], lds, r32, hi, qr); SBAR(); }
            if (limw >= 192) { qkt<3>(s[6], s[7], lds, r32, hi, qr); SBAR(); }
            constexpr float C2 = LOG2E * ATT_SCALE; const float NEG = -__builtin_inff();
            float mx = -1e30f;
            int lim2 = lim - 4 * hi; asm volatile("" : "+v"(lim2));
#pragma unroll
            for (int i = 0; i < 8; ++i) if (limw >= (i >> 1) * 64) {
#pragma unroll
                for (int r = 0; r < 16; ++r) { const int key0 = (i >> 1) * 64 + (i & 1) * 32 + (r & 3) + 8 * (r >> 2); const float v = key0 <= lim2 ? s[i][r] * C2 : NEG; s[i][r] = v; mx = fmaxf(mx, v); } }
            { auto q2 = __builtin_amdgcn_permlane32_swap(__float_as_uint(mx), __float_as_uint(mx), false, false); mx = fmaxf(__uint_as_float(q2[0]), __uint_as_float(q2[1])); }
            float sum = 0.f;
#pragma unroll
            for (int i = 0; i < 8; ++i) {
                if (limw >= (i >> 1) * 64) {
#pragma unroll
                    for (int r = 0; r < 16; ++r) { const float p = __builtin_amdgcn_exp2f(s[i][r] - mx); s[i][r] = p; sum += p; }
                } else {
#pragma unroll
                    for (int r = 0; r < 16; ++r) s[i][r] = 0.f; } }
            { auto q2 = __builtin_amdgcn_permlane32_swap(__float_as_uint(sum), __float_as_uint(sum), false, false); sum = __uint_as_float(q2[0]) + __uint_as_float(q2[1]); }
            const float inv = sum > 0.f ? 1.0f / sum : 0.f;
            float prev_pt = 0.f;
#pragma unroll
            for (int c = 0; c < 32; ++c) { const int i = c >> 2, a = c & 3; const float tl = 0.5f * s[i][4 * a + 3] * inv;
                auto q2 = __builtin_amdgcn_permlane32_swap(__float_as_uint(tl), __float_as_uint(tl), false, false);
                const float pt = __uint_as_float(hi ? q2[0] : q2[1]);
                imp[c] += (s[i][4 * a] + s[i][4 * a + 1] + s[i][4 * a + 2]) * inv + tl + (hi ? pt : prev_pt);
                prev_pt = pt; }
        }
        const int cur = t >> 6;
        int hi2 = hi; asm volatile("" : "+v"(hi2));
        unsigned key[32];
#pragma unroll
        for (int c = 0; c < 32; ++c) { const int j = 2 * c + hi2; const bool ok = j <= cur, forced = (j == 0) || (j == cur) || (j == cur - 1);
            const float sc_ = forced ? 1e4f : imp[c];
            key[c] = (ok ? (__float_as_uint(sc_) & ~63u) : 0u) | (unsigned)(63 - j); }
        unsigned T = 0u;
#pragma unroll 1
        for (int bit = 30; bit >= 0; --bit) { const unsigned Tc = T | (1u << bit); unsigned cn = 0u;
#pragma unroll
            for (int c = 0; c < 32; ++c) cn += (key[c] >= Tc) ? 1u : 0u;
            { auto q2 = __builtin_amdgcn_permlane32_swap(cn, cn, false, false); cn = q2[0] + q2[1]; }
            T = cn >= 16u ? Tc : T; }
        unsigned wlo = 0u, whi = 0u;
#pragma unroll
        for (int c = 0; c < 32; ++c) { const unsigned selbit = (key[c] >= T && (2 * c + hi2) <= cur) ? 1u : 0u;
            if (c < 16) wlo |= selbit << (2 * c); else whi |= selbit << (2 * (c - 16)); }
        wlo <<= hi; whi <<= hi;
        { auto q2 = __builtin_amdgcn_permlane32_swap(wlo, wlo, false, false); wlo = q2[0] | q2[1]; }
        { auto q2 = __builtin_amdgcn_permlane32_swap(whi, whi, false, false); whi = q2[0] | q2[1]; }
        if (hi == 0) SEL[(size_t)(b * NKVH + g) * SEQ + t] = ((unsigned long long)whi << 32) | wlo;
        __syncthreads();
    }
}

typedef att::Ctx AttnCtx;
__device__ __forceinline__ void nsa_blk(const AttnCtx& C, int L, int pass, att::Blk& k) {
    const int qt = 15 - L / 48, bh = L % 48, b = bh / 12, h = bh % 12, g = h / 3;
    const int row0 = b * SEQ + qt * 256;
    k.Q = C.Q1 + (size_t)row0 * NSAW + h * 128; k.ldq = NSAW; k.t0 = qt * 256; k.row0 = row0; k.hcol = h * 128; k.bg = b * NKVH + g;
    if (pass == 0) { k.K = C.KV + (size_t)((2 * 4 + b) * 4 + g) * SEQ * 128; k.voff = 16 * SEQ * 128; k.ldk = 128; k.j_lo = 0; k.j_hi = 4 * qt + 4; k.mode = att::MODE_SEL; k.epi = att::EPI_ACC0; k.gcol = h * 3 + 1; }
    else if (pass == 1) { k.K = C.KV + (size_t)((4 * 4 + b) * 4 + g) * SEQ * 128; k.voff = 16 * SEQ * 128; k.ldk = 128; k.j_lo = qt >= 2 ? 4 * qt - 8 : 0; k.j_hi = 4 * qt + 4; k.mode = att::MODE_WIN; k.epi = att::EPI_ACC1; k.gcol = h * 3 + 2; }
    else { k.K = C.KC + (size_t)b * 256 * 512 + g * 128; k.voff = (int)(C.VC - C.KC); k.ldk = 512; k.j_lo = 0; k.j_hi = (qt >> 2) + 1; k.mode = att::MODE_CMP; k.epi = att::EPI_FIN; k.gcol = h * 3 + 0; }
}
__device__ __forceinline__ void mem_blk(const AttnCtx& C, int X, att::Blk& k) {
    const int qt = X & 15, mh = (X >> 4) & 3, b = X >> 6;
    const int row0 = b * SEQ + qt * 256;
    k.Q = C.QM + (size_t)row0 * C.qm_ld + C.qm_c0 + mh * 128; k.ldq = C.qm_ld; k.t0 = qt * 256; k.row0 = row0; k.hcol = mh * 128; k.bg = 0; k.gcol = 0;
    k.K = C.MKV + (size_t)b * 256 * 1024 + mh * 128; k.voff = 512; k.ldk = 1024; k.j_lo = 0; k.j_hi = 4; k.mode = att::MODE_NONE; k.epi = att::EPI_MEM;
}
struct AttnStream {
    int G, c, n_nsa, n_mem, cnt_nsa, total; bool tab;
    __device__ __forceinline__ void init(int G_, int c_, int n_nsa_, int n_mem_) {
        G = G_; c = c_; n_nsa = n_nsa_; n_mem = n_mem_;
        tab = (G == 256 && n_nsa == 768);
        if (tab) { cnt_nsa = 0;
#pragma unroll
            for (int r = 0; r < 4; ++r) cnt_nsa += NSA_TAB[c * 4 + r] != 0xffff ? 1 : 0; }
        else { const int full = n_nsa / G, rem = n_nsa - full * G, pos = (full & 1) ? G - 1 - c : c; cnt_nsa = full + (pos < rem ? 1 : 0); }
        const int cnt_mem = c < n_mem ? (n_mem - c + G - 1) / G : 0;
        total = 3 * cnt_nsa + cnt_mem;
    }
    __device__ __forceinline__ void get(const AttnCtx& C, int s, att::Blk& k) const {
        if (s < 3 * cnt_nsa) { const int r = s / 3, pass = s - 3 * r; const int L = tab ? (int)NSA_TAB[c * 4 + r] : r * G + ((r & 1) ? G - 1 - c : c); nsa_blk(C, L, pass, k); }
        else { const int sm = s - 3 * cnt_nsa; mem_blk(C, sm * G + c, k); }
    }
};
__device__ __forceinline__ void attn_run(Frame& F, const AttnCtx& C, int n_nsa, int n_mem) {
    AttnStream S; S.init(F.G, F.vcu, n_nsa, n_mem);
    if (S.total > 0) {
        att::Blk cur, nxt; att::Seam seam;
        S.get(C, 0, cur);
        att::attn_prime(F.tid(), cur, F.ldsg, seam);
        for (int s = 0; s < S.total; ++s) {
            const int tid = F.tid();
            S.get(C, s, cur);
            S.get(C, s + 1 < S.total ? s + 1 : s, nxt);
            att::attn_block(tid, C, cur, nxt.Q, nxt.K, nxt.voff, nxt.ldq, nxt.ldk, nxt.j_lo, F.ldsg, seam);
        }
    }
    VM_WAIT(); __syncthreads();
}
__device__ __forceinline__ void attn_run_mem(Frame& F, const AttnCtx& C, int n_mem) {
    const int G = F.G, c = F.vcu, cnt = c < n_mem ? (n_mem - c + G - 1) / G : 0;
    if (cnt > 0) {
        att::Blk cur, nxt; att::Seam seam;
        mem_blk(C, c, cur);
        const int tid = F.tid();
        att::attn_prime(tid, cur, F.ldsg, seam);
        for (int s = 0; s < cnt; ++s) {
            mem_blk(C, s * G + c, cur);
            mem_blk(C, (s + 1 < cnt ? s + 1 : s) * G + c, nxt);
            att::attn_block(tid, C, cur, nxt.Q, nxt.K, nxt.voff, nxt.ldq, nxt.ldk, nxt.j_lo, F.ldsg, seam);
        }
    }
    VM_WAIT(); __syncthreads();
}

__device__ __forceinline__ void p11_final(Frame& F) {
    unsigned char* ws = F.ptr(IX_WS); float* out = (float*)F.ptr(IX_OUT); const float* final_g = F.fin(IX_FINAL_G);
    const float* SS2 = WSP(float, WS_SS2); const bf16* H2B = WSP(bf16, WS_C);
    const int gw = F.vcu * NWAVES + F.wave, NGW = F.G * NWAVES, lane = F.tid() & 63;
    f32x4 g[8];
#pragma unroll
    for (int j = 0; j < 8; ++j) g[j] = ((const f32x4*)final_g)[64 * j + lane];
    for (int m = gw; m < MTOK; m += 4 * NGW) {
        v2u a[4][8]; float rv[4];
#pragma unroll
        for (int q = 0; q < 4; ++q) { const int mm = m + q * NGW < MTOK ? m + q * NGW : m; const v2u* p = (const v2u*)(H2B + (size_t)mm * DM) + lane;
#pragma unroll
            for (int j = 0; j < 8; ++j) a[q][j] = __builtin_nontemporal_load(p + 64 * j);
            rv[q] = lane < 32 ? SS2[(size_t)mm * 32 + lane] : 0.f; }
#pragma unroll
        for (int q = 0; q < 4; ++q) { const int mm = m + q * NGW; if (mm < MTOK) {
            const float rinv = 1.0f / sqrtf(wave_sum(rv[q]) * (1.f / DM) + EPS);
            f32x4* o = (f32x4*)(out + (size_t)mm * DM) + lane;
#pragma unroll
            for (int j = 0; j < 8; ++j) __builtin_nontemporal_store((f32x4){bflo(a[q][j].x), bfhi(a[q][j].x), bflo(a[q][j].y), bfhi(a[q][j].y)} * rinv * g[j], o + 64 * j); } }
    }
}

#ifndef WGM_P1
#define WGM_P1 4
#endif
#ifndef WGM_P3
#define WGM_P3 4
#endif
#ifndef WGM_P4
#define WGM_P4 2
#endif
#ifndef WGM_P5
#define WGM_P5 2
#endif
#ifndef WGM_P10
#define WGM_P10 2
#endif
__global__ void __launch_bounds__(NTHREADS, 2) fwd_kernel(Args args) {
    extern __shared__ __attribute__((aligned(16))) unsigned char lds[];
    Frame F;
    F.lds = (LAS unsigned char*)lds; F.ldsg = (char*)lds;
    F.wave = __builtin_amdgcn_readfirstlane((int)threadIdx.x >> 6);
    F.G = gridDim.x; { const int bx = blockIdx.x; F.vcu = (F.G % 8 == 0) ? (bx % 8) * (F.G / 8) + bx / 8 : bx; }
    if (threadIdx.x < 19) { const unsigned long long v = threadIdx.x < 17 ? (unsigned long long)args.in[threadIdx.x < 17 ? threadIdx.x : 0] : (threadIdx.x == 17 ? (unsigned long long)args.out : (unsigned long long)args.ws);
        ((LAS unsigned long long*)(F.lds + TAB_OFF))[threadIdx.x] = v; }
    if (threadIdx.x == 32) { ((LAS unsigned*)(F.lds + MISC_OFF))[0] = 0u; ((LAS unsigned*)(F.lds + MISC_OFF))[1] = 0u; }
    if (!MK_PER_PHASE && threadIdx.x == 0) (void)xb_add((unsigned*)(args.ws + WS_CTL) + 1024 + XB_XCNT(xb_xcc_id()), 1u);
    __syncthreads();
    const int lo = args.ph_lo, hi = args.ph_hi;
#ifndef PH_MASK
#define PH_MASK 0xfff
#endif
#define IN(k) (((PH_MASK >> (k)) & 1) && lo <= (k) && (k) < hi)
#ifndef REPEAT_MASK
#define REPEAT_MASK 0
#endif
#define REPS(k) (1 + ((REPEAT_MASK >> (k)) & 1))
#define GBAR() xcd_barrier((unsigned*)(F.ptr(IX_WS) + WS_CTL) + 1024, (volatile LAS unsigned*)(F.lds + MISC_OFF), (unsigned)F.G, F.tid())
#define SEAM(k) do { if (IN(k) && IN((k) + 1)) xcd_barrier((unsigned*)(F.ptr(IX_WS) + WS_CTL) + 1024, (volatile LAS unsigned*)(F.lds + MISC_OFF), (unsigned)F.G, F.tid()); } while (0)
#ifdef CLKPROBE_A
#define PROBE_T(k, slot) do { if ((k) == ((slot) ? CLKPROBE_B : CLKPROBE_A) && blockIdx.x == 0 && F.tid() == 0) { volatile unsigned long long* pr_ = (volatile unsigned long long*)(F.ptr(IX_WS) + WS_CTL + 32768); pr_[(slot)] = __builtin_amdgcn_s_memrealtime(); pr_[2 + (slot)] = __builtin_amdgcn_s_memtime(); } } while (0)
#else
#define PROBE_T(k, slot) do { } while (0)
#endif
    const size_t TILE_B = (size_t)256 * DM * 2;

    PROBE_T(0, 0);
    if (IN(0)) for (int rep = 0; rep < REPS(0); ++rep) { if (rep) GBAR(); p0_prologue(F); } SEAM(0);
#ifdef DUP0
    GBAR(); p0_prologue(F); GBAR();
#endif

    PROBE_T(1, 0);
    if (IN(1)) for (int rep = 0; rep < REPS(1); ++rep) { if (rep) GBAR(); unsigned char* ws = F.ptr(IX_WS);
        pg8::Geo g{DM, DM, DM / 64, 256};
        SchedLin S{64, 16, 1, F.G, (int)blockIdx.x, WGM_P1, (const char*)WSP(bf16, WS_B), (const char*)WSP(bf16, WS_W1T), TILE_B, 0, TILE_B, 0, 0, 0, nullptr, nullptr, 0, 0};
        Epi1 E{WSP(bf16, WS_A)};
        pg8::gemm_phase<Epi1, SchedLin, true, true>(F.lds, F.tid(), g, S, E);
        {
            pg8::Geo g2{DM, DM, 4, 256};
            SchedMem S2{F.G, (int)blockIdx.x, (const char*)WSP(bf16, WS_MEMN), (const char*)WSP(bf16, WS_WMT)};
            Epi6 E2{(float*)(ws + WS_D), 1024, (size_t)1024 * 1024};
            pg8::gemm_phase<Epi6, SchedMem, true, true>(F.lds, F.tid(), g2, S2, E2);
        }
    } PROBE_T(1, 1); SEAM(1);

#ifdef DUPBAR
    for (int i = 0; i < 10; ++i) GBAR();
#endif
    PROBE_T(2, 0);
    if (IN(2)) for (int rep = 0; rep < REPS(2); ++rep) { if (rep) GBAR(); p2_pool(F); } SEAM(2);

    PROBE_T(3, 0);
    if (IN(3)) for (int rep = 0; rep < REPS(3); ++rep) { if (rep) GBAR(); unsigned char* ws = F.ptr(IX_WS);
        pg8::Geo g{POOLW, 384, 6, 256};
        SchedLin S{64, 2, 4, F.G, (int)blockIdx.x, WGM_P3, (const char*)WSP(bf16, WS_C), (const char*)WSP(bf16, WS_WPT), (size_t)256 * POOLW * 2, (size_t)384 * 2, (size_t)256 * 384 * 2, (size_t)512 * 384 * 2,
                   0, 0, nullptr, nullptr, 0, 0};
        Epi3 E{F.fin(IX_A_POOL_SCALE), WSP(bf16, WS_A), WSP(bf16, WS_B)};
        pg8::gemm_phase<Epi3, SchedLin, true, true>(F.lds, F.tid(), g, S, E);
#ifdef DUP3G
        GBAR(); pg8::gemm_phase<Epi3, SchedLin, true, true>(F.lds, F.tid(), g, S, E);
#endif
        AttnCtx C{}; C.QM = WSP(bf16, WS_A); C.qm_ld = N1; C.qm_c0 = 2 * POOLW; C.ZM = WSP(bf16, WS_A); C.zm_ld = N1; C.zm_c0 = 2 * POOLW + MEMW;
        C.MKV = WSP(bf16, WS_MKV); C.Y = WSP(bf16, WS_B);
#ifndef NO_ATT3
        attn_run_mem(F, C, NB * 4 * 16);
#ifdef DUP3A
        GBAR(); attn_run_mem(F, C, NB * 4 * 16);
#endif
#endif
    } PROBE_T(3, 1); SEAM(3);

    PROBE_T(4, 0);
    if (IN(4)) for (int rep = 0; rep < REPS(4); ++rep) { if (rep) GBAR(); unsigned char* ws = F.ptr(IX_WS);
        pg8::Geo g{DM, DM, DM / 64, 256};
        SchedLin S{64, 8, 1, F.G, (int)blockIdx.x, WGM_P4, (const char*)WSP(bf16, WS_B), (const char*)WSP(bf16, WS_WO0T), TILE_B, 0, TILE_B, 0, 0, 0, nullptr, nullptr, 0, 0};
        bf16* h1b = (bf16*)F.ptr(IX_OUT);
        EpiRes<false> E{F.fin(IX_X), h1b, WSP(float, WS_SS1)};
        pg8::gemm_phase<EpiRes<false>, SchedLin, true, true>(F.lds, F.tid(), g, S, E);
    } PROBE_T(4, 1); SEAM(4);

    PROBE_T(5, 0);
    if (IN(5)) for (int rep = 0; rep < REPS(5); ++rep) { if (rep) GBAR(); unsigned char* ws = F.ptr(IX_WS);
        rinv_pass(F); GBAR();
        pg8::Geo g{DM, DM, DM / 64, 256};
        SchedLin S{64, 28, 1, F.G, (int)blockIdx.x, WGM_P5, (const char*)F.ptr(IX_OUT), (const char*)WSP(bf16, WS_W4T), TILE_B, 0, TILE_B, 0, 0, 0, nullptr, nullptr, 0, 0};
        Epi5 E{WSP(float, WS_RINV1), WSP(bf16, WS_KVB), WSP(bf16, WS_Q1), WSP(bf16, WS_ZQ), WSP(bf16, WS_QM1), WSP(bf16, WS_ZM1)};
        pg8::gemm_phase<Epi5, SchedLin, true, true>(F.lds, F.tid(), g, S, E);
        {
            pg8::Geo g2{DM, DM, 8, 256};
            SchedGate S2{F.G, (int)blockIdx.x, (const char*)F.ptr(IX_OUT), (const char*)(WSP(bf16, WS_W4T) + (size_t)28 * 256 * DM)};
            EpiG E2{WSP(float, WS_C)};
            pg8::gemm_phase<EpiG, SchedGate, true, true>(F.lds, F.tid(), g2, S2, E2);
        }
    } PROBE_T(5, 1); SEAM(5);

    PROBE_T(6, 0);
    if (IN(6)) for (int rep = 0; rep < REPS(6); ++rep) { if (rep) GBAR(); unsigned char* ws = F.ptr(IX_WS);
        pg8::Geo g{16 * 128, 4096, 8, 256};
        SchedCmp S{F.G, (int)blockIdx.x, (const char*)WSP(bf16, WS_KVB), (const char*)WSP(bf16, WS_WC1T)};
        Epi6 E{WSP(float, WS_B), 256, (size_t)4096 * 256};
        pg8::gemm_phase<Epi6, SchedCmp, true, true>(F.lds, F.tid(), g, S, E);
        gates_finish(F); rope_pass(F);
    } PROBE_T(6, 1); SEAM(6);

    PROBE_T(7, 0);
    if (IN(7)) for (int rep = 0; rep < REPS(7); ++rep) { if (rep) GBAR(); p7_cmp2(F); } SEAM(7);

    PROBE_T(8, 0);
    if (IN(8)) for (int rep = 0; rep < REPS(8); ++rep) { if (rep) GBAR(); p8_select(F); }
#ifdef DUP8
    GBAR(); p8_select(F);
#endif
    SEAM(8);

    PROBE_T(9, 0);
    if (IN(9)) for (int rep = 0; rep < REPS(9); ++rep) { if (rep) GBAR(); unsigned char* ws = F.ptr(IX_WS);
        AttnCtx C{}; C.KV = WSP(bf16, WS_KVB); C.KC = WSP(bf16, WS_KCMP); C.VC = WSP(bf16, WS_VCMP); C.Q1 = WSP(bf16, WS_Q1); C.ZQ = WSP(bf16, WS_ZQ);
        C.QM = WSP(bf16, WS_QM1); C.qm_ld = MEMW; C.qm_c0 = 0; C.ZM = WSP(bf16, WS_ZM1); C.zm_ld = MEMW; C.zm_c0 = 0; C.MKV = WSP(bf16, WS_MKV) + (size_t)1024 * 1024;
        C.gates = WSP(float, WS_GATES); C.SEL = WSP(unsigned long long, WS_SEL); C.YACC = WSP(float, WS_C); C.Y = WSP(bf16, WS_B);
        attn_run(F, C, NB * NHEAD * 16, NB * 4 * 16);
    } PROBE_T(9, 1); SEAM(9);

    PROBE_T(10, 0);
    if (IN(10)) for (int rep = 0; rep < REPS(10); ++rep) { if (rep) GBAR(); unsigned char* ws = F.ptr(IX_WS);
        pg8::Geo g{DM, DM, DM / 64, 256};
        SchedLin S{64, 8, 1, F.G, (int)blockIdx.x, WGM_P10, (const char*)WSP(bf16, WS_B), (const char*)WSP(bf16, WS_WO1T), TILE_B, 0, TILE_B, 0, 0, 0, nullptr, nullptr, 0, 0};
        EpiRes<true> E{F.ptr(IX_OUT), WSP(bf16, WS_C), WSP(float, WS_SS2)};
        pg8::gemm_phase<EpiRes<true>, SchedLin, true, true>(F.lds, F.tid(), g, S, E);
    } PROBE_T(10, 1); SEAM(10);

    PROBE_T(11, 0);
    if (IN(11)) for (int rep = 0; rep < REPS(11); ++rep) { if (rep) GBAR(); p11_final(F); }
    PROBE_T(11, 1);
#ifdef CLKPROBE_A
    if (blockIdx.x == 0 && F.tid() == 0) { volatile unsigned long long* pr_ = (volatile unsigned long long*)(F.ptr(IX_WS) + WS_CTL + 32768);
#ifdef CLKGHZ
        const unsigned long long ticks = (pr_[3] - pr_[2]) * CLKGHZ / (pr_[1] - pr_[0] ? pr_[1] - pr_[0] : 1ull);
#else
        const unsigned long long ticks = (pr_[1] - pr_[0]) * CLKMULT;
#endif
        const unsigned long long t0 = __builtin_amdgcn_s_memrealtime();
        while (__builtin_amdgcn_s_memrealtime() - t0 < ticks) __builtin_amdgcn_s_sleep(8); }
#endif
#undef IN
#undef SEAM
}

extern "C" void kernel_launch(void* const* d_in, const int* in_sizes, int n_in, void* d_out, int out_size, void* d_ws, size_t ws_size, hipStream_t stream) {
    static int grid = 0;
    if (grid == 0) {
        if (n_in != 17 || in_sizes[0] != MTOK * DM || out_size != MTOK * DM || ws_size < WS_END) {
            fprintf(stderr, "kernel_launch: unexpected shapes (n_in %d, in0 %d, out %d, ws %zu < %zu)\n", n_in, n_in > 0 ? in_sizes[0] : -1, out_size, ws_size, (size_t)WS_END); grid = -1; return; }
        int dev = 0, cus = 0, per_cu = 0;
        if (hipGetDevice(&dev) != hipSuccess || hipDeviceGetAttribute(&cus, hipDeviceAttributeMultiprocessorCount, dev) != hipSuccess) { fprintf(stderr, "kernel_launch: device query failed\n"); grid = -1; return; }
        if (hipFuncSetAttribute((const void*)fwd_kernel, hipFuncAttributeMaxDynamicSharedMemorySize, LDS_BYTES) != hipSuccess) { fprintf(stderr, "kernel_launch: hipFuncSetAttribute failed\n"); grid = -1; return; }
        if (hipOccupancyMaxActiveBlocksPerMultiprocessor(&per_cu, (const void*)fwd_kernel, NTHREADS, LDS_BYTES) != hipSuccess || per_cu < 1) {
            fprintf(stderr, "kernel_launch: occupancy query says %d blocks per CU\n", per_cu); (void)hipGetLastError(); per_cu = 1; }
        grid = cus * (per_cu > 1 ? 1 : per_cu);
    }
    if (grid < 0) return;
    (void)hipMemsetAsync((char*)d_ws + WS_CTL, 0, 65536, stream);
    Args a{};
    for (int i = 0; i < 17; ++i) a.in[i] = d_in[i];
    a.out = (float*)d_out; a.ws = (unsigned char*)d_ws;
#if MK_PER_PHASE
    for (int p = 0; p < NPHASE; ++p) { a.ph_lo = p; a.ph_hi = p + 1; hipLaunchKernelGGL(fwd_kernel, dim3(grid), dim3(NTHREADS), LDS_BYTES, stream, a); }
#else
    a.ph_lo = 0; a.ph_hi = NPHASE;
    void* kargs[] = {&a};
    hipError_t e = hipLaunchCooperativeKernel((const void*)fwd_kernel, dim3(grid), dim3(NTHREADS), kargs, LDS_BYTES, stream);
    if (e != hipSuccess) fprintf(stderr, "kernel_launch: cooperative launch failed: %s (grid %d)\n", hipGetErrorString(e), grid);
#endif
}
```

```cpp
#include <hip/hip_runtime.h>
#include <hip/hip_cooperative_groups.h>
#include <cstdio>
#include <cstdint>
namespace cg = cooperative_groups;

#define LAS __attribute__((address_space(3)))
typedef unsigned short bf16;
typedef unsigned v4u __attribute__((ext_vector_type(4)));
typedef unsigned v2u __attribute__((ext_vector_type(2)));
typedef float f32x4 __attribute__((ext_vector_type(4)));
typedef float f32x2 __attribute__((ext_vector_type(2)));
typedef float f32x16 __attribute__((ext_vector_type(16)));
typedef short bf16x8 __attribute__((ext_vector_type(8)));
typedef short s16x4 __attribute__((ext_vector_type(4)));

constexpr int NB = 4, SEQ = 4096, DM = 2048, MTOK = NB * SEQ;
constexpr int MEMLEN = 256, HD = 128;
constexpr int POOLW = 1536, MEMW = 512, NSAW = 1536, NHEAD = 12, NKVH = 4;
constexpr int N1 = 4096;
constexpr int NKV = 3072;
constexpr int N4 = 7424;
constexpr int NCMP = 255, CMPHID = 256;
constexpr float EPS = 1e-6f;
constexpr float LOG2E = 1.4426950408889634f;
constexpr float ATT_SCALE = 0.08838834764831845f;

constexpr size_t MiB = 1u << 20;
constexpr size_t WS_CTL = 0;
constexpr size_t WS_W1T = 1 * MiB;
constexpr size_t WS_WO0T = 17 * MiB;
constexpr size_t WS_W4T = 25 * MiB;
constexpr size_t WS_WO1T = 54 * MiB;
constexpr size_t WS_WMT = 62 * MiB;
constexpr size_t WS_WPT = 70 * MiB;
constexpr size_t WS_WC1T = 72 * MiB;
constexpr size_t WS_MEMN = 76 * MiB;
constexpr size_t WS_MKV = 80 * MiB;
constexpr size_t WS_ROPE = 84 * MiB;
constexpr size_t WS_ROPEC = 86 * MiB;
constexpr size_t WS_SS1 = 87 * MiB;
constexpr size_t WS_SS2 = 89 * MiB;
constexpr size_t WS_SEL = 91 * MiB;
constexpr size_t WS_KCMP = 92 * MiB;
constexpr size_t WS_VCMP = 93 * MiB;
constexpr size_t WS_GATES = 94 * MiB;
constexpr size_t WS_CBIAS = 97 * MiB;
constexpr size_t WS_RINV1 = 97 * MiB + 512 * 1024;
constexpr size_t WS_W2T = 97 * MiB + 64 * 1024;
constexpr size_t WS_A = 98 * MiB;
constexpr size_t WS_KVB = WS_A;
constexpr size_t WS_QM1 = WS_A + 97 * MiB;
constexpr size_t WS_ZM1 = WS_A + 113 * MiB;
constexpr size_t WS_B = 228 * MiB;
constexpr size_t WS_C = 292 * MiB;
constexpr size_t WS_D = 388 * MiB;
constexpr size_t WS_Q1 = WS_D, WS_ZQ = WS_D + 48 * MiB;
constexpr size_t WS_END = 484 * MiB;

#define LDS_WAIT() asm volatile("s_waitcnt lgkmcnt(0)" ::: "memory")
#define VM_WAIT() asm volatile("s_waitcnt vmcnt(0)" ::: "memory")
__device__ __forceinline__ unsigned f2bf(float f) { unsigned u = __builtin_bit_cast(unsigned, f); return (u + 0x7fffu + ((u >> 16) & 1u)) >> 16; }
__device__ __forceinline__ unsigned pk2(float lo, float hi) { return f2bf(lo) | (f2bf(hi) << 16); }
__device__ __forceinline__ float bf2f(unsigned short b) { return __builtin_bit_cast(float, (unsigned)b << 16); }
__device__ __forceinline__ float bflo(unsigned w) { return __builtin_bit_cast(float, w << 16); }
__device__ __forceinline__ float bfhi(unsigned w) { return __builtin_bit_cast(float, w & 0xffff0000u); }
__device__ __forceinline__ unsigned cvtpk(float lo, float hi) { unsigned r; asm volatile("v_cvt_pk_bf16_f32 %0, %1, %2" : "=v"(r) : "v"(lo), "v"(hi)); return r; }
__device__ __forceinline__ float silu_f(float x) { return x * __builtin_amdgcn_rcpf(1.f + __builtin_amdgcn_exp2f(-x * LOG2E)); }
__device__ __forceinline__ float sigmoid_f(float x) { return __builtin_amdgcn_rcpf(1.f + __builtin_amdgcn_exp2f(-x * LOG2E)); }
__device__ __forceinline__ float wave_sum(float v) {
#pragma unroll
    for (int o = 1; o < 64; o <<= 1) v += __shfl_xor(v, o);
    return v;
}

namespace pg8 {
#define PG8_LAS __attribute__((address_space(3)))
constexpr int BM = 256, BK = 64, HALF = 128, HTB = HALF * BK * 2, STAGE_BYTES = 8 * HTB, NXCD = 8, WGM = 8;
__host__ __device__ __forceinline__ int lds_byte(int r, int c) { const int st = (r >> 4) * 2 + (c >> 5), rr = r & 15, cc = c & 31, ob = rr * 64 + cc * 2; return st * 1024 + (ob ^ (((ob >> 9) & 1) << 5)); }
__host__ __device__ __forceinline__ int perm32(int rho) { const int n = rho >> 4, i = rho & 15; return 8 * (i >> 2) + 4 * n + (i & 3); }
__host__ __device__ __forceinline__ void stage_rc(int b, int& R, int& C) { const int st = b / 1024, sb = b % 1024, swz = sb ^ (((sb >> 9) & 1) << 5); R = (st >> 1) * 16 + swz / 64; C = (st & 1) * 32 + (swz % 64) / 2; }

struct Unit { int pm, pn, z, kind; const char* a; const char* b; };
__device__ __forceinline__ void tile_swz(int wgid, int nM, int nN, int wgm, int& pm, int& pn) {
    const int nwg = nM * nN;
    { const int q = nwg / NXCD, r = nwg % NXCD, xcd = wgid % NXCD, off = wgid / NXCD; wgid = (xcd < r ? xcd * (q + 1) : r * (q + 1) + (xcd - r) * q) + off; }
    const int nig = wgm * nN, gid = wgid / nig, fm = gid * wgm, gsz = (nM - fm) < wgm ? (nM - fm) : wgm;
    pm = fm + ((wgid % nig) % gsz); pn = (wgid % nig) / gsz;
}
struct Geo { int lda, ldb, nt; int kpairA; };

template <class Epi, class Sched, bool ALIGN_EPI, bool SP2>
__device__ __forceinline__ void gemm_phase(PG8_LAS unsigned char* lds, const int tid, const Geo g, const Sched& S, const Epi& E) {
    const int wid = __builtin_amdgcn_readfirstlane(tid >> 6), lane = tid & 63, wr = wid >> 2, wc = wid & 3, fr = lane & 15, fq = lane >> 4;
    const int nt = g.nt;
    unsigned voffA[2], voffB[2];
#pragma unroll
    for (int i = 0; i < 2; ++i) { int R, C; stage_rc(tid * 16 + i * 8192, R, C);
        const int Rb = Epi::PERM ? 64 * (R >> 5) + perm32(R & 31) : R;
        voffA[i] = (unsigned)(R * g.lda + C) * 2u; voffB[i] = (unsigned)(Rb * g.ldb + C) * 2u; }
    const size_t kstep = (size_t)(BK * 2);
    const size_t hstepA = (size_t)HALF * g.lda * 2, hstepB = (size_t)(Epi::PERM ? 32 : HALF) * g.ldb * 2;
    const size_t kpairA = (size_t)g.kpairA;
    const unsigned ldsw = (unsigned)wid * 1024u;
    const int aoff = lds_byte(wr * 64 + fr, fq * 8), boff = lds_byte(wc * 32 + fr, fq * 8);
#define PG8_SA(b, h) (((b) * 2 + (h)) * HTB)
#define PG8_SB(b, h) ((4 + (b) * 2 + (h)) * HTB)
#define PG8_STAGE(bufoff, gbase, voff) do { _Pragma("unroll") for (int _i = 0; _i < 2; ++_i) \
        __builtin_amdgcn_global_load_lds((const unsigned*)((const char*)(gbase) + (voff)[_i]), (PG8_LAS unsigned*)(lds + (bufoff) + ldsw + _i * 8192), 16, 0, 0); } while (0)
#define PG8_LDA(dst, b, h) do { _Pragma("unroll") for (int m = 0; m < 4; ++m) _Pragma("unroll") for (int k = 0; k < 2; ++k) dst[m][k] = *(const PG8_LAS bf16x8*)(lds + PG8_SA(b, h) + aoff + m * 2048 + k * 1024); } while (0)
#define PG8_LDB(dst, b, h) do { _Pragma("unroll") for (int n = 0; n < 2; ++n) _Pragma("unroll") for (int k = 0; k < 2; ++k) dst[n][k] = *(const PG8_LAS bf16x8*)(lds + PG8_SB(b, h) + boff + n * 2048 + k * 1024); } while (0)
#define PG8_MMA(ai, bj, At, Bt) do { __builtin_amdgcn_s_setprio(1); _Pragma("unroll") for (int m = 0; m < 4; ++m) _Pragma("unroll") for (int n = 0; n < 2; ++n) _Pragma("unroll") for (int k = 0; k < 2; ++k) \
        acc[ai][bj][m][n] = __builtin_amdgcn_mfma_f32_16x16x32_bf16(Bt[n][k], At[m][k], acc[ai][bj][m][n], 0, 0, 0); __builtin_amdgcn_s_setprio(0); } while (0)
#define PG8_WAIT_V(n) asm volatile("s_waitcnt vmcnt(" #n ")" ::: "memory")
#define PG8_WAIT_L(n) asm volatile("s_waitcnt lgkmcnt(" #n ")" ::: "memory")
#define PG8_BAR __builtin_amdgcn_s_barrier()
#define PG8_SCHED __builtin_amdgcn_sched_barrier(0)
    Unit cur, nxt; int ui = 0;
    if (!S.next(0, cur)) return;
    f32x4 acc[2][2][4][2];
    typename Epi::State est;
    E.begin(acc, est, cur, wr, wc, fr, fq);
    bf16x8 At[4][2], B0[2][2], B1[2][2];
    const char* cA = cur.a; const char* cB = cur.b;
    if constexpr (SP2) {
        PG8_STAGE(PG8_SB(0, 0), cB, voffB); PG8_STAGE(PG8_SB(0, 1), cB + hstepB, voffB); PG8_STAGE(PG8_SA(0, 0), cA, voffA); PG8_STAGE(PG8_SA(0, 1), cA + hstepA, voffA);
        if (wr == 1) PG8_BAR;
        PG8_WAIT_V(2); PG8_BAR;
        PG8_STAGE(PG8_SB(1, 0), cB + kstep, voffB); PG8_STAGE(PG8_SA(1, 0), cA + kstep, voffA); PG8_STAGE(PG8_SB(1, 1), cB + hstepB + kstep, voffB);
        PG8_WAIT_V(6); PG8_BAR;
    } else {
        PG8_STAGE(PG8_SB(0, 0), cB, voffB); PG8_STAGE(PG8_SA(0, 0), cA, voffA); PG8_STAGE(PG8_SB(0, 1), cB + hstepB, voffB); PG8_STAGE(PG8_SA(0, 1), cA + hstepA, voffA);
        if (wr == 1) PG8_BAR;
        PG8_WAIT_V(4); PG8_BAR;
        PG8_STAGE(PG8_SB(1, 0), cB + kstep, voffB); PG8_STAGE(PG8_SA(1, 0), cA + kstep, voffA); PG8_STAGE(PG8_SB(1, 1), cB + hstepB + kstep, voffB);
        PG8_WAIT_V(6); PG8_BAR;
    }
    for (;;) {
        const bool has_next = S.next(ui + 1, nxt);
        const char* nA = has_next ? nxt.a : cA; const char* nB = has_next ? nxt.b : cB;
        for (int t = 0; t < nt; t += 2) {
            const bool last = (t == nt - 2);
            const char* a0p = cA + (size_t)(t >> 1) * kpairA;
            const char* a1 = a0p + kstep;
            const char* a2 = last ? nA : a0p + kpairA; const char* b2 = last ? nB : cB + (size_t)(t + 2) * kstep;
            const char* a3 = a2 + kstep; const char* b3 = b2 + kstep;
            if constexpr (SP2) {
            PG8_LDB(B0, 0, 0); PG8_LDB(B1, 0, 1); PG8_SCHED; PG8_LDA(At, 0, 0); PG8_STAGE(PG8_SA(1, 1), a1 + hstepA, voffA);
            PG8_WAIT_V(8); PG8_WAIT_L(0); PG8_BAR; PG8_MMA(0, 0, At, B0); PG8_MMA(0, 1, At, B1); PG8_BAR; PG8_SCHED;
            PG8_LDA(At, 0, 1); PG8_STAGE(PG8_SB(0, 0), b2, voffB); PG8_STAGE(PG8_SB(0, 1), b2 + hstepB, voffB); PG8_STAGE(PG8_SA(0, 0), a2, voffA);
            PG8_WAIT_V(8); PG8_WAIT_L(0); PG8_BAR; PG8_MMA(1, 0, At, B0); PG8_MMA(1, 1, At, B1); PG8_BAR; PG8_SCHED;
            PG8_LDB(B0, 1, 0); PG8_LDB(B1, 1, 1); PG8_SCHED; PG8_LDA(At, 1, 0); PG8_STAGE(PG8_SA(0, 1), a2 + hstepA, voffA);
            PG8_WAIT_V(8); PG8_WAIT_L(0); PG8_BAR; PG8_MMA(0, 0, At, B0); PG8_MMA(0, 1, At, B1); PG8_BAR; PG8_SCHED;
            PG8_LDA(At, 1, 1); PG8_STAGE(PG8_SB(1, 0), b3, voffB); PG8_STAGE(PG8_SB(1, 1), b3 + hstepB, voffB); PG8_STAGE(PG8_SA(1, 0), a3, voffA);
            PG8_WAIT_V(8); PG8_WAIT_L(0); PG8_BAR; PG8_MMA(1, 0, At, B0); PG8_MMA(1, 1, At, B1); PG8_BAR; PG8_SCHED;
            } else {
            PG8_LDB(B0, 0, 0); PG8_SCHED; PG8_LDA(At, 0, 0); PG8_STAGE(PG8_SA(1, 1), a1 + hstepA, voffA);
            PG8_WAIT_L(8); PG8_BAR; PG8_WAIT_L(0); PG8_MMA(0, 0, At, B0); PG8_BAR; PG8_SCHED;
            PG8_LDB(B1, 0, 1); PG8_STAGE(PG8_SB(0, 0), b2, voffB);
            PG8_BAR; PG8_WAIT_L(0); PG8_MMA(0, 1, At, B1); PG8_BAR;
            PG8_LDA(At, 0, 1); PG8_STAGE(PG8_SA(0, 0), a2, voffA);
            PG8_BAR; PG8_WAIT_L(0); PG8_MMA(1, 0, At, B0); PG8_BAR; PG8_SCHED;
            PG8_STAGE(PG8_SB(0, 1), b2 + hstepB, voffB);
            PG8_WAIT_V(6); PG8_BAR; PG8_MMA(1, 1, At, B1); PG8_BAR;
            PG8_LDB(B0, 1, 0); PG8_SCHED; PG8_LDA(At, 1, 0); PG8_STAGE(PG8_SA(0, 1), a2 + hstepA, voffA);
            PG8_WAIT_L(8); PG8_BAR; PG8_WAIT_L(0); PG8_MMA(0, 0, At, B0); PG8_BAR; PG8_SCHED;
            PG8_LDB(B1, 1, 1); PG8_STAGE(PG8_SB(1, 0), b3, voffB);
            PG8_BAR; PG8_WAIT_L(0); PG8_MMA(0, 1, At, B1); PG8_BAR;
            PG8_LDA(At, 1, 1); PG8_STAGE(PG8_SA(1, 0), a3, voffA);
            PG8_BAR; PG8_WAIT_L(0); PG8_MMA(1, 0, At, B0); PG8_BAR; PG8_SCHED;
            PG8_STAGE(PG8_SB(1, 1), b3 + hstepB, voffB);
            PG8_WAIT_V(6); PG8_BAR; PG8_MMA(1, 1, At, B1); PG8_BAR;
            }
        }
        if constexpr (ALIGN_EPI) { if (wr == 0) PG8_BAR; }
        E(acc, est, cur, wr, wc, fr, fq);
        if (!has_next) break;
        cur = nxt; cA = nA; cB = nB; ++ui;
        E.begin(acc, est, cur, wr, wc, fr, fq);
        if constexpr (ALIGN_EPI) { if (wr == 1) PG8_BAR; }
    }
    PG8_WAIT_V(0);
    if constexpr (!ALIGN_EPI) { if (wr == 0) PG8_BAR; }
    PG8_BAR;
#undef PG8_SA
#undef PG8_SB
#undef PG8_STAGE
#undef PG8_LDA
#undef PG8_LDB
#undef PG8_MMA
#undef PG8_WAIT_V
#undef PG8_WAIT_L
#undef PG8_BAR
#undef PG8_SCHED
}
}

namespace att {
#ifndef AT_SELMASK
#define AT_SELMASK 1
#endif
constexpr int D = 128, NW = 8, QBLK = 32, KVBLK = 64, QB = NW * QBLK;
constexpr int SHM_V = KVBLK * D * 2, SHM_K = KVBLK * D * 2;
constexpr int LDS_BYTES = 2 * SHM_V + 2 * SHM_K + NW * 64 * 4;
constexpr float THR = 8.f;
#define KSWZ(row, colB) ((row) * 256 + ((colB) ^ (((row) & 7) << 4)))
#define SBAR() __builtin_amdgcn_sched_barrier(0)
__device__ __forceinline__ int v_st(int k, int c) { const int kk = (k & ~0xC) | ((k & 4) << 1) | ((k & 8) >> 1); return ((kk >> 3) * 4 + (c >> 5)) * 512 + ((kk & 7) * 32 + (c & 31)) * 2; }
__device__ __forceinline__ int v_rd_base(int lane) { return ((lane & 3) << 3) | (((lane >> 2) & 3) << 6) | (((lane >> 4) & 1) << 5) | (((lane >> 5) & 1) << 8); }
constexpr int v_rd_off(int d0, int ks, int half) { return d0 * 512 + ks * 4096 + half * 2048; }
__device__ __forceinline__ int crow(int r, int hi) { return (r & 3) + 8 * (r >> 2) + 4 * hi; }
__device__ __forceinline__ bf16x8 load8(const bf16* p) { return *reinterpret_cast<const bf16x8*>(p); }

__device__ __forceinline__ void mask_tile(f32x16& p0, f32x16& p1, int dq, unsigned W) {
    const float NEG = -__builtin_inff();
#pragma unroll
    for (int r = 0; r < 16; ++r) {
        const int c = (r & 3) + 8 * (r >> 2);
        if ((unsigned)(dq - c) >= W) p0[r] = NEG;
        if ((unsigned)(dq - c - 32) >= W) p1[r] = NEG;
    }
}
__device__ __forceinline__ void partialSM(f32x16& p0, f32x16& p1, float& m_reg, float& mn, float& alpha) {
    float pmax = p0[0];
#pragma unroll
    for (int r = 1; r < 16; ++r) pmax = fmaxf(pmax, p0[r]);
#pragma unroll
    for (int r = 0; r < 16; ++r) pmax = fmaxf(pmax, p1[r]);
    { auto rr = __builtin_amdgcn_permlane32_swap(__float_as_uint(pmax), __float_as_uint(pmax), false, false);
      pmax = fmaxf(__uint_as_float(rr[0]), __uint_as_float(rr[1])); }
    constexpr float C2 = LOG2E * ATT_SCALE;
    if (__builtin_expect(__all((pmax - m_reg) * ATT_SCALE <= THR), 1)) { mn = m_reg; alpha = 1.f; }
    else { mn = fmaxf(m_reg, pmax); alpha = __builtin_amdgcn_exp2f((m_reg - mn) * C2); m_reg = mn; }
    const float mnL = -mn * C2;
#pragma unroll
    for (int r = 0; r < 16; ++r) p0[r] = fmaf(p0[r], C2, mnL);
#pragma unroll
    for (int r = 0; r < 16; ++r) p1[r] = fmaf(p1[r], C2, mnL);
#pragma unroll
    for (int r = 0; r < 16; ++r) p0[r] = __builtin_amdgcn_exp2f(p0[r]);
}
__device__ __forceinline__ void finishSM(f32x16& p0, f32x16& p1, float alpha, float& l_reg, bf16x8& pa0, bf16x8& pa1, bf16x8& pa2, bf16x8& pa3, int keep) {
#pragma unroll
    for (int r = 0; r < 16; ++r) p1[r] = __builtin_amdgcn_exp2f(p1[r]);
    float ps = 0;
#pragma unroll
    for (int r = 0; r < 16; ++r) ps += p0[r];
#pragma unroll
    for (int r = 0; r < 16; ++r) ps += p1[r];
    { auto rr = __builtin_amdgcn_permlane32_swap(__float_as_uint(ps), __float_as_uint(ps), false, false);
      ps = __uint_as_float(rr[0]) + __uint_as_float(rr[1]); }
    l_reg = l_reg * alpha + (keep ? ps : 0.f);
#define PK4(P, B_, OUT) do { unsigned a0 = cvtpk(P[B_+0], P[B_+1]), a1 = cvtpk(P[B_+2], P[B_+3]);                          \
        unsigned b0 = cvtpk(P[B_+4], P[B_+5]), b1 = cvtpk(P[B_+6], P[B_+7]);                                             \
        auto r0 = __builtin_amdgcn_permlane32_swap(a0, b0, false, false); auto r1 = __builtin_amdgcn_permlane32_swap(a1, b1, false, false); \
        v4u w = {keep ? r0[0] : 0u, keep ? r1[0] : 0u, keep ? r0[1] : 0u, keep ? r1[1] : 0u}; OUT = *reinterpret_cast<bf16x8*>(&w); } while (0)
    PK4(p0, 0, pa0); PK4(p0, 8, pa1); PK4(p1, 0, pa2); PK4(p1, 8, pa3);
#undef PK4
}
template <int KB>
__device__ __forceinline__ void qkt(f32x16& p0, f32x16& p1, const char* K_lds, int r32, int hi, const bf16x8* qr) {
    p0 = f32x16{}; p1 = f32x16{};
    const char* kb[4];
#pragma unroll
    for (int dd = 0; dd < 4; ++dd) kb[dd] = K_lds + KB * SHM_K + KSWZ(r32, (dd * 16 + hi * 8) * 2);
#pragma unroll
    for (int d0 = 0; d0 < 8; ++d0) { const char* a = kb[d0 & 3] + (d0 >> 2) * 128;
        bf16x8 b0 = *reinterpret_cast<const bf16x8*>(a);
        bf16x8 b1 = *reinterpret_cast<const bf16x8*>(a + 32 * 256);
        p0 = __builtin_amdgcn_mfma_f32_32x32x16_bf16(b0, qr[d0], p0, 0, 0, 0);
        p1 = __builtin_amdgcn_mfma_f32_32x32x16_bf16(b1, qr[d0], p1, 0, 0, 0); }
}
template <int VB>
__device__ __forceinline__ void pv_tile(f32x16* o, int vb0, bf16x8 pa0, bf16x8 pa1, bf16x8 pa2, bf16x8 pa3) {
#define TRRD(dst, off) asm volatile("ds_read_b64_tr_b16 %0, %1 offset:%2" : "=&v"(dst) : "v"(vb0), "i"(off) : "memory")
#define PV_D0(d0) do { s16x4 l0, l1, l2, l3, h0, h1, h2, h3; constexpr int b_ = VB * SHM_V + v_rd_off(d0, 0, 0);   \
        TRRD(l0, b_); TRRD(h0, b_ + 2048); TRRD(l1, b_ + 4096); TRRD(h1, b_ + 6144); TRRD(l2, b_ + 8192); TRRD(h2, b_ + 10240); TRRD(l3, b_ + 12288); TRRD(h3, b_ + 14336); \
        asm volatile("s_waitcnt lgkmcnt(0)" ::: "memory"); SBAR();   \
        o[d0] = __builtin_amdgcn_mfma_f32_32x32x16_bf16(pa0, (bf16x8){l0[0], l0[1], l0[2], l0[3], h0[0], h0[1], h0[2], h0[3]}, o[d0], 0, 0, 0);   \
        o[d0] = __builtin_amdgcn_mfma_f32_32x32x16_bf16(pa1, (bf16x8){l1[0], l1[1], l1[2], l1[3], h1[0], h1[1], h1[2], h1[3]}, o[d0], 0, 0, 0);   \
        o[d0] = __builtin_amdgcn_mfma_f32_32x32x16_bf16(pa2, (bf16x8){l2[0], l2[1], l2[2], l2[3], h2[0], h2[1], h2[2], h2[3]}, o[d0], 0, 0, 0);   \
        o[d0] = __builtin_amdgcn_mfma_f32_32x32x16_bf16(pa3, (bf16x8){l3[0], l3[1], l3[2], l3[3], h3[0], h3[1], h3[2], h3[3]}, o[d0], 0, 0, 0); } while (0)
    PV_D0(0); PV_D0(1); PV_D0(2); PV_D0(3);
#undef PV_D0
#undef TRRD
}

enum { MODE_NONE = 0, MODE_SEL = 1, MODE_WIN = 2, MODE_CMP = 3 };
enum { EPI_MEM = 0, EPI_ACC0 = 1, EPI_ACC1 = 2, EPI_FIN = 3 };
struct Ctx { const bf16 *KV, *KC, *VC, *Q1, *ZQ, *QM, *ZM, *MKV; const float* gates; const unsigned long long* SEL; float* YACC; bf16* Y; int qm_ld, zm_ld, qm_c0, zm_c0; };
struct Blk {
    const bf16* Q; const bf16* K; int voff;
    int ldq, ldk;
    int j_lo, j_hi;
    int t0;
    int mode, epi;
    int row0, hcol, gcol, bg;
};
constexpr int LDS_WS = 2 * SHM_V + 2 * SHM_K;
constexpr int LDS_SEL = LDS_WS + NW * 64 * 4;
constexpr int LDS_STG = LDS_SEL + NW * 32 * 8;
constexpr int LDS_BYTES2 = LDS_STG + NW * 32 * 68 * 4;
struct Seam { bf16x8 qr[8]; bf16x8 st_v0, st_v1, st_k0, st_k1; };
#define AROW(p, k0, rr) ((p) + (size_t)((k0) + (rr)) * ldk + sc)
#define VMWN(n) asm volatile("s_waitcnt vmcnt(%0)" :: "i"(n) : "memory")
#define SLOAD_H(Kp, Vp, k0) do { S.st_v0 = load8(AROW(Vp, k0, sr)); S.st_v1 = load8(AROW(Vp, k0, 32 + sr));              \
                         S.st_k0 = load8(AROW(Kp, k0, sr)); S.st_k1 = load8(AROW(Kp, k0, 32 + sr)); } while (0)
#define SWRITE_HK(bf) do { *(bf16x8*)(K_lds + (bf) * SHM_K + kws) = S.st_k0; *(bf16x8*)(K_lds + (bf) * SHM_K + kws + 32 * 256) = S.st_k1; } while (0)
#define SWRITE_HV(bf) do { *(bf16x8*)(V_lds + (bf) * SHM_V + vst0) = S.st_v0; *(bf16x8*)(V_lds + (bf) * SHM_V + vst1) = S.st_v1; } while (0)
#define SWRITE_H(bf) do { SWRITE_HV(bf); SWRITE_HK(bf); } while (0)

__device__ __forceinline__ void attn_prime(const int tid, const Blk& cur, char* lds, Seam& S) {
    const int wid = __builtin_amdgcn_readfirstlane(tid >> 6), lane = tid & 63, r32 = lane & 31, hi = lane >> 5;
    const int sr = tid >> 4, sc = (tid & 15) * 8, kws = KSWZ(sr, sc * 2); char* K_lds = lds + 2 * SHM_V;
    const int ldk = cur.ldk; const int kb0 = cur.j_lo * KVBLK;
#pragma unroll
    for (int i = 0; i < 8; ++i) S.qr[i] = load8(cur.Q + (size_t)(wid * QBLK + (lane >> 4) + 4 * i) * cur.ldq + (lane & 15) * 8);
    SLOAD_H(cur.K, cur.K + cur.voff, kb0); VM_WAIT(); SWRITE_HK(0);
    __syncthreads();
}
__device__ __forceinline__ void attn_block(const int tid, const Ctx& C, const Blk& cur, const bf16* nQ, const bf16* nK, int nvoff, int nldq, int nldk, int nj_lo, char* lds, Seam& S) {
    const int wid = __builtin_amdgcn_readfirstlane(tid >> 6), lane = tid & 63, r32 = lane & 31, hi = lane >> 5;
#ifdef AT_TILE2X
    const int j_lo = cur.j_lo, NT0 = cur.j_hi - cur.j_lo, NT = (cur.mode == AT_TILE2X) ? 2 * NT0 : NT0;
#define TIX(t) ((t) >= NT0 ? (t) - NT0 : (t))
#else
    const int j_lo = cur.j_lo, NT = cur.j_hi - cur.j_lo;
#define TIX(t) (t)
#endif
    const int kbn = nj_lo * KVBLK;
    const int mode = cur.mode;
    const int trow = cur.t0 + wid * QBLK;
    int pos, pmin, pmax; unsigned W;
    if (mode == MODE_CMP) { pos = (trow + r32 - 31) >> 4; pmin = (trow - 31) >> 4; pmax = trow >> 4; W = 0x7fffffffu; }
    else if (mode == MODE_NONE) { pos = 1 << 29; pmin = 1 << 29; pmax = 1 << 29; W = 0x7fffffffu; }
    else { pos = trow + r32; pmin = trow; pmax = trow + QBLK - 1; W = (mode == MODE_WIN) ? 512u : 0x7fffffffu; }
    const int qm = pos - 4 * hi;
    char* V_lds = lds; char* K_lds = lds + 2 * SHM_V;
    float* ws = (float*)(lds + LDS_WS) + wid * 64; float* li_l = ws, * al_l = ws + 32;
    unsigned long long* sel_l = (unsigned long long*)(lds + LDS_SEL) + wid * 32;
    if (mode == MODE_SEL && hi == 0) sel_l[r32] = C.SEL[(size_t)cur.bg * SEQ + trow + r32];
    float m_reg = -1e30f, l_reg = 0; f32x16 o[4] = {};
    const int sr = tid >> 4, sc = (tid & 15) * 8, vst0 = v_st(sr, sc), vst1 = v_st(32 + sr, sc), kws = KSWZ(sr, sc * 2);
    const int vb0 = (int)(uintptr_t)V_lds + v_rd_base(lane);
    const bf16* Kh = cur.K; const bf16* Vh = cur.K + cur.voff; const int ldk = cur.ldk;
#define RESC(a) do { if (__any((a) < 1.f)) { if (hi == 0) al_l[r32] = (a); asm volatile("s_waitcnt lgkmcnt(0)" ::: "memory");              \
                     for (int d_ = 0; d_ < 4; ++d_) for (int r = 0; r < 16; ++r) o[d_][r] *= al_l[crow(r, hi)]; } } while (0)
#define KBASE(t) ((j_lo + TIX(t)) * KVBLK)
#define MASKT(P0_, P1_, t, KP_) do { const int kb_ = KBASE(t); KP_ = 1; \
        if (mode == MODE_SEL) { const int bit_ = (int)((sel_l[r32] >> (j_lo + TIX(t))) & 1ull); \
            if (kb_ + KVBLK - 1 > pmin) mask_tile(P0_, P1_, bit_ ? qm - kb_ : -(1 << 30), W);       \
            else KP_ = bit_; }                                                                         \
        else if (kb_ + KVBLK - 1 > pmin || kb_ <= pmax - (int)W) mask_tile(P0_, P1_, qm - kb_, W); } while (0)
    constexpr int NQL = 8;
#define SEAM_K0() do { VMWN(NQL); SWRITE_HK(0); SBAR(); } while (0)
    f32x16 pA0, pA1, pB0, pB1; float mnA, mnB, alA, alB; int kpA = 1, kpB = 1; bf16x8 pa0, pa1, pa2, pa3;
    {
        char* stq = lds + LDS_STG + wid * (32 * 272);
#pragma unroll
        for (int i = 0; i < 8; ++i) *(bf16x8*)(stq + ((lane >> 4) + 4 * i) * 272 + (lane & 15) * 16) = S.qr[i];
        asm volatile("s_waitcnt lgkmcnt(0)" ::: "memory");
#pragma unroll
        for (int d0 = 0; d0 < 8; ++d0) S.qr[d0] = *(const bf16x8*)(stq + r32 * 272 + (2 * d0 + hi) * 16);
        asm volatile("s_waitcnt lgkmcnt(0)" ::: "memory");
    }
    SWRITE_HV(0); SBAR();
    if (NT > 1) { SLOAD_H(Kh, Vh, KBASE(1)); }
    SBAR(); qkt<0>(pA0, pA1, K_lds, r32, hi, S.qr);
    MASKT(pA0, pA1, 0, kpA); partialSM(pA0, pA1, m_reg, mnA, alA);
    if (NT > 1) { VM_WAIT(); SWRITE_H(1); }
    __syncthreads();
#define HALF_STEP(PX0, PX1, mnX, alX, kpX, PY0, PY1, alY, kpY, t, KB, VB, SB) do {                                                      \
        SBAR(); if ((t) + 1 < NT) { SLOAD_H(Kh, Vh, KBASE((t) + 1)); SBAR(); }         \
        qkt<KB>(PX0, PX1, K_lds, r32, hi, S.qr);                                             \
        finishSM(PY0, PY1, alY, l_reg, pa0, pa1, pa2, pa3, kpY); SBAR();                                                      \
        pv_tile<VB>(o, vb0, pa0, pa1, pa2, pa3); MASKT(PX0, PX1, (t), kpX); partialSM(PX0, PX1, m_reg, mnX, alX);                                        \
        __syncthreads();                                                                                                      \
        if ((t) + 1 < NT) { VM_WAIT(); SWRITE_H(SB); }                                                                          \
        RESC(alX); __syncthreads(); } while (0)
    for (int t = 1; t + 1 < NT; t += 2) {
        HALF_STEP(pB0, pB1, mnB, alB, kpB, pA0, pA1, alA, kpA, t, 1, 0, 0);
        HALF_STEP(pA0, pA1, mnA, alA, kpA, pB0, pB1, alB, kpB, t + 1, 0, 1, 1);
    }
    const bool even = (NT & 1) == 0;
    if (even) { SBAR(); qkt<1>(pB0, pB1, K_lds, r32, hi, S.qr); SBAR(); }
    { const int ldk = nldk; SLOAD_H(nK, nK + nvoff, kbn); SBAR(); }
#pragma unroll
    for (int i = 0; i < 8; ++i) S.qr[i] = load8(nQ + (size_t)(wid * QBLK + (lane >> 4) + 4 * i) * nldq + (lane & 15) * 8);
    SBAR();
    finishSM(pA0, pA1, alA, l_reg, pa0, pa1, pa2, pa3, kpA); SBAR();
    pv_tile<0>(o, vb0, pa0, pa1, pa2, pa3);
    if (even) { MASKT(pB0, pB1, NT - 1, kpB); partialSM(pB0, pB1, m_reg, mnB, alB); __syncthreads(); RESC(alB);
        finishSM(pB0, pB1, alB, l_reg, pa0, pa1, pa2, pa3, kpB); SBAR(); pv_tile<1>(o, vb0, pa0, pa1, pa2, pa3); }
    SBAR(); SEAM_K0();
    {
        const int epi = cur.epi;
        float fac = l_reg > 0.f ? __builtin_amdgcn_rcpf(l_reg) : 0.f;
        if (epi != EPI_MEM) fac *= C.gates[(size_t)(cur.row0 + wid * QBLK + r32) * 36 + cur.gcol];
        if (hi == 0) li_l[r32] = fac;
        asm volatile("s_waitcnt lgkmcnt(0)" ::: "memory");
        float* stg = (float*)(lds + LDS_STG) + wid * (32 * 68);
        const int rrow = lane >> 4, c4 = (lane & 15) * 4;
        const size_t grow = (size_t)cur.row0 + wid * QBLK + rrow;
        const bool fin = (epi == EPI_FIN);
        float* accb = C.YACC + grow * NSAW + cur.hcol + c4;
        const bf16* zb = fin ? C.ZQ + grow * NSAW + cur.hcol + c4 : C.ZM + grow * C.zm_ld + C.zm_c0 + cur.hcol + c4;
        const int ldz = fin ? NSAW : C.zm_ld;
        bf16* yb = C.Y + grow * DM + (fin ? 0 : POOLW) + cur.hcol + c4;
#pragma unroll
        for (int half = 0; half < 2; ++half) {
#pragma unroll
            for (int r = 0; r < 16; ++r) { const float f = li_l[crow(r, hi)]; float* w = stg + crow(r, hi) * 68 + r32; w[0] = o[2 * half][r] * f; w[32] = o[2 * half + 1][r] * f; }
            asm volatile("s_waitcnt lgkmcnt(0)" ::: "memory");
            f32x4 v[8];
#pragma unroll
            for (int i = 0; i < 8; ++i) v[i] = *(const f32x4*)(stg + (rrow + 4 * i) * 68 + c4);
            const int co = half * 64;
            if (epi == EPI_ACC0) {
#pragma unroll
                for (int i = 0; i < 8; ++i) *(f32x4*)(accb + (size_t)(4 * i) * NSAW + co) = v[i];
            } else if (epi == EPI_ACC1) {
                f32x4 a[8];
#pragma unroll
                for (int i = 0; i < 8; ++i) a[i] = *(const f32x4*)(accb + (size_t)(4 * i) * NSAW + co);
#pragma unroll
                for (int i = 0; i < 8; ++i) *(f32x4*)(accb + (size_t)(4 * i) * NSAW + co) = a[i] + v[i];
            } else {
                v2u z[8];
#pragma unroll
                for (int i = 0; i < 8; ++i) z[i] = *(const v2u*)(zb + (size_t)(4 * i) * ldz + co);
                if (fin) { f32x4 a[8];
#pragma unroll
                    for (int i = 0; i < 8; ++i) a[i] = *(const f32x4*)(accb + (size_t)(4 * i) * NSAW + co);
#pragma unroll
                    for (int i = 0; i < 8; ++i) v[i] = v[i] + a[i]; }
#pragma unroll
                for (int i = 0; i < 8; ++i) { v2u w; w.x = pk2(v[i][0] * bflo(z[i].x), v[i][1] * bfhi(z[i].x)); w.y = pk2(v[i][2] * bflo(z[i].y), v[i][3] * bfhi(z[i].y));
                    *(v2u*)(yb + (size_t)(4 * i) * DM + co) = w; }
            }
            asm volatile("s_waitcnt lgkmcnt(0)" ::: "memory");
        }
    }
    __syncthreads();
#undef RESC
#undef TIX
#undef KBASE
#undef MASKT
#undef SEAM_K0
#undef HALF_STEP
}
#undef AROW
#undef VMWN
#undef SLOAD_H
#undef SWRITE_HK
#undef SWRITE_HV
#undef SWRITE_H
}
__device__ const unsigned short NSA_TAB[256 * 4] = {
    0, 384, 674, 65535,
    1, 385, 675, 65535,
    144, 480, 484, 65535,
    145, 481, 485, 65535,
    96, 482, 528, 65535,
    97, 483, 529, 65535,
    48, 388, 676, 65535,
    49, 389, 677, 65535,
    148, 432, 530, 65535,
    149, 433, 531, 65535,
    192, 386, 532, 65535,
    193, 387, 533, 65535,
    4, 288, 722, 65535,
    5, 289, 723, 65535,
    98, 436, 576, 65535,
    99, 437, 577, 65535,
    100, 434, 578, 65535,
    101, 435, 579, 65535,
    2, 292, 724, 65535,
    3, 293, 725, 65535,
    146, 336, 628, 65535,
    147, 337, 629, 65535,
    50, 338, 672, 65535,
    51, 339, 673, 65535,
    52, 244, 720, 65535,
    53, 245, 721, 65535,
    194, 340, 580, 65535,
    195, 341, 581, 65535,
    196, 290, 624, 65535,
    197, 291, 625, 65535,
    240, 242, 626, 65535,
    241, 243, 627, 65535,
    6, 390, 680, 65535,
    7, 391, 681, 65535,
    150, 486, 490, 65535,
    151, 487, 491, 65535,
    102, 488, 534, 65535,
    103, 489, 535, 65535,
    54, 394, 682, 65535,
    55, 395, 683, 65535,
    154, 438, 536, 65535,
    155, 439, 537, 65535,
    198, 392, 538, 65535,
    199, 393, 539, 65535,
    10, 294, 728, 65535,
    11, 295, 729, 65535,
    104, 442, 582, 65535,
    105, 443, 583, 65535,
    106, 440, 584, 65535,
    107, 441, 585, 65535,
    8, 298, 730, 65535,
    9, 299, 731, 65535,
    152, 342, 634, 65535,
    153, 343, 635, 65535,
    56, 344, 678, 65535,
    57, 345, 679, 65535,
    58, 250, 726, 65535,
    59, 251, 727, 65535,
    200, 346, 586, 65535,
    201, 347, 587, 65535,
    202, 296, 630, 65535,
    203, 297, 631, 65535,
    246, 248, 632, 65535,
    247, 249, 633, 65535,
    12, 396, 686, 65535,
    13, 397, 687, 65535,
    156, 492, 496, 65535,
    157, 493, 497, 65535,
    108, 494, 540, 65535,
    109, 495, 541, 65535,
    60, 400, 688, 65535,
    61, 401, 689, 65535,
    160, 444, 542, 65535,
    161, 445, 543, 65535,
    204, 398, 544, 65535,
    205, 399, 545, 65535,
    16, 300, 734, 65535,
    17, 301, 735, 65535,
    110, 448, 588, 65535,
    111, 449, 589, 65535,
    112, 446, 590, 65535,
    113, 447, 591, 65535,
    14, 304, 736, 65535,
    15, 305, 737, 65535,
    158, 348, 640, 65535,
    159, 349, 641, 65535,
    62, 350, 684, 65535,
    63, 351, 685, 65535,
    64, 256, 732, 65535,
    65, 257, 733, 65535,
    206, 352, 592, 65535,
    207, 353, 593, 65535,
    208, 302, 636, 65535,
    209, 303, 637, 65535,
    252, 254, 638, 65535,
    253, 255, 639, 65535,
    18, 402, 692, 65535,
    19, 403, 693, 65535,
    162, 498, 502, 65535,
    163, 499, 503, 65535,
    114, 500, 546, 65535,
    115, 501, 547, 65535,
    66, 406, 694, 65535,
    67, 407, 695, 65535,
    166, 450, 548, 65535,
    167, 451, 549, 65535,
    210, 404, 550, 65535,
    211, 405, 551, 65535,
    22, 306, 740, 65535,
    23, 307, 741, 65535,
    116, 454, 594, 65535,
    117, 455, 595, 65535,
    118, 452, 596, 65535,
    119, 453, 597, 65535,
    20, 310, 742, 65535,
    21, 311, 743, 65535,
    164, 354, 646, 65535,
    165, 355, 647, 65535,
    68, 356, 690, 65535,
    69, 357, 691, 65535,
    70, 262, 738, 65535,
    71, 263, 739, 65535,
    212, 358, 598, 65535,
    213, 359, 599, 65535,
    214, 308, 642, 65535,
    215, 309, 643, 65535,
    258, 260, 644, 65535,
    259, 261, 645, 65535,
    24, 408, 698, 65535,
    25, 409, 699, 65535,
    168, 504, 508, 65535,
    169, 505, 509, 65535,
    120, 506, 552, 65535,
    121, 507, 553, 65535,
    72, 412, 700, 65535,
    73, 413, 701, 65535,
    172, 456, 554, 65535,
    173, 457, 555, 65535,
    216, 410, 556, 65535,
    217, 411, 557, 65535,
    28, 312, 746, 65535,
    29, 313, 747, 65535,
    122, 460, 600, 65535,
    123, 461, 601, 65535,
    124, 458, 602, 65535,
    125, 459, 603, 65535,
    26, 316, 748, 65535,
    27, 317, 749, 65535,
    170, 360, 652, 65535,
    171, 361, 653, 65535,
    74, 362, 696, 65535,
    75, 363, 697, 65535,
    76, 268, 744, 65535,
    77, 269, 745, 65535,
    218, 364, 604, 65535,
    219, 365, 605, 65535,
    220, 314, 648, 65535,
    221, 315, 649, 65535,
    264, 266, 650, 65535,
    265, 267, 651, 65535,
    30, 414, 704, 65535,
    31, 415, 705, 65535,
    174, 510, 514, 65535,
    175, 511, 515, 65535,
    126, 512, 558, 65535,
    127, 513, 559, 65535,
    78, 418, 706, 65535,
    79, 419, 707, 65535,
    178, 462, 560, 65535,
    179, 463, 561, 65535,
    222, 416, 562, 65535,
    223, 417, 563, 65535,
    34, 318, 752, 65535,
    35, 319, 753, 65535,
    128, 466, 606, 65535,
    129, 467, 607, 65535,
    130, 464, 608, 65535,
    131, 465, 609, 65535,
    32, 322, 754, 65535,
    33, 323, 755, 65535,
    176, 366, 658, 65535,
    177, 367, 659, 65535,
    80, 368, 702, 65535,
    81, 369, 703, 65535,
    82, 274, 750, 65535,
    83, 275, 751, 65535,
    224, 370, 610, 65535,
    225, 371, 611, 65535,
    226, 320, 654, 65535,
    227, 321, 655, 65535,
    270, 272, 656, 65535,
    271, 273, 657, 65535,
    36, 420, 710, 65535,
    37, 421, 711, 65535,
    180, 516, 520, 65535,
    181, 517, 521, 65535,
    132, 518, 564, 65535,
    133, 519, 565, 65535,
    84, 424, 712, 65535,
    85, 425, 713, 65535,
    184, 468, 566, 65535,
    185, 469, 567, 65535,
    228, 422, 568, 65535,
    229, 423, 569, 65535,
    40, 324, 758, 65535,
    41, 325, 759, 65535,
    134, 472, 612, 65535,
    135, 473, 613, 65535,
    136, 470, 614, 65535,
    137, 471, 615, 65535,
    38, 328, 760, 65535,
    39, 329, 761, 65535,
    182, 372, 664, 65535,
    183, 373, 665, 65535,
    86, 374, 708, 65535,
    87, 375, 709, 65535,
    88, 280, 756, 65535,
    89, 281, 757, 65535,
    230, 376, 616, 65535,
    231, 377, 617, 65535,
    232, 326, 660, 65535,
    233, 327, 661, 65535,
    276, 278, 662, 65535,
    277, 279, 663, 65535,
    42, 426, 716, 65535,
    43, 427, 717, 65535,
    186, 522, 526, 65535,
    187, 523, 527, 65535,
    138, 524, 570, 65535,
    139, 525, 571, 65535,
    90, 430, 718, 65535,
    91, 431, 719, 65535,
    190, 474, 572, 65535,
    191, 475, 573, 65535,
    234, 428, 574, 65535,
    235, 429, 575, 65535,
    46, 330, 764, 65535,
    47, 331, 765, 65535,
    140, 478, 618, 65535,
    141, 479, 619, 65535,
    142, 476, 620, 65535,
    143, 477, 621, 65535,
    44, 334, 766, 65535,
    45, 335, 767, 65535,
    188, 378, 670, 65535,
    189, 379, 671, 65535,
    92, 380, 714, 65535,
    93, 381, 715, 65535,
    94, 286, 762, 65535,
    95, 287, 763, 65535,
    236, 382, 622, 65535,
    237, 383, 623, 65535,
    238, 332, 666, 65535,
    239, 333, 667, 65535,
    282, 284, 668, 65535,
    283, 285, 669, 65535,
};

constexpr int NWAVES = 8, NTHREADS = 512;
constexpr int LDS_BYTES = 147456;
constexpr int NPHASE = 12;
#ifndef MK_PER_PHASE
#define MK_PER_PHASE 0
#endif

struct Args { const void* in[17]; float* out; unsigned char* ws; int ph_lo, ph_hi; };

constexpr int TAB_OFF = LDS_BYTES - 1024;
enum { IX_X = 0, IX_MEM, IX_POS, IX_NORM_G, IX_MEM_NORM_G, IX_W_MEM_KV, IX_W_OUT, IX_A_W_IN, IX_A_W_POOL, IX_A_POOL_SCALE, IX_B_W_IN, IX_KV_NORM_G, IX_W_KV, IX_CMP_PE, IX_CMP_W1, IX_CMP_W2, IX_FINAL_G, IX_OUT, IX_WS };
__device__ __forceinline__ int lane_fresh() { int l; asm volatile("v_mbcnt_lo_u32_b32 %0, -1, 0\n\tv_mbcnt_hi_u32_b32 %0, -1, %0" : "=v"(l)); return l; }
struct Frame {
    LAS unsigned char* lds; char* ldsg;
    int wave, vcu, G;
    __device__ __forceinline__ int tid() const { return wave * 64 + lane_fresh(); }
    __device__ __forceinline__ unsigned char* ptr(int k) const {
        volatile LAS unsigned* t = (volatile LAS unsigned*)(lds + TAB_OFF);
        const unsigned lo = t[2 * k], hi = t[2 * k + 1];
        typedef __attribute__((address_space(1))) unsigned char gchar;
        return (unsigned char*)(gchar*)(((unsigned long long)(unsigned)__builtin_amdgcn_readfirstlane(hi) << 32) | (unsigned)__builtin_amdgcn_readfirstlane(lo));
    }
    __device__ __forceinline__ const float* fin(int k) const { return (const float*)ptr(k); }
};
#define WSP(T, off) ((T*)(ws + (off)))

#define XB_TMO      128
#define XB_XCNT(j)  (256  + 64 * (j))
#define XB_XSUB(j)  (1280 + 64 * (j))
#define XB_XGEN(j)  (2304 + 64 * (j))
#define XB_TOP      3328
#define XB_TOPGEN   3392
#define XCD_BAR_WORDS 3456
#define XB_SPIN_CAP (1u << 20)
constexpr int MISC_OFF = LDS_BYTES - 512;
__device__ __forceinline__ unsigned xb_ld(unsigned* p)              { return __hip_atomic_load(p, __ATOMIC_RELAXED, __HIP_MEMORY_SCOPE_AGENT); }
__device__ __forceinline__ unsigned xb_add(unsigned* p, unsigned v) { return __hip_atomic_fetch_add(p, v, __ATOMIC_RELAXED, __HIP_MEMORY_SCOPE_AGENT); }
__device__ __forceinline__ unsigned xb_xcc_id() { return (unsigned)__builtin_amdgcn_s_getreg((3 << 11) | 20) & 0xFu; }
#define XB_SPIN(cond, bar) do { unsigned _sp = 0; while (cond) { __builtin_amdgcn_s_sleep(1); \
    if ((++_sp & 255u) == 0u) { if (xb_ld(&(bar)[XB_TMO])) break; if (_sp > XB_SPIN_CAP) { atomicAdd(&(bar)[XB_TMO], 1u); break; } } } } while (0)
__device__ __forceinline__ void xcd_barrier_complete(unsigned* bar, unsigned x, unsigned G, unsigned& nloc, unsigned& nx) {
    unsigned sum, cnt, mine, sp = 0u;
    for (;;) {
        sum = 0u; cnt = 0u; mine = 0u;
#pragma unroll
        for (unsigned j = 0; j < 16; ++j) { const unsigned c = xb_ld(&bar[XB_XCNT(j)]); sum += c; cnt += (c > 0u) ? 1u : 0u; mine = (j == x) ? c : mine; }
        if (sum == G) break;
        __builtin_amdgcn_s_sleep(1);
        if ((++sp & 255u) == 0u) { if (xb_ld(&bar[XB_TMO])) break; if (sp > XB_SPIN_CAP) { atomicAdd(&bar[XB_TMO], 1u); break; } }
    }
    nloc = mine > 0u ? mine : 1u; nx = cnt > 0u ? cnt : 1u;
}
__device__ __forceinline__ void xcd_barrier(unsigned* bar, volatile LAS unsigned* st, unsigned G, int tid) {
    asm volatile("s_waitcnt vmcnt(0)" ::: "memory");
    __syncthreads();
    if (tid == 0) {
        const unsigned x = xb_xcc_id();
        __builtin_amdgcn_s_waitcnt(0);
        unsigned nloc = st[0], nx = st[1];
        if (nloc == 0u) { xcd_barrier_complete(bar, x, G, nloc, nx); st[0] = nloc; st[1] = nx; }
        const unsigned old = xb_add(&bar[XB_XSUB(x)], 1u);
        const unsigned gen = old / nloc;
        if (old + 1u == (gen + 1u) * nloc) {
            __builtin_amdgcn_fence(__ATOMIC_RELEASE, "agent");
            asm volatile("s_waitcnt vmcnt(0)" ::: "memory");
            const unsigned og = xb_add(&bar[XB_TOP], 1u);
            const unsigned tg = og / nx;
            if (og + 1u == (tg + 1u) * nx) xb_add(&bar[XB_TOPGEN], 1u);
            else XB_SPIN(xb_ld(&bar[XB_TOPGEN]) == tg, bar);
            __builtin_amdgcn_fence(__ATOMIC_ACQUIRE, "agent");
            xb_add(&bar[XB_XGEN(x)], 1u);
            asm volatile("s_waitcnt vmcnt(0)" ::: "memory");
        } else {
            XB_SPIN(xb_ld(&bar[XB_XGEN(x)]) == gen, bar);
            __builtin_amdgcn_fence(__ATOMIC_ACQUIRE, "agent");
            asm volatile("s_waitcnt vmcnt(0)" ::: "memory");
        }
    }
    __syncthreads();
}

struct TDesc { const float* W; const float* gain; bf16* WT; int ldw, c0, nv, ldt, row0, k0; };
__device__ __forceinline__ void tload(const TDesc& d, f32x4 (&v)[16], int lane) {
    const int n4 = (lane & 15) * 4, kr = lane >> 4;
    const float* src = d.W + (size_t)(d.k0 + kr) * d.ldw + d.c0 + n4;
    if (n4 < d.nv) {
#pragma unroll
        for (int i = 0; i < 16; ++i) v[i] = __builtin_nontemporal_load((const f32x4*)(src + (size_t)(4 * i) * d.ldw));
    } else {
#pragma unroll
        for (int i = 0; i < 16; ++i) v[i] = (f32x4){0.f, 0.f, 0.f, 0.f};
    }
}
__device__ __forceinline__ void tproc(const TDesc& d, f32x4 (&v)[16], LAS float* scr, int lane) {
    const int n4 = (lane & 15) * 4, kr = lane >> 4;
    if (d.gain) {
#pragma unroll
        for (int i = 0; i < 16; ++i) v[i] = v[i] * d.gain[d.k0 + kr + 4 * i];
    }
#pragma unroll
    for (int i = 0; i < 16; ++i) { LAS float* q = scr + (kr + 4 * i) * 65 + n4; q[0] = v[i][0]; q[1] = v[i][1]; q[2] = v[i][2]; q[3] = v[i][3]; }
    LDS_WAIT(); asm volatile("" ::: "memory");
    const int ch = lane & 7;
#pragma unroll
    for (int j = 0; j < 8; ++j) { const int n = (lane >> 3) + 8 * j; const LAS float* s = scr + (8 * ch) * 65 + n;
        v4u o; o.x = pk2(s[0 * 65], s[1 * 65]); o.y = pk2(s[2 * 65], s[3 * 65]); o.z = pk2(s[4 * 65], s[5 * 65]); o.w = pk2(s[6 * 65], s[7 * 65]);
        if (n < d.nv) *(v4u*)(d.WT + (size_t)(d.row0 + n) * d.ldt + d.k0 + 8 * ch) = o; }
    LDS_WAIT(); asm volatile("" ::: "memory");
}
__device__ __forceinline__ void rms_load(const float* xrow, f32x4 (&v)[8], int lane) {
    const f32x4* xr = (const f32x4*)xrow + lane;
#pragma unroll
    for (int j = 0; j < 8; ++j) v[j] = __builtin_nontemporal_load(xr + 64 * j);
}
__device__ __forceinline__ void rms_finish(f32x4 (&v)[8], const float* g, bf16* orow, int lane) {
    float s = 0.f;
#pragma unroll
    for (int j = 0; j < 8; ++j) s += (v[j].x * v[j].x + v[j].y * v[j].y) + (v[j].z * v[j].z + v[j].w * v[j].w);
    const float rinv = 1.0f / sqrtf(wave_sum(s) * (1.f / DM) + EPS);
    unsigned long long* o8 = (unsigned long long*)orow + lane;
#pragma unroll
    for (int j = 0; j < 8; ++j) { f32x4 gg = g ? ((const f32x4*)g)[64 * j + lane] : (f32x4){1.f, 1.f, 1.f, 1.f};
        o8[64 * j] = (unsigned long long)pk2(v[j].x * rinv * gg.x, v[j].y * rinv * gg.y) | ((unsigned long long)pk2(v[j].z * rinv * gg.z, v[j].w * rinv * gg.w) << 32); }
}
__device__ __forceinline__ void sincos_acc(float angf, float& c, float& s) {
    const double a = (double)angf;
    const double kq = rint(a * 0.63661977236758134308);
    const double r = fma(-kq, 6.123233995736766e-17, fma(-kq, 1.5707963267948966, a));
    const double r2 = r * r;
    double sp = -2.5052108385441718775e-08; sp = fma(sp, r2, 2.7557319223985890653e-06); sp = fma(sp, r2, -1.9841269841269841270e-04); sp = fma(sp, r2, 8.3333333333333332177e-03); sp = fma(sp, r2, -1.6666666666666665741e-01);
    const double sn = fma(sp * r2, r, r) + r2 * r2 * r2 * r2 * r2 * r2 * r * 1.6059043836821614599e-10;
    double cp = 2.0876756987868098979e-09; cp = fma(cp, r2, -2.7557319223985890653e-07); cp = fma(cp, r2, 2.4801587301587301566e-05); cp = fma(cp, r2, -1.3888888888888889419e-03); cp = fma(cp, r2, 4.1666666666666664354e-02); cp = fma(cp, r2, -0.5);
    const double cs = fma(cp, r2, 1.0);
    const int q = ((int)kq) & 3;
    const double sv = (q & 1) ? cs : sn, cv = (q & 1) ? sn : cs;
    s = (float)((q & 2) ? -sv : sv);
    c = (float)(((q + 1) & 2) ? -cv : cv);
}
__device__ __forceinline__ float rope_inv(int i) {
    return (float)exp2(-(double)i * (18.931568569324174 / 16.0));
}

template <int WHICH>
__device__ __forceinline__ void transposes(Frame& F, int gw, int NGW, int lane) {
    unsigned char* ws = F.ptr(IX_WS);
    LAS float* scr = (LAS float*)(F.lds + F.wave * 16640);
    const float* a_w_in = F.fin(IX_A_W_IN); const float* w_out = F.fin(IX_W_OUT); const float* w_kv = F.fin(IX_W_KV); const float* b_w_in = F.fin(IX_B_W_IN);
    const float* norm_g = F.fin(IX_NORM_G); const float* kv_norm_g = F.fin(IX_KV_NORM_G); const float* mem_norm_g = F.fin(IX_MEM_NORM_G); const float* w_mem_kv = F.fin(IX_W_MEM_KV);
    const float* a_w_pool = F.fin(IX_A_W_POOL); const float* cmp_w1 = F.fin(IX_CMP_W1);
    bf16* W1T = WSP(bf16, WS_W1T); bf16* WO0T = WSP(bf16, WS_WO0T); bf16* W4T = WSP(bf16, WS_W4T); bf16* WO1T = WSP(bf16, WS_WO1T);
    bf16* WMT = WSP(bf16, WS_WMT); bf16* WPT = WSP(bf16, WS_WPT); bf16* WC1T = WSP(bf16, WS_WC1T);
#define SEG(W_, ldw_, K_, c0_, nc_, WT_, row0_, gain_) if (!done_) { const int nb_ = ((nc_) + 63) / 64, ni_ = ((K_) / 64) * nb_; \
        if (r < ni_) { const int kb = r / nb_, nb = r % nb_; int nv = (nc_) - nb * 64; nv = nv > 64 ? 64 : nv; \
            d.W = W_; d.gain = gain_; d.WT = WT_; d.ldw = ldw_; d.c0 = (c0_) + nb * 64; d.nv = nv; d.ldt = K_; d.row0 = (row0_) + nb * 64; d.k0 = kb * 64; done_ = true; } else r -= ni_; }
#define TDECODE(it_, dd_) do { TDesc& d = (dd_); int r = (it_); bool done_ = false; \
      if constexpr (WHICH == 0) { \
        SEG(a_w_in, N1, DM, 0, N1, W1T, 0, nullptr) \
        SEG(w_mem_kv, 1024, DM, 0, 1024, WMT, 0, mem_norm_g) \
      } else { \
        SEG(w_out, DM, DM, 0, DM, WO0T, 0, nullptr) \
        SEG(w_out + (size_t)DM * DM, DM, DM, 0, DM, WO1T, 0, nullptr) \
        SEG(w_kv, NKV, DM, 0, NKV, W4T, 0, kv_norm_g) \
        SEG(b_w_in, 4132, DM, 0, 1536, W4T, 3072, norm_g + DM)            \
        SEG(b_w_in, 4132, DM, 1572, 1536, W4T, 4608, norm_g + DM)         \
        SEG(b_w_in, 4132, DM, 3108, 512, W4T, 6144, norm_g + DM)          \
        SEG(b_w_in, 4132, DM, 3620, 512, W4T, 6656, norm_g + DM)          \
        SEG(b_w_in, 4132, DM, 1536, 36, W4T, 7168, norm_g + DM)           \
        SEG(w_mem_kv + (size_t)DM * 1024, 1024, DM, 0, 1024, WMT + (size_t)1024 * DM, 0, mem_norm_g + DM) \
        SEG(a_w_pool + 0 * 384 * 384, 384, 384, 0, 384, WPT + 0 * 512 * 384, 0, nullptr) \
        SEG(a_w_pool + 1 * 384 * 384, 384, 384, 0, 384, WPT + 1 * 512 * 384, 0, nullptr) \
        SEG(a_w_pool + 2 * 384 * 384, 384, 384, 0, 384, WPT + 2 * 512 * 384, 0, nullptr) \
        SEG(a_w_pool + 3 * 384 * 384, 384, 384, 0, 384, WPT + 3 * 512 * 384, 0, nullptr) \
        SEG(cmp_w1, 256, 4096, 0, 256, WC1T, 0, nullptr) \
        SEG(cmp_w1 + (size_t)4096 * 256, 256, 4096, 0, 256, WC1T + (size_t)256 * 4096, 0, nullptr) \
      } \
    } while (0)
    constexpr int NITEMS = WHICH == 0 ? 32 * 64 + 32 * 16 : 2 * 32 * 32 + 32 * 48 + 32 * (24 + 24 + 8 + 8 + 1) + 32 * 16 + 4 * 6 * 6 + 2 * 64 * 4;
    {
        TDesc da{}, db{}; f32x4 va[16], vb[16];
        if (gw < NITEMS) { TDECODE(gw, da); tload(da, va, lane); }
        for (int it = gw; it < NITEMS; it += 2 * NGW) {
            const bool hb = it + NGW < NITEMS;
            if (hb) { TDECODE(it + NGW, db); tload(db, vb, lane); }
            tproc(da, va, scr, lane);
            if (it + 2 * NGW < NITEMS) { TDECODE(it + 2 * NGW, da); tload(da, va, lane); }
            if (hb) tproc(db, vb, scr, lane);
        }
    }
#undef TDECODE
#undef SEG
}

__device__ __forceinline__ void p0_prologue(Frame& F) {
    const int tid = F.tid(), lane = tid & 63; unsigned char* ws = F.ptr(IX_WS);
    const int gw = F.vcu * NWAVES + F.wave, NGW = F.G * NWAVES;
    const float* norm_g = F.fin(IX_NORM_G); const float* cmp_w1 = F.fin(IX_CMP_W1);
    bf16* W4T = WSP(bf16, WS_W4T); bf16* WPT = WSP(bf16, WS_WPT);
    transposes<0>(F, gw, NGW, lane);
    transposes<1>(F, gw, NGW, lane);
    bf16* XN = WSP(bf16, WS_B); bf16* MEMN = WSP(bf16, WS_MEMN);
    { const float* xin = F.fin(IX_X); const float* memin = F.fin(IX_MEM);
      constexpr int NROWS = MTOK + NB * MEMLEN;
      for (int m = gw; m < NROWS; m += 4 * NGW) {
          f32x4 a[8], b[8], c[8], d[8];
          const int m1 = m + NGW, m2 = m + 2 * NGW, m3 = m + 3 * NGW;
#define RSRC(mm) ((mm) < MTOK ? xin + (size_t)(mm) * DM : memin + (size_t)((mm) - MTOK) * DM)
#define RFIN(mm, v) do { if ((mm) < MTOK) rms_finish(v, norm_g, XN + (size_t)(mm) * DM, lane); else rms_finish(v, nullptr, MEMN + (size_t)((mm) - MTOK) * DM, lane); } while (0)
          rms_load(RSRC(m), a, lane);
          if (m1 < NROWS) rms_load(RSRC(m1), b, lane);
          if (m2 < NROWS) rms_load(RSRC(m2), c, lane);
          if (m3 < NROWS) rms_load(RSRC(m3), d, lane);
          RFIN(m, a);
          if (m1 < NROWS) RFIN(m1, b);
          if (m2 < NROWS) RFIN(m2, c);
          if (m3 < NROWS) RFIN(m3, d);
#undef RSRC
#undef RFIN
      } }
    const int gt = F.vcu * NTHREADS + tid, NGT = F.G * NTHREADS; const int* positions = (const int*)F.ptr(IX_POS);
    float* ROPE = WSP(float, WS_ROPE); float* ROPEC = WSP(float, WS_ROPEC);
    {
    for (int i = gt; i < MTOK * 16; i += NGT) { const int tok = i >> 4, fi = i & 15;
        const float ang = (float)positions[tok] * rope_inv(fi); float c, s; sincos_acc(ang, c, s);
        ROPE[tok * 32 + fi] = c; ROPE[tok * 32 + 16 + fi] = s; }
    for (int i = gt; i < NB * 256 * 16; i += NGT) { const int bn = i >> 4, fi = i & 15, b = bn >> 8, n = bn & 255;
        float c = 1.f, s = 0.f;
        if (n < NCMP) { const float ang = (float)positions[b * SEQ + 16 * n + 31] * rope_inv(fi); sincos_acc(ang, c, s); }
        ROPEC[bn * 32 + fi] = c; ROPEC[bn * 32 + 16 + fi] = s; }
    }
    { v4u z = {0u, 0u, 0u, 0u};
      v4u* p = (v4u*)(W4T + (size_t)7204 * DM); for (int i = gt; i < 220 * DM / 8; i += NGT) p[i] = z;
      for (int g = 0; g < 4; ++g) { v4u* q = (v4u*)(WPT + (size_t)g * 512 * 384 + 384 * 384); for (int i = gt; i < 128 * 384 / 8; i += NGT) q[i] = z; }
      v4u* kvp = (v4u*)(WSP(bf16, WS_KVB) + (size_t)MTOK * NKV); for (int i = gt; i < 32 * NKV / 8; i += NGT) kvp[i] = z;
      for (int b = 0; b < NB; ++b) { v4u* k = (v4u*)(WSP(bf16, WS_KCMP) + (size_t)(b * 256 + 255) * 512); v4u* v = (v4u*)(WSP(bf16, WS_VCMP) + (size_t)(b * 256 + 255) * 512);
          for (int i = gt; i < 512 / 8; i += NGT) { k[i] = z; v[i] = z; } } }
    { const float* w2 = F.fin(IX_CMP_W2); bf16* W2T = WSP(bf16, WS_W2T);
      for (int i = gt; i < 2 * 128 * 256; i += NGT) { const int k = i & 255, n = (i >> 8) & 127, kv = i >> 15; W2T[i] = (bf16)f2bf(w2[((size_t)kv * 256 + k) * 128 + n]); } }
    __syncthreads();
    for (int item = F.vcu; item < 64; item += F.G) {
        const int ks = item & 7, kv = (item >> 3) & 1, j = (item >> 4) * 64 + lane; const float* pe = F.fin(IX_CMP_PE) + kv * 4096; const float* w1 = cmp_w1 + (size_t)kv * 4096 * 256;
        float a = 0.f; const int kb = ks * 512 + F.wave * 64;
#pragma unroll 8
        for (int k = kb; k < kb + 64; ++k) a = fmaf(pe[k], w1[(size_t)k * 256 + j], a);
        LAS float* red = (LAS float*)F.lds;
        red[F.wave * 64 + lane] = a; __syncthreads();
        if (F.wave == 0) { float t = 0.f; for (int w = 0; w < 8; ++w) t += red[w * 64 + lane]; WSP(float, WS_CBIAS)[(ks * 2 + kv) * 256 + j] = t; }
        __syncthreads();
    }
}

__device__ __forceinline__ void st_bf4(bf16* p, f32x4 v) { v2u w; w.x = cvtpk(v[0], v[1]); w.y = cvtpk(v[2], v[3]); *(v2u*)p = w; }
__device__ __forceinline__ f32x4 silu4(f32x4 v) { return (f32x4){silu_f(v[0]), silu_f(v[1]), silu_f(v[2]), silu_f(v[3])}; }
__device__ __forceinline__ void p2_pool(Frame& F) {
    unsigned char* ws = F.ptr(IX_WS);
    {
        const float* SL = (const float*)(ws + WS_D); bf16* MKV0 = WSP(bf16, WS_MKV);
        const int gt0 = F.vcu * NTHREADS + F.tid(), NGT0 = F.G * NTHREADS;
        for (int i = gt0; i < 2 * 1024 * 1024 / 4; i += NGT0) { const float* s0 = SL + (size_t)(i >> 18) * 8 * 1024 * 1024 + (size_t)(i & 262143) * 4; f32x4 a = *(const f32x4*)s0;
#pragma unroll
            for (int z = 1; z < 8; ++z) a += *(const f32x4*)(s0 + (size_t)z * 1024 * 1024);
            st_bf4(MKV0 + (size_t)i * 4, a); }
    }
    const bf16* PROJ = WSP(bf16, WS_A); bf16* POOLED = WSP(bf16, WS_C);
    const int gt = F.vcu * NTHREADS + F.tid(), NGT = F.G * NTHREADS;
    constexpr int NV = POOLW / 8;
    for (int idx = gt; idx < (MTOK / 32) * NV; idx += NGT) {
        const int vec = idx % NV, chunk = idx / NV, g = vec / 48, win = 2 << g;
        const int row0 = chunk * 32, tb0 = row0 & (SEQ - 1);
        const bf16* up = PROJ + (size_t)row0 * N1 + vec * 8;
        float S[8];
#pragma unroll
        for (int e = 0; e < 8; ++e) S[e] = 0.f;
        for (int i = 1; i < win; ++i) if (tb0 - i >= 0) { const v4u w = *(const v4u*)(up - (size_t)i * N1);
            S[0] += bflo(w.x); S[1] += bfhi(w.x); S[2] += bflo(w.y); S[3] += bfhi(w.y); S[4] += bflo(w.z); S[5] += bfhi(w.z); S[6] += bflo(w.w); S[7] += bfhi(w.w); }
        for (int t = 0; t < 32; ++t) {
            const v4u w = *(const v4u*)(up + (size_t)t * N1);
            float u[8] = {bflo(w.x), bfhi(w.x), bflo(w.y), bfhi(w.y), bflo(w.z), bfhi(w.z), bflo(w.w), bfhi(w.w)};
            const int tb = tb0 + t; const float inv = 1.0f / (float)(tb + 1 < win ? tb + 1 : win);
            float o[8];
#pragma unroll
            for (int e = 0; e < 8; ++e) { S[e] += u[e]; o[e] = S[e] * inv - u[e]; }
            v4u ow; ow.x = pk2(o[0], o[1]); ow.y = pk2(o[2], o[3]); ow.z = pk2(o[4], o[5]); ow.w = pk2(o[6], o[7]);
            *(v4u*)(POOLED + (size_t)(row0 + t) * POOLW + vec * 8) = ow;
            if (tb - win + 1 >= 0) { const v4u x = *(const v4u*)(up + (ptrdiff_t)(t - win + 1) * N1);
                S[0] -= bflo(x.x); S[1] -= bfhi(x.x); S[2] -= bflo(x.y); S[3] -= bfhi(x.y); S[4] -= bflo(x.z); S[5] -= bfhi(x.z); S[6] -= bflo(x.w); S[7] -= bfhi(x.w); }
        }
    }
}

struct SchedLin {
    int nM, nN, nz, G, c, wgm;
    const char* A; const char* B; size_t a_pm, a_z, b_pn, b_z;
    int xM, xN; const char* XA; const char* XB; size_t xa_pm, xb_pn;
    __device__ __forceinline__ bool next(int i, pg8::Unit& u) const {
        const long L = (long)i * G + c; const int per = nM * nN; const long tot = (long)per * nz;
        if (L < tot) { const int z = (int)(L / per); int pm, pn; pg8::tile_swz((int)(L % per), nM, nN, wgm, pm, pn);
            u.pm = pm; u.pn = pn; u.z = z; u.kind = 0; u.a = A + pm * a_pm + z * a_z; u.b = B + pn * b_pn + z * b_z; return true; }
        const long X = L - tot; if (X >= (long)xM * xN) return false;
        u.pm = (int)(X / xN); u.pn = (int)(X % xN); u.z = 0; u.kind = 1; u.a = XA + u.pm * xa_pm; u.b = XB + u.pn * xb_pn; return true;
    }
};
struct SchedCmp {
    int G, c; const char* KV; const char* W;
    __device__ __forceinline__ bool next(int i, pg8::Unit& u) const {
        const int L = i * G + c; if (L >= 256) return false;
        const int pm = L & 15, kv = (L >> 4) & 1, ks = L >> 5, b = pm >> 2, g = pm & 3;
        u.pm = pm; u.pn = 0; u.z = ks * 2 + kv; u.kind = 0;
        u.a = KV + ((size_t)((kv * 4 + b) * 4 + g) * SEQ * 128 + ks * 512) * 2;
        u.b = W + ((size_t)kv * 256 * 4096 + ks * 512) * 2;
        return true;
    }
};

struct SchedMem {
    int G, c; const char* A; const char* B;
    __device__ __forceinline__ bool next(int i, pg8::Unit& u) const {
        const int L = i * G + c; if (L >= 256) return false;
        const int pm = L & 3, pn = (L >> 2) & 3, ks = (L >> 4) & 7, layer = L >> 7;
        u.pm = pm; u.pn = pn; u.z = layer * 8 + ks; u.kind = 0;
        u.a = A + (size_t)pm * 256 * DM * 2 + ks * 512;
        u.b = B + ((size_t)layer * 1024 + pn * 256) * DM * 2 + ks * 512;
        return true;
    }
};
struct SchedGate {
    int G, c; const char* A; const char* B;
    __device__ __forceinline__ bool next(int i, pg8::Unit& u) const {
        const int L = i * G + c; if (L >= 256) return false;
        const int pm = L >> 2, ks = L & 3;
        u.pm = pm; u.pn = 0; u.z = ks; u.kind = 0;
        u.a = A + (size_t)pm * 256 * DM * 2 + ks * 1024;
        u.b = B + ks * 1024;
        return true;
    }
};

#define EPI_ROWS(ai, m) (u.pm * 256 + (ai) * 128 + wr * 64 + (m) * 16 + fr)
#define EPI_COL(bj, n) ((bj) * 128 + wc * 32 + (n) * 16 + fq * 4)
typedef f32x4 acc_t[2][2][4][2];

#define EPI_C8(bj) (64 * wc + 32 * (bj) + 8 * fq)
__device__ __forceinline__ void st_bf8(bf16* p, f32x4 a, f32x4 b) { v4u w; w.x = cvtpk(a[0], a[1]); w.y = cvtpk(a[2], a[3]); w.z = cvtpk(b[0], b[1]); w.w = cvtpk(b[2], b[3]); *(v4u*)p = w; }
struct Epi1 {
    static constexpr bool PERM = true;
    bf16* proj;
    struct State {};
    __device__ __forceinline__ void begin(acc_t& acc, State&, const pg8::Unit&, int, int, int, int) const {
#pragma unroll
        for (int a = 0; a < 2; ++a)
#pragma unroll
            for (int b = 0; b < 2; ++b)
#pragma unroll
                for (int m = 0; m < 4; ++m)
#pragma unroll
                    for (int n = 0; n < 2; ++n) acc[a][b][m][n] = (f32x4){0.f, 0.f, 0.f, 0.f};
    }
    __device__ __forceinline__ void operator()(const acc_t& acc, State&, const pg8::Unit& u, int wr, int wc, int fr, int fq) const {
        const bool act = (u.pn >= 6 && u.pn < 12) || u.pn >= 14;
#pragma unroll
        for (int ai = 0; ai < 2; ++ai)
#pragma unroll
            for (int m = 0; m < 4; ++m) { bf16* rowp = proj + (size_t)EPI_ROWS(ai, m) * N1 + u.pn * 256;
#pragma unroll
                for (int bj = 0; bj < 2; ++bj) { f32x4 v0 = acc[ai][bj][m][0], v1 = acc[ai][bj][m][1]; if (act) { v0 = silu4(v0); v1 = silu4(v1); } st_bf8(rowp + EPI_C8(bj), v0, v1); } }
    }
};
struct Epi3 {
    static constexpr bool PERM = true;
    const float* scale; const bf16* proj; bf16* y0;
    struct State {};
    __device__ __forceinline__ void begin(acc_t& acc, State&, const pg8::Unit&, int, int, int, int) const {
#pragma unroll
        for (int a = 0; a < 2; ++a)
#pragma unroll
            for (int b = 0; b < 2; ++b)
#pragma unroll
                for (int m = 0; m < 4; ++m)
#pragma unroll
                    for (int n = 0; n < 2; ++n) acc[a][b][m][n] = (f32x4){0.f, 0.f, 0.f, 0.f};
    }
    __device__ __forceinline__ void operator()(const acc_t& acc, State&, const pg8::Unit& u, int wr, int wc, int fr, int fq) const {
        const int g = u.z;
#pragma unroll
        for (int ai = 0; ai < 2; ++ai)
#pragma unroll
            for (int m = 0; m < 4; ++m) { const size_t row = EPI_ROWS(ai, m);
#pragma unroll
                for (int bj = 0; bj < 2; ++bj) { const int d = u.pn * 256 + EPI_C8(bj);
                    if (d < 384) {
                        const f32x4 sc0 = *(const f32x4*)(scale + g * 384 + d), sc1 = *(const f32x4*)(scale + g * 384 + d + 4);
                        const v4u zw = *(const v4u*)(proj + row * N1 + POOLW + g * 384 + d);
                        f32x4 v0 = acc[ai][bj][m][0] * sc0, v1 = acc[ai][bj][m][1] * sc1;
                        v0[0] *= bflo(zw.x); v0[1] *= bfhi(zw.x); v0[2] *= bflo(zw.y); v0[3] *= bfhi(zw.y); v1[0] *= bflo(zw.z); v1[1] *= bfhi(zw.z); v1[2] *= bflo(zw.w); v1[3] *= bfhi(zw.w);
                        st_bf8(y0 + row * DM + g * 384 + d, v0, v1); } }
                asm volatile("" ::: "memory"); }
    }
};
template <bool RES_BF16>
struct EpiRes {
    static constexpr bool PERM = true;
    const void* res; bf16* hb; float* ss;
    struct State {};
    __device__ __forceinline__ void begin(acc_t& acc, State&, const pg8::Unit& u, int wr, int wc, int fr, int fq) const {
#pragma unroll
        for (int ai = 0; ai < 2; ++ai)
#pragma unroll
            for (int m = 0; m < 4; ++m) { const size_t row = EPI_ROWS(ai, m);
#pragma unroll
                for (int bj = 0; bj < 2; ++bj) { const size_t off = row * DM + u.pn * 256 + EPI_C8(bj);
                    if constexpr (RES_BF16) { const v4u w = *(const v4u*)((const bf16*)res + off);
                        acc[ai][bj][m][0] = (f32x4){bflo(w.x), bfhi(w.x), bflo(w.y), bfhi(w.y)}; acc[ai][bj][m][1] = (f32x4){bflo(w.z), bfhi(w.z), bflo(w.w), bfhi(w.w)}; }
                    else { acc[ai][bj][m][0] = __builtin_nontemporal_load((const f32x4*)((const float*)res + off)); acc[ai][bj][m][1] = __builtin_nontemporal_load((const f32x4*)((const float*)res + off + 4)); } } }
    }
    __device__ __forceinline__ void operator()(const acc_t& acc, State&, const pg8::Unit& u, int wr, int wc, int fr, int fq) const {
#pragma unroll
        for (int ai = 0; ai < 2; ++ai)
#pragma unroll
            for (int m = 0; m < 4; ++m) { const size_t row = EPI_ROWS(ai, m); float s = 0.f;
#pragma unroll
                for (int bj = 0; bj < 2; ++bj) { const f32x4 h0 = acc[ai][bj][m][0], h1 = acc[ai][bj][m][1];
                    st_bf8(hb + row * DM + u.pn * 256 + EPI_C8(bj), h0, h1);
                    s += (h0[0] * h0[0] + h0[1] * h0[1]) + (h0[2] * h0[2] + h0[3] * h0[3]) + (h1[0] * h1[0] + h1[1] * h1[1]) + (h1[2] * h1[2] + h1[3] * h1[3]); }
                s += __shfl_xor(s, 16); s += __shfl_xor(s, 32);
                if (fq == 0) ss[row * 32 + u.pn * 4 + wc] = s; }
    }
};
struct Epi5 {
    static constexpr bool PERM = true;
    const float* rinv1; bf16 *kv, *q1, *zq, *qm1, *zm1;
    struct State { float rinv[2][4]; };
    __device__ __forceinline__ void begin(acc_t& acc, State& st, const pg8::Unit& u, int wr, int wc, int fr, int fq) const {
#pragma unroll
        for (int a = 0; a < 2; ++a)
#pragma unroll
            for (int b = 0; b < 2; ++b)
#pragma unroll
                for (int m = 0; m < 4; ++m)
#pragma unroll
                    for (int n = 0; n < 2; ++n) acc[a][b][m][n] = (f32x4){0.f, 0.f, 0.f, 0.f};
#pragma unroll
        for (int ai = 0; ai < 2; ++ai)
#pragma unroll
            for (int m = 0; m < 4; ++m) st.rinv[ai][m] = rinv1[EPI_ROWS(ai, m)];
    }
    __device__ __forceinline__ void operator()(const acc_t& acc, State& st, const pg8::Unit& u, int wr, int wc, int fr, int fq) const {
        const int pn = u.pn;
        bf16* base; int ld, c0; bool act = false;
        const bool kvt = pn < 12;
        if (kvt) { base = kv; ld = 128; c0 = 0; }
        else if (pn < 18) { base = q1; ld = NSAW; c0 = (pn - 12) * 256; }
        else if (pn < 24) { base = zq; ld = NSAW; c0 = (pn - 18) * 256; act = true; }
        else if (pn < 26) { base = qm1; ld = MEMW; c0 = (pn - 24) * 256; }
        else { base = zm1; ld = MEMW; c0 = (pn - 26) * 256; act = true; }
#pragma unroll
        for (int ai = 0; ai < 2; ++ai)
#pragma unroll
            for (int m = 0; m < 4; ++m) { const size_t row = EPI_ROWS(ai, m);
                const float rinv = st.rinv[ai][m];
#pragma unroll
                for (int bj = 0; bj < 2; ++bj) {
                    f32x4 v0 = acc[ai][bj][m][0] * rinv, v1 = acc[ai][bj][m][1] * rinv;
                    if (act) { v0 = silu4(v0); v1 = silu4(v1); }
                    if (kvt) { const int g = (pn & 1) * 2 + (wc >> 1), d = 64 * (wc & 1) + 32 * bj + 8 * fq; const size_t b = row >> 12, t = row & (SEQ - 1);
                        st_bf8(kv + ((((size_t)(pn >> 1) * 4 + b) * 4 + g) * SEQ + t) * 128 + d, v0, v1); }
                    else st_bf8(base + row * ld + c0 + EPI_C8(bj), v0, v1); } }
    }
};
struct Epi6 {
    static constexpr bool PERM = false;
    float* base; int ld; size_t plane;
    struct State {};
    __device__ __forceinline__ void begin(acc_t& acc, State&, const pg8::Unit&, int, int, int, int) const {
#pragma unroll
        for (int a = 0; a < 2; ++a)
#pragma unroll
            for (int b = 0; b < 2; ++b)
#pragma unroll
                for (int m = 0; m < 4; ++m)
#pragma unroll
                    for (int n = 0; n < 2; ++n) acc[a][b][m][n] = (f32x4){0.f, 0.f, 0.f, 0.f};
    }
    __device__ __forceinline__ void operator()(const acc_t& acc, State&, const pg8::Unit& u, int wr, int wc, int fr, int fq) const {
        float* b0 = base + (size_t)u.z * plane + u.pn * 256;
#pragma unroll
        for (int ai = 0; ai < 2; ++ai)
#pragma unroll
            for (int m = 0; m < 4; ++m) { float* rowp = b0 + (size_t)EPI_ROWS(ai, m) * ld;
#pragma unroll
                for (int bj = 0; bj < 2; ++bj)
#pragma unroll
                    for (int n = 0; n < 2; ++n) *(f32x4*)(rowp + EPI_COL(bj, n)) = acc[ai][bj][m][n]; }
    }
};
struct EpiG {
    static constexpr bool PERM = true;
    float* slab;
    struct State {};
    __device__ __forceinline__ void begin(acc_t& acc, State&, const pg8::Unit&, int, int, int, int) const {
#pragma unroll
        for (int a = 0; a < 2; ++a)
#pragma unroll
            for (int b = 0; b < 2; ++b)
#pragma unroll
                for (int m = 0; m < 4; ++m)
#pragma unroll
                    for (int n = 0; n < 2; ++n) acc[a][b][m][n] = (f32x4){0.f, 0.f, 0.f, 0.f};
    }
    __device__ __forceinline__ void operator()(const acc_t& acc, State&, const pg8::Unit& u, int wr, int wc, int fr, int fq) const {
        if (wc != 0) return;
        float* b0 = slab + (size_t)u.z * MTOK * 36;
#pragma unroll
        for (int ai = 0; ai < 2; ++ai)
#pragma unroll
            for (int m = 0; m < 4; ++m) { float* rowp = b0 + (size_t)EPI_ROWS(ai, m) * 36;
                *(f32x4*)(rowp + 8 * fq) = acc[ai][0][m][0]; *(f32x4*)(rowp + 8 * fq + 4) = acc[ai][0][m][1];
                if (fq == 0) *(f32x4*)(rowp + 32) = acc[ai][1][m][0]; }
    }
};

__device__ __forceinline__ void rinv_pass(Frame& F) {
    unsigned char* ws = F.ptr(IX_WS); const float* SS1 = WSP(float, WS_SS1); float* RINV = WSP(float, WS_RINV1);
    const int gt = F.vcu * NTHREADS + F.tid(), NGT = F.G * NTHREADS;
    for (int i = gt; i < MTOK * 4; i += NGT) { const int row = i >> 2, q = i & 3;
        const f32x4 a = *(const f32x4*)(SS1 + (size_t)row * 32 + q * 8), b = *(const f32x4*)(SS1 + (size_t)row * 32 + q * 8 + 4);
        float s = ((a[0] + a[1]) + (a[2] + a[3])) + ((b[0] + b[1]) + (b[2] + b[3]));
        s += __shfl_xor(s, 1); s += __shfl_xor(s, 2);
        if (q == 0) RINV[row] = 1.0f / sqrtf(s * (1.f / DM) + EPS); }
}
__device__ __forceinline__ void gates_finish(Frame& F) {
    unsigned char* ws = F.ptr(IX_WS); const float* SL = WSP(float, WS_C); const float* RINV = WSP(float, WS_RINV1); float* GATES = WSP(float, WS_GATES);
    const int gt = F.vcu * NTHREADS + F.tid(), NGT = F.G * NTHREADS;
    for (int i = gt; i < MTOK * 9; i += NGT) { const int row = i / 9, c4 = (i - row * 9) * 4;
        const float rinv = RINV[row];
        f32x4 a = *(const f32x4*)(SL + (size_t)row * 36 + c4);
#pragma unroll
        for (int z = 1; z < 4; ++z) a += *(const f32x4*)(SL + (size_t)z * MTOK * 36 + (size_t)row * 36 + c4);
        a = a * rinv;
        *(f32x4*)(GATES + (size_t)row * 36 + c4) = (f32x4){sigmoid_f(a[0]), sigmoid_f(a[1]), sigmoid_f(a[2]), sigmoid_f(a[3])}; }
}
__device__ __forceinline__ void rope_pass(Frame& F) {
    unsigned char* ws = F.ptr(IX_WS); bf16* Q1 = WSP(bf16, WS_Q1); bf16* KV = WSP(bf16, WS_KVB); const float* ROPE = WSP(float, WS_ROPE);
    const int gt = F.vcu * NTHREADS + F.tid(), NGT = F.G * NTHREADS;
    constexpr int NQI = MTOK * NHEAD * 2, NKI = 2 * MTOK * NKVH * 2, NI = NQI + NKI;
    for (int i0 = gt; i0 < NI; i0 += 5 * NGT) {
        bf16* pp[5]; v4u x1[5], x2[5]; f32x4 c0[5], c1[5], s0[5], s1[5];
#pragma unroll
        for (int e = 0; e < 5; ++e) { const int i = i0 + e * NGT; pp[e] = nullptr;
            if (i < NI) { const int q = i & 1; int row; bf16* p;
                if (i < NQI) { const int rh = i >> 1; row = rh / NHEAD; p = Q1 + (size_t)row * NSAW + (rh - row * NHEAD) * 128; }
                else { const int k = (i - NQI) >> 1, t = k & (SEQ - 1), sg = k >> 12, kind = 2 + 2 * (sg >> 4), bg = sg & 15;
                    row = (bg >> 2) * SEQ + t; p = KV + (((size_t)kind * 16 + bg) * SEQ + t) * 128; }
                p += 8 * q; pp[e] = p; const float* rp = ROPE + (size_t)row * 32 + 8 * q;
                x1[e] = *(const v4u*)p; x2[e] = *(const v4u*)(p + 16);
                c0[e] = *(const f32x4*)rp; c1[e] = *(const f32x4*)(rp + 4); s0[e] = *(const f32x4*)(rp + 16); s1[e] = *(const f32x4*)(rp + 20); } }
#pragma unroll
        for (int e = 0; e < 5; ++e) if (pp[e]) {
            const f32x4 a0 = {bflo(x1[e].x), bfhi(x1[e].x), bflo(x1[e].y), bfhi(x1[e].y)}, a1 = {bflo(x1[e].z), bfhi(x1[e].z), bflo(x1[e].w), bfhi(x1[e].w)};
            const f32x4 b0 = {bflo(x2[e].x), bfhi(x2[e].x), bflo(x2[e].y), bfhi(x2[e].y)}, b1 = {bflo(x2[e].z), bfhi(x2[e].z), bflo(x2[e].w), bfhi(x2[e].w)};
            st_bf8(pp[e], a0 * c0[e] - b0 * s0[e], a1 * c1[e] - b1 * s1[e]);
            st_bf8(pp[e] + 16, b0 * c0[e] + a0 * s0[e], b1 * c1[e] + a1 * s1[e]); }
    }
}
__device__ __forceinline__ void p7_cmp2(Frame& F) {
    unsigned char* ws = F.ptr(IX_WS); bf16* KCo = WSP(bf16, WS_KCMP); bf16* VCo = WSP(bf16, WS_VCMP);
    const float* HID = WSP(float, WS_B); const float* CB = WSP(float, WS_CBIAS); const float* ROPEC = WSP(float, WS_ROPEC); const bf16* W2T = WSP(bf16, WS_W2T);
    constexpr int HP = 528;
    LAS unsigned char* hb = F.lds;
    LAS float* os = (LAS float*)(F.lds + 32 * HP);
    for (int unit = F.vcu; unit < 256; unit += F.G) {
        const int tid = F.tid(), lane = tid & 63, wv = __builtin_amdgcn_readfirstlane(tid >> 6), fr = lane & 15, fq = lane >> 4;
        const int kv = unit >> 7, row0 = (unit & 127) * 32;
        {
            const int r = tid >> 4, c16 = (tid & 15) * 16;
            f32x4 a[4] = {{0.f, 0.f, 0.f, 0.f}, {0.f, 0.f, 0.f, 0.f}, {0.f, 0.f, 0.f, 0.f}, {0.f, 0.f, 0.f, 0.f}};
#pragma unroll
            for (int ks = 0; ks < 8; ++ks) { const float* pp = HID + ((size_t)(ks * 2 + kv) * 4096 + row0 + r) * 256 + c16;
#pragma unroll
                for (int e = 0; e < 4; ++e) a[e] += *(const f32x4*)(pp + 4 * e); }
#pragma unroll
            for (int ks = 0; ks < 8; ++ks) { const float* cb = CB + (ks * 2 + kv) * 256 + c16;
#pragma unroll
                for (int e = 0; e < 4; ++e) a[e] += *(const f32x4*)(cb + 4 * e); }
            v4u w0, w1;
            w0.x = cvtpk(silu_f(a[0][0]), silu_f(a[0][1])); w0.y = cvtpk(silu_f(a[0][2]), silu_f(a[0][3])); w0.z = cvtpk(silu_f(a[1][0]), silu_f(a[1][1])); w0.w = cvtpk(silu_f(a[1][2]), silu_f(a[1][3]));
            w1.x = cvtpk(silu_f(a[2][0]), silu_f(a[2][1])); w1.y = cvtpk(silu_f(a[2][2]), silu_f(a[2][3])); w1.z = cvtpk(silu_f(a[3][0]), silu_f(a[3][1])); w1.w = cvtpk(silu_f(a[3][2]), silu_f(a[3][3]));
            *(LAS v4u*)(hb + r * HP + c16 * 2) = w0; *(LAS v4u*)(hb + r * HP + c16 * 2 + 16) = w1;
        }
        bf16x8 bfr[8];
        { const bf16* wrow = W2T + ((size_t)kv * 128 + 16 * wv + fr) * 256 + 8 * fq;
#pragma unroll
          for (int ks = 0; ks < 8; ++ks) bfr[ks] = *(const bf16x8*)(wrow + 32 * ks); }
        __syncthreads();
        {
            f32x4 d0 = {0.f, 0.f, 0.f, 0.f}, d1 = {0.f, 0.f, 0.f, 0.f};
#pragma unroll
            for (int ks = 0; ks < 8; ++ks) {
                const bf16x8 a0 = *(const LAS bf16x8*)(hb + fr * HP + (32 * ks + 8 * fq) * 2), a1 = *(const LAS bf16x8*)(hb + (16 + fr) * HP + (32 * ks + 8 * fq) * 2);
                d0 = __builtin_amdgcn_mfma_f32_16x16x32_bf16(a0, bfr[ks], d0, 0, 0, 0);
                d1 = __builtin_amdgcn_mfma_f32_16x16x32_bf16(a1, bfr[ks], d1, 0, 0, 0); }
#pragma unroll
            for (int j = 0; j < 4; ++j) { os[(4 * fq + j) * 128 + 16 * wv + fr] = d0[j]; os[(16 + 4 * fq + j) * 128 + 16 * wv + fr] = d1[j]; }
        }
        __syncthreads();
        {
            const int r = tid >> 4, d8 = (tid & 15) * 8;
            const int row = row0 + r, bg = row >> 8, n = row & 255, b = bg >> 2, g = bg & 3;
            if (n < NCMP) {
                float o[8];
#pragma unroll
                for (int e = 0; e < 8; ++e) { const int d = d8 + e; float v = os[r * 128 + d];
                    if (kv == 0 && d8 < 32) { const int fi = d & 15; const float c = ROPEC[(b * 256 + n) * 32 + fi], s = ROPEC[(b * 256 + n) * 32 + 16 + fi];
                        v = d8 < 16 ? v * c - os[r * 128 + d + 16] * s : v * c + os[r * 128 + d - 16] * s; }
                    o[e] = v; }
                bf16* dst = (kv == 0 ? KCo : VCo) + (size_t)(b * 256 + n) * 512 + g * 128 + d8;
                v4u w; w.x = pk2(o[0], o[1]); w.y = pk2(o[2], o[3]); w.z = pk2(o[4], o[5]); w.w = pk2(o[6], o[7]); *(v4u*)dst = w;
            }
        }
        __syncthreads();
    }
}

__device__ __forceinline__ void p8_select(Frame& F) {
    using namespace att;
    char* lds = F.ldsg; unsigned char* ws = F.ptr(IX_WS);
    const bf16* KC = WSP(bf16, WS_KCMP); const bf16* Q1 = WSP(bf16, WS_Q1); unsigned long long* SEL = WSP(unsigned long long, WS_SEL);
    const int wid = F.wave;
    for (int unit = F.vcu; unit < NB * NKVH * 16; unit += F.G) {
        const int tid = F.tid(), lane = tid & 63, r32 = lane & 31, hi = lane >> 5;
        const int sr = tid >> 4, sc = (tid & 15) * 8;
        const int qt = unit & 15, g = (unit >> 4) & 3, b = unit >> 6;
#pragma unroll
        for (int tt = 0; tt < 4; ++tt)
#pragma unroll
            for (int hf = 0; hf < 2; ++hf) { const int key = tt * 64 + hf * 32 + sr;
                *(bf16x8*)(lds + tt * SHM_K + KSWZ(hf * 32 + sr, sc * 2)) = load8(KC + (size_t)(b * 256 + key) * 512 + g * 128 + sc); }
        __syncthreads();
        const int tw = ((wid < 4) ? qt : 31 - qt) * 128 + (wid & 3) * 32, t = tw + r32, lim = (t - 31) >> 4;
        const int limw = tw >> 4;
        float imp[32];
#pragma unroll
        for (int c = 0; c < 32; ++c) imp[c] = 0.f;
        for (int rr = 0; rr < 3; ++rr) {
            const int h = g * 3 + rr; bf16x8 qr[8];
#pragma unroll
            for (int d0 = 0; d0 < 8; ++d0) qr[d0] = load8(Q1 + (size_t)(b * SEQ + t) * NSAW + h * 128 + d0 * 16 + hi * 8);
            f32x16 s[8];
            SBAR(); qkt<0>(s[0], s[1], lds, r32, hi, qr); SBAR();
            if (limw >= 64) { qkt<1>(s[2], s[3], lds, r32, hi, qr); SBAR(); }
            if (limw >= 128) { qkt<2>(s[4], s[5], lds, r32, hi, qr); SBAR(); }
            if (limw >= 192) { qkt<3>(s[6], s[7], lds, r32, hi, qr); SBAR(); }
            constexpr float C2 = LOG2E * ATT_SCALE; const float NEG = -__builtin_inff();
            float mx = -1e30f;
            int lim2 = lim - 4 * hi; asm volatile("" : "+v"(lim2));
#pragma unroll
            for (int i = 0; i < 8; ++i) if (limw >= (i >> 1) * 64) {
#pragma unroll
                for (int r = 0; r < 16; ++r) { const int key0 = (i >> 1) * 64 + (i & 1) * 32 + (r & 3) + 8 * (r >> 2); const float v = key0 <= lim2 ? s[i][r] * C2 : NEG; s[i][r] = v; mx = fmaxf(mx, v); } }
            { auto q2 = __builtin_amdgcn_permlane32_swap(__float_as_uint(mx), __float_as_uint(mx), false, false); mx = fmaxf(__uint_as_float(q2[0]), __uint_as_float(q2[1])); }
            float sum = 0.f;
#pragma unroll
            for (int i = 0; i < 8; ++i) {
                if (limw >= (i >> 1) * 64) {
#pragma unroll
                    for (int r = 0; r < 16; ++r) { const float p = __builtin_amdgcn_exp2f(s[i][r] - mx); s[i][r] = p; sum += p; }
                } else {
#pragma unroll
                    for (int r = 0; r < 16; ++r) s[i][r] = 0.f; } }
            { auto q2 = __builtin_amdgcn_permlane32_swap(__float_as_uint(sum), __float_as_uint(sum), false, false); sum = __uint_as_float(q2[0]) + __uint_as_float(q2[1]); }
            const float inv = sum > 0.f ? 1.0f / sum : 0.f;
            float prev_pt = 0.f;
#pragma unroll
            for (int c = 0; c < 32; ++c) { const int i = c >> 2, a = c & 3; const float tl = 0.5f * s[i][4 * a + 3] * inv;
                auto q2 = __builtin_amdgcn_permlane32_swap(__float_as_uint(tl), __float_as_uint(tl), false, false);
                const float pt = __uint_as_float(hi ? q2[0] : q2[1]);
                imp[c] += (s[i][4 * a] + s[i][4 * a + 1] + s[i][4 * a + 2]) * inv + tl + (hi ? pt : prev_pt);
                prev_pt = pt; }
        }
        const int cur = t >> 6;
        int hi2 = hi; asm volatile("" : "+v"(hi2));
        unsigned key[32];
#pragma unroll
        for (int c = 0; c < 32; ++c) { const int j = 2 * c + hi2; const bool ok = j <= cur, forced = (j == 0) || (j == cur) || (j == cur - 1);
            const float sc_ = forced ? 1e4f : imp[c];
            key[c] = (ok ? (__float_as_uint(sc_) & ~63u) : 0u) | (unsigned)(63 - j); }
        unsigned T = 0u;
#pragma unroll 1
        for (int bit = 30; bit >= 0; --bit) { const unsigned Tc = T | (1u << bit); unsigned cn = 0u;
#pragma unroll
            for (int c = 0; c < 32; ++c) cn += (key[c] >= Tc) ? 1u : 0u;
            { auto q2 = __builtin_amdgcn_permlane32_swap(cn, cn, false, false); cn = q2[0] + q2[1]; }
            T = cn >= 16u ? Tc : T; }
        unsigned wlo = 0u, whi = 0u;
#pragma unroll
        for (int c = 0; c < 32; ++c) { const unsigned selbit = (key[c] >= T && (2 * c + hi2) <= cur) ? 1u : 0u;
            if (c < 16) wlo |= selbit << (2 * c); else whi |= selbit << (2 * (c - 16)); }
        wlo <<= hi; whi <<= hi;
        { auto q2 = __builtin_amdgcn_permlane32_swap(wlo, wlo, false, false); wlo = q2[0] | q2[1]; }
        { auto q2 = __builtin_amdgcn_permlane32_swap(whi, whi, false, false); whi = q2[0] | q2[1]; }
        if (hi == 0) SEL[(size_t)(b * NKVH + g) * SEQ + t] = ((unsigned long long)whi << 32) | wlo;
        __syncthreads();
    }
}

typedef att::Ctx AttnCtx;
__device__ __forceinline__ void nsa_blk(const AttnCtx& C, int L, int pass, att::Blk& k) {
    const int qt = 15 - L / 48, bh = L % 48, b = bh / 12, h = bh % 12, g = h / 3;
    const int row0 = b * SEQ + qt * 256;
    k.Q = C.Q1 + (size_t)row0 * NSAW + h * 128; k.ldq = NSAW; k.t0 = qt * 256; k.row0 = row0; k.hcol = h * 128; k.bg = b * NKVH + g;
    if (pass == 0) { k.K = C.KV + (size_t)((2 * 4 + b) * 4 + g) * SEQ * 128; k.voff = 16 * SEQ * 128; k.ldk = 128; k.j_lo = 0; k.j_hi = 4 * qt + 4; k.mode = att::MODE_SEL; k.epi = att::EPI_ACC0; k.gcol = h * 3 + 1; }
    else if (pass == 1) { k.K = C.KV + (size_t)((4 * 4 + b) * 4 + g) * SEQ * 128; k.voff = 16 * SEQ * 128; k.ldk = 128; k.j_lo = qt >= 2 ? 4 * qt - 8 : 0; k.j_hi = 4 * qt + 4; k.mode = att::MODE_WIN; k.epi = att::EPI_ACC1; k.gcol = h * 3 + 2; }
    else { k.K = C.KC + (size_t)b * 256 * 512 + g * 128; k.voff = (int)(C.VC - C.KC); k.ldk = 512; k.j_lo = 0; k.j_hi = (qt >> 2) + 1; k.mode = att::MODE_CMP; k.epi = att::EPI_FIN; k.gcol = h * 3 + 0; }
}
__device__ __forceinline__ void mem_blk(const AttnCtx& C, int X, att::Blk& k) {
    const int qt = X & 15, mh = (X >> 4) & 3, b = X >> 6;
    const int row0 = b * SEQ + qt * 256;
    k.Q = C.QM + (size_t)row0 * C.qm_ld + C.qm_c0 + mh * 128; k.ldq = C.qm_ld; k.t0 = qt * 256; k.row0 = row0; k.hcol = mh * 128; k.bg = 0; k.gcol = 0;
    k.K = C.MKV + (size_t)b * 256 * 1024 + mh * 128; k.voff = 512; k.ldk = 1024; k.j_lo = 0; k.j_hi = 4; k.mode = att::MODE_NONE; k.epi = att::EPI_MEM;
}
struct AttnStream {
    int G, c, n_nsa, n_mem, cnt_nsa, total; bool tab;
    __device__ __forceinline__ void init(int G_, int c_, int n_nsa_, int n_mem_) {
        G = G_; c = c_; n_nsa = n_nsa_; n_mem = n_mem_;
        tab = (G == 256 && n_nsa == 768);
        if (tab) { cnt_nsa = 0;
#pragma unroll
            for (int r = 0; r < 4; ++r) cnt_nsa += NSA_TAB[c * 4 + r] != 0xffff ? 1 : 0; }
        else { const int full = n_nsa / G, rem = n_nsa - full * G, pos = (full & 1) ? G - 1 - c : c; cnt_nsa = full + (pos < rem ? 1 : 0); }
        const int cnt_mem = c < n_mem ? (n_mem - c + G - 1) / G : 0;
        total = 3 * cnt_nsa + cnt_mem;
    }
    __device__ __forceinline__ void get(const AttnCtx& C, int s, att::Blk& k) const {
        if (s < 3 * cnt_nsa) { const int r = s / 3, pass = s - 3 * r; const int L = tab ? (int)NSA_TAB[c * 4 + r] : r * G + ((r & 1) ? G - 1 - c : c); nsa_blk(C, L, pass, k); }
        else { const int sm = s - 3 * cnt_nsa; mem_blk(C, sm * G + c, k); }
    }
};
__device__ __forceinline__ void attn_run(Frame& F, const AttnCtx& C, int n_nsa, int n_mem) {
    AttnStream S; S.init(F.G, F.vcu, n_nsa, n_mem);
    if (S.total > 0) {
        att::Blk cur, nxt; att::Seam seam;
        S.get(C, 0, cur);
        att::attn_prime(F.tid(), cur, F.ldsg, seam);
        for (int s = 0; s < S.total; ++s) {
            const int tid = F.tid();
            S.get(C, s, cur);
            S.get(C, s + 1 < S.total ? s + 1 : s, nxt);
            att::attn_block(tid, C, cur, nxt.Q, nxt.K, nxt.voff, nxt.ldq, nxt.ldk, nxt.j_lo, F.ldsg, seam);
        }
    }
    VM_WAIT(); __syncthreads();
}
__device__ __forceinline__ void attn_run_mem(Frame& F, const AttnCtx& C, int n_mem) {
    const int G = F.G, c = F.vcu, cnt = c < n_mem ? (n_mem - c + G - 1) / G : 0;
    if (cnt > 0) {
        att::Blk cur, nxt; att::Seam seam;
        mem_blk(C, c, cur);
        const int tid = F.tid();
        att::attn_prime(tid, cur, F.ldsg, seam);
        for (int s = 0; s < cnt; ++s) {
            mem_blk(C, s * G + c, cur);
            mem_blk(C, (s + 1 < cnt ? s + 1 : s) * G + c, nxt);
            att::attn_block(tid, C, cur, nxt.Q, nxt.K, nxt.voff, nxt.ldq, nxt.ldk, nxt.j_lo, F.ldsg, seam);
        }
    }
    VM_WAIT(); __syncthreads();
}

__device__ __forceinline__ void p11_final(Frame& F) {
    unsigned char* ws = F.ptr(IX_WS); float* out = (float*)F.ptr(IX_OUT); const float* final_g = F.fin(IX_FINAL_G);
    const float* SS2 = WSP(float, WS_SS2); const bf16* H2B = WSP(bf16, WS_C);
    const int gw = F.vcu * NWAVES + F.wave, NGW = F.G * NWAVES, lane = F.tid() & 63;
    f32x4 g[8];
#pragma unroll
    for (int j = 0; j < 8; ++j) g[j] = ((const f32x4*)final_g)[64 * j + lane];
    for (int m = gw; m < MTOK; m += 4 * NGW) {
        v2u a[4][8]; float rv[4];
#pragma unroll
        for (int q = 0; q < 4; ++q) { const int mm = m + q * NGW < MTOK ? m + q * NGW : m; const v2u* p = (const v2u*)(H2B + (size_t)mm * DM) + lane;
#pragma unroll
            for (int j = 0; j < 8; ++j) a[q][j] = __builtin_nontemporal_load(p + 64 * j);
            rv[q] = lane < 32 ? SS2[(size_t)mm * 32 + lane] : 0.f; }
#pragma unroll
        for (int q = 0; q < 4; ++q) { const int mm = m + q * NGW; if (mm < MTOK) {
            const float rinv = 1.0f / sqrtf(wave_sum(rv[q]) * (1.f / DM) + EPS);
            f32x4* o = (f32x4*)(out + (size_t)mm * DM) + lane;
#pragma unroll
            for (int j = 0; j < 8; ++j) __builtin_nontemporal_store((f32x4){bflo(a[q][j].x), bfhi(a[q][j].x), bflo(a[q][j].y), bfhi(a[q][j].y)} * rinv * g[j], o + 64 * j); } }
    }
}

#ifndef WGM_P1
#define WGM_P1 4
#endif
#ifndef WGM_P3
#define WGM_P3 4
#endif
#ifndef WGM_P4
#define WGM_P4 2
#endif
#ifndef WGM_P5
#define WGM_P5 2
#endif
#ifndef WGM_P10
#define WGM_P10 2
#endif
__global__ void __launch_bounds__(NTHREADS, 2) fwd_kernel(Args args) {
    extern __shared__ __attribute__((aligned(16))) unsigned char lds[];
    Frame F;
    F.lds = (LAS unsigned char*)lds; F.ldsg = (char*)lds;
    F.wave = __builtin_amdgcn_readfirstlane((int)threadIdx.x >> 6);
    F.G = gridDim.x; { const int bx = blockIdx.x; F.vcu = (F.G % 8 == 0) ? (bx % 8) * (F.G / 8) + bx / 8 : bx; }
    if (threadIdx.x < 19) { const unsigned long long v = threadIdx.x < 17 ? (unsigned long long)args.in[threadIdx.x < 17 ? threadIdx.x : 0] : (threadIdx.x == 17 ? (unsigned long long)args.out : (unsigned long long)args.ws);
        ((LAS unsigned long long*)(F.lds + TAB_OFF))[threadIdx.x] = v; }
    if (threadIdx.x == 32) { ((LAS unsigned*)(F.lds + MISC_OFF))[0] = 0u; ((LAS unsigned*)(F.lds + MISC_OFF))[1] = 0u; }
    if (!MK_PER_PHASE && threadIdx.x == 0) (void)xb_add((unsigned*)(args.ws + WS_CTL) + 1024 + XB_XCNT(xb_xcc_id()), 1u);
    __syncthreads();
    const int lo = args.ph_lo, hi = args.ph_hi;
#ifndef PH_MASK
#define PH_MASK 0xfff
#endif
#define IN(k) (((PH_MASK >> (k)) & 1) && lo <= (k) && (k) < hi)
#ifndef REPEAT_MASK
#define REPEAT_MASK 0
#endif
#define REPS(k) (1 + ((REPEAT_MASK >> (k)) & 1))
#define GBAR() xcd_barrier((unsigned*)(F.ptr(IX_WS) + WS_CTL) + 1024, (volatile LAS unsigned*)(F.lds + MISC_OFF), (unsigned)F.G, F.tid())
#define SEAM(k) do { if (IN(k) && IN((k) + 1)) xcd_barrier((unsigned*)(F.ptr(IX_WS) + WS_CTL) + 1024, (volatile LAS unsigned*)(F.lds + MISC_OFF), (unsigned)F.G, F.tid()); } while (0)
#ifdef CLKPROBE_A
#define PROBE_T(k, slot) do { if ((k) == ((slot) ? CLKPROBE_B : CLKPROBE_A) && blockIdx.x == 0 && F.tid() == 0) { volatile unsigned long long* pr_ = (volatile unsigned long long*)(F.ptr(IX_WS) + WS_CTL + 32768); pr_[(slot)] = __builtin_amdgcn_s_memrealtime(); pr_[2 + (slot)] = __builtin_amdgcn_s_memtime(); } } while (0)
#else
#define PROBE_T(k, slot) do { } while (0)
#endif
    const size_t TILE_B = (size_t)256 * DM * 2;

    PROBE_T(0, 0);
    if (IN(0)) for (int rep = 0; rep < REPS(0); ++rep) { if (rep) GBAR(); p0_prologue(F); } PROBE_T(0, 1); SEAM(0);
#ifdef DUP0
    GBAR(); p0_prologue(F); GBAR();
#endif

    PROBE_T(1, 0);
    if (IN(1)) for (int rep = 0; rep < REPS(1); ++rep) { if (rep) GBAR(); unsigned char* ws = F.ptr(IX_WS);
        pg8::Geo g{DM, DM, DM / 64, 256};
        SchedLin S{64, 16, 1, F.G, (int)blockIdx.x, WGM_P1, (const char*)WSP(bf16, WS_B), (const char*)WSP(bf16, WS_W1T), TILE_B, 0, TILE_B, 0, 0, 0, nullptr, nullptr, 0, 0};
        Epi1 E{WSP(bf16, WS_A)};
        pg8::gemm_phase<Epi1, SchedLin, true, true>(F.lds, F.tid(), g, S, E);
        {
            pg8::Geo g2{DM, DM, 4, 256};
            SchedMem S2{F.G, (int)blockIdx.x, (const char*)WSP(bf16, WS_MEMN), (const char*)WSP(bf16, WS_WMT)};
            Epi6 E2{(float*)(ws + WS_D), 1024, (size_t)1024 * 1024};
            pg8::gemm_phase<Epi6, SchedMem, true, true>(F.lds, F.tid(), g2, S2, E2);
        }
    } PROBE_T(1, 1); SEAM(1);

#ifdef DUPBAR
    for (int i = 0; i < 10; ++i) GBAR();
#endif
    PROBE_T(2, 0);
    if (IN(2)) for (int rep = 0; rep < REPS(2); ++rep) { if (rep) GBAR(); p2_pool(F); } PROBE_T(2, 1); SEAM(2);

    PROBE_T(3, 0);
    if (IN(3)) for (int rep = 0; rep < REPS(3); ++rep) { if (rep) GBAR(); unsigned char* ws = F.ptr(IX_WS);
        pg8::Geo g{POOLW, 384, 6, 256};
        SchedLin S{64, 2, 4, F.G, (int)blockIdx.x, WGM_P3, (const char*)WSP(bf16, WS_C), (const char*)WSP(bf16, WS_WPT), (size_t)256 * POOLW * 2, (size_t)384 * 2, (size_t)256 * 384 * 2, (size_t)512 * 384 * 2,
                   0, 0, nullptr, nullptr, 0, 0};
        Epi3 E{F.fin(IX_A_POOL_SCALE), WSP(bf16, WS_A), WSP(bf16, WS_B)};
        pg8::gemm_phase<Epi3, SchedLin, true, true>(F.lds, F.tid(), g, S, E);
#ifdef DUP3G
        GBAR(); pg8::gemm_phase<Epi3, SchedLin, true, true>(F.lds, F.tid(), g, S, E);
#endif
        AttnCtx C{}; C.QM = WSP(bf16, WS_A); C.qm_ld = N1; C.qm_c0 = 2 * POOLW; C.ZM = WSP(bf16, WS_A); C.zm_ld = N1; C.zm_c0 = 2 * POOLW + MEMW;
        C.MKV = WSP(bf16, WS_MKV); C.Y = WSP(bf16, WS_B);
#ifndef NO_ATT3
        attn_run_mem(F, C, NB * 4 * 16);
#ifdef DUP3A
        GBAR(); attn_run_mem(F, C, NB * 4 * 16);
#endif
#endif
    } PROBE_T(3, 1); SEAM(3);

    PROBE_T(4, 0);
    if (IN(4)) for (int rep = 0; rep < REPS(4); ++rep) { if (rep) GBAR(); unsigned char* ws = F.ptr(IX_WS);
        pg8::Geo g{DM, DM, DM / 64, 256};
        SchedLin S{64, 8, 1, F.G, (int)blockIdx.x, WGM_P4, (const char*)WSP(bf16, WS_B), (const char*)WSP(bf16, WS_WO0T), TILE_B, 0, TILE_B, 0, 0, 0, nullptr, nullptr, 0, 0};
        bf16* h1b = (bf16*)F.ptr(IX_OUT);
        EpiRes<false> E{F.fin(IX_X), h1b, WSP(float, WS_SS1)};
        pg8::gemm_phase<EpiRes<false>, SchedLin, true, true>(F.lds, F.tid(), g, S, E);
    } PROBE_T(4, 1); SEAM(4);

    PROBE_T(5, 0);
    if (IN(5)) for (int rep = 0; rep < REPS(5); ++rep) { if (rep) GBAR(); unsigned char* ws = F.ptr(IX_WS);
        rinv_pass(F); GBAR();
        pg8::Geo g{DM, DM, DM / 64, 256};
        SchedLin S{64, 28, 1, F.G, (int)blockIdx.x, WGM_P5, (const char*)F.ptr(IX_OUT), (const char*)WSP(bf16, WS_W4T), TILE_B, 0, TILE_B, 0, 0, 0, nullptr, nullptr, 0, 0};
        Epi5 E{WSP(float, WS_RINV1), WSP(bf16, WS_KVB), WSP(bf16, WS_Q1), WSP(bf16, WS_ZQ), WSP(bf16, WS_QM1), WSP(bf16, WS_ZM1)};
        pg8::gemm_phase<Epi5, SchedLin, true, true>(F.lds, F.tid(), g, S, E);
        {
            pg8::Geo g2{DM, DM, 8, 256};
            SchedGate S2{F.G, (int)blockIdx.x, (const char*)F.ptr(IX_OUT), (const char*)(WSP(bf16, WS_W4T) + (size_t)28 * 256 * DM)};
            EpiG E2{WSP(float, WS_C)};
            pg8::gemm_phase<EpiG, SchedGate, true, true>(F.lds, F.tid(), g2, S2, E2);
        }
    } PROBE_T(5, 1); SEAM(5);

    PROBE_T(6, 0);
    if (IN(6)) for (int rep = 0; rep < REPS(6); ++rep) { if (rep) GBAR(); unsigned char* ws = F.ptr(IX_WS);
        pg8::Geo g{16 * 128, 4096, 8, 256};
        SchedCmp S{F.G, (int)blockIdx.x, (const char*)WSP(bf16, WS_KVB), (const char*)WSP(bf16, WS_WC1T)};
        Epi6 E{WSP(float, WS_B), 256, (size_t)4096 * 256};
        pg8::gemm_phase<Epi6, SchedCmp, true, true>(F.lds, F.tid(), g, S, E);
        gates_finish(F); rope_pass(F);
    } PROBE_T(6, 1); SEAM(6);

    PROBE_T(7, 0);
    if (IN(7)) for (int rep = 0; rep < REPS(7); ++rep) { if (rep) GBAR(); p7_cmp2(F); } PROBE_T(7, 1); SEAM(7);

    PROBE_T(8, 0);
    if (IN(8)) for (int rep = 0; rep < REPS(8); ++rep) { if (rep) GBAR(); p8_select(F); } PROBE_T(8, 1);
#ifdef DUP8
    GBAR(); p8_select(F);
#endif
    SEAM(8);

    PROBE_T(9, 0);
    if (IN(9)) for (int rep = 0; rep < REPS(9); ++rep) { if (rep) GBAR(); unsigned char* ws = F.ptr(IX_WS);
        AttnCtx C{}; C.KV = WSP(bf16, WS_KVB); C.KC = WSP(bf16, WS_KCMP); C.VC = WSP(bf16, WS_VCMP); C.Q1 = WSP(bf16, WS_Q1); C.ZQ = WSP(bf16, WS_ZQ);
        C.QM = WSP(bf16, WS_QM1); C.qm_ld = MEMW; C.qm_c0 = 0; C.ZM = WSP(bf16, WS_ZM1); C.zm_ld = MEMW; C.zm_c0 = 0; C.MKV = WSP(bf16, WS_MKV) + (size_t)1024 * 1024;
        C.gates = WSP(float, WS_GATES); C.SEL = WSP(unsigned long long, WS_SEL); C.YACC = WSP(float, WS_C); C.Y = WSP(bf16, WS_B);
        attn_run(F, C, NB * NHEAD * 16, NB * 4 * 16);
    } PROBE_T(9, 1); SEAM(9);

    PROBE_T(10, 0);
    if (IN(10)) for (int rep = 0; rep < REPS(10); ++rep) { if (rep) GBAR(); unsigned char* ws = F.ptr(IX_WS);
        pg8::Geo g{DM, DM, DM / 64, 256};
        SchedLin S{64, 8, 1, F.G, (int)blockIdx.x, WGM_P10, (const char*)WSP(bf16, WS_B), (const char*)WSP(bf16, WS_WO1T), TILE_B, 0, TILE_B, 0, 0, 0, nullptr, nullptr, 0, 0};
        EpiRes<true> E{F.ptr(IX_OUT), WSP(bf16, WS_C), WSP(float, WS_SS2)};
        pg8::gemm_phase<EpiRes<true>, SchedLin, true, true>(F.lds, F.tid(), g, S, E);
    } PROBE_T(10, 1); SEAM(10);

    PROBE_T(11, 0);
    if (IN(11)) for (int rep = 0; rep < REPS(11); ++rep) { if (rep) GBAR(); p11_final(F); }
    PROBE_T(11, 1);
#ifdef CLKPROBE_A
    if (blockIdx.x == 0 && F.tid() == 0) { volatile unsigned long long* pr_ = (volatile unsigned long long*)(F.ptr(IX_WS) + WS_CTL + 32768);
#ifdef CLKGHZ
        const unsigned long long ticks = (pr_[3] - pr_[2]) * CLKGHZ / (pr_[1] - pr_[0] ? pr_[1] - pr_[0] : 1ull);
#else
        const unsigned long long ticks = (pr_[1] - pr_[0]) * CLKMULT;
#endif
        const unsigned long long t0 = __builtin_amdgcn_s_memrealtime();
        while (__builtin_amdgcn_s_memrealtime() - t0 < ticks) __builtin_amdgcn_s_sleep(8); }
#endif
#undef IN
#undef SEAM
}

extern "C" void kernel_launch(void* const* d_in, const int* in_sizes, int n_in, void* d_out, int out_size, void* d_ws, size_t ws_size, hipStream_t stream) {
    static int grid = 0;
    if (grid == 0) {
        if (n_in != 17 || in_sizes[0] != MTOK * DM || out_size != MTOK * DM || ws_size < WS_END) {
            fprintf(stderr, "kernel_launch: unexpected shapes (n_in %d, in0 %d, out %d, ws %zu < %zu)\n", n_in, n_in > 0 ? in_sizes[0] : -1, out_size, ws_size, (size_t)WS_END); grid = -1; return; }
        int dev = 0, cus = 0, per_cu = 0;
        if (hipGetDevice(&dev) != hipSuccess || hipDeviceGetAttribute(&cus, hipDeviceAttributeMultiprocessorCount, dev) != hipSuccess) { fprintf(stderr, "kernel_launch: device query failed\n"); grid = -1; return; }
        if (hipFuncSetAttribute((const void*)fwd_kernel, hipFuncAttributeMaxDynamicSharedMemorySize, LDS_BYTES) != hipSuccess) { fprintf(stderr, "kernel_launch: hipFuncSetAttribute failed\n"); grid = -1; return; }
        if (hipOccupancyMaxActiveBlocksPerMultiprocessor(&per_cu, (const void*)fwd_kernel, NTHREADS, LDS_BYTES) != hipSuccess || per_cu < 1) {
            fprintf(stderr, "kernel_launch: occupancy query says %d blocks per CU\n", per_cu); (void)hipGetLastError(); per_cu = 1; }
        grid = cus * (per_cu > 1 ? 1 : per_cu);
    }
    if (grid < 0) return;
    (void)hipMemsetAsync((char*)d_ws + WS_CTL, 0, 65536, stream);
    Args a{};
    for (int i = 0; i < 17; ++i) a.in[i] = d_in[i];
    a.out = (float*)d_out; a.ws = (unsigned char*)d_ws;
#if MK_PER_PHASE
    for (int p = 0; p < NPHASE; ++p) { a.ph_lo = p; a.ph_hi = p + 1; hipLaunchKernelGGL(fwd_kernel, dim3(grid), dim3(NTHREADS), LDS_BYTES, stream, a); }
#else
    a.ph_lo = 0; a.ph_hi = NPHASE;
    void* kargs[] = {&a};
    hipError_t e = hipLaunchCooperativeKernel((const void*)fwd_kernel, dim3(grid), dim3(NTHREADS), kargs, LDS_BYTES, stream);
    if (e != hipSuccess) fprintf(stderr, "kernel_launch: cooperative launch failed: %s (grid %d)\n", hipGetErrorString(e), grid);
#endif
}
```

```cpp
#include <hip/hip_runtime.h>
#include <hip/hip_cooperative_groups.h>
#include <cstdio>
#include <cstdint>
namespace cg = cooperative_groups;

#define LAS __attribute__((address_space(3)))
typedef unsigned short bf16;
typedef unsigned v4u __attribute__((ext_vector_type(4)));
typedef unsigned v2u __attribute__((ext_vector_type(2)));
typedef float f32x4 __attribute__((ext_vector_type(4)));
typedef float f32x2 __attribute__((ext_vector_type(2)));
typedef float f32x16 __attribute__((ext_vector_type(16)));
typedef short bf16x8 __attribute__((ext_vector_type(8)));
typedef short s16x4 __attribute__((ext_vector_type(4)));

constexpr int NB = 4, SEQ = 4096, DM = 2048, MTOK = NB * SEQ;
constexpr int MEMLEN = 256, HD = 128;
constexpr int POOLW = 1536, MEMW = 512, NSAW = 1536, NHEAD = 12, NKVH = 4;
constexpr int N1 = 4096;
constexpr int NKV = 3072;
constexpr int N4 = 7424;
constexpr int NCMP = 255, CMPHID = 256;
constexpr float EPS = 1e-6f;
constexpr float LOG2E = 1.4426950408889634f;
constexpr float ATT_SCALE = 0.08838834764831845f;

constexpr size_t MiB = 1u << 20;
constexpr size_t WS_CTL = 0;
constexpr size_t WS_W1T = 1 * MiB;
constexpr size_t WS_WO0T = 17 * MiB;
constexpr size_t WS_W4T = 25 * MiB;
constexpr size_t WS_WO1T = 54 * MiB;
constexpr size_t WS_WMT = 62 * MiB;
constexpr size_t WS_WPT = 70 * MiB;
constexpr size_t WS_WC1T = 72 * MiB;
constexpr size_t WS_MEMN = 76 * MiB;
constexpr size_t WS_MKV = 80 * MiB;
constexpr size_t WS_ROPE = 84 * MiB;
constexpr size_t WS_ROPEC = 86 * MiB;
constexpr size_t WS_SS1 = 87 * MiB;
constexpr size_t WS_SS2 = 89 * MiB;
constexpr size_t WS_SEL = 91 * MiB;
constexpr size_t WS_KCMP = 92 * MiB;
constexpr size_t WS_VCMP = 93 * MiB;
constexpr size_t WS_GATES = 94 * MiB;
constexpr size_t WS_CBIAS = 97 * MiB;
constexpr size_t WS_RINV1 = 97 * MiB + 512 * 1024;
constexpr size_t WS_W2T = 97 * MiB + 64 * 1024;
constexpr size_t WS_A = 98 * MiB;
constexpr size_t WS_KVB = WS_A;
constexpr size_t WS_QM1 = WS_A + 97 * MiB;
constexpr size_t WS_ZM1 = WS_A + 113 * MiB;
constexpr size_t WS_B = 228 * MiB;
constexpr size_t WS_C = 292 * MiB;
constexpr size_t WS_D = 388 * MiB;
constexpr size_t WS_Q1 = WS_D, WS_ZQ = WS_D + 48 * MiB;
constexpr size_t WS_END = 484 * MiB;

#define LDS_WAIT() asm volatile("s_waitcnt lgkmcnt(0)" ::: "memory")
#define VM_WAIT() asm volatile("s_waitcnt vmcnt(0)" ::: "memory")
__device__ __forceinline__ unsigned f2bf(float f) { unsigned u = __builtin_bit_cast(unsigned, f); return (u + 0x7fffu + ((u >> 16) & 1u)) >> 16; }
__device__ __forceinline__ unsigned pk2(float lo, float hi) { return f2bf(lo) | (f2bf(hi) << 16); }
__device__ __forceinline__ float bf2f(unsigned short b) { return __builtin_bit_cast(float, (unsigned)b << 16); }
__device__ __forceinline__ float bflo(unsigned w) { return __builtin_bit_cast(float, w << 16); }
__device__ __forceinline__ float bfhi(unsigned w) { return __builtin_bit_cast(float, w & 0xffff0000u); }
__device__ __forceinline__ unsigned cvtpk(float lo, float hi) { unsigned r; asm volatile("v_cvt_pk_bf16_f32 %0, %1, %2" : "=v"(r) : "v"(lo), "v"(hi)); return r; }
__device__ __forceinline__ float silu_f(float x) { return x * __builtin_amdgcn_rcpf(1.f + __builtin_amdgcn_exp2f(-x * LOG2E)); }
__device__ __forceinline__ float sigmoid_f(float x) { return __builtin_amdgcn_rcpf(1.f + __builtin_amdgcn_exp2f(-x * LOG2E)); }
__device__ __forceinline__ float wave_sum(float v) {
#pragma unroll
    for (int o = 1; o < 64; o <<= 1) v += __shfl_xor(v, o);
    return v;
}

namespace pg8 {
#define PG8_LAS __attribute__((address_space(3)))
constexpr int BM = 256, BK = 64, HALF = 128, HTB = HALF * BK * 2, STAGE_BYTES = 8 * HTB, NXCD = 8, WGM = 8;
__host__ __device__ __forceinline__ int lds_byte(int r, int c) { const int st = (r >> 4) * 2 + (c >> 5), rr = r & 15, cc = c & 31, ob = rr * 64 + cc * 2; return st * 1024 + (ob ^ (((ob >> 9) & 1) << 5)); }
__host__ __device__ __forceinline__ int perm32(int rho) { const int n = rho >> 4, i = rho & 15; return 8 * (i >> 2) + 4 * n + (i & 3); }
__host__ __device__ __forceinline__ void stage_rc(int b, int& R, int& C) { const int st = b / 1024, sb = b % 1024, swz = sb ^ (((sb >> 9) & 1) << 5); R = (st >> 1) * 16 + swz / 64; C = (st & 1) * 32 + (swz % 64) / 2; }

struct Unit { int pm, pn, z, kind; const char* a; const char* b; };
__device__ __forceinline__ void tile_swz(int wgid, int nM, int nN, int wgm, int& pm, int& pn) {
    const int nwg = nM * nN;
    { const int q = nwg / NXCD, r = nwg % NXCD, xcd = wgid % NXCD, off = wgid / NXCD; wgid = (xcd < r ? xcd * (q + 1) : r * (q + 1) + (xcd - r) * q) + off; }
    const int nig = wgm * nN, gid = wgid / nig, fm = gid * wgm, gsz = (nM - fm) < wgm ? (nM - fm) : wgm;
    pm = fm + ((wgid % nig) % gsz); pn = (wgid % nig) / gsz;
}
struct Geo { int lda, ldb, nt; int kpairA; };

template <class Epi, class Sched, bool ALIGN_EPI, bool SP2>
__device__ __forceinline__ void gemm_phase(PG8_LAS unsigned char* lds, const int tid, const Geo g, const Sched& S, const Epi& E) {
    const int wid = __builtin_amdgcn_readfirstlane(tid >> 6), lane = tid & 63, wr = wid >> 2, wc = wid & 3, fr = lane & 15, fq = lane >> 4;
    const int nt = g.nt;
    unsigned voffA[2], voffB[2];
#pragma unroll
    for (int i = 0; i < 2; ++i) { int R, C; stage_rc(tid * 16 + i * 8192, R, C);
        const int Rb = Epi::PERM ? 64 * (R >> 5) + perm32(R & 31) : R;
        voffA[i] = (unsigned)(R * g.lda + C) * 2u; voffB[i] = (unsigned)(Rb * g.ldb + C) * 2u; }
    const size_t kstep = (size_t)(BK * 2);
    const size_t hstepA = (size_t)HALF * g.lda * 2, hstepB = (size_t)(Epi::PERM ? 32 : HALF) * g.ldb * 2;
    const size_t kpairA = (size_t)g.kpairA;
    const unsigned ldsw = (unsigned)wid * 1024u;
    const int aoff = lds_byte(wr * 64 + fr, fq * 8), boff = lds_byte(wc * 32 + fr, fq * 8);
#define PG8_SA(b, h) (((b) * 2 + (h)) * HTB)
#define PG8_SB(b, h) ((4 + (b) * 2 + (h)) * HTB)
#define PG8_STAGE(bufoff, gbase, voff) do { _Pragma("unroll") for (int _i = 0; _i < 2; ++_i) \
        __builtin_amdgcn_global_load_lds((const unsigned*)((const char*)(gbase) + (voff)[_i]), (PG8_LAS unsigned*)(lds + (bufoff) + ldsw + _i * 8192), 16, 0, 0); } while (0)
#define PG8_LDA(dst, b, h) do { _Pragma("unroll") for (int m = 0; m < 4; ++m) _Pragma("unroll") for (int k = 0; k < 2; ++k) dst[m][k] = *(const PG8_LAS bf16x8*)(lds + PG8_SA(b, h) + aoff + m * 2048 + k * 1024); } while (0)
#define PG8_LDB(dst, b, h) do { _Pragma("unroll") for (int n = 0; n < 2; ++n) _Pragma("unroll") for (int k = 0; k < 2; ++k) dst[n][k] = *(const PG8_LAS bf16x8*)(lds + PG8_SB(b, h) + boff + n * 2048 + k * 1024); } while (0)
#define PG8_MMA(ai, bj, At, Bt) do { __builtin_amdgcn_s_setprio(1); _Pragma("unroll") for (int m = 0; m < 4; ++m) _Pragma("unroll") for (int n = 0; n < 2; ++n) _Pragma("unroll") for (int k = 0; k < 2; ++k) \
        acc[ai][bj][m][n] = __builtin_amdgcn_mfma_f32_16x16x32_bf16(Bt[n][k], At[m][k], acc[ai][bj][m][n], 0, 0, 0); __builtin_amdgcn_s_setprio(0); } while (0)
#define PG8_WAIT_V(n) asm volatile("s_waitcnt vmcnt(" #n ")" ::: "memory")
#define PG8_WAIT_L(n) asm volatile("s_waitcnt lgkmcnt(" #n ")" ::: "memory")
#define PG8_BAR __builtin_amdgcn_s_barrier()
#define PG8_SCHED __builtin_amdgcn_sched_barrier(0)
    Unit cur, nxt; int ui = 0;
    if (!S.next(0, cur)) return;
    f32x4 acc[2][2][4][2];
    typename Epi::State est;
    E.begin(acc, est, cur, wr, wc, fr, fq);
    bf16x8 At[4][2], B0[2][2], B1[2][2];
    const char* cA = cur.a; const char* cB = cur.b;
    if constexpr (SP2) {
        PG8_STAGE(PG8_SB(0, 0), cB, voffB); PG8_STAGE(PG8_SB(0, 1), cB + hstepB, voffB); PG8_STAGE(PG8_SA(0, 0), cA, voffA); PG8_STAGE(PG8_SA(0, 1), cA + hstepA, voffA);
        if (wr == 1) PG8_BAR;
        PG8_WAIT_V(2); PG8_BAR;
        PG8_STAGE(PG8_SB(1, 0), cB + kstep, voffB); PG8_STAGE(PG8_SA(1, 0), cA + kstep, voffA); PG8_STAGE(PG8_SB(1, 1), cB + hstepB + kstep, voffB);
        PG8_WAIT_V(6); PG8_BAR;
    } else {
        PG8_STAGE(PG8_SB(0, 0), cB, voffB); PG8_STAGE(PG8_SA(0, 0), cA, voffA); PG8_STAGE(PG8_SB(0, 1), cB + hstepB, voffB); PG8_STAGE(PG8_SA(0, 1), cA + hstepA, voffA);
        if (wr == 1) PG8_BAR;
        PG8_WAIT_V(4); PG8_BAR;
        PG8_STAGE(PG8_SB(1, 0), cB + kstep, voffB); PG8_STAGE(PG8_SA(1, 0), cA + kstep, voffA); PG8_STAGE(PG8_SB(1, 1), cB + hstepB + kstep, voffB);
        PG8_WAIT_V(6); PG8_BAR;
    }
    for (;;) {
        const bool has_next = S.next(ui + 1, nxt);
        const char* nA = has_next ? nxt.a : cA; const char* nB = has_next ? nxt.b : cB;
        for (int t = 0; t < nt; t += 2) {
            const bool last = (t == nt - 2);
            const char* a0p = cA + (size_t)(t >> 1) * kpairA;
            const char* a1 = a0p + kstep;
            const char* a2 = last ? nA : a0p + kpairA; const char* b2 = last ? nB : cB + (size_t)(t + 2) * kstep;
            const char* a3 = a2 + kstep; const char* b3 = b2 + kstep;
            if constexpr (SP2) {
            PG8_LDB(B0, 0, 0); PG8_LDB(B1, 0, 1); PG8_SCHED; PG8_LDA(At, 0, 0); PG8_STAGE(PG8_SA(1, 1), a1 + hstepA, voffA);
            PG8_WAIT_V(8); PG8_WAIT_L(0); PG8_BAR; PG8_MMA(0, 0, At, B0); PG8_MMA(0, 1, At, B1); PG8_BAR; PG8_SCHED;
            PG8_LDA(At, 0, 1); PG8_STAGE(PG8_SB(0, 0), b2, voffB); PG8_STAGE(PG8_SB(0, 1), b2 + hstepB, voffB); PG8_STAGE(PG8_SA(0, 0), a2, voffA);
            PG8_WAIT_V(8); PG8_WAIT_L(0); PG8_BAR; PG8_MMA(1, 0, At, B0); PG8_MMA(1, 1, At, B1); PG8_BAR; PG8_SCHED;
            PG8_LDB(B0, 1, 0); PG8_LDB(B1, 1, 1); PG8_SCHED; PG8_LDA(At, 1, 0); PG8_STAGE(PG8_SA(0, 1), a2 + hstepA, voffA);
            PG8_WAIT_V(8); PG8_WAIT_L(0); PG8_BAR; PG8_MMA(0, 0, At, B0); PG8_MMA(0, 1, At, B1); PG8_BAR; PG8_SCHED;
            PG8_LDA(At, 1, 1); PG8_STAGE(PG8_SB(1, 0), b3, voffB); PG8_STAGE(PG8_SB(1, 1), b3 + hstepB, voffB); PG8_STAGE(PG8_SA(1, 0), a3, voffA);
            PG8_WAIT_V(8); PG8_WAIT_L(0); PG8_BAR; PG8_MMA(1, 0, At, B0); PG8_MMA(1, 1, At, B1); PG8_BAR; PG8_SCHED;
            } else {
            PG8_LDB(B0, 0, 0); PG8_SCHED; PG8_LDA(At, 0, 0); PG8_STAGE(PG8_SA(1, 1), a1 + hstepA, voffA);
            PG8_WAIT_L(8); PG8_BAR; PG8_WAIT_L(0); PG8_MMA(0, 0, At, B0); PG8_BAR; PG8_SCHED;
            PG8_LDB(B1, 0, 1); PG8_STAGE(PG8_SB(0, 0), b2, voffB);
            PG8_BAR; PG8_WAIT_L(0); PG8_MMA(0, 1, At, B1); PG8_BAR;
            PG8_LDA(At, 0, 1); PG8_STAGE(PG8_SA(0, 0), a2, voffA);
            PG8_BAR; PG8_WAIT_L(0); PG8_MMA(1, 0, At, B0); PG8_BAR; PG8_SCHED;
            PG8_STAGE(PG8_SB(0, 1), b2 + hstepB, voffB);
            PG8_WAIT_V(6); PG8_BAR; PG8_MMA(1, 1, At, B1); PG8_BAR;
            PG8_LDB(B0, 1, 0); PG8_SCHED; PG8_LDA(At, 1, 0); PG8_STAGE(PG8_SA(0, 1), a2 + hstepA, voffA);
            PG8_WAIT_L(8); PG8_BAR; PG8_WAIT_L(0); PG8_MMA(0, 0, At, B0); PG8_BAR; PG8_SCHED;
            PG8_LDB(B1, 1, 1); PG8_STAGE(PG8_SB(1, 0), b3, voffB);
            PG8_BAR; PG8_WAIT_L(0); PG8_MMA(0, 1, At, B1); PG8_BAR;
            PG8_LDA(At, 1, 1); PG8_STAGE(PG8_SA(1, 0), a3, voffA);
            PG8_BAR; PG8_WAIT_L(0); PG8_MMA(1, 0, At, B0); PG8_BAR; PG8_SCHED;
            PG8_STAGE(PG8_SB(1, 1), b3 + hstepB, voffB);
            PG8_WAIT_V(6); PG8_BAR; PG8_MMA(1, 1, At, B1); PG8_BAR;
            }
        }
        if constexpr (ALIGN_EPI) { if (wr == 0) PG8_BAR; }
        E(acc, est, cur, wr, wc, fr, fq);
        if (!has_next) break;
        cur = nxt; cA = nA; cB = nB; ++ui;
        E.begin(acc, est, cur, wr, wc, fr, fq);
        if constexpr (ALIGN_EPI) { if (wr == 1) PG8_BAR; }
    }
    PG8_WAIT_V(0);
    if constexpr (!ALIGN_EPI) { if (wr == 0) PG8_BAR; }
    PG8_BAR;
#undef PG8_SA
#undef PG8_SB
#undef PG8_STAGE
#undef PG8_LDA
#undef PG8_LDB
#undef PG8_MMA
#undef PG8_WAIT_V
#undef PG8_WAIT_L
#undef PG8_BAR
#undef PG8_SCHED
}
}

namespace att {
#ifndef AT_SELMASK
#define AT_SELMASK 1
#endif
constexpr int D = 128, NW = 8, QBLK = 32, KVBLK = 64, QB = NW * QBLK;
constexpr int SHM_V = KVBLK * D * 2, SHM_K = KVBLK * D * 2;
constexpr int LDS_BYTES = 2 * SHM_V + 2 * SHM_K + NW * 64 * 4;
constexpr float THR = 8.f;
#define KSWZ(row, colB) ((row) * 256 + ((colB) ^ (((row) & 7) << 4)))
#define SBAR() __builtin_amdgcn_sched_barrier(0)
__device__ __forceinline__ int v_st(int k, int c) { const int kk = (k & ~0xC) | ((k & 4) << 1) | ((k & 8) >> 1); return ((kk >> 3) * 4 + (c >> 5)) * 512 + ((kk & 7) * 32 + (c & 31)) * 2; }
__device__ __forceinline__ int v_rd_base(int lane) { return ((lane & 3) << 3) | (((lane >> 2) & 3) << 6) | (((lane >> 4) & 1) << 5) | (((lane >> 5) & 1) << 8); }
constexpr int v_rd_off(int d0, int ks, int half) { return d0 * 512 + ks * 4096 + half * 2048; }
__device__ __forceinline__ int crow(int r, int hi) { return (r & 3) + 8 * (r >> 2) + 4 * hi; }
__device__ __forceinline__ bf16x8 load8(const bf16* p) { return *reinterpret_cast<const bf16x8*>(p); }

__device__ __forceinline__ void mask_tile(f32x16& p0, f32x16& p1, int dq, unsigned W) {
    const float NEG = -__builtin_inff();
#pragma unroll
    for (int r = 0; r < 16; ++r) {
        const int c = (r & 3) + 8 * (r >> 2);
        if ((unsigned)(dq - c) >= W) p0[r] = NEG;
        if ((unsigned)(dq - c - 32) >= W) p1[r] = NEG;
    }
}
__device__ __forceinline__ void partialSM(f32x16& p0, f32x16& p1, float& m_reg, float& mn, float& alpha) {
    float pmax = p0[0];
#pragma unroll
    for (int r = 1; r < 16; ++r) pmax = fmaxf(pmax, p0[r]);
#pragma unroll
    for (int r = 0; r < 16; ++r) pmax = fmaxf(pmax, p1[r]);
    { auto rr = __builtin_amdgcn_permlane32_swap(__float_as_uint(pmax), __float_as_uint(pmax), false, false);
      pmax = fmaxf(__uint_as_float(rr[0]), __uint_as_float(rr[1])); }
    constexpr float C2 = LOG2E * ATT_SCALE;
    if (__builtin_expect(__all((pmax - m_reg) * ATT_SCALE <= THR), 1)) { mn = m_reg; alpha = 1.f; }
    else { mn = fmaxf(m_reg, pmax); alpha = __builtin_amdgcn_exp2f((m_reg - mn) * C2); m_reg = mn; }
    const float mnL = -mn * C2;
#pragma unroll
    for (int r = 0; r < 16; ++r) p0[r] = fmaf(p0[r], C2, mnL);
#pragma unroll
    for (int r = 0; r < 16; ++r) p1[r] = fmaf(p1[r], C2, mnL);
#pragma unroll
    for (int r = 0; r < 16; ++r) p0[r] = __builtin_amdgcn_exp2f(p0[r]);
}
__device__ __forceinline__ void finishSM(f32x16& p0, f32x16& p1, float alpha, float& l_reg, bf16x8& pa0, bf16x8& pa1, bf16x8& pa2, bf16x8& pa3, int keep) {
#pragma unroll
    for (int r = 0; r < 16; ++r) p1[r] = __builtin_amdgcn_exp2f(p1[r]);
    float ps = 0;
#pragma unroll
    for (int r = 0; r < 16; ++r) ps += p0[r];
#pragma unroll
    for (int r = 0; r < 16; ++r) ps += p1[r];
    { auto rr = __builtin_amdgcn_permlane32_swap(__float_as_uint(ps), __float_as_uint(ps), false, false);
      ps = __uint_as_float(rr[0]) + __uint_as_float(rr[1]); }
    l_reg = l_reg * alpha + (keep ? ps : 0.f);
#define PK4(P, B_, OUT) do { unsigned a0 = cvtpk(P[B_+0], P[B_+1]), a1 = cvtpk(P[B_+2], P[B_+3]);                          \
        unsigned b0 = cvtpk(P[B_+4], P[B_+5]), b1 = cvtpk(P[B_+6], P[B_+7]);                                             \
        auto r0 = __builtin_amdgcn_permlane32_swap(a0, b0, false, false); auto r1 = __builtin_amdgcn_permlane32_swap(a1, b1, false, false); \
        v4u w = {keep ? r0[0] : 0u, keep ? r1[0] : 0u, keep ? r0[1] : 0u, keep ? r1[1] : 0u}; OUT = *reinterpret_cast<bf16x8*>(&w); } while (0)
    PK4(p0, 0, pa0); PK4(p0, 8, pa1); PK4(p1, 0, pa2); PK4(p1, 8, pa3);
#undef PK4
}
template <int KB>
__device__ __forceinline__ void qkt(f32x16& p0, f32x16& p1, const char* K_lds, int r32, int hi, const bf16x8* qr) {
    p0 = f32x16{}; p1 = f32x16{};
    const char* kb[4];
#pragma unroll
    for (int dd = 0; dd < 4; ++dd) kb[dd] = K_lds + KB * SHM_K + KSWZ(r32, (dd * 16 + hi * 8) * 2);
#pragma unroll
    for (int d0 = 0; d0 < 8; ++d0) { const char* a = kb[d0 & 3] + (d0 >> 2) * 128;
        bf16x8 b0 = *reinterpret_cast<const bf16x8*>(a);
        bf16x8 b1 = *reinterpret_cast<const bf16x8*>(a + 32 * 256);
        p0 = __builtin_amdgcn_mfma_f32_32x32x16_bf16(b0, qr[d0], p0, 0, 0, 0);
        p1 = __builtin_amdgcn_mfma_f32_32x32x16_bf16(b1, qr[d0], p1, 0, 0, 0); }
}
template <int VB>
__device__ __forceinline__ void pv_tile(f32x16* o, int vb0, bf16x8 pa0, bf16x8 pa1, bf16x8 pa2, bf16x8 pa3) {
#define TRRD(dst, off) asm volatile("ds_read_b64_tr_b16 %0, %1 offset:%2" : "=&v"(dst) : "v"(vb0), "i"(off) : "memory")
#define PV_D0(d0) do { s16x4 l0, l1, l2, l3, h0, h1, h2, h3; constexpr int b_ = VB * SHM_V + v_rd_off(d0, 0, 0);   \
        TRRD(l0, b_); TRRD(h0, b_ + 2048); TRRD(l1, b_ + 4096); TRRD(h1, b_ + 6144); TRRD(l2, b_ + 8192); TRRD(h2, b_ + 10240); TRRD(l3, b_ + 12288); TRRD(h3, b_ + 14336); \
        asm volatile("s_waitcnt lgkmcnt(0)" ::: "memory"); SBAR();   \
        o[d0] = __builtin_amdgcn_mfma_f32_32x32x16_bf16(pa0, (bf16x8){l0[0], l0[1], l0[2], l0[3], h0[0], h0[1], h0[2], h0[3]}, o[d0], 0, 0, 0);   \
        o[d0] = __builtin_amdgcn_mfma_f32_32x32x16_bf16(pa1, (bf16x8){l1[0], l1[1], l1[2], l1[3], h1[0], h1[1], h1[2], h1[3]}, o[d0], 0, 0, 0);   \
        o[d0] = __builtin_amdgcn_mfma_f32_32x32x16_bf16(pa2, (bf16x8){l2[0], l2[1], l2[2], l2[3], h2[0], h2[1], h2[2], h2[3]}, o[d0], 0, 0, 0);   \
        o[d0] = __builtin_amdgcn_mfma_f32_32x32x16_bf16(pa3, (bf16x8){l3[0], l3[1], l3[2], l3[3], h3[0], h3[1], h3[2], h3[3]}, o[d0], 0, 0, 0); } while (0)
    PV_D0(0); PV_D0(1); PV_D0(2); PV_D0(3);
#undef PV_D0
#undef TRRD
}

enum { MODE_NONE = 0, MODE_SEL = 1, MODE_WIN = 2, MODE_CMP = 3 };
enum { EPI_MEM = 0, EPI_ACC0 = 1, EPI_ACC1 = 2, EPI_FIN = 3 };
struct Ctx { const bf16 *KV, *KC, *VC, *Q1, *ZQ, *QM, *ZM, *MKV; const float* gates; const unsigned long long* SEL; float* YACC; bf16* Y; int qm_ld, zm_ld, qm_c0, zm_c0; };
struct Blk {
    const bf16* Q; const bf16* K; int voff;
    int ldq, ldk;
    int j_lo, j_hi;
    int t0;
    int mode, epi;
    int row0, hcol, gcol, bg;
};
constexpr int LDS_WS = 2 * SHM_V + 2 * SHM_K;
constexpr int LDS_SEL = LDS_WS + NW * 64 * 4;
constexpr int LDS_STG = LDS_SEL + NW * 32 * 8;
constexpr int LDS_BYTES2 = LDS_STG + NW * 32 * 68 * 4;
struct Seam { bf16x8 qr[8]; bf16x8 st_v0, st_v1, st_k0, st_k1; };
#define AROW(p, k0, rr) ((p) + (size_t)((k0) + (rr)) * ldk + sc)
#define VMWN(n) asm volatile("s_waitcnt vmcnt(%0)" :: "i"(n) : "memory")
#define SLOAD_H(Kp, Vp, k0) do { S.st_v0 = load8(AROW(Vp, k0, sr)); S.st_v1 = load8(AROW(Vp, k0, 32 + sr));              \
                         S.st_k0 = load8(AROW(Kp, k0, sr)); S.st_k1 = load8(AROW(Kp, k0, 32 + sr)); } while (0)
#define SWRITE_HK(bf) do { *(bf16x8*)(K_lds + (bf) * SHM_K + kws) = S.st_k0; *(bf16x8*)(K_lds + (bf) * SHM_K + kws + 32 * 256) = S.st_k1; } while (0)
#define SWRITE_HV(bf) do { *(bf16x8*)(V_lds + (bf) * SHM_V + vst0) = S.st_v0; *(bf16x8*)(V_lds + (bf) * SHM_V + vst1) = S.st_v1; } while (0)
#define SWRITE_H(bf) do { SWRITE_HV(bf); SWRITE_HK(bf); } while (0)

__device__ __forceinline__ void attn_prime(const int tid, const Blk& cur, char* lds, Seam& S) {
    const int wid = __builtin_amdgcn_readfirstlane(tid >> 6), lane = tid & 63, r32 = lane & 31, hi = lane >> 5;
    const int sr = tid >> 4, sc = (tid & 15) * 8, kws = KSWZ(sr, sc * 2); char* K_lds = lds + 2 * SHM_V;
    const int ldk = cur.ldk; const int kb0 = cur.j_lo * KVBLK;
#pragma unroll
    for (int i = 0; i < 8; ++i) S.qr[i] = load8(cur.Q + (size_t)(wid * QBLK + (lane >> 4) + 4 * i) * cur.ldq + (lane & 15) * 8);
    SLOAD_H(cur.K, cur.K + cur.voff, kb0); VM_WAIT(); SWRITE_HK(0);
    __syncthreads();
}
__device__ __forceinline__ void attn_block(const int tid, const Ctx& C, const Blk& cur, const bf16* nQ, const bf16* nK, int nvoff, int nldq, int nldk, int nj_lo, char* lds, Seam& S) {
    const int wid = __builtin_amdgcn_readfirstlane(tid >> 6), lane = tid & 63, r32 = lane & 31, hi = lane >> 5;
#ifdef AT_TILE2X
    const int j_lo = cur.j_lo, NT0 = cur.j_hi - cur.j_lo, NT = (cur.mode == AT_TILE2X) ? 2 * NT0 : NT0;
#define TIX(t) ((t) >= NT0 ? (t) - NT0 : (t))
#else
    const int j_lo = cur.j_lo, NT = cur.j_hi - cur.j_lo;
#define TIX(t) (t)
#endif
    const int kbn = nj_lo * KVBLK;
    const int mode = cur.mode;
    const int trow = cur.t0 + wid * QBLK;
    int pos, pmin, pmax; unsigned W;
    if (mode == MODE_CMP) { pos = (trow + r32 - 31) >> 4; pmin = (trow - 31) >> 4; pmax = trow >> 4; W = 0x7fffffffu; }
    else if (mode == MODE_NONE) { pos = 1 << 29; pmin = 1 << 29; pmax = 1 << 29; W = 0x7fffffffu; }
    else { pos = trow + r32; pmin = trow; pmax = trow + QBLK - 1; W = (mode == MODE_WIN) ? 512u : 0x7fffffffu; }
    const int qm = pos - 4 * hi;
    char* V_lds = lds; char* K_lds = lds + 2 * SHM_V;
    float* ws = (float*)(lds + LDS_WS) + wid * 64; float* li_l = ws, * al_l = ws + 32;
    unsigned long long* sel_l = (unsigned long long*)(lds + LDS_SEL) + wid * 32;
    if (mode == MODE_SEL && hi == 0) sel_l[r32] = C.SEL[(size_t)cur.bg * SEQ + trow + r32];
    float m_reg = -1e30f, l_reg = 0; f32x16 o[4] = {};
    const int sr = tid >> 4, sc = (tid & 15) * 8, vst0 = v_st(sr, sc), vst1 = v_st(32 + sr, sc), kws = KSWZ(sr, sc * 2);
    const int vb0 = (int)(uintptr_t)V_lds + v_rd_base(lane);
    const bf16* Kh = cur.K; const bf16* Vh = cur.K + cur.voff; const int ldk = cur.ldk;
#define RESC(a) do { if (__any((a) < 1.f)) { if (hi == 0) al_l[r32] = (a); asm volatile("s_waitcnt lgkmcnt(0)" ::: "memory");              \
                     for (int d_ = 0; d_ < 4; ++d_) for (int r = 0; r < 16; ++r) o[d_][r] *= al_l[crow(r, hi)]; } } while (0)
#define KBASE(t) ((j_lo + TIX(t)) * KVBLK)
#define MASKT(P0_, P1_, t, KP_) do { const int kb_ = KBASE(t); KP_ = 1; \
        if (mode == MODE_SEL) { const int bit_ = (int)((sel_l[r32] >> (j_lo + TIX(t))) & 1ull); \
            if (kb_ + KVBLK - 1 > pmin) mask_tile(P0_, P1_, bit_ ? qm - kb_ : -(1 << 30), W);       \
            else KP_ = bit_; }                                                                         \
        else if (kb_ + KVBLK - 1 > pmin || kb_ <= pmax - (int)W) mask_tile(P0_, P1_, qm - kb_, W); } while (0)
    constexpr int NQL = 8;
#define SEAM_K0() do { VMWN(NQL); SWRITE_HK(0); SBAR(); } while (0)
    f32x16 pA0, pA1, pB0, pB1; float mnA, mnB, alA, alB; int kpA = 1, kpB = 1; bf16x8 pa0, pa1, pa2, pa3;
    {
        char* stq = lds + LDS_STG + wid * (32 * 272);
#pragma unroll
        for (int i = 0; i < 8; ++i) *(bf16x8*)(stq + ((lane >> 4) + 4 * i) * 272 + (lane & 15) * 16) = S.qr[i];
        asm volatile("s_waitcnt lgkmcnt(0)" ::: "memory");
#pragma unroll
        for (int d0 = 0; d0 < 8; ++d0) S.qr[d0] = *(const bf16x8*)(stq + r32 * 272 + (2 * d0 + hi) * 16);
        asm volatile("s_waitcnt lgkmcnt(0)" ::: "memory");
    }
    SWRITE_HV(0); SBAR();
    if (NT > 1) { SLOAD_H(Kh, Vh, KBASE(1)); }
    SBAR(); qkt<0>(pA0, pA1, K_lds, r32, hi, S.qr);
    MASKT(pA0, pA1, 0, kpA); partialSM(pA0, pA1, m_reg, mnA, alA);
    if (NT > 1) { VM_WAIT(); SWRITE_H(1); }
    __syncthreads();
#define HALF_STEP(PX0, PX1, mnX, alX, kpX, PY0, PY1, alY, kpY, t, KB, VB, SB) do {                                                      \
        SBAR(); if ((t) + 1 < NT) { SLOAD_H(Kh, Vh, KBASE((t) + 1)); SBAR(); }         \
        qkt<KB>(PX0, PX1, K_lds, r32, hi, S.qr);                                             \
        finishSM(PY0, PY1, alY, l_reg, pa0, pa1, pa2, pa3, kpY); SBAR();                                                      \
        pv_tile<VB>(o, vb0, pa0, pa1, pa2, pa3); MASKT(PX0, PX1, (t), kpX); partialSM(PX0, PX1, m_reg, mnX, alX);                                        \
        __syncthreads();                                                                                                      \
        if ((t) + 1 < NT) { VM_WAIT(); SWRITE_H(SB); }                                                                          \
        RESC(alX); __syncthreads(); } while (0)
    for (int t = 1; t + 1 < NT; t += 2) {
        HALF_STEP(pB0, pB1, mnB, alB, kpB, pA0, pA1, alA, kpA, t, 1, 0, 0);
        HALF_STEP(pA0, pA1, mnA, alA, kpA, pB0, pB1, alB, kpB, t + 1, 0, 1, 1);
    }
    const bool even = (NT & 1) == 0;
    if (even) { SBAR(); qkt<1>(pB0, pB1, K_lds, r32, hi, S.qr); SBAR(); }
    { const int ldk = nldk; SLOAD_H(nK, nK + nvoff, kbn); SBAR(); }
#pragma unroll
    for (int i = 0; i < 8; ++i) S.qr[i] = load8(nQ + (size_t)(wid * QBLK + (lane >> 4) + 4 * i) * nldq + (lane & 15) * 8);
    SBAR();
    finishSM(pA0, pA1, alA, l_reg, pa0, pa1, pa2, pa3, kpA); SBAR();
    pv_tile<0>(o, vb0, pa0, pa1, pa2, pa3);
    if (even) { MASKT(pB0, pB1, NT - 1, kpB); partialSM(pB0, pB1, m_reg, mnB, alB); __syncthreads(); RESC(alB);
        finishSM(pB0, pB1, alB, l_reg, pa0, pa1, pa2, pa3, kpB); SBAR(); pv_tile<1>(o, vb0, pa0, pa1, pa2, pa3); }
    SBAR(); SEAM_K0();
    {
        const int epi = cur.epi;
        float fac = l_reg > 0.f ? __builtin_amdgcn_rcpf(l_reg) : 0.f;
        if (epi != EPI_MEM) fac *= C.gates[(size_t)(cur.row0 + wid * QBLK + r32) * 36 + cur.gcol];
        if (hi == 0) li_l[r32] = fac;
        asm volatile("s_waitcnt lgkmcnt(0)" ::: "memory");
        float* stg = (float*)(lds + LDS_STG) + wid * (32 * 68);
        const int rrow = lane >> 4, c4 = (lane & 15) * 4;
        const size_t grow = (size_t)cur.row0 + wid * QBLK + rrow;
        const bool fin = (epi == EPI_FIN);
        float* accb = C.YACC + grow * NSAW + cur.hcol + c4;
        const bf16* zb = fin ? C.ZQ + grow * NSAW + cur.hcol + c4 : C.ZM + grow * C.zm_ld + C.zm_c0 + cur.hcol + c4;
        const int ldz = fin ? NSAW : C.zm_ld;
        bf16* yb = C.Y + grow * DM + (fin ? 0 : POOLW) + cur.hcol + c4;
#pragma unroll
        for (int half = 0; half < 2; ++half) {
#pragma unroll
            for (int r = 0; r < 16; ++r) { const float f = li_l[crow(r, hi)]; float* w = stg + crow(r, hi) * 68 + r32; w[0] = o[2 * half][r] * f; w[32] = o[2 * half + 1][r] * f; }
            asm volatile("s_waitcnt lgkmcnt(0)" ::: "memory");
            f32x4 v[8];
#pragma unroll
            for (int i = 0; i < 8; ++i) v[i] = *(const f32x4*)(stg + (rrow + 4 * i) * 68 + c4);
            const int co = half * 64;
            if (epi == EPI_ACC0) {
#pragma unroll
                for (int i = 0; i < 8; ++i) *(f32x4*)(accb + (size_t)(4 * i) * NSAW + co) = v[i];
            } else if (epi == EPI_ACC1) {
                f32x4 a[8];
#pragma unroll
                for (int i = 0; i < 8; ++i) a[i] = *(const f32x4*)(accb + (size_t)(4 * i) * NSAW + co);
#pragma unroll
                for (int i = 0; i < 8; ++i) *(f32x4*)(accb + (size_t)(4 * i) * NSAW + co) = a[i] + v[i];
            } else {
                v2u z[8];
#pragma unroll
                for (int i = 0; i < 8; ++i) z[i] = *(const v2u*)(zb + (size_t)(4 * i) * ldz + co);
                if (fin) { f32x4 a[8];
#pragma unroll
                    for (int i = 0; i < 8; ++i) a[i] = *(const f32x4*)(accb + (size_t)(4 * i) * NSAW + co);
#pragma unroll
                    for (int i = 0; i < 8; ++i) v[i] = v[i] + a[i]; }
#pragma unroll
                for (int i = 0; i < 8; ++i) { v2u w; w.x = pk2(v[i][0] * bflo(z[i].x), v[i][1] * bfhi(z[i].x)); w.y = pk2(v[i][2] * bflo(z[i].y), v[i][3] * bfhi(z[i].y));
                    *(v2u*)(yb + (size_t)(4 * i) * DM + co) = w; }
            }
            asm volatile("s_waitcnt lgkmcnt(0)" ::: "memory");
        }
    }
    __syncthreads();
#undef RESC
#undef TIX
#undef KBASE
#undef MASKT
#undef SEAM_K0
#undef HALF_STEP
}
#undef AROW
#undef VMWN
#undef SLOAD_H
#undef SWRITE_HK
#undef SWRITE_HV
#undef SWRITE_H
}
__device__ const unsigned short NSA_TAB[256 * 4] = {
    0, 384, 674, 65535,
    1, 385, 675, 65535,
    144, 480, 484, 65535,
    145, 481, 485, 65535,
    96, 482, 528, 65535,
    97, 483, 529, 65535,
    48, 388, 676, 65535,
    49, 389, 677, 65535,
    148, 432, 530, 65535,
    149, 433, 531, 65535,
    192, 386, 532, 65535,
    193, 387, 533, 65535,
    4, 288, 722, 65535,
    5, 289, 723, 65535,
    98, 436, 576, 65535,
    99, 437, 577, 65535,
    100, 434, 578, 65535,
    101, 435, 579, 65535,
    2, 292, 724, 65535,
    3, 293, 725, 65535,
    146, 336, 628, 65535,
    147, 337, 629, 65535,
    50, 338, 672, 65535,
    51, 339, 673, 65535,
    52, 244, 720, 65535,
    53, 245, 721, 65535,
    194, 340, 580, 65535,
    195, 341, 581, 65535,
    196, 290, 624, 65535,
    197, 291, 625, 65535,
    240, 242, 626, 65535,
    241, 243, 627, 65535,
    6, 390, 680, 65535,
    7, 391, 681, 65535,
    150, 486, 490, 65535,
    151, 487, 491, 65535,
    102, 488, 534, 65535,
    103, 489, 535, 65535,
    54, 394, 682, 65535,
    55, 395, 683, 65535,
    154, 438, 536, 65535,
    155, 439, 537, 65535,
    198, 392, 538, 65535,
    199, 393, 539, 65535,
    10, 294, 728, 65535,
    11, 295, 729, 65535,
    104, 442, 582, 65535,
    105, 443, 583, 65535,
    106, 440, 584, 65535,
    107, 441, 585, 65535,
    8, 298, 730, 65535,
    9, 299, 731, 65535,
    152, 342, 634, 65535,
    153, 343, 635, 65535,
    56, 344, 678, 65535,
    57, 345, 679, 65535,
    58, 250, 726, 65535,
    59, 251, 727, 65535,
    200, 346, 586, 65535,
    201, 347, 587, 65535,
    202, 296, 630, 65535,
    203, 297, 631, 65535,
    246, 248, 632, 65535,
    247, 249, 633, 65535,
    12, 396, 686, 65535,
    13, 397, 687, 65535,
    156, 492, 496, 65535,
    157, 493, 497, 65535,
    108, 494, 540, 65535,
    109, 495, 541, 65535,
    60, 400, 688, 65535,
    61, 401, 689, 65535,
    160, 444, 542, 65535,
    161, 445, 543, 65535,
    204, 398, 544, 65535,
    205, 399, 545, 65535,
    16, 300, 734, 65535,
    17, 301, 735, 65535,
    110, 448, 588, 65535,
    111, 449, 589, 65535,
    112, 446, 590, 65535,
    113, 447, 591, 65535,
    14, 304, 736, 65535,
    15, 305, 737, 65535,
    158, 348, 640, 65535,
    159, 349, 641, 65535,
    62, 350, 684, 65535,
    63, 351, 685, 65535,
    64, 256, 732, 65535,
    65, 257, 733, 65535,
    206, 352, 592, 65535,
    207, 353, 593, 65535,
    208, 302, 636, 65535,
    209, 303, 637, 65535,
    252, 254, 638, 65535,
    253, 255, 639, 65535,
    18, 402, 692, 65535,
    19, 403, 693, 65535,
    162, 498, 502, 65535,
    163, 499, 503, 65535,
    114, 500, 546, 65535,
    115, 501, 547, 65535,
    66, 406, 694, 65535,
    67, 407, 695, 65535,
    166, 450, 548, 65535,
    167, 451, 549, 65535,
    210, 404, 550, 65535,
    211, 405, 551, 65535,
    22, 306, 740, 65535,
    23, 307, 741, 65535,
    116, 454, 594, 65535,
    117, 455, 595, 65535,
    118, 452, 596, 65535,
    119, 453, 597, 65535,
    20, 310, 742, 65535,
    21, 311, 743, 65535,
    164, 354, 646, 65535,
    165, 355, 647, 65535,
    68, 356, 690, 65535,
    69, 357, 691, 65535,
    70, 262, 738, 65535,
    71, 263, 739, 65535,
    212, 358, 598, 65535,
    213, 359, 599, 65535,
    214, 308, 642, 65535,
    215, 309, 643, 65535,
    258, 260, 644, 65535,
    259, 261, 645, 65535,
    24, 408, 698, 65535,
    25, 409, 699, 65535,
    168, 504, 508, 65535,
    169, 505, 509, 65535,
    120, 506, 552, 65535,
    121, 507, 553, 65535,
    72, 412, 700, 65535,
    73, 413, 701, 65535,
    172, 456, 554, 65535,
    173, 457, 555, 65535,
    216, 410, 556, 65535,
    217, 411, 557, 65535,
    28, 312, 746, 65535,
    29, 313, 747, 65535,
    122, 460, 600, 65535,
    123, 461, 601, 65535,
    124, 458, 602, 65535,
    125, 459, 603, 65535,
    26, 316, 748, 65535,
    27, 317, 749, 65535,
    170, 360, 652, 65535,
    171, 361, 653, 65535,
    74, 362, 696, 65535,
    75, 363, 697, 65535,
    76, 268, 744, 65535,
    77, 269, 745, 65535,
    218, 364, 604, 65535,
    219, 365, 605, 65535,
    220, 314, 648, 65535,
    221, 315, 649, 65535,
    264, 266, 650, 65535,
    265, 267, 651, 65535,
    30, 414, 704, 65535,
    31, 415, 705, 65535,
    174, 510, 514, 65535,
    175, 511, 515, 65535,
    126, 512, 558, 65535,
    127, 513, 559, 65535,
    78, 418, 706, 65535,
    79, 419, 707, 65535,
    178, 462, 560, 65535,
    179, 463, 561, 65535,
    222, 416, 562, 65535,
    223, 417, 563, 65535,
    34, 318, 752, 65535,
    35, 319, 753, 65535,
    128, 466, 606, 65535,
    129, 467, 607, 65535,
    130, 464, 608, 65535,
    131, 465, 609, 65535,
    32, 322, 754, 65535,
    33, 323, 755, 65535,
    176, 366, 658, 65535,
    177, 367, 659, 65535,
    80, 368, 702, 65535,
    81, 369, 703, 65535,
    82, 274, 750, 65535,
    83, 275, 751, 65535,
    224, 370, 610, 65535,
    225, 371, 611, 65535,
    226, 320, 654, 65535,
    227, 321, 655, 65535,
    270, 272, 656, 65535,
    271, 273, 657, 65535,
    36, 420, 710, 65535,
    37, 421, 711, 65535,
    180, 516, 520, 65535,
    181, 517, 521, 65535,
    132, 518, 564, 65535,
    133, 519, 565, 65535,
    84, 424, 712, 65535,
    85, 425, 713, 65535,
    184, 468, 566, 65535,
    185, 469, 567, 65535,
    228, 422, 568, 65535,
    229, 423, 569, 65535,
    40, 324, 758, 65535,
    41, 325, 759, 65535,
    134, 472, 612, 65535,
    135, 473, 613, 65535,
    136, 470, 614, 65535,
    137, 471, 615, 65535,
    38, 328, 760, 65535,
    39, 329, 761, 65535,
    182, 372, 664, 65535,
    183, 373, 665, 65535,
    86, 374, 708, 65535,
    87, 375, 709, 65535,
    88, 280, 756, 65535,
    89, 281, 757, 65535,
    230, 376, 616, 65535,
    231, 377, 617, 65535,
    232, 326, 660, 65535,
    233, 327, 661, 65535,
    276, 278, 662, 65535,
    277, 279, 663, 65535,
    42, 426, 716, 65535,
    43, 427, 717, 65535,
    186, 522, 526, 65535,
    187, 523, 527, 65535,
    138, 524, 570, 65535,
    139, 525, 571, 65535,
    90, 430, 718, 65535,
    91, 431, 719, 65535,
    190, 474, 572, 65535,
    191, 475, 573, 65535,
    234, 428, 574, 65535,
    235, 429, 575, 65535,
    46, 330, 764, 65535,
    47, 331, 765, 65535,
    140, 478, 618, 65535,
    141, 479, 619, 65535,
    142, 476, 620, 65535,
    143, 477, 621, 65535,
    44, 334, 766, 65535,
    45, 335, 767, 65535,
    188, 378, 670, 65535,
    189, 379, 671, 65535,
    92, 380, 714, 65535,
    93, 381, 715, 65535,
    94, 286, 762, 65535,
    95, 287, 763, 65535,
    236, 382, 622, 65535,
    237, 383, 623, 65535,
    238, 332, 666, 65535,
    239, 333, 667, 65535,
    282, 284, 668, 65535,
    283, 285, 669, 65535,
};

constexpr int NWAVES = 8, NTHREADS = 512;
constexpr int LDS_BYTES = 147456;
constexpr int NPHASE = 12;
#ifndef MK_PER_PHASE
#define MK_PER_PHASE 0
#endif

struct Args { const void* in[17]; float* out; unsigned char* ws; int ph_lo, ph_hi; };

constexpr int TAB_OFF = LDS_BYTES - 1024;
enum { IX_X = 0, IX_MEM, IX_POS, IX_NORM_G, IX_MEM_NORM_G, IX_W_MEM_KV, IX_W_OUT, IX_A_W_IN, IX_A_W_POOL, IX_A_POOL_SCALE, IX_B_W_IN, IX_KV_NORM_G, IX_W_KV, IX_CMP_PE, IX_CMP_W1, IX_CMP_W2, IX_FINAL_G, IX_OUT, IX_WS };
__device__ __forceinline__ int lane_fresh() { int l; asm volatile("v_mbcnt_lo_u32_b32 %0, -1, 0\n\tv_mbcnt_hi_u32_b32 %0, -1, %0" : "=v"(l)); return l; }
struct Frame {
    LAS unsigned char* lds; char* ldsg;
    int wave, vcu, G;
    __device__ __forceinline__ int tid() const { return wave * 64 + lane_fresh(); }
    __device__ __forceinline__ unsigned char* ptr(int k) const {
        volatile LAS unsigned* t = (volatile LAS unsigned*)(lds + TAB_OFF);
        const unsigned lo = t[2 * k], hi = t[2 * k + 1];
        typedef __attribute__((address_space(1))) unsigned char gchar;
        return (unsigned char*)(gchar*)(((unsigned long long)(unsigned)__builtin_amdgcn_readfirstlane(hi) << 32) | (unsigned)__builtin_amdgcn_readfirstlane(lo));
    }
    __device__ __forceinline__ const float* fin(int k) const { return (const float*)ptr(k); }
};
#define WSP(T, off) ((T*)(ws + (off)))

#define XB_TMO      128
#define XB_XCNT(j)  (256  + 64 * (j))
#define XB_XSUB(j)  (1280 + 64 * (j))
#define XB_XGEN(j)  (2304 + 64 * (j))
#define XB_TOP      3328
#define XB_TOPGEN   3392
#define XCD_BAR_WORDS 3456
#define XB_SPIN_CAP (1u << 20)
constexpr int MISC_OFF = LDS_BYTES - 512;
__device__ __forceinline__ unsigned xb_ld(unsigned* p)              { return __hip_atomic_load(p, __ATOMIC_RELAXED, __HIP_MEMORY_SCOPE_AGENT); }
__device__ __forceinline__ unsigned xb_add(unsigned* p, unsigned v) { return __hip_atomic_fetch_add(p, v, __ATOMIC_RELAXED, __HIP_MEMORY_SCOPE_AGENT); }
__device__ __forceinline__ unsigned xb_xcc_id() { return (unsigned)__builtin_amdgcn_s_getreg((3 << 11) | 20) & 0xFu; }
#define XB_SPIN(cond, bar) do { unsigned _sp = 0; while (cond) { __builtin_amdgcn_s_sleep(1); \
    if ((++_sp & 255u) == 0u) { if (xb_ld(&(bar)[XB_TMO])) break; if (_sp > XB_SPIN_CAP) { atomicAdd(&(bar)[XB_TMO], 1u); break; } } } } while (0)
__device__ __forceinline__ void xcd_barrier_complete(unsigned* bar, unsigned x, unsigned G, unsigned& nloc, unsigned& nx) {
    unsigned sum, cnt, mine, sp = 0u;
    for (;;) {
        sum = 0u; cnt = 0u; mine = 0u;
#pragma unroll
        for (unsigned j = 0; j < 16; ++j) { const unsigned c = xb_ld(&bar[XB_XCNT(j)]); sum += c; cnt += (c > 0u) ? 1u : 0u; mine = (j == x) ? c : mine; }
        if (sum == G) break;
        __builtin_amdgcn_s_sleep(1);
        if ((++sp & 255u) == 0u) { if (xb_ld(&bar[XB_TMO])) break; if (sp > XB_SPIN_CAP) { atomicAdd(&bar[XB_TMO], 1u); break; } }
    }
    nloc = mine > 0u ? mine : 1u; nx = cnt > 0u ? cnt : 1u;
}
__device__ __forceinline__ void xcd_barrier(unsigned* bar, volatile LAS unsigned* st, unsigned G, int tid) {
    asm volatile("s_waitcnt vmcnt(0)" ::: "memory");
    __syncthreads();
    if (tid == 0) {
        const unsigned x = xb_xcc_id();
        __builtin_amdgcn_s_waitcnt(0);
        unsigned nloc = st[0], nx = st[1];
        if (nloc == 0u) { xcd_barrier_complete(bar, x, G, nloc, nx); st[0] = nloc; st[1] = nx; }
        const unsigned old = xb_add(&bar[XB_XSUB(x)], 1u);
        const unsigned gen = old / nloc;
        if (old + 1u == (gen + 1u) * nloc) {
            __builtin_amdgcn_fence(__ATOMIC_RELEASE, "agent");
            asm volatile("s_waitcnt vmcnt(0)" ::: "memory");
            const unsigned og = xb_add(&bar[XB_TOP], 1u);
            const unsigned tg = og / nx;
            if (og + 1u == (tg + 1u) * nx) xb_add(&bar[XB_TOPGEN], 1u);
            else XB_SPIN(xb_ld(&bar[XB_TOPGEN]) == tg, bar);
            __builtin_amdgcn_fence(__ATOMIC_ACQUIRE, "agent");
            xb_add(&bar[XB_XGEN(x)], 1u);
            asm volatile("s_waitcnt vmcnt(0)" ::: "memory");
        } else {
            XB_SPIN(xb_ld(&bar[XB_XGEN(x)]) == gen, bar);
            __builtin_amdgcn_fence(__ATOMIC_ACQUIRE, "agent");
            asm volatile("s_waitcnt vmcnt(0)" ::: "memory");
        }
    }
    __syncthreads();
}

struct TDesc { const float* W; const float* gain; bf16* WT; int ldw, c0, nv, ldt, row0, k0; };
__device__ __forceinline__ void tload(const TDesc& d, f32x4 (&v)[16], int lane) {
    const int n4 = (lane & 15) * 4, kr = lane >> 4;
    const float* src = d.W + (size_t)(d.k0 + kr) * d.ldw + d.c0 + n4;
    if (n4 < d.nv) {
#pragma unroll
        for (int i = 0; i < 16; ++i) v[i] = __builtin_nontemporal_load((const f32x4*)(src + (size_t)(4 * i) * d.ldw));
    } else {
#pragma unroll
        for (int i = 0; i < 16; ++i) v[i] = (f32x4){0.f, 0.f, 0.f, 0.f};
    }
}
__device__ __forceinline__ void tproc(const TDesc& d, f32x4 (&v)[16], LAS float* scr, int lane) {
    const int n4 = (lane & 15) * 4, kr = lane >> 4;
    if (d.gain) {
#pragma unroll
        for (int i = 0; i < 16; ++i) v[i] = v[i] * d.gain[d.k0 + kr + 4 * i];
    }
#pragma unroll
    for (int i = 0; i < 16; ++i) { LAS float* q = scr + (kr + 4 * i) * 65 + n4; q[0] = v[i][0]; q[1] = v[i][1]; q[2] = v[i][2]; q[3] = v[i][3]; }
    LDS_WAIT(); asm volatile("" ::: "memory");
    const int ch = lane & 7;
#pragma unroll
    for (int j = 0; j < 8; ++j) { const int n = (lane >> 3) + 8 * j; const LAS float* s = scr + (8 * ch) * 65 + n;
        v4u o; o.x = pk2(s[0 * 65], s[1 * 65]); o.y = pk2(s[2 * 65], s[3 * 65]); o.z = pk2(s[4 * 65], s[5 * 65]); o.w = pk2(s[6 * 65], s[7 * 65]);
        if (n < d.nv) *(v4u*)(d.WT + (size_t)(d.row0 + n) * d.ldt + d.k0 + 8 * ch) = o; }
    LDS_WAIT(); asm volatile("" ::: "memory");
}
__device__ __forceinline__ void rms_load(const float* xrow, f32x4 (&v)[8], int lane) {
    const f32x4* xr = (const f32x4*)xrow + lane;
#pragma unroll
    for (int j = 0; j < 8; ++j) v[j] = __builtin_nontemporal_load(xr + 64 * j);
}
__device__ __forceinline__ void rms_finish(f32x4 (&v)[8], const float* g, bf16* orow, int lane) {
    float s = 0.f;
#pragma unroll
    for (int j = 0; j < 8; ++j) s += (v[j].x * v[j].x + v[j].y * v[j].y) + (v[j].z * v[j].z + v[j].w * v[j].w);
    const float rinv = 1.0f / sqrtf(wave_sum(s) * (1.f / DM) + EPS);
    unsigned long long* o8 = (unsigned long long*)orow + lane;
#pragma unroll
    for (int j = 0; j < 8; ++j) { f32x4 gg = g ? ((const f32x4*)g)[64 * j + lane] : (f32x4){1.f, 1.f, 1.f, 1.f};
        o8[64 * j] = (unsigned long long)pk2(v[j].x * rinv * gg.x, v[j].y * rinv * gg.y) | ((unsigned long long)pk2(v[j].z * rinv * gg.z, v[j].w * rinv * gg.w) << 32); }
}
__device__ __forceinline__ void sincos_acc(float angf, float& c, float& s) {
    const double a = (double)angf;
    const double kq = rint(a * 0.63661977236758134308);
    const double r = fma(-kq, 6.123233995736766e-17, fma(-kq, 1.5707963267948966, a));
    const double r2 = r * r;
    double sp = -2.5052108385441718775e-08; sp = fma(sp, r2, 2.7557319223985890653e-06); sp = fma(sp, r2, -1.9841269841269841270e-04); sp = fma(sp, r2, 8.3333333333333332177e-03); sp = fma(sp, r2, -1.6666666666666665741e-01);
    const double sn = fma(sp * r2, r, r) + r2 * r2 * r2 * r2 * r2 * r2 * r * 1.6059043836821614599e-10;
    double cp = 2.0876756987868098979e-09; cp = fma(cp, r2, -2.7557319223985890653e-07); cp = fma(cp, r2, 2.4801587301587301566e-05); cp = fma(cp, r2, -1.3888888888888889419e-03); cp = fma(cp, r2, 4.1666666666666664354e-02); cp = fma(cp, r2, -0.5);
    const double cs = fma(cp, r2, 1.0);
    const int q = ((int)kq) & 3;
    const double sv = (q & 1) ? cs : sn, cv = (q & 1) ? sn : cs;
    s = (float)((q & 2) ? -sv : sv);
    c = (float)(((q + 1) & 2) ? -cv : cv);
}
__device__ __forceinline__ float rope_inv(int i) {
    return (float)exp2(-(double)i * (18.931568569324174 / 16.0));
}

template <int WHICH>
__device__ __forceinline__ void transposes(Frame& F, int gw, int NGW, int lane) {
    unsigned char* ws = F.ptr(IX_WS);
    LAS float* scr = (LAS float*)(F.lds + F.wave * 16640);
    const float* a_w_in = F.fin(IX_A_W_IN); const float* w_out = F.fin(IX_W_OUT); const float* w_kv = F.fin(IX_W_KV); const float* b_w_in = F.fin(IX_B_W_IN);
    const float* norm_g = F.fin(IX_NORM_G); const float* kv_norm_g = F.fin(IX_KV_NORM_G); const float* mem_norm_g = F.fin(IX_MEM_NORM_G); const float* w_mem_kv = F.fin(IX_W_MEM_KV);
    const float* a_w_pool = F.fin(IX_A_W_POOL); const float* cmp_w1 = F.fin(IX_CMP_W1);
    bf16* W1T = WSP(bf16, WS_W1T); bf16* WO0T = WSP(bf16, WS_WO0T); bf16* W4T = WSP(bf16, WS_W4T); bf16* WO1T = WSP(bf16, WS_WO1T);
    bf16* WMT = WSP(bf16, WS_WMT); bf16* WPT = WSP(bf16, WS_WPT); bf16* WC1T = WSP(bf16, WS_WC1T);
#define SEG(W_, ldw_, K_, c0_, nc_, WT_, row0_, gain_) if (!done_) { const int nb_ = ((nc_) + 63) / 64, ni_ = ((K_) / 64) * nb_; \
        if (r < ni_) { const int kb = r / nb_, nb = r % nb_; int nv = (nc_) - nb * 64; nv = nv > 64 ? 64 : nv; \
            d.W = W_; d.gain = gain_; d.WT = WT_; d.ldw = ldw_; d.c0 = (c0_) + nb * 64; d.nv = nv; d.ldt = K_; d.row0 = (row0_) + nb * 64; d.k0 = kb * 64; done_ = true; } else r -= ni_; }
#define TDECODE(it_, dd_) do { TDesc& d = (dd_); int r = (it_); bool done_ = false; \
      if constexpr (WHICH == 0) { \
        SEG(a_w_in, N1, DM, 0, N1, W1T, 0, nullptr) \
        SEG(w_mem_kv, 1024, DM, 0, 1024, WMT, 0, mem_norm_g) \
      } else { \
        SEG(w_out, DM, DM, 0, DM, WO0T, 0, nullptr) \
        SEG(w_out + (size_t)DM * DM, DM, DM, 0, DM, WO1T, 0, nullptr) \
        SEG(w_kv, NKV, DM, 0, NKV, W4T, 0, kv_norm_g) \
        SEG(b_w_in, 4132, DM, 0, 1536, W4T, 3072, norm_g + DM)            \
        SEG(b_w_in, 4132, DM, 1572, 1536, W4T, 4608, norm_g + DM)         \
        SEG(b_w_in, 4132, DM, 3108, 512, W4T, 6144, norm_g + DM)          \
        SEG(b_w_in, 4132, DM, 3620, 512, W4T, 6656, norm_g + DM)          \
        SEG(b_w_in, 4132, DM, 1536, 36, W4T, 7168, norm_g + DM)           \
        SEG(w_mem_kv + (size_t)DM * 1024, 1024, DM, 0, 1024, WMT + (size_t)1024 * DM, 0, mem_norm_g + DM) \
        SEG(a_w_pool + 0 * 384 * 384, 384, 384, 0, 384, WPT + 0 * 512 * 384, 0, nullptr) \
        SEG(a_w_pool + 1 * 384 * 384, 384, 384, 0, 384, WPT + 1 * 512 * 384, 0, nullptr) \
        SEG(a_w_pool + 2 * 384 * 384, 384, 384, 0, 384, WPT + 2 * 512 * 384, 0, nullptr) \
        SEG(a_w_pool + 3 * 384 * 384, 384, 384, 0, 384, WPT + 3 * 512 * 384, 0, nullptr) \
        SEG(cmp_w1, 256, 4096, 0, 256, WC1T, 0, nullptr) \
        SEG(cmp_w1 + (size_t)4096 * 256, 256, 4096, 0, 256, WC1T + (size_t)256 * 4096, 0, nullptr) \
      } \
    } while (0)
    constexpr int NITEMS = WHICH == 0 ? 32 * 64 + 32 * 16 : 2 * 32 * 32 + 32 * 48 + 32 * (24 + 24 + 8 + 8 + 1) + 32 * 16 + 4 * 6 * 6 + 2 * 64 * 4;
    {
        TDesc da{}, db{}; f32x4 va[16], vb[16];
        if (gw < NITEMS) { TDECODE(gw, da); tload(da, va, lane); }
        for (int it = gw; it < NITEMS; it += 2 * NGW) {
            const bool hb = it + NGW < NITEMS;
            if (hb) { TDECODE(it + NGW, db); tload(db, vb, lane); }
            tproc(da, va, scr, lane);
            if (it + 2 * NGW < NITEMS) { TDECODE(it + 2 * NGW, da); tload(da, va, lane); }
            if (hb) tproc(db, vb, scr, lane);
        }
    }
#undef TDECODE
#undef SEG
}

__device__ __forceinline__ void p0_prologue(Frame& F) {
    const int tid = F.tid(), lane = tid & 63; unsigned char* ws = F.ptr(IX_WS);
    const int gw = F.vcu * NWAVES + F.wave, NGW = F.G * NWAVES;
    const float* norm_g = F.fin(IX_NORM_G); const float* cmp_w1 = F.fin(IX_CMP_W1);
    bf16* W4T = WSP(bf16, WS_W4T); bf16* WPT = WSP(bf16, WS_WPT);
    transposes<0>(F, gw, NGW, lane);
    transposes<1>(F, gw, NGW, lane);
    bf16* XN = WSP(bf16, WS_B); bf16* MEMN = WSP(bf16, WS_MEMN);
    { const float* xin = F.fin(IX_X); const float* memin = F.fin(IX_MEM);
      constexpr int NROWS = MTOK + NB * MEMLEN;
      for (int m = gw; m < NROWS; m += 4 * NGW) {
          f32x4 a[8], b[8], c[8], d[8];
          const int m1 = m + NGW, m2 = m + 2 * NGW, m3 = m + 3 * NGW;
#define RSRC(mm) ((mm) < MTOK ? xin + (size_t)(mm) * DM : memin + (size_t)((mm) - MTOK) * DM)
#define RFIN(mm, v) do { if ((mm) < MTOK) rms_finish(v, norm_g, XN + (size_t)(mm) * DM, lane); else rms_finish(v, nullptr, MEMN + (size_t)((mm) - MTOK) * DM, lane); } while (0)
          rms_load(RSRC(m), a, lane);
          if (m1 < NROWS) rms_load(RSRC(m1), b, lane);
          if (m2 < NROWS) rms_load(RSRC(m2), c, lane);
          if (m3 < NROWS) rms_load(RSRC(m3), d, lane);
          RFIN(m, a);
          if (m1 < NROWS) RFIN(m1, b);
          if (m2 < NROWS) RFIN(m2, c);
          if (m3 < NROWS) RFIN(m3, d);
#undef RSRC
#undef RFIN
      } }
    const int gt = F.vcu * NTHREADS + tid, NGT = F.G * NTHREADS; const int* positions = (const int*)F.ptr(IX_POS);
    float* ROPE = WSP(float, WS_ROPE); float* ROPEC = WSP(float, WS_ROPEC);
    {
    for (int i = gt; i < MTOK * 16; i += NGT) { const int tok = i >> 4, fi = i & 15;
        const float ang = (float)positions[tok] * rope_inv(fi); float c, s; sincos_acc(ang, c, s);
        ROPE[tok * 32 + fi] = c; ROPE[tok * 32 + 16 + fi] = s; }
    for (int i = gt; i < NB * 256 * 16; i += NGT) { const int bn = i >> 4, fi = i & 15, b = bn >> 8, n = bn & 255;
        float c = 1.f, s = 0.f;
        if (n < NCMP) { const float ang = (float)positions[b * SEQ + 16 * n + 31] * rope_inv(fi); sincos_acc(ang, c, s); }
        ROPEC[bn * 32 + fi] = c; ROPEC[bn * 32 + 16 + fi] = s; }
    }
    { v4u z = {0u, 0u, 0u, 0u};
      v4u* p = (v4u*)(W4T + (size_t)7204 * DM); for (int i = gt; i < 220 * DM / 8; i += NGT) p[i] = z;
      for (int g = 0; g < 4; ++g) { v4u* q = (v4u*)(WPT + (size_t)g * 512 * 384 + 384 * 384); for (int i = gt; i < 128 * 384 / 8; i += NGT) q[i] = z; }
      v4u* kvp = (v4u*)(WSP(bf16, WS_KVB) + (size_t)MTOK * NKV); for (int i = gt; i < 32 * NKV / 8; i += NGT) kvp[i] = z;
      for (int b = 0; b < NB; ++b) { v4u* k = (v4u*)(WSP(bf16, WS_KCMP) + (size_t)(b * 256 + 255) * 512); v4u* v = (v4u*)(WSP(bf16, WS_VCMP) + (size_t)(b * 256 + 255) * 512);
          for (int i = gt; i < 512 / 8; i += NGT) { k[i] = z; v[i] = z; } } }
    { const float* w2 = F.fin(IX_CMP_W2); bf16* W2T = WSP(bf16, WS_W2T);
      for (int i = gt; i < 2 * 128 * 256; i += NGT) { const int k = i & 255, n = (i >> 8) & 127, kv = i >> 15; W2T[i] = (bf16)f2bf(w2[((size_t)kv * 256 + k) * 128 + n]); } }
    __syncthreads();
    for (int item = F.vcu; item < 64; item += F.G) {
        const int ks = item & 7, kv = (item >> 3) & 1, j = (item >> 4) * 64 + lane; const float* pe = F.fin(IX_CMP_PE) + kv * 4096; const float* w1 = cmp_w1 + (size_t)kv * 4096 * 256;
        float a = 0.f; const int kb = ks * 512 + F.wave * 64;
#pragma unroll 8
        for (int k = kb; k < kb + 64; ++k) a = fmaf(pe[k], w1[(size_t)k * 256 + j], a);
        LAS float* red = (LAS float*)F.lds;
        red[F.wave * 64 + lane] = a; __syncthreads();
        if (F.wave == 0) { float t = 0.f; for (int w = 0; w < 8; ++w) t += red[w * 64 + lane]; WSP(float, WS_CBIAS)[(ks * 2 + kv) * 256 + j] = t; }
        __syncthreads();
    }
}

__device__ __forceinline__ void st_bf4(bf16* p, f32x4 v) { v2u w; w.x = cvtpk(v[0], v[1]); w.y = cvtpk(v[2], v[3]); *(v2u*)p = w; }
__device__ __forceinline__ f32x4 silu4(f32x4 v) { return (f32x4){silu_f(v[0]), silu_f(v[1]), silu_f(v[2]), silu_f(v[3])}; }
__device__ __forceinline__ void p2_pool(Frame& F) {
    unsigned char* ws = F.ptr(IX_WS);
    {
        const float* SL = (const float*)(ws + WS_D); bf16* MKV0 = WSP(bf16, WS_MKV);
        const int gt0 = F.vcu * NTHREADS + F.tid(), NGT0 = F.G * NTHREADS;
        for (int i = gt0; i < 2 * 1024 * 1024 / 4; i += NGT0) { const float* s0 = SL + (size_t)(i >> 18) * 8 * 1024 * 1024 + (size_t)(i & 262143) * 4; f32x4 a = *(const f32x4*)s0;
#pragma unroll
            for (int z = 1; z < 8; ++z) a += *(const f32x4*)(s0 + (size_t)z * 1024 * 1024);
            st_bf4(MKV0 + (size_t)i * 4, a); }
    }
    const bf16* PROJ = WSP(bf16, WS_A); bf16* POOLED = WSP(bf16, WS_C);
    const int gt = F.vcu * NTHREADS + F.tid(), NGT = F.G * NTHREADS;
    constexpr int NV = POOLW / 8;
    for (int idx = gt; idx < (MTOK / 32) * NV; idx += NGT) {
        const int vec = idx % NV, chunk = idx / NV, g = vec / 48, win = 2 << g;
        const int row0 = chunk * 32, tb0 = row0 & (SEQ - 1);
        const bf16* up = PROJ + (size_t)row0 * N1 + vec * 8;
        float S[8];
#pragma unroll
        for (int e = 0; e < 8; ++e) S[e] = 0.f;
#define P2_ADD(V_, sg) do { const v4u q_ = (V_); S[0] sg bflo(q_.x); S[1] sg bfhi(q_.x); S[2] sg bflo(q_.y); S[3] sg bfhi(q_.y); S[4] sg bflo(q_.z); S[5] sg bfhi(q_.z); S[6] sg bflo(q_.w); S[7] sg bfhi(q_.w); } while (0)
        {
            v4u hw[15];
#pragma unroll
            for (int i = 1; i < 16; ++i) hw[i - 1] = (i < win && tb0 - i >= 0) ? *(const v4u*)(up - (size_t)i * N1) : (v4u){0u, 0u, 0u, 0u};
#pragma unroll
            for (int i = 0; i < 15; ++i) P2_ADD(hw[i], +=);
        }
#pragma unroll 1
        for (int t8 = 0; t8 < 32; t8 += 8) {
            v4u w[8], x[8];
#pragma unroll
            for (int e = 0; e < 8; ++e) w[e] = *(const v4u*)(up + (size_t)(t8 + e) * N1);
#pragma unroll
            for (int e = 0; e < 8; ++e) { const int tt = t8 + e - win + 1; x[e] = (tb0 + tt >= 0) ? *(const v4u*)(up + (ptrdiff_t)tt * N1) : (v4u){0u, 0u, 0u, 0u}; }
#pragma unroll
            for (int e = 0; e < 8; ++e) {
                const float u[8] = {bflo(w[e].x), bfhi(w[e].x), bflo(w[e].y), bfhi(w[e].y), bflo(w[e].z), bfhi(w[e].z), bflo(w[e].w), bfhi(w[e].w)};
                const int tb = tb0 + t8 + e; const float inv = 1.0f / (float)(tb + 1 < win ? tb + 1 : win);
                float o[8];
#pragma unroll
                for (int c = 0; c < 8; ++c) { S[c] += u[c]; o[c] = S[c] * inv - u[c]; }
                v4u ow; ow.x = pk2(o[0], o[1]); ow.y = pk2(o[2], o[3]); ow.z = pk2(o[4], o[5]); ow.w = pk2(o[6], o[7]);
                *(v4u*)(POOLED + (size_t)(row0 + t8 + e) * POOLW + vec * 8) = ow;
                P2_ADD(x[e], -=);
            }
        }
#undef P2_ADD
    }
}

struct SchedLin {
    int nM, nN, nz, G, c, wgm;
    const char* A; const char* B; size_t a_pm, a_z, b_pn, b_z;
    int xM, xN; const char* XA; const char* XB; size_t xa_pm, xb_pn;
    __device__ __forceinline__ bool next(int i, pg8::Unit& u) const {
        const long L = (long)i * G + c; const int per = nM * nN; const long tot = (long)per * nz;
        if (L < tot) { const int z = (int)(L / per); int pm, pn; pg8::tile_swz((int)(L % per), nM, nN, wgm, pm, pn);
            u.pm = pm; u.pn = pn; u.z = z; u.kind = 0; u.a = A + pm * a_pm + z * a_z; u.b = B + pn * b_pn + z * b_z; return true; }
        const long X = L - tot; if (X >= (long)xM * xN) return false;
        u.pm = (int)(X / xN); u.pn = (int)(X % xN); u.z = 0; u.kind = 1; u.a = XA + u.pm * xa_pm; u.b = XB + u.pn * xb_pn; return true;
    }
};
struct SchedCmp {
    int G, c; const char* KV; const char* W;
    __device__ __forceinline__ bool next(int i, pg8::Unit& u) const {
        const int L = i * G + c; if (L >= 256) return false;
        const int pm = L & 15, kv = (L >> 4) & 1, ks = L >> 5, b = pm >> 2, g = pm & 3;
        u.pm = pm; u.pn = 0; u.z = ks * 2 + kv; u.kind = 0;
        u.a = KV + ((size_t)((kv * 4 + b) * 4 + g) * SEQ * 128 + ks * 512) * 2;
        u.b = W + ((size_t)kv * 256 * 4096 + ks * 512) * 2;
        return true;
    }
};

struct SchedMem {
    int G, c; const char* A; const char* B;
    __device__ __forceinline__ bool next(int i, pg8::Unit& u) const {
        const int L = i * G + c; if (L >= 256) return false;
        const int pm = L & 3, pn = (L >> 2) & 3, ks = (L >> 4) & 7, layer = L >> 7;
        u.pm = pm; u.pn = pn; u.z = layer * 8 + ks; u.kind = 0;
        u.a = A + (size_t)pm * 256 * DM * 2 + ks * 512;
        u.b = B + ((size_t)layer * 1024 + pn * 256) * DM * 2 + ks * 512;
        return true;
    }
};
struct SchedGate {
    int G, c; const char* A; const char* B;
    __device__ __forceinline__ bool next(int i, pg8::Unit& u) const {
        const int L = i * G + c; if (L >= 256) return false;
        const int pm = L >> 2, ks = L & 3;
        u.pm = pm; u.pn = 0; u.z = ks; u.kind = 0;
        u.a = A + (size_t)pm * 256 * DM * 2 + ks * 1024;
        u.b = B + ks * 1024;
        return true;
    }
};

#define EPI_ROWS(ai, m) (u.pm * 256 + (ai) * 128 + wr * 64 + (m) * 16 + fr)
#define EPI_COL(bj, n) ((bj) * 128 + wc * 32 + (n) * 16 + fq * 4)
typedef f32x4 acc_t[2][2][4][2];

#define EPI_C8(bj) (64 * wc + 32 * (bj) + 8 * fq)
__device__ __forceinline__ void st_bf8(bf16* p, f32x4 a, f32x4 b) { v4u w; w.x = cvtpk(a[0], a[1]); w.y = cvtpk(a[2], a[3]); w.z = cvtpk(b[0], b[1]); w.w = cvtpk(b[2], b[3]); *(v4u*)p = w; }
struct Epi1 {
    static constexpr bool PERM = true;
    bf16* proj;
    struct State {};
    __device__ __forceinline__ void begin(acc_t& acc, State&, const pg8::Unit&, int, int, int, int) const {
#pragma unroll
        for (int a = 0; a < 2; ++a)
#pragma unroll
            for (int b = 0; b < 2; ++b)
#pragma unroll
                for (int m = 0; m < 4; ++m)
#pragma unroll
                    for (int n = 0; n < 2; ++n) acc[a][b][m][n] = (f32x4){0.f, 0.f, 0.f, 0.f};
    }
    __device__ __forceinline__ void operator()(const acc_t& acc, State&, const pg8::Unit& u, int wr, int wc, int fr, int fq) const {
        const bool act = (u.pn >= 6 && u.pn < 12) || u.pn >= 14;
#pragma unroll
        for (int ai = 0; ai < 2; ++ai)
#pragma unroll
            for (int m = 0; m < 4; ++m) { bf16* rowp = proj + (size_t)EPI_ROWS(ai, m) * N1 + u.pn * 256;
#pragma unroll
                for (int bj = 0; bj < 2; ++bj) { f32x4 v0 = acc[ai][bj][m][0], v1 = acc[ai][bj][m][1]; if (act) { v0 = silu4(v0); v1 = silu4(v1); } st_bf8(rowp + EPI_C8(bj), v0, v1); } }
    }
};
struct Epi3 {
    static constexpr bool PERM = true;
    const float* scale; const bf16* proj; bf16* y0;
    struct State {};
    __device__ __forceinline__ void begin(acc_t& acc, State&, const pg8::Unit&, int, int, int, int) const {
#pragma unroll
        for (int a = 0; a < 2; ++a)
#pragma unroll
            for (int b = 0; b < 2; ++b)
#pragma unroll
                for (int m = 0; m < 4; ++m)
#pragma unroll
                    for (int n = 0; n < 2; ++n) acc[a][b][m][n] = (f32x4){0.f, 0.f, 0.f, 0.f};
    }
    __device__ __forceinline__ void operator()(const acc_t& acc, State&, const pg8::Unit& u, int wr, int wc, int fr, int fq) const {
        const int g = u.z;
#pragma unroll
        for (int ai = 0; ai < 2; ++ai)
#pragma unroll
            for (int m = 0; m < 4; ++m) { const size_t row = EPI_ROWS(ai, m);
#pragma unroll
                for (int bj = 0; bj < 2; ++bj) { const int d = u.pn * 256 + EPI_C8(bj);
                    if (d < 384) {
                        const f32x4 sc0 = *(const f32x4*)(scale + g * 384 + d), sc1 = *(const f32x4*)(scale + g * 384 + d + 4);
                        const v4u zw = *(const v4u*)(proj + row * N1 + POOLW + g * 384 + d);
                        f32x4 v0 = acc[ai][bj][m][0] * sc0, v1 = acc[ai][bj][m][1] * sc1;
                        v0[0] *= bflo(zw.x); v0[1] *= bfhi(zw.x); v0[2] *= bflo(zw.y); v0[3] *= bfhi(zw.y); v1[0] *= bflo(zw.z); v1[1] *= bfhi(zw.z); v1[2] *= bflo(zw.w); v1[3] *= bfhi(zw.w);
                        st_bf8(y0 + row * DM + g * 384 + d, v0, v1); } }
                asm volatile("" ::: "memory"); }
    }
};
template <bool RES_BF16>
struct EpiRes {
    static constexpr bool PERM = true;
    const void* res; bf16* hb; float* ss;
    struct State {};
    __device__ __forceinline__ void begin(acc_t& acc, State&, const pg8::Unit& u, int wr, int wc, int fr, int fq) const {
#pragma unroll
        for (int ai = 0; ai < 2; ++ai)
#pragma unroll
            for (int m = 0; m < 4; ++m) { const size_t row = EPI_ROWS(ai, m);
#pragma unroll
                for (int bj = 0; bj < 2; ++bj) { const size_t off = row * DM + u.pn * 256 + EPI_C8(bj);
                    if constexpr (RES_BF16) { const v4u w = *(const v4u*)((const bf16*)res + off);
                        acc[ai][bj][m][0] = (f32x4){bflo(w.x), bfhi(w.x), bflo(w.y), bfhi(w.y)}; acc[ai][bj][m][1] = (f32x4){bflo(w.z), bfhi(w.z), bflo(w.w), bfhi(w.w)}; }
                    else { acc[ai][bj][m][0] = __builtin_nontemporal_load((const f32x4*)((const float*)res + off)); acc[ai][bj][m][1] = __builtin_nontemporal_load((const f32x4*)((const float*)res + off + 4)); } } }
    }
    __device__ __forceinline__ void operator()(const acc_t& acc, State&, const pg8::Unit& u, int wr, int wc, int fr, int fq) const {
#pragma unroll
        for (int ai = 0; ai < 2; ++ai)
#pragma unroll
            for (int m = 0; m < 4; ++m) { const size_t row = EPI_ROWS(ai, m); float s = 0.f;
#pragma unroll
                for (int bj = 0; bj < 2; ++bj) { const f32x4 h0 = acc[ai][bj][m][0], h1 = acc[ai][bj][m][1];
                    st_bf8(hb + row * DM + u.pn * 256 + EPI_C8(bj), h0, h1);
                    s += (h0[0] * h0[0] + h0[1] * h0[1]) + (h0[2] * h0[2] + h0[3] * h0[3]) + (h1[0] * h1[0] + h1[1] * h1[1]) + (h1[2] * h1[2] + h1[3] * h1[3]); }
                s += __shfl_xor(s, 16); s += __shfl_xor(s, 32);
                if (fq == 0) ss[row * 32 + u.pn * 4 + wc] = s; }
    }
};
struct Epi5 {
    static constexpr bool PERM = true;
    const float* rinv1; bf16 *kv, *q1, *zq, *qm1, *zm1;
    struct State { float rinv[2][4]; };
    __device__ __forceinline__ void begin(acc_t& acc, State& st, const pg8::Unit& u, int wr, int wc, int fr, int fq) const {
#pragma unroll
        for (int a = 0; a < 2; ++a)
#pragma unroll
            for (int b = 0; b < 2; ++b)
#pragma unroll
                for (int m = 0; m < 4; ++m)
#pragma unroll
                    for (int n = 0; n < 2; ++n) acc[a][b][m][n] = (f32x4){0.f, 0.f, 0.f, 0.f};
#pragma unroll
        for (int ai = 0; ai < 2; ++ai)
#pragma unroll
            for (int m = 0; m < 4; ++m) st.rinv[ai][m] = rinv1[EPI_ROWS(ai, m)];
    }
    __device__ __forceinline__ void operator()(const acc_t& acc, State& st, const pg8::Unit& u, int wr, int wc, int fr, int fq) const {
        const int pn = u.pn;
        bf16* base; int ld, c0; bool act = false;
        const bool kvt = pn < 12;
        if (kvt) { base = kv; ld = 128; c0 = 0; }
        else if (pn < 18) { base = q1; ld = NSAW; c0 = (pn - 12) * 256; }
        else if (pn < 24) { base = zq; ld = NSAW; c0 = (pn - 18) * 256; act = true; }
        else if (pn < 26) { base = qm1; ld = MEMW; c0 = (pn - 24) * 256; }
        else { base = zm1; ld = MEMW; c0 = (pn - 26) * 256; act = true; }
#pragma unroll
        for (int ai = 0; ai < 2; ++ai)
#pragma unroll
            for (int m = 0; m < 4; ++m) { const size_t row = EPI_ROWS(ai, m);
                const float rinv = st.rinv[ai][m];
#pragma unroll
                for (int bj = 0; bj < 2; ++bj) {
                    f32x4 v0 = acc[ai][bj][m][0] * rinv, v1 = acc[ai][bj][m][1] * rinv;
                    if (act) { v0 = silu4(v0); v1 = silu4(v1); }
                    if (kvt) { const int g = (pn & 1) * 2 + (wc >> 1), d = 64 * (wc & 1) + 32 * bj + 8 * fq; const size_t b = row >> 12, t = row & (SEQ - 1);
                        st_bf8(kv + ((((size_t)(pn >> 1) * 4 + b) * 4 + g) * SEQ + t) * 128 + d, v0, v1); }
                    else st_bf8(base + row * ld + c0 + EPI_C8(bj), v0, v1); } }
    }
};
struct Epi6 {
    static constexpr bool PERM = false;
    float* base; int ld; size_t plane;
    struct State {};
    __device__ __forceinline__ void begin(acc_t& acc, State&, const pg8::Unit&, int, int, int, int) const {
#pragma unroll
        for (int a = 0; a < 2; ++a)
#pragma unroll
            for (int b = 0; b < 2; ++b)
#pragma unroll
                for (int m = 0; m < 4; ++m)
#pragma unroll
                    for (int n = 0; n < 2; ++n) acc[a][b][m][n] = (f32x4){0.f, 0.f, 0.f, 0.f};
    }
    __device__ __forceinline__ void operator()(const acc_t& acc, State&, const pg8::Unit& u, int wr, int wc, int fr, int fq) const {
        float* b0 = base + (size_t)u.z * plane + u.pn * 256;
#pragma unroll
        for (int ai = 0; ai < 2; ++ai)
#pragma unroll
            for (int m = 0; m < 4; ++m) { float* rowp = b0 + (size_t)EPI_ROWS(ai, m) * ld;
#pragma unroll
                for (int bj = 0; bj < 2; ++bj)
#pragma unroll
                    for (int n = 0; n < 2; ++n) *(f32x4*)(rowp + EPI_COL(bj, n)) = acc[ai][bj][m][n]; }
    }
};
struct EpiG {
    static constexpr bool PERM = true;
    float* slab;
    struct State {};
    __device__ __forceinline__ void begin(acc_t& acc, State&, const pg8::Unit&, int, int, int, int) const {
#pragma unroll
        for (int a = 0; a < 2; ++a)
#pragma unroll
            for (int b = 0; b < 2; ++b)
#pragma unroll
                for (int m = 0; m < 4; ++m)
#pragma unroll
                    for (int n = 0; n < 2; ++n) acc[a][b][m][n] = (f32x4){0.f, 0.f, 0.f, 0.f};
    }
    __device__ __forceinline__ void operator()(const acc_t& acc, State&, const pg8::Unit& u, int wr, int wc, int fr, int fq) const {
        if (wc != 0) return;
        float* b0 = slab + (size_t)u.z * MTOK * 36;
#pragma unroll
        for (int ai = 0; ai < 2; ++ai)
#pragma unroll
            for (int m = 0; m < 4; ++m) { float* rowp = b0 + (size_t)EPI_ROWS(ai, m) * 36;
                *(f32x4*)(rowp + 8 * fq) = acc[ai][0][m][0]; *(f32x4*)(rowp + 8 * fq + 4) = acc[ai][0][m][1];
                if (fq == 0) *(f32x4*)(rowp + 32) = acc[ai][1][m][0]; }
    }
};

__device__ __forceinline__ void rinv_pass(Frame& F) {
    unsigned char* ws = F.ptr(IX_WS); const float* SS1 = WSP(float, WS_SS1); float* RINV = WSP(float, WS_RINV1);
    const int gt = F.vcu * NTHREADS + F.tid(), NGT = F.G * NTHREADS;
    for (int i = gt; i < MTOK * 4; i += NGT) { const int row = i >> 2, q = i & 3;
        const f32x4 a = *(const f32x4*)(SS1 + (size_t)row * 32 + q * 8), b = *(const f32x4*)(SS1 + (size_t)row * 32 + q * 8 + 4);
        float s = ((a[0] + a[1]) + (a[2] + a[3])) + ((b[0] + b[1]) + (b[2] + b[3]));
        s += __shfl_xor(s, 1); s += __shfl_xor(s, 2);
        if (q == 0) RINV[row] = 1.0f / sqrtf(s * (1.f / DM) + EPS); }
}
__device__ __forceinline__ void gates_finish(Frame& F) {
    unsigned char* ws = F.ptr(IX_WS); const float* SL = WSP(float, WS_C); const float* RINV = WSP(float, WS_RINV1); float* GATES = WSP(float, WS_GATES);
    const int gt = F.vcu * NTHREADS + F.tid(), NGT = F.G * NTHREADS;
    for (int i = gt; i < MTOK * 9; i += NGT) { const int row = i / 9, c4 = (i - row * 9) * 4;
        const float rinv = RINV[row];
        f32x4 a = *(const f32x4*)(SL + (size_t)row * 36 + c4);
#pragma unroll
        for (int z = 1; z < 4; ++z) a += *(const f32x4*)(SL + (size_t)z * MTOK * 36 + (size_t)row * 36 + c4);
        a = a * rinv;
        *(f32x4*)(GATES + (size_t)row * 36 + c4) = (f32x4){sigmoid_f(a[0]), sigmoid_f(a[1]), sigmoid_f(a[2]), sigmoid_f(a[3])}; }
}
__device__ __forceinline__ void rope_pass(Frame& F) {
    unsigned char* ws = F.ptr(IX_WS); bf16* Q1 = WSP(bf16, WS_Q1); bf16* KV = WSP(bf16, WS_KVB); const float* ROPE = WSP(float, WS_ROPE);
    const int gt = F.vcu * NTHREADS + F.tid(), NGT = F.G * NTHREADS;
    constexpr int NQI = MTOK * NHEAD * 2, NKI = 2 * MTOK * NKVH * 2, NI = NQI + NKI;
    for (int i0 = gt; i0 < NI; i0 += 5 * NGT) {
        bf16* pp[5]; v4u x1[5], x2[5]; f32x4 c0[5], c1[5], s0[5], s1[5];
#pragma unroll
        for (int e = 0; e < 5; ++e) { const int i = i0 + e * NGT; pp[e] = nullptr;
            if (i < NI) { const int q = i & 1; int row; bf16* p;
                if (i < NQI) { const int rh = i >> 1; row = rh / NHEAD; p = Q1 + (size_t)row * NSAW + (rh - row * NHEAD) * 128; }
                else { const int k = (i - NQI) >> 1, t = k & (SEQ - 1), sg = k >> 12, kind = 2 + 2 * (sg >> 4), bg = sg & 15;
                    row = (bg >> 2) * SEQ + t; p = KV + (((size_t)kind * 16 + bg) * SEQ + t) * 128; }
                p += 8 * q; pp[e] = p; const float* rp = ROPE + (size_t)row * 32 + 8 * q;
                x1[e] = *(const v4u*)p; x2[e] = *(const v4u*)(p + 16);
                c0[e] = *(const f32x4*)rp; c1[e] = *(const f32x4*)(rp + 4); s0[e] = *(const f32x4*)(rp + 16); s1[e] = *(const f32x4*)(rp + 20); } }
#pragma unroll
        for (int e = 0; e < 5; ++e) if (pp[e]) {
            const f32x4 a0 = {bflo(x1[e].x), bfhi(x1[e].x), bflo(x1[e].y), bfhi(x1[e].y)}, a1 = {bflo(x1[e].z), bfhi(x1[e].z), bflo(x1[e].w), bfhi(x1[e].w)};
            const f32x4 b0 = {bflo(x2[e].x), bfhi(x2[e].x), bflo(x2[e].y), bfhi(x2[e].y)}, b1 = {bflo(x2[e].z), bfhi(x2[e].z), bflo(x2[e].w), bfhi(x2[e].w)};
            st_bf8(pp[e], a0 * c0[e] - b0 * s0[e], a1 * c1[e] - b1 * s1[e]);
            st_bf8(pp[e] + 16, b0 * c0[e] + a0 * s0[e], b1 * c1[e] + a1 * s1[e]); }
    }
}
__device__ __forceinline__ void p7_cmp2(Frame& F) {
    unsigned char* ws = F.ptr(IX_WS); bf16* KCo = WSP(bf16, WS_KCMP); bf16* VCo = WSP(bf16, WS_VCMP);
    const float* HID = WSP(float, WS_B); const float* CB = WSP(float, WS_CBIAS); const float* ROPEC = WSP(float, WS_ROPEC); const bf16* W2T = WSP(bf16, WS_W2T);
    constexpr int HP = 528;
    LAS unsigned char* hb = F.lds;
    LAS float* os = (LAS float*)(F.lds + 32 * HP);
    for (int unit = F.vcu; unit < 256; unit += F.G) {
        const int tid = F.tid(), lane = tid & 63, wv = __builtin_amdgcn_readfirstlane(tid >> 6), fr = lane & 15, fq = lane >> 4;
        const int kv = unit >> 7, row0 = (unit & 127) * 32;
        {
            const int r = tid >> 4, c16 = (tid & 15) * 16;
            f32x4 a[4] = {{0.f, 0.f, 0.f, 0.f}, {0.f, 0.f, 0.f, 0.f}, {0.f, 0.f, 0.f, 0.f}, {0.f, 0.f, 0.f, 0.f}};
#pragma unroll
            for (int ks = 0; ks < 8; ++ks) { const float* pp = HID + ((size_t)(ks * 2 + kv) * 4096 + row0 + r) * 256 + c16;
#pragma unroll
                for (int e = 0; e < 4; ++e) a[e] += *(const f32x4*)(pp + 4 * e); }
#pragma unroll
            for (int ks = 0; ks < 8; ++ks) { const float* cb = CB + (ks * 2 + kv) * 256 + c16;
#pragma unroll
                for (int e = 0; e < 4; ++e) a[e] += *(const f32x4*)(cb + 4 * e); }
            v4u w0, w1;
            w0.x = cvtpk(silu_f(a[0][0]), silu_f(a[0][1])); w0.y = cvtpk(silu_f(a[0][2]), silu_f(a[0][3])); w0.z = cvtpk(silu_f(a[1][0]), silu_f(a[1][1])); w0.w = cvtpk(silu_f(a[1][2]), silu_f(a[1][3]));
            w1.x = cvtpk(silu_f(a[2][0]), silu_f(a[2][1])); w1.y = cvtpk(silu_f(a[2][2]), silu_f(a[2][3])); w1.z = cvtpk(silu_f(a[3][0]), silu_f(a[3][1])); w1.w = cvtpk(silu_f(a[3][2]), silu_f(a[3][3]));
            *(LAS v4u*)(hb + r * HP + c16 * 2) = w0; *(LAS v4u*)(hb + r * HP + c16 * 2 + 16) = w1;
        }
        bf16x8 bfr[8];
        { const bf16* wrow = W2T + ((size_t)kv * 128 + 16 * wv + fr) * 256 + 8 * fq;
#pragma unroll
          for (int ks = 0; ks < 8; ++ks) bfr[ks] = *(const bf16x8*)(wrow + 32 * ks); }
        __syncthreads();
        {
            f32x4 d0 = {0.f, 0.f, 0.f, 0.f}, d1 = {0.f, 0.f, 0.f, 0.f};
#pragma unroll
            for (int ks = 0; ks < 8; ++ks) {
                const bf16x8 a0 = *(const LAS bf16x8*)(hb + fr * HP + (32 * ks + 8 * fq) * 2), a1 = *(const LAS bf16x8*)(hb + (16 + fr) * HP + (32 * ks + 8 * fq) * 2);
                d0 = __builtin_amdgcn_mfma_f32_16x16x32_bf16(a0, bfr[ks], d0, 0, 0, 0);
                d1 = __builtin_amdgcn_mfma_f32_16x16x32_bf16(a1, bfr[ks], d1, 0, 0, 0); }
#pragma unroll
            for (int j = 0; j < 4; ++j) { os[(4 * fq + j) * 128 + 16 * wv + fr] = d0[j]; os[(16 + 4 * fq + j) * 128 + 16 * wv + fr] = d1[j]; }
        }
        __syncthreads();
        {
            const int r = tid >> 4, d8 = (tid & 15) * 8;
            const int row = row0 + r, bg = row >> 8, n = row & 255, b = bg >> 2, g = bg & 3;
            if (n < NCMP) {
                float o[8];
#pragma unroll
                for (int e = 0; e < 8; ++e) { const int d = d8 + e; float v = os[r * 128 + d];
                    if (kv == 0 && d8 < 32) { const int fi = d & 15; const float c = ROPEC[(b * 256 + n) * 32 + fi], s = ROPEC[(b * 256 + n) * 32 + 16 + fi];
                        v = d8 < 16 ? v * c - os[r * 128 + d + 16] * s : v * c + os[r * 128 + d - 16] * s; }
                    o[e] = v; }
                bf16* dst = (kv == 0 ? KCo : VCo) + (size_t)(b * 256 + n) * 512 + g * 128 + d8;
                v4u w; w.x = pk2(o[0], o[1]); w.y = pk2(o[2], o[3]); w.z = pk2(o[4], o[5]); w.w = pk2(o[6], o[7]); *(v4u*)dst = w;
            }
        }
        __syncthreads();
    }
}

__device__ __forceinline__ void p8_select(Frame& F) {
    using namespace att;
    char* lds = F.ldsg; unsigned char* ws = F.ptr(IX_WS);
    const bf16* KC = WSP(bf16, WS_KCMP); const bf16* Q1 = WSP(bf16, WS_Q1); unsigned long long* SEL = WSP(unsigned long long, WS_SEL);
    const int wid = F.wave;
    for (int unit = F.vcu; unit < NB * NKVH * 16; unit += F.G) {
        const int tid = F.tid(), lane = tid & 63, r32 = lane & 31, hi = lane >> 5;
        const int sr = tid >> 4, sc = (tid & 15) * 8;
        const int qt = unit & 15, g = (unit >> 4) & 3, b = unit >> 6;
#pragma unroll
        for (int tt = 0; tt < 4; ++tt)
#pragma unroll
            for (int hf = 0; hf < 2; ++hf) { const int key = tt * 64 + hf * 32 + sr;
                *(bf16x8*)(lds + tt * SHM_K + KSWZ(hf * 32 + sr, sc * 2)) = load8(KC + (size_t)(b * 256 + key) * 512 + g * 128 + sc); }
        __syncthreads();
        const int tw = ((wid < 4) ? qt : 31 - qt) * 128 + (wid & 3) * 32, t = tw + r32, lim = (t - 31) >> 4;
        const int limw = tw >> 4;
        float imp[32];
#pragma unroll
        for (int c = 0; c < 32; ++c) imp[c] = 0.f;
        for (int rr = 0; rr < 3; ++rr) {
            const int h = g * 3 + rr; bf16x8 qr[8];
#pragma unroll
            for (int d0 = 0; d0 < 8; ++d0) qr[d0] = load8(Q1 + (size_t)(b * SEQ + t) * NSAW + h * 128 + d0 * 16 + hi * 8);
            f32x16 s[8];
            SBAR(); qkt<0>(s[0], s[1], lds, r32, hi, qr); SBAR();
            if (limw >= 64) { qkt<1>(s[2], s[3], lds, r32, hi, qr); SBAR(); }
            if (limw >= 128) { qkt<2>(s[4], s[5], lds, r32, hi, qr); SBAR(); }
            if (limw >= 192) { qkt<3>(s[6], s[7], lds, r32, hi, qr); SBAR(); }
            constexpr float C2 = LOG2E * ATT_SCALE; const float NEG = -__builtin_inff();
            float mx = -1e30f;
            int lim2 = lim - 4 * hi; asm volatile("" : "+v"(lim2));
#pragma unroll
            for (int i = 0; i < 8; ++i) if (limw >= (i >> 1) * 64) {
#pragma unroll
                for (int r = 0; r < 16; ++r) { const int key0 = (i >> 1) * 64 + (i & 1) * 32 + (r & 3) + 8 * (r >> 2); const float v = key0 <= lim2 ? s[i][r] * C2 : NEG; s[i][r] = v; mx = fmaxf(mx, v); } }
            { auto q2 = __builtin_amdgcn_permlane32_swap(__float_as_uint(mx), __float_as_uint(mx), false, false); mx = fmaxf(__uint_as_float(q2[0]), __uint_as_float(q2[1])); }
            float sum = 0.f;
#pragma unroll
            for (int i = 0; i < 8; ++i) {
                if (limw >= (i >> 1) * 64) {
#pragma unroll
                    for (int r = 0; r < 16; ++r) { const float p = __builtin_amdgcn_exp2f(s[i][r] - mx); s[i][r] = p; sum += p; }
                } else {
#pragma unroll
                    for (int r = 0; r < 16; ++r) s[i][r] = 0.f; } }
            { auto q2 = __builtin_amdgcn_permlane32_swap(__float_as_uint(sum), __float_as_uint(sum), false, false); sum = __uint_as_float(q2[0]) + __uint_as_float(q2[1]); }
            const float inv = sum > 0.f ? 1.0f / sum : 0.f;
            float prev_pt = 0.f;
#pragma unroll
            for (int c = 0; c < 32; ++c) { const int i = c >> 2, a = c & 3; const float tl = 0.5f * s[i][4 * a + 3] * inv;
                auto q2 = __builtin_amdgcn_permlane32_swap(__float_as_uint(tl), __float_as_uint(tl), false, false);
                const float pt = __uint_as_float(hi ? q2[0] : q2[1]);
                imp[c] += (s[i][4 * a] + s[i][4 * a + 1] + s[i][4 * a + 2]) * inv + tl + (hi ? pt : prev_pt);
                prev_pt = pt; }
        }
        const int cur = t >> 6;
        int hi2 = hi; asm volatile("" : "+v"(hi2));
        unsigned key[32];
#pragma unroll
        for (int c = 0; c < 32; ++c) { const int j = 2 * c + hi2; const bool ok = j <= cur, forced = (j == 0) || (j == cur) || (j == cur - 1);
            const float sc_ = forced ? 1e4f : imp[c];
            key[c] = (ok ? (__float_as_uint(sc_) & ~63u) : 0u) | (unsigned)(63 - j); }
        unsigned T = 0u;
#pragma unroll 1
        for (int bit = 30; bit >= 0; --bit) { const unsigned Tc = T | (1u << bit); unsigned cn = 0u;
#pragma unroll
            for (int c = 0; c < 32; ++c) cn += (key[c] >= Tc) ? 1u : 0u;
            { auto q2 = __builtin_amdgcn_permlane32_swap(cn, cn, false, false); cn = q2[0] + q2[1]; }
            T = cn >= 16u ? Tc : T; }
        unsigned wlo = 0u, whi = 0u;
#pragma unroll
        for (int c = 0; c < 32; ++c) { const unsigned selbit = (key[c] >= T && (2 * c + hi2) <= cur) ? 1u : 0u;
            if (c < 16) wlo |= selbit << (2 * c); else whi |= selbit << (2 * (c - 16)); }
        wlo <<= hi; whi <<= hi;
        { auto q2 = __builtin_amdgcn_permlane32_swap(wlo, wlo, false, false); wlo = q2[0] | q2[1]; }
        { auto q2 = __builtin_amdgcn_permlane32_swap(whi, whi, false, false); whi = q2[0] | q2[1]; }
        if (hi == 0) SEL[(size_t)(b * NKVH + g) * SEQ + t] = ((unsigned long long)whi << 32) | wlo;
        __syncthreads();
    }
}

typedef att::Ctx AttnCtx;
__device__ __forceinline__ void nsa_blk(const AttnCtx& C, int L, int pass, att::Blk& k) {
    const int qt = 15 - L / 48, bh = L % 48, b = bh / 12, h = bh % 12, g = h / 3;
    const int row0 = b * SEQ + qt * 256;
    k.Q = C.Q1 + (size_t)row0 * NSAW + h * 128; k.ldq = NSAW; k.t0 = qt * 256; k.row0 = row0; k.hcol = h * 128; k.bg = b * NKVH + g;
    if (pass == 0) { k.K = C.KV + (size_t)((2 * 4 + b) * 4 + g) * SEQ * 128; k.voff = 16 * SEQ * 128; k.ldk = 128; k.j_lo = 0; k.j_hi = 4 * qt + 4; k.mode = att::MODE_SEL; k.epi = att::EPI_ACC0; k.gcol = h * 3 + 1; }
    else if (pass == 1) { k.K = C.KV + (size_t)((4 * 4 + b) * 4 + g) * SEQ * 128; k.voff = 16 * SEQ * 128; k.ldk = 128; k.j_lo = qt >= 2 ? 4 * qt - 8 : 0; k.j_hi = 4 * qt + 4; k.mode = att::MODE_WIN; k.epi = att::EPI_ACC1; k.gcol = h * 3 + 2; }
    else { k.K = C.KC + (size_t)b * 256 * 512 + g * 128; k.voff = (int)(C.VC - C.KC); k.ldk = 512; k.j_lo = 0; k.j_hi = (qt >> 2) + 1; k.mode = att::MODE_CMP; k.epi = att::EPI_FIN; k.gcol = h * 3 + 0; }
}
__device__ __forceinline__ void mem_blk(const AttnCtx& C, int X, att::Blk& k) {
    const int qt = X & 15, mh = (X >> 4) & 3, b = X >> 6;
    const int row0 = b * SEQ + qt * 256;
    k.Q = C.QM + (size_t)row0 * C.qm_ld + C.qm_c0 + mh * 128; k.ldq = C.qm_ld; k.t0 = qt * 256; k.row0 = row0; k.hcol = mh * 128; k.bg = 0; k.gcol = 0;
    k.K = C.MKV + (size_t)b * 256 * 1024 + mh * 128; k.voff = 512; k.ldk = 1024; k.j_lo = 0; k.j_hi = 4; k.mode = att::MODE_NONE; k.epi = att::EPI_MEM;
}
struct AttnStream {
    int G, c, n_nsa, n_mem, cnt_nsa, total; bool tab;
    __device__ __forceinline__ void init(int G_, int c_, int n_nsa_, int n_mem_) {
        G = G_; c = c_; n_nsa = n_nsa_; n_mem = n_mem_;
        tab = (G == 256 && n_nsa == 768);
        if (tab) { cnt_nsa = 0;
#pragma unroll
            for (int r = 0; r < 4; ++r) cnt_nsa += NSA_TAB[c * 4 + r] != 0xffff ? 1 : 0; }
        else { const int full = n_nsa / G, rem = n_nsa - full * G, pos = (full & 1) ? G - 1 - c : c; cnt_nsa = full + (pos < rem ? 1 : 0); }
        const int cnt_mem = c < n_mem ? (n_mem - c + G - 1) / G : 0;
        total = 3 * cnt_nsa + cnt_mem;
    }
    __device__ __forceinline__ void get(const AttnCtx& C, int s, att::Blk& k) const {
        if (s < 3 * cnt_nsa) { const int r = s / 3, pass = s - 3 * r; const int L = tab ? (int)NSA_TAB[c * 4 + r] : r * G + ((r & 1) ? G - 1 - c : c); nsa_blk(C, L, pass, k); }
        else { const int sm = s - 3 * cnt_nsa; mem_blk(C, sm * G + c, k); }
    }
};
__device__ __forceinline__ void attn_run(Frame& F, const AttnCtx& C, int n_nsa, int n_mem) {
    AttnStream S; S.init(F.G, F.vcu, n_nsa, n_mem);
    if (S.total > 0) {
        att::Blk cur, nxt; att::Seam seam;
        S.get(C, 0, cur);
        att::attn_prime(F.tid(), cur, F.ldsg, seam);
        for (int s = 0; s < S.total; ++s) {
            const int tid = F.tid();
            S.get(C, s, cur);
            S.get(C, s + 1 < S.total ? s + 1 : s, nxt);
            att::attn_block(tid, C, cur, nxt.Q, nxt.K, nxt.voff, nxt.ldq, nxt.ldk, nxt.j_lo, F.ldsg, seam);
        }
    }
    VM_WAIT(); __syncthreads();
}
__device__ __forceinline__ void attn_run_mem(Frame& F, const AttnCtx& C, int n_mem) {
    const int G = F.G, c = F.vcu, cnt = c < n_mem ? (n_mem - c + G - 1) / G : 0;
    if (cnt > 0) {
        att::Blk cur, nxt; att::Seam seam;
        mem_blk(C, c, cur);
        const int tid = F.tid();
        att::attn_prime(tid, cur, F.ldsg, seam);
        for (int s = 0; s < cnt; ++s) {
            mem_blk(C, s * G + c, cur);
            mem_blk(C, (s + 1 < cnt ? s + 1 : s) * G + c, nxt);
            att::attn_block(tid, C, cur, nxt.Q, nxt.K, nxt.voff, nxt.ldq, nxt.ldk, nxt.j_lo, F.ldsg, seam);
        }
    }
    VM_WAIT(); __syncthreads();
}

__device__ __forceinline__ void p11_final(Frame& F) {
    unsigned char* ws = F.ptr(IX_WS); float* out = (float*)F.ptr(IX_OUT); const float* final_g = F.fin(IX_FINAL_G);
    const float* SS2 = WSP(float, WS_SS2); const bf16* H2B = WSP(bf16, WS_C);
    const int gw = F.vcu * NWAVES + F.wave, NGW = F.G * NWAVES, lane = F.tid() & 63;
    f32x4 g[8];
#pragma unroll
    for (int j = 0; j < 8; ++j) g[j] = ((const f32x4*)final_g)[64 * j + lane];
    for (int m = gw; m < MTOK; m += 4 * NGW) {
        v2u a[4][8]; float rv[4];
#pragma unroll
        for (int q = 0; q < 4; ++q) { const int mm = m + q * NGW < MTOK ? m + q * NGW : m; const v2u* p = (const v2u*)(H2B + (size_t)mm * DM) + lane;
#pragma unroll
            for (int j = 0; j < 8; ++j) a[q][j] = __builtin_nontemporal_load(p + 64 * j);
            rv[q] = lane < 32 ? SS2[(size_t)mm * 32 + lane] : 0.f; }
#pragma unroll
        for (int q = 0; q < 4; ++q) { const int mm = m + q * NGW; if (mm < MTOK) {
            const float rinv = 1.0f / sqrtf(wave_sum(rv[q]) * (1.f / DM) + EPS);
            f32x4* o = (f32x4*)(out + (size_t)mm * DM) + lane;
#pragma unroll
            for (int j = 0; j < 8; ++j) __builtin_nontemporal_store((f32x4){bflo(a[q][j].x), bfhi(a[q][j].x), bflo(a[q][j].y), bfhi(a[q][j].y)} * rinv * g[j], o + 64 * j); } }
    }
}

#ifndef WGM_P1
#define WGM_P1 4
#endif
#ifndef WGM_P3
#define WGM_P3 4
#endif
#ifndef WGM_P4
#define WGM_P4 2
#endif
#ifndef WGM_P5
#define WGM_P5 2
#endif
#ifndef WGM_P10
#define WGM_P10 2
#endif
__global__ void __launch_bounds__(NTHREADS, 2) fwd_kernel(Args args) {
    extern __shared__ __attribute__((aligned(16))) unsigned char lds[];
    Frame F;
    F.lds = (LAS unsigned char*)lds; F.ldsg = (char*)lds;
    F.wave = __builtin_amdgcn_readfirstlane((int)threadIdx.x >> 6);
    F.G = gridDim.x; { const int bx = blockIdx.x; F.vcu = (F.G % 8 == 0) ? (bx % 8) * (F.G / 8) + bx / 8 : bx; }
    if (threadIdx.x < 19) { const unsigned long long v = threadIdx.x < 17 ? (unsigned long long)args.in[threadIdx.x < 17 ? threadIdx.x : 0] : (threadIdx.x == 17 ? (unsigned long long)args.out : (unsigned long long)args.ws);
        ((LAS unsigned long long*)(F.lds + TAB_OFF))[threadIdx.x] = v; }
    if (threadIdx.x == 32) { ((LAS unsigned*)(F.lds + MISC_OFF))[0] = 0u; ((LAS unsigned*)(F.lds + MISC_OFF))[1] = 0u; }
    if (!MK_PER_PHASE && threadIdx.x == 0) (void)xb_add((unsigned*)(args.ws + WS_CTL) + 1024 + XB_XCNT(xb_xcc_id()), 1u);
    __syncthreads();
    const int lo = args.ph_lo, hi = args.ph_hi;
#ifndef PH_MASK
#define PH_MASK 0xfff
#endif
#define IN(k) (((PH_MASK >> (k)) & 1) && lo <= (k) && (k) < hi)
#ifndef REPEAT_MASK
#define REPEAT_MASK 0
#endif
#define REPS(k) (1 + ((REPEAT_MASK >> (k)) & 1))
#define GBAR() xcd_barrier((unsigned*)(F.ptr(IX_WS) + WS_CTL) + 1024, (volatile LAS unsigned*)(F.lds + MISC_OFF), (unsigned)F.G, F.tid())
#define SEAM(k) do { if (IN(k) && IN((k) + 1)) xcd_barrier((unsigned*)(F.ptr(IX_WS) + WS_CTL) + 1024, (volatile LAS unsigned*)(F.lds + MISC_OFF), (unsigned)F.G, F.tid()); } while (0)
#ifdef CLKPROBE_A
#define PROBE_T(k, slot) do { if ((k) == ((slot) ? CLKPROBE_B : CLKPROBE_A) && blockIdx.x == 0 && F.tid() == 0) { volatile unsigned long long* pr_ = (volatile unsigned long long*)(F.ptr(IX_WS) + WS_CTL + 32768); pr_[(slot)] = __builtin_amdgcn_s_memrealtime(); pr_[2 + (slot)] = __builtin_amdgcn_s_memtime(); } } while (0)
#else
#define PROBE_T(k, slot) do { } while (0)
#endif
    const size_t TILE_B = (size_t)256 * DM * 2;

    PROBE_T(0, 0);
    if (IN(0)) for (int rep = 0; rep < REPS(0); ++rep) { if (rep) GBAR(); p0_prologue(F); } PROBE_T(0, 1); SEAM(0);
#ifdef DUP0
    GBAR(); p0_prologue(F); GBAR();
#endif

    PROBE_T(1, 0);
    if (IN(1)) for (int rep = 0; rep < REPS(1); ++rep) { if (rep) GBAR(); unsigned char* ws = F.ptr(IX_WS);
        pg8::Geo g{DM, DM, DM / 64, 256};
        SchedLin S{64, 16, 1, F.G, (int)blockIdx.x, WGM_P1, (const char*)WSP(bf16, WS_B), (const char*)WSP(bf16, WS_W1T), TILE_B, 0, TILE_B, 0, 0, 0, nullptr, nullptr, 0, 0};
        Epi1 E{WSP(bf16, WS_A)};
        pg8::gemm_phase<Epi1, SchedLin, true, true>(F.lds, F.tid(), g, S, E);
        {
            pg8::Geo g2{DM, DM, 4, 256};
            SchedMem S2{F.G, (int)blockIdx.x, (const char*)WSP(bf16, WS_MEMN), (const char*)WSP(bf16, WS_WMT)};
            Epi6 E2{(float*)(ws + WS_D), 1024, (size_t)1024 * 1024};
            pg8::gemm_phase<Epi6, SchedMem, true, true>(F.lds, F.tid(), g2, S2, E2);
        }
    } PROBE_T(1, 1); SEAM(1);

#ifdef DUPBAR
    for (int i = 0; i < 10; ++i) GBAR();
#endif
    PROBE_T(2, 0);
    if (IN(2)) for (int rep = 0; rep < REPS(2); ++rep) { if (rep) GBAR(); p2_pool(F); } PROBE_T(2, 1); SEAM(2);

    PROBE_T(3, 0);
    if (IN(3)) for (int rep = 0; rep < REPS(3); ++rep) { if (rep) GBAR(); unsigned char* ws = F.ptr(IX_WS);
        pg8::Geo g{POOLW, 384, 6, 256};
        SchedLin S{64, 2, 4, F.G, (int)blockIdx.x, WGM_P3, (const char*)WSP(bf16, WS_C), (const char*)WSP(bf16, WS_WPT), (size_t)256 * POOLW * 2, (size_t)384 * 2, (size_t)256 * 384 * 2, (size_t)512 * 384 * 2,
                   0, 0, nullptr, nullptr, 0, 0};
        Epi3 E{F.fin(IX_A_POOL_SCALE), WSP(bf16, WS_A), WSP(bf16, WS_B)};
        pg8::gemm_phase<Epi3, SchedLin, true, true>(F.lds, F.tid(), g, S, E);
#ifdef DUP3G
        GBAR(); pg8::gemm_phase<Epi3, SchedLin, true, true>(F.lds, F.tid(), g, S, E);
#endif
        AttnCtx C{}; C.QM = WSP(bf16, WS_A); C.qm_ld = N1; C.qm_c0 = 2 * POOLW; C.ZM = WSP(bf16, WS_A); C.zm_ld = N1; C.zm_c0 = 2 * POOLW + MEMW;
        C.MKV = WSP(bf16, WS_MKV); C.Y = WSP(bf16, WS_B);
#ifndef NO_ATT3
        attn_run_mem(F, C, NB * 4 * 16);
#ifdef DUP3A
        GBAR(); attn_run_mem(F, C, NB * 4 * 16);
#endif
#endif
    } PROBE_T(3, 1); SEAM(3);

    PROBE_T(4, 0);
    if (IN(4)) for (int rep = 0; rep < REPS(4); ++rep) { if (rep) GBAR(); unsigned char* ws = F.ptr(IX_WS);
        pg8::Geo g{DM, DM, DM / 64, 256};
        SchedLin S{64, 8, 1, F.G, (int)blockIdx.x, WGM_P4, (const char*)WSP(bf16, WS_B), (const char*)WSP(bf16, WS_WO0T), TILE_B, 0, TILE_B, 0, 0, 0, nullptr, nullptr, 0, 0};
        bf16* h1b = (bf16*)F.ptr(IX_OUT);
        EpiRes<false> E{F.fin(IX_X), h1b, WSP(float, WS_SS1)};
        pg8::gemm_phase<EpiRes<false>, SchedLin, true, true>(F.lds, F.tid(), g, S, E);
    } PROBE_T(4, 1); SEAM(4);

    PROBE_T(5, 0);
    if (IN(5)) for (int rep = 0; rep < REPS(5); ++rep) { if (rep) GBAR(); unsigned char* ws = F.ptr(IX_WS);
        rinv_pass(F); GBAR();
        pg8::Geo g{DM, DM, DM / 64, 256};
        SchedLin S{64, 28, 1, F.G, (int)blockIdx.x, WGM_P5, (const char*)F.ptr(IX_OUT), (const char*)WSP(bf16, WS_W4T), TILE_B, 0, TILE_B, 0, 0, 0, nullptr, nullptr, 0, 0};
        Epi5 E{WSP(float, WS_RINV1), WSP(bf16, WS_KVB), WSP(bf16, WS_Q1), WSP(bf16, WS_ZQ), WSP(bf16, WS_QM1), WSP(bf16, WS_ZM1)};
        pg8::gemm_phase<Epi5, SchedLin, true, true>(F.lds, F.tid(), g, S, E);
        {
            pg8::Geo g2{DM, DM, 8, 256};
            SchedGate S2{F.G, (int)blockIdx.x, (const char*)F.ptr(IX_OUT), (const char*)(WSP(bf16, WS_W4T) + (size_t)28 * 256 * DM)};
            EpiG E2{WSP(float, WS_C)};
            pg8::gemm_phase<EpiG, SchedGate, true, true>(F.lds, F.tid(), g2, S2, E2);
        }
    } PROBE_T(5, 1); SEAM(5);

    PROBE_T(6, 0);
    if (IN(6)) for (int rep = 0; rep < REPS(6); ++rep) { if (rep) GBAR(); unsigned char* ws = F.ptr(IX_WS);
        pg8::Geo g{16 * 128, 4096, 8, 256};
        SchedCmp S{F.G, (int)blockIdx.x, (const char*)WSP(bf16, WS_KVB), (const char*)WSP(bf16, WS_WC1T)};
        Epi6 E{WSP(float, WS_B), 256, (size_t)4096 * 256};
        pg8::gemm_phase<Epi6, SchedCmp, true, true>(F.lds, F.tid(), g, S, E);
        PROBE_T(60, 0); gates_finish(F); PROBE_T(60, 1); PROBE_T(61, 0); rope_pass(F); PROBE_T(61, 1);
    } PROBE_T(6, 1); SEAM(6);

    PROBE_T(7, 0);
    if (IN(7)) for (int rep = 0; rep < REPS(7); ++rep) { if (rep) GBAR(); p7_cmp2(F); } PROBE_T(7, 1); SEAM(7);

    PROBE_T(8, 0);
    if (IN(8)) for (int rep = 0; rep < REPS(8); ++rep) { if (rep) GBAR(); p8_select(F); } PROBE_T(8, 1);
#ifdef DUP8
    GBAR(); p8_select(F);
#endif
    SEAM(8);

    PROBE_T(9, 0);
    if (IN(9)) for (int rep = 0; rep < REPS(9); ++rep) { if (rep) GBAR(); unsigned char* ws = F.ptr(IX_WS);
        AttnCtx C{}; C.KV = WSP(bf16, WS_KVB); C.KC = WSP(bf16, WS_KCMP); C.VC = WSP(bf16, WS_VCMP); C.Q1 = WSP(bf16, WS_Q1); C.ZQ = WSP(bf16, WS_ZQ);
        C.QM = WSP(bf16, WS_QM1); C.qm_ld = MEMW; C.qm_c0 = 0; C.ZM = WSP(bf16, WS_ZM1); C.zm_ld = MEMW; C.zm_c0 = 0; C.MKV = WSP(bf16, WS_MKV) + (size_t)1024 * 1024;
        C.gates = WSP(float, WS_GATES); C.SEL = WSP(unsigned long long, WS_SEL); C.YACC = WSP(float, WS_C); C.Y = WSP(bf16, WS_B);
        attn_run(F, C, NB * NHEAD * 16, NB * 4 * 16);
    } PROBE_T(9, 1); SEAM(9);

    PROBE_T(10, 0);
    if (IN(10)) for (int rep = 0; rep < REPS(10); ++rep) { if (rep) GBAR(); unsigned char* ws = F.ptr(IX_WS);
        pg8::Geo g{DM, DM, DM / 64, 256};
        SchedLin S{64, 8, 1, F.G, (int)blockIdx.x, WGM_P10, (const char*)WSP(bf16, WS_B), (const char*)WSP(bf16, WS_WO1T), TILE_B, 0, TILE_B, 0, 0, 0, nullptr, nullptr, 0, 0};
        EpiRes<true> E{F.ptr(IX_OUT), WSP(bf16, WS_C), WSP(float, WS_SS2)};
        pg8::gemm_phase<EpiRes<true>, SchedLin, true, true>(F.lds, F.tid(), g, S, E);
    } PROBE_T(10, 1); SEAM(10);

    PROBE_T(11, 0);
    if (IN(11)) for (int rep = 0; rep < REPS(11); ++rep) { if (rep) GBAR(); p11_final(F); }
    PROBE_T(11, 1);
#ifdef CLKPROBE_A
    if (blockIdx.x == 0 && F.tid() == 0) { volatile unsigned long long* pr_ = (volatile unsigned long long*)(F.ptr(IX_WS) + WS_CTL + 32768);
#ifdef CLKGHZ
        const unsigned long long ticks = (pr_[3] - pr_[2]) * CLKGHZ / (pr_[1] - pr_[0] ? pr_[1] - pr_[0] : 1ull);
#else
        const unsigned long long ticks = (pr_[1] - pr_[0]) * CLKMULT;
#endif
        const unsigned long long t0 = __builtin_amdgcn_s_memrealtime();
        while (__builtin_amdgcn_s_memrealtime() - t0 < ticks) __builtin_amdgcn_s_sleep(8); }
#endif
#undef IN
#undef SEAM
}

extern "C" void kernel_launch(void* const* d_in, const int* in_sizes, int n_in, void* d_out, int out_size, void* d_ws, size_t ws_size, hipStream_t stream) {
    static int grid = 0;
    if (grid == 0) {
        if (n_in != 17 || in_sizes[0] != MTOK * DM || out_size != MTOK * DM || ws_size < WS_END) {
            fprintf(stderr, "kernel_launch: unexpected shapes (n_in %d, in0 %d, out %d, ws %zu < %zu)\n", n_in, n_in > 0 ? in_sizes[0] : -1, out_size, ws_size, (size_t)WS_END); grid = -1; return; }
        int dev = 0, cus = 0, per_cu = 0;
        if (hipGetDevice(&dev) != hipSuccess || hipDeviceGetAttribute(&cus, hipDeviceAttributeMultiprocessorCount, dev) != hipSuccess) { fprintf(stderr, "kernel_launch: device query failed\n"); grid = -1; return; }
        if (hipFuncSetAttribute((const void*)fwd_kernel, hipFuncAttributeMaxDynamicSharedMemorySize, LDS_BYTES) != hipSuccess) { fprintf(stderr, "kernel_launch: hipFuncSetAttribute failed\n"); grid = -1; return; }
        if (hipOccupancyMaxActiveBlocksPerMultiprocessor(&per_cu, (const void*)fwd_kernel, NTHREADS, LDS_BYTES) != hipSuccess || per_cu < 1) {
            fprintf(stderr, "kernel_launch: occupancy query says %d blocks per CU\n", per_cu); (void)hipGetLastError(); per_cu = 1; }
        grid = cus * (per_cu > 1 ? 1 : per_cu);
    }
    if (grid < 0) return;
    (void)hipMemsetAsync((char*)d_ws + WS_CTL, 0, 65536, stream);
    Args a{};
    for (int i = 0; i < 17; ++i) a.in[i] = d_in[i];
    a.out = (float*)d_out; a.ws = (unsigned char*)d_ws;
#if MK_PER_PHASE
    for (int p = 0; p < NPHASE; ++p) { a.ph_lo = p; a.ph_hi = p + 1; hipLaunchKernelGGL(fwd_kernel, dim3(grid), dim3(NTHREADS), LDS_BYTES, stream, a); }
#else
    a.ph_lo = 0; a.ph_hi = NPHASE;
    void* kargs[] = {&a};
    hipError_t e = hipLaunchCooperativeKernel((const void*)fwd_kernel, dim3(grid), dim3(NTHREADS), kargs, LDS_BYTES, stream);
    if (e != hipSuccess) fprintf(stderr, "kernel_launch: cooperative launch failed: %s (grid %d)\n", hipGetErrorString(e), grid);
#endif
}
```

```cpp
#include <hip/hip_runtime.h>
#include <hip/hip_cooperative_groups.h>
#include <cstdio>
#include <cstdint>
namespace cg = cooperative_groups;

#define LAS __attribute__((address_space(3)))
typedef unsigned short bf16;
typedef unsigned v4u __attribute__((ext_vector_type(4)));
typedef unsigned v2u __attribute__((ext_vector_type(2)));
typedef float f32x4 __attribute__((ext_vector_type(4)));
typedef float f32x2 __attribute__((ext_vector_type(2)));
typedef float f32x16 __attribute__((ext_vector_type(16)));
typedef short bf16x8 __attribute__((ext_vector_type(8)));
typedef short s16x4 __attribute__((ext_vector_type(4)));

constexpr int NB = 4, SEQ = 4096, DM = 2048, MTOK = NB * SEQ;
constexpr int MEMLEN = 256, HD = 128;
constexpr int POOLW = 1536, MEMW = 512, NSAW = 1536, NHEAD = 12, NKVH = 4;
constexpr int N1 = 4096;
constexpr int NKV = 3072;
constexpr int N4 = 7424;
constexpr int NCMP = 255, CMPHID = 256;
constexpr float EPS = 1e-6f;
constexpr float LOG2E = 1.4426950408889634f;
constexpr float ATT_SCALE = 0.08838834764831845f;

constexpr size_t MiB = 1u << 20;
constexpr size_t WS_CTL = 0;
constexpr size_t WS_W1T = 1 * MiB;
constexpr size_t WS_WO0T = 17 * MiB;
constexpr size_t WS_W4T = 25 * MiB;
constexpr size_t WS_WO1T = 54 * MiB;
constexpr size_t WS_WMT = 62 * MiB;
constexpr size_t WS_WPT = 70 * MiB;
constexpr size_t WS_WC1T = 72 * MiB;
constexpr size_t WS_MEMN = 76 * MiB;
constexpr size_t WS_MKV = 80 * MiB;
constexpr size_t WS_ROPE = 84 * MiB;
constexpr size_t WS_ROPEC = 86 * MiB;
constexpr size_t WS_SS1 = 87 * MiB;
constexpr size_t WS_SS2 = 89 * MiB;
constexpr size_t WS_SEL = 91 * MiB;
constexpr size_t WS_KCMP = 92 * MiB;
constexpr size_t WS_VCMP = 93 * MiB;
constexpr size_t WS_GATES = 94 * MiB;
constexpr size_t WS_CBIAS = 97 * MiB;
constexpr size_t WS_CBIASF = 97 * MiB + 256 * 1024;
constexpr size_t WS_RINV1 = 97 * MiB + 512 * 1024;
constexpr size_t WS_RINV0 = 97 * MiB + 576 * 1024;
constexpr size_t WS_XB = 292 * MiB + 16 * MiB;
constexpr size_t WS_W2T = 97 * MiB + 64 * 1024;
constexpr size_t WS_A = 98 * MiB;
constexpr size_t WS_KVB = WS_A;
constexpr size_t WS_QM1 = WS_A + 97 * MiB;
constexpr size_t WS_ZM1 = WS_A + 113 * MiB;
constexpr size_t WS_B = 228 * MiB;
constexpr size_t WS_C = 292 * MiB;
constexpr size_t WS_D = 388 * MiB;
constexpr size_t WS_Q1 = WS_D, WS_ZQ = WS_D + 48 * MiB;
constexpr size_t WS_W1U = WS_D + 80 * MiB;
constexpr size_t WS_END = 484 * MiB;

#define LDS_WAIT() asm volatile("s_waitcnt lgkmcnt(0)" ::: "memory")
#define VM_WAIT() asm volatile("s_waitcnt vmcnt(0)" ::: "memory")
__device__ __forceinline__ unsigned f2bf(float f) { unsigned u = __builtin_bit_cast(unsigned, f); return (u + 0x7fffu + ((u >> 16) & 1u)) >> 16; }
__device__ __forceinline__ unsigned pk2(float lo, float hi) { return f2bf(lo) | (f2bf(hi) << 16); }
__device__ __forceinline__ float bf2f(unsigned short b) { return __builtin_bit_cast(float, (unsigned)b << 16); }
__device__ __forceinline__ float bflo(unsigned w) { return __builtin_bit_cast(float, w << 16); }
__device__ __forceinline__ float bfhi(unsigned w) { return __builtin_bit_cast(float, w & 0xffff0000u); }
__device__ __forceinline__ unsigned cvtpk(float lo, float hi) { unsigned r; asm volatile("v_cvt_pk_bf16_f32 %0, %1, %2" : "=v"(r) : "v"(lo), "v"(hi)); return r; }
__device__ __forceinline__ float silu_f(float x) { return x * __builtin_amdgcn_rcpf(1.f + __builtin_amdgcn_exp2f(-x * LOG2E)); }
__device__ __forceinline__ float sigmoid_f(float x) { return __builtin_amdgcn_rcpf(1.f + __builtin_amdgcn_exp2f(-x * LOG2E)); }
__device__ __forceinline__ float wave_sum(float v) {
#pragma unroll
    for (int o = 1; o < 64; o <<= 1) v += __shfl_xor(v, o);
    return v;
}

namespace pg8 {
#define PG8_LAS __attribute__((address_space(3)))
constexpr int BM = 256, BK = 64, HALF = 128, HTB = HALF * BK * 2, STAGE_BYTES = 8 * HTB, NXCD = 8, WGM = 8;
__host__ __device__ __forceinline__ int lds_byte(int r, int c) { const int st = (r >> 4) * 2 + (c >> 5), rr = r & 15, cc = c & 31, ob = rr * 64 + cc * 2; return st * 1024 + (ob ^ (((ob >> 9) & 1) << 5)); }
__host__ __device__ __forceinline__ int perm32(int rho) { const int n = rho >> 4, i = rho & 15; return 8 * (i >> 2) + 4 * n + (i & 3); }
__host__ __device__ __forceinline__ void stage_rc(int b, int& R, int& C) { const int st = b / 1024, sb = b % 1024, swz = sb ^ (((sb >> 9) & 1) << 5); R = (st >> 1) * 16 + swz / 64; C = (st & 1) * 32 + (swz % 64) / 2; }

struct Unit { int pm, pn, z, kind; const char* a; const char* b; };
__device__ __forceinline__ void tile_swz(int wgid, int nM, int nN, int wgm, int& pm, int& pn) {
    const int nwg = nM * nN;
    { const int q = nwg / NXCD, r = nwg % NXCD, xcd = wgid % NXCD, off = wgid / NXCD; wgid = (xcd < r ? xcd * (q + 1) : r * (q + 1) + (xcd - r) * q) + off; }
    const int nig = wgm * nN, gid = wgid / nig, fm = gid * wgm, gsz = (nM - fm) < wgm ? (nM - fm) : wgm;
    pm = fm + ((wgid % nig) % gsz); pn = (wgid % nig) / gsz;
}
struct Geo { int lda, ldb, nt; int kpairA; volatile unsigned long long* probe = nullptr; };

template <class Epi, class Sched, bool ALIGN_EPI, bool SP2>
__device__ __forceinline__ void gemm_phase(PG8_LAS unsigned char* lds, const int tid, const Geo g, const Sched& S, const Epi& E) {
    const int wid = __builtin_amdgcn_readfirstlane(tid >> 6), lane = tid & 63, wr = wid >> 2, wc = wid & 3, fr = lane & 15, fq = lane >> 4;
    const int nt = g.nt;
    unsigned voffA[2], voffB[2];
#pragma unroll
    for (int i = 0; i < 2; ++i) { int R, C; stage_rc(tid * 16 + i * 8192, R, C);
        const int Rb = Epi::PERM ? 64 * (R >> 5) + perm32(R & 31) : R;
        voffA[i] = (unsigned)(R * g.lda + C) * 2u; voffB[i] = (unsigned)(Rb * g.ldb + C) * 2u; }
    const size_t kstep = (size_t)(BK * 2);
    const size_t hstepA = (size_t)HALF * g.lda * 2, hstepB = (size_t)(Epi::PERM ? 32 : HALF) * g.ldb * 2;
    const size_t kpairA = (size_t)g.kpairA;
    const unsigned ldsw = (unsigned)wid * 1024u;
    const int aoff = lds_byte(wr * 64 + fr, fq * 8), boff = lds_byte(wc * 32 + fr, fq * 8);
#define PG8_SA(b, h) (((b) * 2 + (h)) * HTB)
#define PG8_SB(b, h) ((4 + (b) * 2 + (h)) * HTB)
#define PG8_STAGE(bufoff, gbase, voff) do { _Pragma("unroll") for (int _i = 0; _i < 2; ++_i) \
        __builtin_amdgcn_global_load_lds((const unsigned*)((const char*)(gbase) + (voff)[_i]), (PG8_LAS unsigned*)(lds + (bufoff) + ldsw + _i * 8192), 16, 0, 0); } while (0)
#define PG8_LDA(dst, b, h) do { _Pragma("unroll") for (int m = 0; m < 4; ++m) _Pragma("unroll") for (int k = 0; k < 2; ++k) dst[m][k] = *(const PG8_LAS bf16x8*)(lds + PG8_SA(b, h) + aoff + m * 2048 + k * 1024); } while (0)
#define PG8_LDB(dst, b, h) do { _Pragma("unroll") for (int n = 0; n < 2; ++n) _Pragma("unroll") for (int k = 0; k < 2; ++k) dst[n][k] = *(const PG8_LAS bf16x8*)(lds + PG8_SB(b, h) + boff + n * 2048 + k * 1024); } while (0)
#define PG8_MMA(ai, bj, At, Bt) do { __builtin_amdgcn_s_setprio(1); _Pragma("unroll") for (int m = 0; m < 4; ++m) _Pragma("unroll") for (int n = 0; n < 2; ++n) _Pragma("unroll") for (int k = 0; k < 2; ++k) \
        acc[ai][bj][m][n] = __builtin_amdgcn_mfma_f32_16x16x32_bf16(Bt[n][k], At[m][k], acc[ai][bj][m][n], 0, 0, 0); __builtin_amdgcn_s_setprio(0); } while (0)
#define PG8_WAIT_V(n) asm volatile("s_waitcnt vmcnt(" #n ")" ::: "memory")
#define PG8_WAIT_L(n) asm volatile("s_waitcnt lgkmcnt(" #n ")" ::: "memory")
#define PG8_BAR __builtin_amdgcn_s_barrier()
#define PG8_SCHED __builtin_amdgcn_sched_barrier(0)
    Unit cur, nxt; int ui = 0;
    if (!S.next(0, cur)) return;
    f32x4 acc[2][2][4][2];
    typename Epi::State est;
    E.begin(acc, est, cur, wr, wc, fr, fq);
    bf16x8 At[4][2], B0[2][2], B1[2][2];
    const char* cA = cur.a; const char* cB = cur.b;
    if constexpr (SP2) {
        PG8_STAGE(PG8_SB(0, 0), cB, voffB); PG8_STAGE(PG8_SB(0, 1), cB + hstepB, voffB); PG8_STAGE(PG8_SA(0, 0), cA, voffA); PG8_STAGE(PG8_SA(0, 1), cA + hstepA, voffA);
        if (wr == 1) PG8_BAR;
        PG8_WAIT_V(2); PG8_BAR;
        PG8_STAGE(PG8_SB(1, 0), cB + kstep, voffB); PG8_STAGE(PG8_SA(1, 0), cA + kstep, voffA); PG8_STAGE(PG8_SB(1, 1), cB + hstepB + kstep, voffB);
        PG8_WAIT_V(6); PG8_BAR;
    } else {
        PG8_STAGE(PG8_SB(0, 0), cB, voffB); PG8_STAGE(PG8_SA(0, 0), cA, voffA); PG8_STAGE(PG8_SB(0, 1), cB + hstepB, voffB); PG8_STAGE(PG8_SA(0, 1), cA + hstepA, voffA);
        if (wr == 1) PG8_BAR;
        PG8_WAIT_V(4); PG8_BAR;
        PG8_STAGE(PG8_SB(1, 0), cB + kstep, voffB); PG8_STAGE(PG8_SA(1, 0), cA + kstep, voffA); PG8_STAGE(PG8_SB(1, 1), cB + hstepB + kstep, voffB);
        PG8_WAIT_V(6); PG8_BAR;
    }
    for (;;) {
        const bool has_next = S.next(ui + 1, nxt);
        const char* nA = has_next ? nxt.a : cA; const char* nB = has_next ? nxt.b : cB;
#ifdef KPROBE
#if KPROBE_SPAN >= 0
        if (g.probe && ui == KPROBE && tid == 0) g.probe[0] = __builtin_amdgcn_s_memrealtime();
#endif
#if KPROBE_SPAN > 0
        if (g.probe && ui == KPROBE + KPROBE_SPAN && tid == 0) g.probe[1] = __builtin_amdgcn_s_memrealtime();
#endif
#endif
        for (int t = 0; t < nt; t += 2) {
            const bool last = (t == nt - 2);
            const char* a0p = cA + (size_t)(t >> 1) * kpairA;
            const char* a1 = a0p + kstep;
            const char* a2 = last ? nA : a0p + kpairA; const char* b2 = last ? nB : cB + (size_t)(t + 2) * kstep;
            const char* a3 = a2 + kstep; const char* b3 = b2 + kstep;
            if constexpr (SP2) {
            PG8_LDB(B0, 0, 0); PG8_LDB(B1, 0, 1); PG8_SCHED; PG8_LDA(At, 0, 0); PG8_STAGE(PG8_SA(1, 1), a1 + hstepA, voffA);
            PG8_WAIT_V(8); PG8_WAIT_L(0); PG8_BAR; PG8_MMA(0, 0, At, B0); PG8_MMA(0, 1, At, B1); PG8_BAR; PG8_SCHED;
            PG8_LDA(At, 0, 1); PG8_STAGE(PG8_SB(0, 0), b2, voffB); PG8_STAGE(PG8_SB(0, 1), b2 + hstepB, voffB); PG8_STAGE(PG8_SA(0, 0), a2, voffA);
            PG8_WAIT_V(8); PG8_WAIT_L(0); PG8_BAR; PG8_MMA(1, 0, At, B0); PG8_MMA(1, 1, At, B1); PG8_BAR; PG8_SCHED;
            PG8_LDB(B0, 1, 0); PG8_LDB(B1, 1, 1); PG8_SCHED; PG8_LDA(At, 1, 0); PG8_STAGE(PG8_SA(0, 1), a2 + hstepA, voffA);
            PG8_WAIT_V(8); PG8_WAIT_L(0); PG8_BAR; PG8_MMA(0, 0, At, B0); PG8_MMA(0, 1, At, B1); PG8_BAR; PG8_SCHED;
            PG8_LDA(At, 1, 1); PG8_STAGE(PG8_SB(1, 0), b3, voffB); PG8_STAGE(PG8_SB(1, 1), b3 + hstepB, voffB); PG8_STAGE(PG8_SA(1, 0), a3, voffA);
            PG8_WAIT_V(8); PG8_WAIT_L(0); PG8_BAR; PG8_MMA(1, 0, At, B0); PG8_MMA(1, 1, At, B1); PG8_BAR; PG8_SCHED;
            } else {
            PG8_LDB(B0, 0, 0); PG8_SCHED; PG8_LDA(At, 0, 0); PG8_STAGE(PG8_SA(1, 1), a1 + hstepA, voffA);
            PG8_WAIT_L(8); PG8_BAR; PG8_WAIT_L(0); PG8_MMA(0, 0, At, B0); PG8_BAR; PG8_SCHED;
            PG8_LDB(B1, 0, 1); PG8_STAGE(PG8_SB(0, 0), b2, voffB);
            PG8_BAR; PG8_WAIT_L(0); PG8_MMA(0, 1, At, B1); PG8_BAR;
            PG8_LDA(At, 0, 1); PG8_STAGE(PG8_SA(0, 0), a2, voffA);
            PG8_BAR; PG8_WAIT_L(0); PG8_MMA(1, 0, At, B0); PG8_BAR; PG8_SCHED;
            PG8_STAGE(PG8_SB(0, 1), b2 + hstepB, voffB);
            PG8_WAIT_V(6); PG8_BAR; PG8_MMA(1, 1, At, B1); PG8_BAR;
            PG8_LDB(B0, 1, 0); PG8_SCHED; PG8_LDA(At, 1, 0); PG8_STAGE(PG8_SA(0, 1), a2 + hstepA, voffA);
            PG8_WAIT_L(8); PG8_BAR; PG8_WAIT_L(0); PG8_MMA(0, 0, At, B0); PG8_BAR; PG8_SCHED;
            PG8_LDB(B1, 1, 1); PG8_STAGE(PG8_SB(1, 0), b3, voffB);
            PG8_BAR; PG8_WAIT_L(0); PG8_MMA(0, 1, At, B1); PG8_BAR;
            PG8_LDA(At, 1, 1); PG8_STAGE(PG8_SA(1, 0), a3, voffA);
            PG8_BAR; PG8_WAIT_L(0); PG8_MMA(1, 0, At, B0); PG8_BAR; PG8_SCHED;
            PG8_STAGE(PG8_SB(1, 1), b3 + hstepB, voffB);
            PG8_WAIT_V(6); PG8_BAR; PG8_MMA(1, 1, At, B1); PG8_BAR;
            }
        }
#if defined(KPROBE) && KPROBE_SPAN == 0
        if (g.probe && ui == KPROBE && tid == 0) g.probe[1] = __builtin_amdgcn_s_memrealtime();
#endif
        if constexpr (ALIGN_EPI) { if (wr == 0) PG8_BAR; }
#if defined(KPROBE) && KPROBE_SPAN == -1
        if (g.probe && ui == KPROBE && tid == 0) g.probe[0] = __builtin_amdgcn_s_memrealtime();
#endif
        E(acc, est, cur, wr, wc, fr, fq);
#if defined(KPROBE) && KPROBE_SPAN == -1
        if (g.probe && ui == KPROBE && tid == 0) g.probe[1] = __builtin_amdgcn_s_memrealtime();
#endif
#if defined(KPROBE) && KPROBE_SPAN == -2
        if (g.probe && ui == KPROBE && tid == 0) g.probe[0] = __builtin_amdgcn_s_memrealtime();
#endif
        if (!has_next) break;
        cur = nxt; cA = nA; cB = nB; ++ui;
        E.begin(acc, est, cur, wr, wc, fr, fq);
        if constexpr (ALIGN_EPI) { if (wr == 1) PG8_BAR; }
#if defined(KPROBE) && KPROBE_SPAN == -2
        if (g.probe && ui == KPROBE + 1 && tid == 0) g.probe[1] = __builtin_amdgcn_s_memrealtime();
#endif
    }
    PG8_WAIT_V(0);
    if constexpr (!ALIGN_EPI) { if (wr == 0) PG8_BAR; }
    PG8_BAR;
#undef PG8_SA
#undef PG8_SB
#undef PG8_STAGE
#undef PG8_LDA
#undef PG8_LDB
#undef PG8_MMA
#undef PG8_WAIT_V
#undef PG8_WAIT_L
#undef PG8_BAR
#undef PG8_SCHED
}
}

namespace att {
#ifndef AT_SELMASK
#define AT_SELMASK 1
#endif
constexpr int D = 128, NW = 8, QBLK = 32, KVBLK = 64, QB = NW * QBLK;
constexpr int SHM_V = KVBLK * D * 2, SHM_K = KVBLK * D * 2;
constexpr int LDS_BYTES = 2 * SHM_V + 2 * SHM_K + NW * 64 * 4;
constexpr float THR = 8.f;
#define KSWZ(row, colB) ((row) * 256 + ((colB) ^ (((row) & 7) << 4)))
#define SBAR() __builtin_amdgcn_sched_barrier(0)
__device__ __forceinline__ int v_st(int k, int c) { const int kk = (k & ~0xC) | ((k & 4) << 1) | ((k & 8) >> 1); return ((kk >> 3) * 4 + (c >> 5)) * 512 + ((kk & 7) * 32 + (c & 31)) * 2; }
__device__ __forceinline__ int v_rd_base(int lane) { return ((lane & 3) << 3) | (((lane >> 2) & 3) << 6) | (((lane >> 4) & 1) << 5) | (((lane >> 5) & 1) << 8); }
constexpr int v_rd_off(int d0, int ks, int half) { return d0 * 512 + ks * 4096 + half * 2048; }
__device__ __forceinline__ int crow(int r, int hi) { return (r & 3) + 8 * (r >> 2) + 4 * hi; }
__device__ __forceinline__ bf16x8 load8(const bf16* p) { return *reinterpret_cast<const bf16x8*>(p); }

__device__ __forceinline__ void mask_tile(f32x16& p0, f32x16& p1, int dq, unsigned W) {
    const float NEG = -__builtin_inff();
#pragma unroll
    for (int r = 0; r < 16; ++r) {
        const int c = (r & 3) + 8 * (r >> 2);
        if ((unsigned)(dq - c) >= W) p0[r] = NEG;
        if ((unsigned)(dq - c - 32) >= W) p1[r] = NEG;
    }
}
__device__ __forceinline__ void partialSM(f32x16& p0, f32x16& p1, float& m_reg, float& mn, float& alpha) {
    float pmax = p0[0];
#pragma unroll
    for (int r = 1; r < 16; ++r) pmax = fmaxf(pmax, p0[r]);
#pragma unroll
    for (int r = 0; r < 16; ++r) pmax = fmaxf(pmax, p1[r]);
    { auto rr = __builtin_amdgcn_permlane32_swap(__float_as_uint(pmax), __float_as_uint(pmax), false, false);
      pmax = fmaxf(__uint_as_float(rr[0]), __uint_as_float(rr[1])); }
    constexpr float C2 = LOG2E * ATT_SCALE;
    if (__builtin_expect(__all((pmax - m_reg) * ATT_SCALE <= THR), 1)) { mn = m_reg; alpha = 1.f; }
    else { mn = fmaxf(m_reg, pmax); alpha = __builtin_amdgcn_exp2f((m_reg - mn) * C2); m_reg = mn; }
    const float mnL = -mn * C2;
#pragma unroll
    for (int r = 0; r < 16; ++r) p0[r] = fmaf(p0[r], C2, mnL);
#pragma unroll
    for (int r = 0; r < 16; ++r) p1[r] = fmaf(p1[r], C2, mnL);
#pragma unroll
    for (int r = 0; r < 16; ++r) p0[r] = __builtin_amdgcn_exp2f(p0[r]);
}
__device__ __forceinline__ void finishSM(f32x16& p0, f32x16& p1, float alpha, float& l_reg, bf16x8& pa0, bf16x8& pa1, bf16x8& pa2, bf16x8& pa3, int keep) {
#pragma unroll
    for (int r = 0; r < 16; ++r) p1[r] = __builtin_amdgcn_exp2f(p1[r]);
    float ps = 0;
#pragma unroll
    for (int r = 0; r < 16; ++r) ps += p0[r];
#pragma unroll
    for (int r = 0; r < 16; ++r) ps += p1[r];
    { auto rr = __builtin_amdgcn_permlane32_swap(__float_as_uint(ps), __float_as_uint(ps), false, false);
      ps = __uint_as_float(rr[0]) + __uint_as_float(rr[1]); }
    l_reg = l_reg * alpha + (keep ? ps : 0.f);
#define PK4(P, B_, OUT) do { unsigned a0 = cvtpk(P[B_+0], P[B_+1]), a1 = cvtpk(P[B_+2], P[B_+3]);                          \
        unsigned b0 = cvtpk(P[B_+4], P[B_+5]), b1 = cvtpk(P[B_+6], P[B_+7]);                                             \
        auto r0 = __builtin_amdgcn_permlane32_swap(a0, b0, false, false); auto r1 = __builtin_amdgcn_permlane32_swap(a1, b1, false, false); \
        v4u w = {keep ? r0[0] : 0u, keep ? r1[0] : 0u, keep ? r0[1] : 0u, keep ? r1[1] : 0u}; OUT = *reinterpret_cast<bf16x8*>(&w); } while (0)
    PK4(p0, 0, pa0); PK4(p0, 8, pa1); PK4(p1, 0, pa2); PK4(p1, 8, pa3);
#undef PK4
}
template <int KB>
__device__ __forceinline__ void qkt(f32x16& p0, f32x16& p1, const char* K_lds, int r32, int hi, const bf16x8* qr) {
    p0 = f32x16{}; p1 = f32x16{};
    const char* kb[4];
#pragma unroll
    for (int dd = 0; dd < 4; ++dd) kb[dd] = K_lds + KB * SHM_K + KSWZ(r32, (dd * 16 + hi * 8) * 2);
#pragma unroll
    for (int d0 = 0; d0 < 8; ++d0) { const char* a = kb[d0 & 3] + (d0 >> 2) * 128;
        bf16x8 b0 = *reinterpret_cast<const bf16x8*>(a);
        bf16x8 b1 = *reinterpret_cast<const bf16x8*>(a + 32 * 256);
        p0 = __builtin_amdgcn_mfma_f32_32x32x16_bf16(b0, qr[d0], p0, 0, 0, 0);
        p1 = __builtin_amdgcn_mfma_f32_32x32x16_bf16(b1, qr[d0], p1, 0, 0, 0); }
}
template <int VB>
__device__ __forceinline__ void pv_tile(f32x16* o, int vb0, bf16x8 pa0, bf16x8 pa1, bf16x8 pa2, bf16x8 pa3) {
#define TRRD(dst, off) asm volatile("ds_read_b64_tr_b16 %0, %1 offset:%2" : "=&v"(dst) : "v"(vb0), "i"(off) : "memory")
#define PV_D0(d0) do { s16x4 l0, l1, l2, l3, h0, h1, h2, h3; constexpr int b_ = VB * SHM_V + v_rd_off(d0, 0, 0);   \
        TRRD(l0, b_); TRRD(h0, b_ + 2048); TRRD(l1, b_ + 4096); TRRD(h1, b_ + 6144); TRRD(l2, b_ + 8192); TRRD(h2, b_ + 10240); TRRD(l3, b_ + 12288); TRRD(h3, b_ + 14336); \
        asm volatile("s_waitcnt lgkmcnt(0)" ::: "memory"); SBAR();   \
        o[d0] = __builtin_amdgcn_mfma_f32_32x32x16_bf16(pa0, (bf16x8){l0[0], l0[1], l0[2], l0[3], h0[0], h0[1], h0[2], h0[3]}, o[d0], 0, 0, 0);   \
        o[d0] = __builtin_amdgcn_mfma_f32_32x32x16_bf16(pa1, (bf16x8){l1[0], l1[1], l1[2], l1[3], h1[0], h1[1], h1[2], h1[3]}, o[d0], 0, 0, 0);   \
        o[d0] = __builtin_amdgcn_mfma_f32_32x32x16_bf16(pa2, (bf16x8){l2[0], l2[1], l2[2], l2[3], h2[0], h2[1], h2[2], h2[3]}, o[d0], 0, 0, 0);   \
        o[d0] = __builtin_amdgcn_mfma_f32_32x32x16_bf16(pa3, (bf16x8){l3[0], l3[1], l3[2], l3[3], h3[0], h3[1], h3[2], h3[3]}, o[d0], 0, 0, 0); } while (0)
    PV_D0(0); PV_D0(1); PV_D0(2); PV_D0(3);
#undef PV_D0
#undef TRRD
}

enum { MODE_NONE = 0, MODE_SEL = 1, MODE_WIN = 2, MODE_CMP = 3 };
enum { EPI_MEM = 0, EPI_ACC0 = 1, EPI_ACC1 = 2, EPI_FIN = 3 };
struct Ctx { const bf16 *KV, *KC, *VC, *Q1, *ZQ, *QM, *ZM, *MKV; const float* gates; const unsigned long long* SEL; float* YACC; bf16* Y; int qm_ld, zm_ld, qm_c0, zm_c0; };
struct Blk {
    const bf16* Q; const bf16* K; int voff;
    int ldq, ldk;
    int j_lo, j_hi;
    int t0;
    int mode, epi;
    int row0, hcol, gcol, bg;
};
constexpr int LDS_WS = 2 * SHM_V + 2 * SHM_K;
constexpr int LDS_SEL = LDS_WS + NW * 64 * 4;
constexpr int LDS_STG = LDS_SEL + NW * 32 * 8;
constexpr int LDS_BYTES2 = LDS_STG + NW * 32 * 68 * 4;
struct Seam { bf16x8 qr[8]; bf16x8 st_v0, st_v1, st_k0, st_k1; };
#define AROW(p, k0, rr) ((p) + (size_t)((k0) + (rr)) * ldk + sc)
#define VMWN(n) asm volatile("s_waitcnt vmcnt(%0)" :: "i"(n) : "memory")
#define SLOAD_H(Kp, Vp, k0) do { S.st_v0 = load8(AROW(Vp, k0, sr)); S.st_v1 = load8(AROW(Vp, k0, 32 + sr));              \
                         S.st_k0 = load8(AROW(Kp, k0, sr)); S.st_k1 = load8(AROW(Kp, k0, 32 + sr)); } while (0)
#define SWRITE_HK(bf) do { *(bf16x8*)(K_lds + (bf) * SHM_K + kws) = S.st_k0; *(bf16x8*)(K_lds + (bf) * SHM_K + kws + 32 * 256) = S.st_k1; } while (0)
#define SWRITE_HV(bf) do { *(bf16x8*)(V_lds + (bf) * SHM_V + vst0) = S.st_v0; *(bf16x8*)(V_lds + (bf) * SHM_V + vst1) = S.st_v1; } while (0)
#define SWRITE_H(bf) do { SWRITE_HV(bf); SWRITE_HK(bf); } while (0)

__device__ __forceinline__ void attn_prime(const int tid, const Blk& cur, char* lds, Seam& S) {
    const int wid = __builtin_amdgcn_readfirstlane(tid >> 6), lane = tid & 63, r32 = lane & 31, hi = lane >> 5;
    const int sr = tid >> 4, sc = (tid & 15) * 8, kws = KSWZ(sr, sc * 2); char* K_lds = lds + 2 * SHM_V;
    const int ldk = cur.ldk; const int kb0 = cur.j_lo * KVBLK;
#pragma unroll
    for (int i = 0; i < 8; ++i) S.qr[i] = load8(cur.Q + (size_t)(wid * QBLK + (lane >> 4) + 4 * i) * cur.ldq + (lane & 15) * 8);
    SLOAD_H(cur.K, cur.K + cur.voff, kb0); VM_WAIT(); SWRITE_HK(0);
    __syncthreads();
}
__device__ __forceinline__ void attn_block(const int tid, const Ctx& C, const Blk& cur, const bf16* nQ, const bf16* nK, int nvoff, int nldq, int nldk, int nj_lo, char* lds, Seam& S) {
    const int wid = __builtin_amdgcn_readfirstlane(tid >> 6), lane = tid & 63, r32 = lane & 31, hi = lane >> 5;
#ifdef AT_TILE2X
    const int j_lo = cur.j_lo, NT0 = cur.j_hi - cur.j_lo, NT = (cur.mode == AT_TILE2X) ? 2 * NT0 : NT0;
#define TIX(t) ((t) >= NT0 ? (t) - NT0 : (t))
#else
    const int j_lo = cur.j_lo, NT = cur.j_hi - cur.j_lo;
#define TIX(t) (t)
#endif
    const int kbn = nj_lo * KVBLK;
    const int mode = cur.mode;
    const int trow = cur.t0 + wid * QBLK;
    int pos, pmin, pmax; unsigned W;
    if (mode == MODE_CMP) { pos = (trow + r32 - 31) >> 4; pmin = (trow - 31) >> 4; pmax = trow >> 4; W = 0x7fffffffu; }
    else if (mode == MODE_NONE) { pos = 1 << 29; pmin = 1 << 29; pmax = 1 << 29; W = 0x7fffffffu; }
    else { pos = trow + r32; pmin = trow; pmax = trow + QBLK - 1; W = (mode == MODE_WIN) ? 512u : 0x7fffffffu; }
    const int qm = pos - 4 * hi;
    char* V_lds = lds; char* K_lds = lds + 2 * SHM_V;
    float* ws = (float*)(lds + LDS_WS) + wid * 64; float* li_l = ws, * al_l = ws + 32;
    unsigned long long* sel_l = (unsigned long long*)(lds + LDS_SEL) + wid * 32;
    if (mode == MODE_SEL && hi == 0) sel_l[r32] = C.SEL[(size_t)cur.bg * SEQ + trow + r32];
    float m_reg = -1e30f, l_reg = 0; f32x16 o[4] = {};
    const int sr = tid >> 4, sc = (tid & 15) * 8, vst0 = v_st(sr, sc), vst1 = v_st(32 + sr, sc), kws = KSWZ(sr, sc * 2);
    const int vb0 = (int)(uintptr_t)V_lds + v_rd_base(lane);
    const bf16* Kh = cur.K; const bf16* Vh = cur.K + cur.voff; const int ldk = cur.ldk;
#define RESC(a) do { if (__any((a) < 1.f)) { if (hi == 0) al_l[r32] = (a); asm volatile("s_waitcnt lgkmcnt(0)" ::: "memory");              \
                     for (int d_ = 0; d_ < 4; ++d_) for (int r = 0; r < 16; ++r) o[d_][r] *= al_l[crow(r, hi)]; } } while (0)
#define KBASE(t) ((j_lo + TIX(t)) * KVBLK)
#define MASKT(P0_, P1_, t, KP_) do { const int kb_ = KBASE(t); KP_ = 1; \
        if (mode == MODE_SEL) { const int bit_ = (int)((sel_l[r32] >> (j_lo + TIX(t))) & 1ull); \
            if (kb_ + KVBLK - 1 > pmin) mask_tile(P0_, P1_, bit_ ? qm - kb_ : -(1 << 30), W);       \
            else KP_ = bit_; }                                                                         \
        else if (kb_ + KVBLK - 1 > pmin || kb_ <= pmax - (int)W) mask_tile(P0_, P1_, qm - kb_, W); } while (0)
    constexpr int NQL = 8;
#define SEAM_K0() do { VMWN(NQL); SWRITE_HK(0); SBAR(); } while (0)
    f32x16 pA0, pA1, pB0, pB1; float mnA, mnB, alA, alB; int kpA = 1, kpB = 1; bf16x8 pa0, pa1, pa2, pa3;
    {
        char* stq = lds + LDS_STG + wid * (32 * 272);
#pragma unroll
        for (int i = 0; i < 8; ++i) *(bf16x8*)(stq + ((lane >> 4) + 4 * i) * 272 + (lane & 15) * 16) = S.qr[i];
        asm volatile("s_waitcnt lgkmcnt(0)" ::: "memory");
#pragma unroll
        for (int d0 = 0; d0 < 8; ++d0) S.qr[d0] = *(const bf16x8*)(stq + r32 * 272 + (2 * d0 + hi) * 16);
        asm volatile("s_waitcnt lgkmcnt(0)" ::: "memory");
    }
    SWRITE_HV(0); SBAR();
    if (NT > 1) { SLOAD_H(Kh, Vh, KBASE(1)); }
    SBAR(); qkt<0>(pA0, pA1, K_lds, r32, hi, S.qr);
    MASKT(pA0, pA1, 0, kpA); partialSM(pA0, pA1, m_reg, mnA, alA);
    if (NT > 1) { VM_WAIT(); SWRITE_H(1); }
    __syncthreads();
#define HALF_STEP(PX0, PX1, mnX, alX, kpX, PY0, PY1, alY, kpY, t, KB, VB, SB) do {                                                      \
        SBAR(); if ((t) + 1 < NT) { SLOAD_H(Kh, Vh, KBASE((t) + 1)); SBAR(); }         \
        qkt<KB>(PX0, PX1, K_lds, r32, hi, S.qr);                                             \
        finishSM(PY0, PY1, alY, l_reg, pa0, pa1, pa2, pa3, kpY); SBAR();                                                      \
        pv_tile<VB>(o, vb0, pa0, pa1, pa2, pa3); MASKT(PX0, PX1, (t), kpX); partialSM(PX0, PX1, m_reg, mnX, alX);                                        \
        __syncthreads();                                                                                                      \
        if ((t) + 1 < NT) { VM_WAIT(); SWRITE_H(SB); }                                                                          \
        RESC(alX); __syncthreads(); } while (0)
    for (int t = 1; t + 1 < NT; t += 2) {
        HALF_STEP(pB0, pB1, mnB, alB, kpB, pA0, pA1, alA, kpA, t, 1, 0, 0);
        HALF_STEP(pA0, pA1, mnA, alA, kpA, pB0, pB1, alB, kpB, t + 1, 0, 1, 1);
    }
    const bool even = (NT & 1) == 0;
    if (even) { SBAR(); qkt<1>(pB0, pB1, K_lds, r32, hi, S.qr); SBAR(); }
    { const int ldk = nldk; SLOAD_H(nK, nK + nvoff, kbn); SBAR(); }
#pragma unroll
    for (int i = 0; i < 8; ++i) S.qr[i] = load8(nQ + (size_t)(wid * QBLK + (lane >> 4) + 4 * i) * nldq + (lane & 15) * 8);
    SBAR();
    finishSM(pA0, pA1, alA, l_reg, pa0, pa1, pa2, pa3, kpA); SBAR();
    pv_tile<0>(o, vb0, pa0, pa1, pa2, pa3);
    if (even) { MASKT(pB0, pB1, NT - 1, kpB); partialSM(pB0, pB1, m_reg, mnB, alB); __syncthreads(); RESC(alB);
        finishSM(pB0, pB1, alB, l_reg, pa0, pa1, pa2, pa3, kpB); SBAR(); pv_tile<1>(o, vb0, pa0, pa1, pa2, pa3); }
    SBAR(); SEAM_K0();
    {
        const int epi = cur.epi;
        float fac = l_reg > 0.f ? __builtin_amdgcn_rcpf(l_reg) : 0.f;
        if (epi != EPI_MEM) fac *= C.gates[(size_t)(cur.row0 + wid * QBLK + r32) * 36 + cur.gcol];
        if (hi == 0) li_l[r32] = fac;
        asm volatile("s_waitcnt lgkmcnt(0)" ::: "memory");
        float* stg = (float*)(lds + LDS_STG) + wid * (32 * 68);
        const int rrow = lane >> 4, c4 = (lane & 15) * 4;
        const size_t grow = (size_t)cur.row0 + wid * QBLK + rrow;
        const bool fin = (epi == EPI_FIN);
        bf16* accb = (bf16*)C.YACC + grow * NSAW + cur.hcol + c4;
        const bf16* zb = fin ? C.ZQ + grow * NSAW + cur.hcol + c4 : C.ZM + grow * C.zm_ld + C.zm_c0 + cur.hcol + c4;
        const int ldz = fin ? NSAW : C.zm_ld;
        bf16* yb = C.Y + grow * DM + (fin ? 0 : POOLW) + cur.hcol + c4;
#pragma unroll
        for (int half = 0; half < 2; ++half) {
#pragma unroll
            for (int r = 0; r < 16; ++r) { const float f = li_l[crow(r, hi)]; float* w = stg + crow(r, hi) * 68 + r32; w[0] = o[2 * half][r] * f; w[32] = o[2 * half + 1][r] * f; }
            asm volatile("s_waitcnt lgkmcnt(0)" ::: "memory");
            f32x4 v[8];
#pragma unroll
            for (int i = 0; i < 8; ++i) v[i] = *(const f32x4*)(stg + (rrow + 4 * i) * 68 + c4);
            const int co = half * 64;
            if (epi == EPI_ACC0) {
#pragma unroll
                for (int i = 0; i < 8; ++i) { v2u w; w.x = cvtpk(v[i][0], v[i][1]); w.y = cvtpk(v[i][2], v[i][3]); *(v2u*)(accb + (size_t)(4 * i) * NSAW + co) = w; }
            } else if (epi == EPI_ACC1) {
                v2u a[8];
#pragma unroll
                for (int i = 0; i < 8; ++i) a[i] = *(const v2u*)(accb + (size_t)(4 * i) * NSAW + co);
#pragma unroll
                for (int i = 0; i < 8; ++i) { v2u w; w.x = cvtpk(v[i][0] + bflo(a[i].x), v[i][1] + bfhi(a[i].x)); w.y = cvtpk(v[i][2] + bflo(a[i].y), v[i][3] + bfhi(a[i].y)); *(v2u*)(accb + (size_t)(4 * i) * NSAW + co) = w; }
            } else {
                v2u z[8];
#pragma unroll
                for (int i = 0; i < 8; ++i) z[i] = *(const v2u*)(zb + (size_t)(4 * i) * ldz + co);
                if (fin) { v2u a[8];
#pragma unroll
                    for (int i = 0; i < 8; ++i) a[i] = *(const v2u*)(accb + (size_t)(4 * i) * NSAW + co);
#pragma unroll
                    for (int i = 0; i < 8; ++i) v[i] = v[i] + (f32x4){bflo(a[i].x), bfhi(a[i].x), bflo(a[i].y), bfhi(a[i].y)}; }
#pragma unroll
                for (int i = 0; i < 8; ++i) { v2u w; w.x = pk2(v[i][0] * bflo(z[i].x), v[i][1] * bfhi(z[i].x)); w.y = pk2(v[i][2] * bflo(z[i].y), v[i][3] * bfhi(z[i].y));
                    __builtin_nontemporal_store(w, (v2u*)(yb + (size_t)(4 * i) * DM + co)); }
            }
            asm volatile("s_waitcnt lgkmcnt(0)" ::: "memory");
        }
    }
    __syncthreads();
#undef RESC
#undef TIX
#undef KBASE
#undef MASKT
#undef SEAM_K0
#undef HALF_STEP
}
#undef AROW
#undef VMWN
#undef SLOAD_H
#undef SWRITE_HK
#undef SWRITE_HV
#undef SWRITE_H
}
__device__ const unsigned short NSA_TAB[256 * 4] = {
    0, 384, 674, 65535,
    1, 385, 675, 65535,
    144, 480, 484, 65535,
    145, 481, 485, 65535,
    96, 482, 528, 65535,
    97, 483, 529, 65535,
    48, 388, 676, 65535,
    49, 389, 677, 65535,
    148, 432, 530, 65535,
    149, 433, 531, 65535,
    192, 386, 532, 65535,
    193, 387, 533, 65535,
    4, 288, 722, 65535,
    5, 289, 723, 65535,
    98, 436, 576, 65535,
    99, 437, 577, 65535,
    100, 434, 578, 65535,
    101, 435, 579, 65535,
    2, 292, 724, 65535,
    3, 293, 725, 65535,
    146, 336, 628, 65535,
    147, 337, 629, 65535,
    50, 338, 672, 65535,
    51, 339, 673, 65535,
    52, 244, 720, 65535,
    53, 245, 721, 65535,
    194, 340, 580, 65535,
    195, 341, 581, 65535,
    196, 290, 624, 65535,
    197, 291, 625, 65535,
    240, 242, 626, 65535,
    241, 243, 627, 65535,
    6, 390, 680, 65535,
    7, 391, 681, 65535,
    150, 486, 490, 65535,
    151, 487, 491, 65535,
    102, 488, 534, 65535,
    103, 489, 535, 65535,
    54, 394, 682, 65535,
    55, 395, 683, 65535,
    154, 438, 536, 65535,
    155, 439, 537, 65535,
    198, 392, 538, 65535,
    199, 393, 539, 65535,
    10, 294, 728, 65535,
    11, 295, 729, 65535,
    104, 442, 582, 65535,
    105, 443, 583, 65535,
    106, 440, 584, 65535,
    107, 441, 585, 65535,
    8, 298, 730, 65535,
    9, 299, 731, 65535,
    152, 342, 634, 65535,
    153, 343, 635, 65535,
    56, 344, 678, 65535,
    57, 345, 679, 65535,
    58, 250, 726, 65535,
    59, 251, 727, 65535,
    200, 346, 586, 65535,
    201, 347, 587, 65535,
    202, 296, 630, 65535,
    203, 297, 631, 65535,
    246, 248, 632, 65535,
    247, 249, 633, 65535,
    12, 396, 686, 65535,
    13, 397, 687, 65535,
    156, 492, 496, 65535,
    157, 493, 497, 65535,
    108, 494, 540, 65535,
    109, 495, 541, 65535,
    60, 400, 688, 65535,
    61, 401, 689, 65535,
    160, 444, 542, 65535,
    161, 445, 543, 65535,
    204, 398, 544, 65535,
    205, 399, 545, 65535,
    16, 300, 734, 65535,
    17, 301, 735, 65535,
    110, 448, 588, 65535,
    111, 449, 589, 65535,
    112, 446, 590, 65535,
    113, 447, 591, 65535,
    14, 304, 736, 65535,
    15, 305, 737, 65535,
    158, 348, 640, 65535,
    159, 349, 641, 65535,
    62, 350, 684, 65535,
    63, 351, 685, 65535,
    64, 256, 732, 65535,
    65, 257, 733, 65535,
    206, 352, 592, 65535,
    207, 353, 593, 65535,
    208, 302, 636, 65535,
    209, 303, 637, 65535,
    252, 254, 638, 65535,
    253, 255, 639, 65535,
    18, 402, 692, 65535,
    19, 403, 693, 65535,
    162, 498, 502, 65535,
    163, 499, 503, 65535,
    114, 500, 546, 65535,
    115, 501, 547, 65535,
    66, 406, 694, 65535,
    67, 407, 695, 65535,
    166, 450, 548, 65535,
    167, 451, 549, 65535,
    210, 404, 550, 65535,
    211, 405, 551, 65535,
    22, 306, 740, 65535,
    23, 307, 741, 65535,
    116, 454, 594, 65535,
    117, 455, 595, 65535,
    118, 452, 596, 65535,
    119, 453, 597, 65535,
    20, 310, 742, 65535,
    21, 311, 743, 65535,
    164, 354, 646, 65535,
    165, 355, 647, 65535,
    68, 356, 690, 65535,
    69, 357, 691, 65535,
    70, 262, 738, 65535,
    71, 263, 739, 65535,
    212, 358, 598, 65535,
    213, 359, 599, 65535,
    214, 308, 642, 65535,
    215, 309, 643, 65535,
    258, 260, 644, 65535,
    259, 261, 645, 65535,
    24, 408, 698, 65535,
    25, 409, 699, 65535,
    168, 504, 508, 65535,
    169, 505, 509, 65535,
    120, 506, 552, 65535,
    121, 507, 553, 65535,
    72, 412, 700, 65535,
    73, 413, 701, 65535,
    172, 456, 554, 65535,
    173, 457, 555, 65535,
    216, 410, 556, 65535,
    217, 411, 557, 65535,
    28, 312, 746, 65535,
    29, 313, 747, 65535,
    122, 460, 600, 65535,
    123, 461, 601, 65535,
    124, 458, 602, 65535,
    125, 459, 603, 65535,
    26, 316, 748, 65535,
    27, 317, 749, 65535,
    170, 360, 652, 65535,
    171, 361, 653, 65535,
    74, 362, 696, 65535,
    75, 363, 697, 65535,
    76, 268, 744, 65535,
    77, 269, 745, 65535,
    218, 364, 604, 65535,
    219, 365, 605, 65535,
    220, 314, 648, 65535,
    221, 315, 649, 65535,
    264, 266, 650, 65535,
    265, 267, 651, 65535,
    30, 414, 704, 65535,
    31, 415, 705, 65535,
    174, 510, 514, 65535,
    175, 511, 515, 65535,
    126, 512, 558, 65535,
    127, 513, 559, 65535,
    78, 418, 706, 65535,
    79, 419, 707, 65535,
    178, 462, 560, 65535,
    179, 463, 561, 65535,
    222, 416, 562, 65535,
    223, 417, 563, 65535,
    34, 318, 752, 65535,
    35, 319, 753, 65535,
    128, 466, 606, 65535,
    129, 467, 607, 65535,
    130, 464, 608, 65535,
    131, 465, 609, 65535,
    32, 322, 754, 65535,
    33, 323, 755, 65535,
    176, 366, 658, 65535,
    177, 367, 659, 65535,
    80, 368, 702, 65535,
    81, 369, 703, 65535,
    82, 274, 750, 65535,
    83, 275, 751, 65535,
    224, 370, 610, 65535,
    225, 371, 611, 65535,
    226, 320, 654, 65535,
    227, 321, 655, 65535,
    270, 272, 656, 65535,
    271, 273, 657, 65535,
    36, 420, 710, 65535,
    37, 421, 711, 65535,
    180, 516, 520, 65535,
    181, 517, 521, 65535,
    132, 518, 564, 65535,
    133, 519, 565, 65535,
    84, 424, 712, 65535,
    85, 425, 713, 65535,
    184, 468, 566, 65535,
    185, 469, 567, 65535,
    228, 422, 568, 65535,
    229, 423, 569, 65535,
    40, 324, 758, 65535,
    41, 325, 759, 65535,
    134, 472, 612, 65535,
    135, 473, 613, 65535,
    136, 470, 614, 65535,
    137, 471, 615, 65535,
    38, 328, 760, 65535,
    39, 329, 761, 65535,
    182, 372, 664, 65535,
    183, 373, 665, 65535,
    86, 374, 708, 65535,
    87, 375, 709, 65535,
    88, 280, 756, 65535,
    89, 281, 757, 65535,
    230, 376, 616, 65535,
    231, 377, 617, 65535,
    232, 326, 660, 65535,
    233, 327, 661, 65535,
    276, 278, 662, 65535,
    277, 279, 663, 65535,
    42, 426, 716, 65535,
    43, 427, 717, 65535,
    186, 522, 526, 65535,
    187, 523, 527, 65535,
    138, 524, 570, 65535,
    139, 525, 571, 65535,
    90, 430, 718, 65535,
    91, 431, 719, 65535,
    190, 474, 572, 65535,
    191, 475, 573, 65535,
    234, 428, 574, 65535,
    235, 429, 575, 65535,
    46, 330, 764, 65535,
    47, 331, 765, 65535,
    140, 478, 618, 65535,
    141, 479, 619, 65535,
    142, 476, 620, 65535,
    143, 477, 621, 65535,
    44, 334, 766, 65535,
    45, 335, 767, 65535,
    188, 378, 670, 65535,
    189, 379, 671, 65535,
    92, 380, 714, 65535,
    93, 381, 715, 65535,
    94, 286, 762, 65535,
    95, 287, 763, 65535,
    236, 382, 622, 65535,
    237, 383, 623, 65535,
    238, 332, 666, 65535,
    239, 333, 667, 65535,
    282, 284, 668, 65535,
    283, 285, 669, 65535,
};

constexpr int NWAVES = 8, NTHREADS = 512;
constexpr int LDS_BYTES = 147456;
constexpr int NPHASE = 12;
#ifndef MK_PER_PHASE
#define MK_PER_PHASE 0
#endif

struct Args { const void* in[17]; float* out; unsigned char* ws; int ph_lo, ph_hi; };

constexpr int TAB_OFF = LDS_BYTES - 1024;
enum { IX_X = 0, IX_MEM, IX_POS, IX_NORM_G, IX_MEM_NORM_G, IX_W_MEM_KV, IX_W_OUT, IX_A_W_IN, IX_A_W_POOL, IX_A_POOL_SCALE, IX_B_W_IN, IX_KV_NORM_G, IX_W_KV, IX_CMP_PE, IX_CMP_W1, IX_CMP_W2, IX_FINAL_G, IX_OUT, IX_WS };
__device__ __forceinline__ int lane_fresh() { int l; asm volatile("v_mbcnt_lo_u32_b32 %0, -1, 0\n\tv_mbcnt_hi_u32_b32 %0, -1, %0" : "=v"(l)); return l; }
struct Frame {
    LAS unsigned char* lds; char* ldsg;
    int wave, vcu, G;
    __device__ __forceinline__ int tid() const { return wave * 64 + lane_fresh(); }
    __device__ __forceinline__ unsigned char* ptr(int k) const {
        volatile LAS unsigned* t = (volatile LAS unsigned*)(lds + TAB_OFF);
        const unsigned lo = t[2 * k], hi = t[2 * k + 1];
        typedef __attribute__((address_space(1))) unsigned char gchar;
        return (unsigned char*)(gchar*)(((unsigned long long)(unsigned)__builtin_amdgcn_readfirstlane(hi) << 32) | (unsigned)__builtin_amdgcn_readfirstlane(lo));
    }
    __device__ __forceinline__ const float* fin(int k) const { return (const float*)ptr(k); }
};
#define WSP(T, off) ((T*)(ws + (off)))

#define XB_TMO      128
#define XB_XCNT(j)  (256  + 64 * (j))
#define XB_XSUB(j)  (1280 + 64 * (j))
#define XB_XGEN(j)  (2304 + 64 * (j))
#define XB_TOP      3328
#define XB_TOPGEN   3392
#define XCD_BAR_WORDS 3456
#define XB_SPIN_CAP (1u << 20)
constexpr int MISC_OFF = LDS_BYTES - 512;
__device__ __forceinline__ unsigned xb_ld(unsigned* p)              { return __hip_atomic_load(p, __ATOMIC_RELAXED, __HIP_MEMORY_SCOPE_AGENT); }
__device__ __forceinline__ unsigned xb_add(unsigned* p, unsigned v) { return __hip_atomic_fetch_add(p, v, __ATOMIC_RELAXED, __HIP_MEMORY_SCOPE_AGENT); }
__device__ __forceinline__ unsigned xb_xcc_id() { return (unsigned)__builtin_amdgcn_s_getreg((3 << 11) | 20) & 0xFu; }
#define XB_SPIN(cond, bar) do { unsigned _sp = 0; while (cond) { __builtin_amdgcn_s_sleep(1); \
    if ((++_sp & 255u) == 0u) { if (xb_ld(&(bar)[XB_TMO])) break; if (_sp > XB_SPIN_CAP) { atomicAdd(&(bar)[XB_TMO], 1u); break; } } } } while (0)
__device__ __forceinline__ void xcd_barrier_complete(unsigned* bar, unsigned x, unsigned G, unsigned& nloc, unsigned& nx) {
    unsigned sum, cnt, mine, sp = 0u;
    for (;;) {
        sum = 0u; cnt = 0u; mine = 0u;
#pragma unroll
        for (unsigned j = 0; j < 16; ++j) { const unsigned c = xb_ld(&bar[XB_XCNT(j)]); sum += c; cnt += (c > 0u) ? 1u : 0u; mine = (j == x) ? c : mine; }
        if (sum == G) break;
        __builtin_amdgcn_s_sleep(1);
        if ((++sp & 255u) == 0u) { if (xb_ld(&bar[XB_TMO])) break; if (sp > XB_SPIN_CAP) { atomicAdd(&bar[XB_TMO], 1u); break; } }
    }
    nloc = mine > 0u ? mine : 1u; nx = cnt > 0u ? cnt : 1u;
}
__device__ __forceinline__ void xcd_barrier(unsigned* bar, volatile LAS unsigned* st, unsigned G, int tid) {
    asm volatile("s_waitcnt vmcnt(0)" ::: "memory");
    __syncthreads();
    if (tid == 0) {
        const unsigned x = xb_xcc_id();
        __builtin_amdgcn_s_waitcnt(0);
        unsigned nloc = st[0], nx = st[1];
        if (nloc == 0u) { xcd_barrier_complete(bar, x, G, nloc, nx); st[0] = nloc; st[1] = nx; }
        const unsigned old = xb_add(&bar[XB_XSUB(x)], 1u);
        const unsigned gen = old / nloc;
        if (old + 1u == (gen + 1u) * nloc) {
            __builtin_amdgcn_fence(__ATOMIC_RELEASE, "agent");
            asm volatile("s_waitcnt vmcnt(0)" ::: "memory");
            const unsigned og = xb_add(&bar[XB_TOP], 1u);
            const unsigned tg = og / nx;
            if (og + 1u == (tg + 1u) * nx) xb_add(&bar[XB_TOPGEN], 1u);
            else XB_SPIN(xb_ld(&bar[XB_TOPGEN]) == tg, bar);
            __builtin_amdgcn_fence(__ATOMIC_ACQUIRE, "agent");
            xb_add(&bar[XB_XGEN(x)], 1u);
            asm volatile("s_waitcnt vmcnt(0)" ::: "memory");
        } else {
            XB_SPIN(xb_ld(&bar[XB_XGEN(x)]) == gen, bar);
            __builtin_amdgcn_fence(__ATOMIC_ACQUIRE, "agent");
            asm volatile("s_waitcnt vmcnt(0)" ::: "memory");
        }
    }
    __syncthreads();
}

struct TDesc { const float* W; const float* gain; bf16* WT; int ldw, c0, nv, ldt, row0, k0; };
__device__ __forceinline__ void tload(const TDesc& d, f32x4 (&v)[16], int lane) {
    const int n4 = (lane & 15) * 4, kr = lane >> 4;
    const float* src = d.W + (size_t)(d.k0 + kr) * d.ldw + d.c0 + n4;
    if (n4 < d.nv) {
#pragma unroll
        for (int i = 0; i < 16; ++i) v[i] = __builtin_nontemporal_load((const f32x4*)(src + (size_t)(4 * i) * d.ldw));
    } else {
#pragma unroll
        for (int i = 0; i < 16; ++i) v[i] = (f32x4){0.f, 0.f, 0.f, 0.f};
    }
}
__device__ __forceinline__ void tproc(const TDesc& d, f32x4 (&v)[16], LAS float* scr, int lane) {
    const int n4 = (lane & 15) * 4, kr = lane >> 4;
    if (d.gain) {
#pragma unroll
        for (int i = 0; i < 16; ++i) v[i] = v[i] * d.gain[d.k0 + kr + 4 * i];
    }
#pragma unroll
    for (int i = 0; i < 16; ++i) { LAS float* q = scr + (kr + 4 * i) * 65 + n4; q[0] = v[i][0]; q[1] = v[i][1]; q[2] = v[i][2]; q[3] = v[i][3]; }
    LDS_WAIT(); asm volatile("" ::: "memory");
    const int ch = lane & 7;
#pragma unroll
    for (int j = 0; j < 8; ++j) { const int n = (lane >> 3) + 8 * j; const LAS float* s = scr + (8 * ch) * 65 + n;
        v4u o; o.x = pk2(s[0 * 65], s[1 * 65]); o.y = pk2(s[2 * 65], s[3 * 65]); o.z = pk2(s[4 * 65], s[5 * 65]); o.w = pk2(s[6 * 65], s[7 * 65]);
        if (n < d.nv) *(v4u*)(d.WT + (size_t)(d.row0 + n) * d.ldt + d.k0 + 8 * ch) = o; }
    LDS_WAIT(); asm volatile("" ::: "memory");
}
__device__ __forceinline__ void rms_load(const float* xrow, f32x4 (&v)[8], int lane) {
    const f32x4* xr = (const f32x4*)xrow + lane;
#pragma unroll
    for (int j = 0; j < 8; ++j) v[j] = __builtin_nontemporal_load(xr + 64 * j);
}
__device__ __forceinline__ void rms_finish(f32x4 (&v)[8], const float* g, bf16* orow, int lane, float* rinv_out = nullptr) {
    float s = 0.f;
#pragma unroll
    for (int j = 0; j < 8; ++j) s += (v[j].x * v[j].x + v[j].y * v[j].y) + (v[j].z * v[j].z + v[j].w * v[j].w);
    float rinv = 1.0f / sqrtf(wave_sum(s) * (1.f / DM) + EPS);
    if (rinv_out) { if (lane == 0) *rinv_out = rinv; rinv = 1.f; }
    unsigned long long* o8 = (unsigned long long*)orow + lane;
#pragma unroll
    for (int j = 0; j < 8; ++j) { f32x4 gg = g ? ((const f32x4*)g)[64 * j + lane] : (f32x4){1.f, 1.f, 1.f, 1.f};
        o8[64 * j] = (unsigned long long)pk2(v[j].x * rinv * gg.x, v[j].y * rinv * gg.y) | ((unsigned long long)pk2(v[j].z * rinv * gg.z, v[j].w * rinv * gg.w) << 32); }
}
__device__ __forceinline__ void sincos_acc(float angf, float& c, float& s) {
    const double a = (double)angf;
    const double kq = rint(a * 0.63661977236758134308);
    const double r = fma(-kq, 6.123233995736766e-17, fma(-kq, 1.5707963267948966, a));
    const double r2 = r * r;
    double sp = -2.5052108385441718775e-08; sp = fma(sp, r2, 2.7557319223985890653e-06); sp = fma(sp, r2, -1.9841269841269841270e-04); sp = fma(sp, r2, 8.3333333333333332177e-03); sp = fma(sp, r2, -1.6666666666666665741e-01);
    const double sn = fma(sp * r2, r, r) + r2 * r2 * r2 * r2 * r2 * r2 * r * 1.6059043836821614599e-10;
    double cp = 2.0876756987868098979e-09; cp = fma(cp, r2, -2.7557319223985890653e-07); cp = fma(cp, r2, 2.4801587301587301566e-05); cp = fma(cp, r2, -1.3888888888888889419e-03); cp = fma(cp, r2, 4.1666666666666664354e-02); cp = fma(cp, r2, -0.5);
    const double cs = fma(cp, r2, 1.0);
    const int q = ((int)kq) & 3;
    const double sv = (q & 1) ? cs : sn, cv = (q & 1) ? sn : cs;
    s = (float)((q & 2) ? -sv : sv);
    c = (float)(((q + 1) & 2) ? -cv : cv);
}
__device__ __forceinline__ float rope_inv(int i) {
    return (float)exp2(-(double)i * (18.931568569324174 / 16.0));
}

template <int WHICH>
__device__ __forceinline__ void transposes(Frame& F, int gw, int NGW, int lane) {
    unsigned char* ws = F.ptr(IX_WS);
    LAS float* scr = (LAS float*)(F.lds + F.wave * 16640);
    const float* a_w_in = F.fin(IX_A_W_IN); const float* w_out = F.fin(IX_W_OUT); const float* w_kv = F.fin(IX_W_KV); const float* b_w_in = F.fin(IX_B_W_IN);
    const float* norm_g = F.fin(IX_NORM_G); const float* kv_norm_g = F.fin(IX_KV_NORM_G); const float* mem_norm_g = F.fin(IX_MEM_NORM_G); const float* w_mem_kv = F.fin(IX_W_MEM_KV);
    const float* a_w_pool = F.fin(IX_A_W_POOL); const float* cmp_w1 = F.fin(IX_CMP_W1);
    bf16* W1T = WSP(bf16, WS_W1T); bf16* WO0T = WSP(bf16, WS_WO0T); bf16* W4T = WSP(bf16, WS_W4T); bf16* WO1T = WSP(bf16, WS_WO1T);
    bf16* WMT = WSP(bf16, WS_WMT); bf16* WPT = WSP(bf16, WS_WPT); bf16* WC1T = WSP(bf16, WS_WC1T);
#define SEG(W_, ldw_, K_, c0_, nc_, WT_, row0_, gain_) if (!done_) { const int nb_ = ((nc_) + 63) / 64, ni_ = ((K_) / 64) * nb_; \
        if (r < ni_) { const int kb = r / nb_, nb = r % nb_; int nv = (nc_) - nb * 64; nv = nv > 64 ? 64 : nv; \
            d.W = W_; d.gain = gain_; d.WT = WT_; d.ldw = ldw_; d.c0 = (c0_) + nb * 64; d.nv = nv; d.ldt = K_; d.row0 = (row0_) + nb * 64; d.k0 = kb * 64; done_ = true; } else r -= ni_; }
#define TDECODE(it_, dd_) do { TDesc& d = (dd_); int r = (it_); bool done_ = false; \
      if constexpr (WHICH == 0) { \
        SEG(a_w_in, N1, DM, POOLW, N1 - POOLW, W1T, POOLW, norm_g)        \
        SEG(w_mem_kv, 1024, DM, 0, 1024, WMT, 0, mem_norm_g) \
      } else { \
        SEG(w_out, DM, DM, 0, DM, WO0T, 0, nullptr) \
        SEG(w_out + (size_t)DM * DM, DM, DM, 0, DM, WO1T, 0, nullptr) \
        SEG(w_kv, NKV, DM, 0, NKV, W4T, 0, kv_norm_g) \
        SEG(b_w_in, 4132, DM, 0, 1536, W4T, 3072, norm_g + DM)            \
        SEG(b_w_in, 4132, DM, 1572, 1536, W4T, 4608, norm_g + DM)         \
        SEG(b_w_in, 4132, DM, 3108, 512, W4T, 6144, norm_g + DM)          \
        SEG(b_w_in, 4132, DM, 3620, 512, W4T, 6656, norm_g + DM)          \
        SEG(b_w_in, 4132, DM, 1536, 36, W4T, 7168, norm_g + DM)           \
        SEG(w_mem_kv + (size_t)DM * 1024, 1024, DM, 0, 1024, WMT + (size_t)1024 * DM, 0, mem_norm_g + DM) \
        SEG(a_w_pool + 0 * 384 * 384, 384, 384, 0, 384, WPT + 0 * 512 * 384, 0, nullptr) \
        SEG(a_w_pool + 1 * 384 * 384, 384, 384, 0, 384, WPT + 1 * 512 * 384, 0, nullptr) \
        SEG(a_w_pool + 2 * 384 * 384, 384, 384, 0, 384, WPT + 2 * 512 * 384, 0, nullptr) \
        SEG(a_w_pool + 3 * 384 * 384, 384, 384, 0, 384, WPT + 3 * 512 * 384, 0, nullptr) \
        SEG(cmp_w1, 256, 4096, 0, 256, WC1T, 0, nullptr) \
        SEG(cmp_w1 + (size_t)4096 * 256, 256, 4096, 0, 256, WC1T + (size_t)256 * 4096, 0, nullptr) \
      } \
    } while (0)
    constexpr int NITEMS = WHICH == 0 ? 32 * 40 + 32 * 16 : 2 * 32 * 32 + 32 * 48 + 32 * (24 + 24 + 8 + 8 + 1) + 32 * 16 + 4 * 6 * 6 + 2 * 64 * 4;
    {
        TDesc da{}, db{}; f32x4 va[16], vb[16];
        if (gw < NITEMS) { TDECODE(gw, da); tload(da, va, lane); }
        for (int it = gw; it < NITEMS; it += 2 * NGW) {
            const bool hb = it + NGW < NITEMS;
            if (hb) { TDECODE(it + NGW, db); tload(db, vb, lane); }
            tproc(da, va, scr, lane);
            if (it + 2 * NGW < NITEMS) { TDECODE(it + 2 * NGW, da); tload(da, va, lane); }
            if (hb) tproc(db, vb, scr, lane);
        }
    }
#undef TDECODE
#undef SEG
}

__device__ __forceinline__ void p0_prologue(Frame& F) {
    const int tid = F.tid(), lane = tid & 63; unsigned char* ws = F.ptr(IX_WS);
    const int gw = F.vcu * NWAVES + F.wave, NGW = F.G * NWAVES;
    const float* norm_g = F.fin(IX_NORM_G); const float* cmp_w1 = F.fin(IX_CMP_W1);
    bf16* W4T = WSP(bf16, WS_W4T); bf16* WPT = WSP(bf16, WS_WPT);
    const int gw1 = (gw + NGW - 1792 % NGW) % NGW, gwx = (gw + 2 * NGW - 1792 % NGW - 6832 % NGW) % NGW;
    transposes<0>(F, gw, NGW, lane);
    transposes<1>(F, gw1, NGW, lane);
    bf16* XN = WSP(bf16, WS_XB); bf16* MEMN = WSP(bf16, WS_MEMN); float* RINV0 = WSP(float, WS_RINV0);
    { const float* xin = F.fin(IX_X); const float* memin = F.fin(IX_MEM);
      constexpr int NROWS = MTOK + NB * MEMLEN;
      for (int m = gwx; m < NROWS; m += 4 * NGW) {
          f32x4 a[8], b[8], c[8], d[8];
          const int m1 = m + NGW, m2 = m + 2 * NGW, m3 = m + 3 * NGW;
#define RSRC(mm) ((mm) < MTOK ? xin + (size_t)(mm) * DM : memin + (size_t)((mm) - MTOK) * DM)
#define RFIN(mm, v) do { if ((mm) < MTOK) rms_finish(v, nullptr, XN + (size_t)(mm) * DM, lane, RINV0 + (mm)); else rms_finish(v, nullptr, MEMN + (size_t)((mm) - MTOK) * DM, lane); } while (0)
          rms_load(RSRC(m), a, lane);
          if (m1 < NROWS) rms_load(RSRC(m1), b, lane);
          if (m2 < NROWS) rms_load(RSRC(m2), c, lane);
          if (m3 < NROWS) rms_load(RSRC(m3), d, lane);
          RFIN(m, a);
          if (m1 < NROWS) RFIN(m1, b);
          if (m2 < NROWS) RFIN(m2, c);
          if (m3 < NROWS) RFIN(m3, d);
#undef RSRC
#undef RFIN
      } }
    const int gt = F.vcu * NTHREADS + tid, NGT = F.G * NTHREADS, gtr = NGT - 1 - gt; const int* positions = (const int*)F.ptr(IX_POS);
    float* ROPE = WSP(float, WS_ROPE); float* ROPEC = WSP(float, WS_ROPEC);
    {
    for (int i = gt; i < MTOK * 16; i += NGT) { const int tok = i >> 4, fi = i & 15;
        const float ang = (float)positions[tok] * rope_inv(fi); float c, s; sincos_acc(ang, c, s);
        ROPE[tok * 32 + fi] = c; ROPE[tok * 32 + 16 + fi] = s; }
    for (int i = gtr; i < NB * 256 * 16; i += NGT) { const int bn = i >> 4, fi = i & 15, b = bn >> 8, n = bn & 255;
        float c = 1.f, s = 0.f;
        if (n < NCMP) { const float ang = (float)positions[b * SEQ + 16 * n + 31] * rope_inv(fi); sincos_acc(ang, c, s); }
        ROPEC[bn * 32 + fi] = c; ROPEC[bn * 32 + 16 + fi] = s; }
    }
    { v4u z = {0u, 0u, 0u, 0u};
      v4u* p = (v4u*)(W4T + (size_t)7204 * DM); for (int i = gtr; i < 220 * DM / 8; i += NGT) p[i] = z;
      for (int g = 0; g < 4; ++g) { v4u* q = (v4u*)(WPT + (size_t)g * 512 * 384 + 384 * 384); for (int i = gtr; i < 128 * 384 / 8; i += NGT) q[i] = z; }
      v4u* kvp = (v4u*)(WSP(bf16, WS_KVB) + (size_t)MTOK * NKV); for (int i = gtr; i < 32 * NKV / 8; i += NGT) kvp[i] = z;
      for (int b = 0; b < NB; ++b) { v4u* k = (v4u*)(WSP(bf16, WS_KCMP) + (size_t)(b * 256 + 255) * 512); v4u* v = (v4u*)(WSP(bf16, WS_VCMP) + (size_t)(b * 256 + 255) * 512);
          for (int i = gtr; i < 512 / 8; i += NGT) { k[i] = z; v[i] = z; } } }
    { const float* a_w_in = F.fin(IX_A_W_IN); bf16* W1U = WSP(bf16, WS_W1U);
      for (int i = gt; i < DM * (POOLW / 8); i += NGT) { const int k = i / (POOLW / 8), c8 = (i - k * (POOLW / 8)) * 8; const float* s = a_w_in + (size_t)k * N1 + c8;
          const float gk = norm_g[k]; const f32x4 a = __builtin_nontemporal_load((const f32x4*)s) * gk, b = __builtin_nontemporal_load((const f32x4*)(s + 4)) * gk; v4u w; w.x = cvtpk(a[0], a[1]); w.y = cvtpk(a[2], a[3]); w.z = cvtpk(b[0], b[1]); w.w = cvtpk(b[2], b[3]); *(v4u*)(W1U + (size_t)k * POOLW + c8) = w; } }
    { const float* w2 = F.fin(IX_CMP_W2); bf16* W2T = WSP(bf16, WS_W2T);
      for (int i = gt; i < 2 * 128 * 256; i += NGT) { const int k = i & 255, n = (i >> 8) & 127, kv = i >> 15; W2T[i] = (bf16)f2bf(w2[((size_t)kv * 256 + k) * 128 + n]); } }
    __syncthreads();
    for (int item = F.vcu; item < 256; item += F.G) {
        const int ks = item & 31, kv = (item >> 5) & 1, j = (item >> 6) * 64 + lane; const float* pe = F.fin(IX_CMP_PE) + kv * 4096; const float* w1 = cmp_w1 + (size_t)kv * 4096 * 256;
        float a = 0.f; const int kb = ks * 128 + F.wave * 16;
#pragma unroll
        for (int k = 0; k < 16; ++k) a = fmaf(pe[kb + k], w1[(size_t)(kb + k) * 256 + j], a);
        LAS float* red = (LAS float*)F.lds;
        red[F.wave * 64 + lane] = a; __syncthreads();
        if (F.wave == 0) { float t = 0.f; for (int w = 0; w < 8; ++w) t += red[w * 64 + lane]; WSP(float, WS_CBIAS)[(ks * 2 + kv) * 256 + j] = t; }
        __syncthreads();
    }
}

__device__ __forceinline__ void st_bf4(bf16* p, f32x4 v) { v2u w; w.x = cvtpk(v[0], v[1]); w.y = cvtpk(v[2], v[3]); *(v2u*)p = w; }
__device__ __forceinline__ f32x4 silu4(f32x4 v) { return (f32x4){silu_f(v[0]), silu_f(v[1]), silu_f(v[2]), silu_f(v[3])}; }
__device__ __forceinline__ void p2_pool(Frame& F) {
    unsigned char* ws = F.ptr(IX_WS);
    if (F.vcu == F.G - 1) {
        const int t = F.tid(); const float* CBP = WSP(float, WS_CBIAS); float s = 0.f;
#pragma unroll
        for (int ks = 0; ks < 32; ++ks) s += CBP[(ks * 2 + (t >> 8)) * 256 + (t & 255)];
        WSP(float, WS_CBIASF)[t] = s; }
    const int Gp = (F.G * 3) >> 2;
    if (F.vcu >= Gp) {
        const float* SL = (const float*)(ws + WS_D); bf16* MKV0 = WSP(bf16, WS_MKV);
        const int gt0 = (F.vcu - Gp) * NTHREADS + F.tid(), NGT0 = (F.G - Gp) * NTHREADS;
        for (int i0 = gt0; i0 < 2 * 1024 * 1024 / 4; i0 += 4 * NGT0) {
            f32x4 a[4][8];
#pragma unroll
            for (int e = 0; e < 4; ++e) { const int i = i0 + e * NGT0; const bool ok = i < 2 * 1024 * 1024 / 4;
                const float* s0 = SL + (size_t)(i >> 18) * 8 * 1024 * 1024 + (size_t)(i & 262143) * 4;
#pragma unroll
                for (int z = 0; z < 8; ++z) a[e][z] = ok ? *(const f32x4*)(s0 + (size_t)z * 1024 * 1024) : (f32x4){0.f, 0.f, 0.f, 0.f}; }
#pragma unroll
            for (int e = 0; e < 4; ++e) { const int i = i0 + e * NGT0;
                if (i < 2 * 1024 * 1024 / 4) { f32x4 s = a[e][0];
#pragma unroll
                    for (int z = 1; z < 8; ++z) s += a[e][z];
                    st_bf4(MKV0 + (size_t)i * 4, s); } }
        }
        return;
    }
    const bf16* PROJ = WSP(bf16, WS_A); bf16* Y0 = WSP(bf16, WS_B); const float* pscale = F.fin(IX_A_POOL_SCALE);
    const int gt = F.vcu * NTHREADS + F.tid(), NGT = Gp * NTHREADS;
    constexpr int NV = POOLW / 8;
    for (int idx = gt; idx < (MTOK / 32) * NV; idx += NGT) {
        const int vec = idx % NV, chunk = idx / NV, g = vec / 48, win = 2 << g;
        const int row0 = chunk * 32, tb0 = row0 & (SEQ - 1);
        const bf16* up = PROJ + (size_t)row0 * N1 + vec * 8;
        const f32x4 sc0 = *(const f32x4*)(pscale + vec * 8), sc1 = *(const f32x4*)(pscale + vec * 8 + 4);
        float S[8];
#pragma unroll
        for (int e = 0; e < 8; ++e) S[e] = 0.f;
#define P2_ADD(V_, sg) do { const v4u q_ = (V_); S[0] sg bflo(q_.x); S[1] sg bfhi(q_.x); S[2] sg bflo(q_.y); S[3] sg bfhi(q_.y); S[4] sg bflo(q_.z); S[5] sg bfhi(q_.z); S[6] sg bflo(q_.w); S[7] sg bfhi(q_.w); } while (0)
        {
            v4u hw[15];
#pragma unroll
            for (int i = 1; i < 16; ++i) hw[i - 1] = (i < win && tb0 - i >= 0) ? *(const v4u*)(up - (size_t)i * N1) : (v4u){0u, 0u, 0u, 0u};
#pragma unroll
            for (int i = 0; i < 15; ++i) P2_ADD(hw[i], +=);
        }
#pragma unroll 1
        for (int t8 = 0; t8 < 32; t8 += 8) {
            v4u w[8], x[8], zg[8];
#pragma unroll
            for (int e = 0; e < 8; ++e) w[e] = *(const v4u*)(up + (size_t)(t8 + e) * N1);
#pragma unroll
            for (int e = 0; e < 8; ++e) zg[e] = *(const v4u*)(up + (size_t)(t8 + e) * N1 + POOLW);
#pragma unroll
            for (int e = 0; e < 8; ++e) { const int tt = t8 + e - win + 1; x[e] = (tb0 + tt >= 0) ? *(const v4u*)(up + (ptrdiff_t)tt * N1) : (v4u){0u, 0u, 0u, 0u}; }
#pragma unroll
            for (int e = 0; e < 8; ++e) {
                const float u[8] = {bflo(w[e].x), bfhi(w[e].x), bflo(w[e].y), bfhi(w[e].y), bflo(w[e].z), bfhi(w[e].z), bflo(w[e].w), bfhi(w[e].w)};
                const int tb = tb0 + t8 + e; const float inv = 1.0f / (float)(tb + 1 < win ? tb + 1 : win);
                float o[8];
#pragma unroll
                for (int c = 0; c < 8; ++c) { S[c] += u[c]; o[c] = S[c] * inv - u[c]; }
                const v4u z = zg[e];
                o[0] *= sc0[0] * bflo(z.x); o[1] *= sc0[1] * bfhi(z.x); o[2] *= sc0[2] * bflo(z.y); o[3] *= sc0[3] * bfhi(z.y);
                o[4] *= sc1[0] * bflo(z.z); o[5] *= sc1[1] * bfhi(z.z); o[6] *= sc1[2] * bflo(z.w); o[7] *= sc1[3] * bfhi(z.w);
                v4u ow; ow.x = pk2(o[0], o[1]); ow.y = pk2(o[2], o[3]); ow.z = pk2(o[4], o[5]); ow.w = pk2(o[6], o[7]);
                *(v4u*)(Y0 + (size_t)(row0 + t8 + e) * DM + vec * 8) = ow;
                P2_ADD(x[e], -=);
            }
        }
#undef P2_ADD
    }
}

struct SchedLin {
    int nM, nN, nz, G, c, wgm;
    const char* A; const char* B; size_t a_pm, a_z, b_pn, b_z;
    int xM, xN; const char* XA; const char* XB; size_t xa_pm, xb_pn;
    __device__ __forceinline__ bool next(int i, pg8::Unit& u) const {
        const long L = (long)i * G + c; const int per = nM * nN; const long tot = (long)per * nz;
        if (L < tot) { const int z = (int)(L / per); int pm, pn; pg8::tile_swz((int)(L % per), nM, nN, wgm, pm, pn);
            u.pm = pm; u.pn = pn; u.z = z; u.kind = 0; u.a = A + pm * a_pm + z * a_z; u.b = B + pn * b_pn + z * b_z; return true; }
        const long X = L - tot; if (X >= (long)xM * xN) return false;
        u.pm = (int)(X / xN); u.pn = (int)(X % xN); u.z = 0; u.kind = 1; u.a = XA + u.pm * xa_pm; u.b = XB + u.pn * xb_pn; return true;
    }
};
struct SchedCmp {
    int G, c; const char* KV; const char* W;
    __device__ __forceinline__ bool next(int i, pg8::Unit& u) const {
        const int L = i * G + c; if (L >= 256) return false;
        const int pm = L & 15, kv = (L >> 4) & 1, ks = L >> 5, b = pm >> 2, g = pm & 3;
        u.pm = pm; u.pn = 0; u.z = ks * 2 + kv; u.kind = 0;
        u.a = KV + ((size_t)((kv * 4 + b) * 4 + g) * SEQ * 128 + ks * 512) * 2;
        u.b = W + ((size_t)kv * 256 * 4096 + ks * 512) * 2;
        return true;
    }
};

struct SchedMem {
    int G, c; const char* A; const char* B;
    __device__ __forceinline__ bool next(int i, pg8::Unit& u) const {
        const int L = i * G + c; if (L >= 256) return false;
        const int pm = L & 3, pn = (L >> 2) & 3, ks = (L >> 4) & 7, layer = L >> 7;
        u.pm = pm; u.pn = pn; u.z = layer * 8 + ks; u.kind = 0;
        u.a = A + (size_t)pm * 256 * DM * 2 + ks * 512;
        u.b = B + ((size_t)layer * 1024 + pn * 256) * DM * 2 + ks * 512;
        return true;
    }
};
struct SchedW {
    int G, c; const char* A; const char* B;
    __device__ __forceinline__ bool next(int i, pg8::Unit& u) const {
        const int L = i * G + c; if (L >= 64) return false;
        const int g = L >> 4, pm = (L >> 3) & 1, pn = L & 7;
        u.pm = pm; u.pn = pn; u.z = g; u.kind = 0;
        u.a = A + (size_t)(g * 512 + pm * 256) * 384 * 2;
        u.b = B + (size_t)pn * 256 * POOLW * 2 + g * 384 * 2;
        return true;
    }
};
struct SchedGate {
    int G, c; const char* A; const char* B;
    __device__ __forceinline__ bool next(int i, pg8::Unit& u) const {
        const int L = i * G + c; if (L >= 256) return false;
        const int pm = L >> 2, ks = L & 3;
        u.pm = pm; u.pn = 0; u.z = ks; u.kind = 0;
        u.a = A + (size_t)pm * 256 * DM * 2 + ks * 1024;
        u.b = B + ks * 1024;
        return true;
    }
};

#define EPI_ROWS(ai, m) (u.pm * 256 + (ai) * 128 + wr * 64 + (m) * 16 + fr)
#define EPI_COL(bj, n) ((bj) * 128 + wc * 32 + (n) * 16 + fq * 4)
typedef f32x4 acc_t[2][2][4][2];

#define EPI_C8(bj) (64 * wc + 32 * (bj) + 8 * fq)
__device__ __forceinline__ void st_bf8(bf16* p, f32x4 a, f32x4 b) { v4u w; w.x = cvtpk(a[0], a[1]); w.y = cvtpk(a[2], a[3]); w.z = cvtpk(b[0], b[1]); w.w = cvtpk(b[2], b[3]); *(v4u*)p = w; }
struct Epi1 {
    static constexpr bool PERM = true;
    bf16* proj; const float* rinv0;
    struct State { float rinv[2][4]; };
    __device__ __forceinline__ void begin(acc_t& acc, State& st, const pg8::Unit& u, int wr, int wc, int fr, int fq) const {
#pragma unroll
        for (int a = 0; a < 2; ++a)
#pragma unroll
            for (int b = 0; b < 2; ++b)
#pragma unroll
                for (int m = 0; m < 4; ++m)
#pragma unroll
                    for (int n = 0; n < 2; ++n) acc[a][b][m][n] = (f32x4){0.f, 0.f, 0.f, 0.f};
#pragma unroll
        for (int ai = 0; ai < 2; ++ai)
#pragma unroll
            for (int m = 0; m < 4; ++m) st.rinv[ai][m] = rinv0[EPI_ROWS(ai, m)];
    }
    __device__ __forceinline__ void operator()(const acc_t& acc, State& st, const pg8::Unit& u, int wr, int wc, int fr, int fq) const {
        const bool act = (u.pn >= 6 && u.pn < 12) || u.pn >= 14;
#pragma unroll
        for (int ai = 0; ai < 2; ++ai)
#pragma unroll
            for (int m = 0; m < 4; ++m) { bf16* rowp = proj + (size_t)EPI_ROWS(ai, m) * N1 + u.pn * 256; const float rinv = st.rinv[ai][m];
#pragma unroll
                for (int bj = 0; bj < 2; ++bj) { f32x4 v0 = acc[ai][bj][m][0] * rinv, v1 = acc[ai][bj][m][1] * rinv; if (act) { v0 = silu4(v0); v1 = silu4(v1); } st_bf8(rowp + EPI_C8(bj), v0, v1); } }
    }
};
struct Epi3 {
    static constexpr bool PERM = true;
    const float* scale; const bf16* proj; bf16* y0;
    struct State {};
    __device__ __forceinline__ void begin(acc_t& acc, State&, const pg8::Unit&, int, int, int, int) const {
#pragma unroll
        for (int a = 0; a < 2; ++a)
#pragma unroll
            for (int b = 0; b < 2; ++b)
#pragma unroll
                for (int m = 0; m < 4; ++m)
#pragma unroll
                    for (int n = 0; n < 2; ++n) acc[a][b][m][n] = (f32x4){0.f, 0.f, 0.f, 0.f};
    }
    __device__ __forceinline__ void operator()(const acc_t& acc, State&, const pg8::Unit& u, int wr, int wc, int fr, int fq) const {
        const int g = u.z;
#pragma unroll
        for (int ai = 0; ai < 2; ++ai)
#pragma unroll
            for (int m = 0; m < 4; ++m) { const size_t row = EPI_ROWS(ai, m);
#pragma unroll
                for (int bj = 0; bj < 2; ++bj) { const int d = u.pn * 256 + EPI_C8(bj);
                    if (d < 384) {
                        const f32x4 sc0 = *(const f32x4*)(scale + g * 384 + d), sc1 = *(const f32x4*)(scale + g * 384 + d + 4);
                        const v4u zw = *(const v4u*)(proj + row * N1 + POOLW + g * 384 + d);
                        f32x4 v0 = acc[ai][bj][m][0] * sc0, v1 = acc[ai][bj][m][1] * sc1;
                        v0[0] *= bflo(zw.x); v0[1] *= bfhi(zw.x); v0[2] *= bflo(zw.y); v0[3] *= bfhi(zw.y); v1[0] *= bflo(zw.z); v1[1] *= bfhi(zw.z); v1[2] *= bflo(zw.w); v1[3] *= bfhi(zw.w);
                        st_bf8(y0 + row * DM + g * 384 + d, v0, v1); } }
                asm volatile("" ::: "memory"); }
    }
};
template <bool RES_BF16>
struct EpiRes {
    static constexpr bool PERM = true;
    const void* res; bf16* hb; float* ss;
    struct State {};
    __device__ __forceinline__ void begin(acc_t& acc, State&, const pg8::Unit& u, int wr, int wc, int fr, int fq) const {
#pragma unroll
        for (int ai = 0; ai < 2; ++ai)
#pragma unroll
            for (int m = 0; m < 4; ++m) { const size_t row = EPI_ROWS(ai, m);
#pragma unroll
                for (int bj = 0; bj < 2; ++bj) { const size_t off = row * DM + u.pn * 256 + EPI_C8(bj);
                    if constexpr (RES_BF16) { const v4u w = __builtin_nontemporal_load((const v4u*)((const bf16*)res + off));
                        acc[ai][bj][m][0] = (f32x4){bflo(w.x), bfhi(w.x), bflo(w.y), bfhi(w.y)}; acc[ai][bj][m][1] = (f32x4){bflo(w.z), bfhi(w.z), bflo(w.w), bfhi(w.w)}; }
                    else { acc[ai][bj][m][0] = __builtin_nontemporal_load((const f32x4*)((const float*)res + off)); acc[ai][bj][m][1] = __builtin_nontemporal_load((const f32x4*)((const float*)res + off + 4)); } } }
    }
    __device__ __forceinline__ void operator()(const acc_t& acc, State&, const pg8::Unit& u, int wr, int wc, int fr, int fq) const {
#pragma unroll
        for (int ai = 0; ai < 2; ++ai)
#pragma unroll
            for (int m = 0; m < 4; ++m) { const size_t row = EPI_ROWS(ai, m); float s = 0.f;
#pragma unroll
                for (int bj = 0; bj < 2; ++bj) { const f32x4 h0 = acc[ai][bj][m][0], h1 = acc[ai][bj][m][1];
                    st_bf8(hb + row * DM + u.pn * 256 + EPI_C8(bj), h0, h1);
                    s += (h0[0] * h0[0] + h0[1] * h0[1]) + (h0[2] * h0[2] + h0[3] * h0[3]) + (h1[0] * h1[0] + h1[1] * h1[1]) + (h1[2] * h1[2] + h1[3] * h1[3]); }
                s += __shfl_xor(s, 16); s += __shfl_xor(s, 32);
                if (fq == 0) ss[row * 32 + u.pn * 4 + wc] = s; }
    }
};
struct Epi5 {
    static constexpr bool PERM = true;
    const float* rinv1; bf16 *kv, *q1, *zq, *qm1, *zm1;
    struct State { float rinv[2][4]; };
    __device__ __forceinline__ void begin(acc_t& acc, State& st, const pg8::Unit& u, int wr, int wc, int fr, int fq) const {
#pragma unroll
        for (int a = 0; a < 2; ++a)
#pragma unroll
            for (int b = 0; b < 2; ++b)
#pragma unroll
                for (int m = 0; m < 4; ++m)
#pragma unroll
                    for (int n = 0; n < 2; ++n) acc[a][b][m][n] = (f32x4){0.f, 0.f, 0.f, 0.f};
#pragma unroll
        for (int ai = 0; ai < 2; ++ai)
#pragma unroll
            for (int m = 0; m < 4; ++m) st.rinv[ai][m] = rinv1[EPI_ROWS(ai, m)];
    }
    __device__ __forceinline__ void operator()(const acc_t& acc, State& st, const pg8::Unit& u, int wr, int wc, int fr, int fq) const {
        const int pn = u.pn;
        bf16* base; int ld, c0; bool act = false;
        const bool kvt = pn < 12;
        if (kvt) { base = kv; ld = 128; c0 = 0; }
        else if (pn < 18) { base = q1; ld = NSAW; c0 = (pn - 12) * 256; }
        else if (pn < 24) { base = zq; ld = NSAW; c0 = (pn - 18) * 256; act = true; }
        else if (pn < 26) { base = qm1; ld = MEMW; c0 = (pn - 24) * 256; }
        else { base = zm1; ld = MEMW; c0 = (pn - 26) * 256; act = true; }
#pragma unroll
        for (int ai = 0; ai < 2; ++ai)
#pragma unroll
            for (int m = 0; m < 4; ++m) { const size_t row = EPI_ROWS(ai, m);
                const float rinv = st.rinv[ai][m];
#pragma unroll
                for (int bj = 0; bj < 2; ++bj) {
                    f32x4 v0 = acc[ai][bj][m][0] * rinv, v1 = acc[ai][bj][m][1] * rinv;
                    if (act) { v0 = silu4(v0); v1 = silu4(v1); }
                    if (kvt) { const int g = (pn & 1) * 2 + (wc >> 1), d = 64 * (wc & 1) + 32 * bj + 8 * fq; const size_t b = row >> 12, t = row & (SEQ - 1);
                        st_bf8(kv + ((((size_t)(pn >> 1) * 4 + b) * 4 + g) * SEQ + t) * 128 + d, v0, v1); }
                    else st_bf8(base + row * ld + c0 + EPI_C8(bj), v0, v1); } }
    }
};
struct Epi6 {
    static constexpr bool PERM = false;
    float* base; int ld; size_t plane;
    struct State {};
    __device__ __forceinline__ void begin(acc_t& acc, State&, const pg8::Unit&, int, int, int, int) const {
#pragma unroll
        for (int a = 0; a < 2; ++a)
#pragma unroll
            for (int b = 0; b < 2; ++b)
#pragma unroll
                for (int m = 0; m < 4; ++m)
#pragma unroll
                    for (int n = 0; n < 2; ++n) acc[a][b][m][n] = (f32x4){0.f, 0.f, 0.f, 0.f};
    }
    __device__ __forceinline__ void operator()(const acc_t& acc, State&, const pg8::Unit& u, int wr, int wc, int fr, int fq) const {
        float* b0 = base + (size_t)u.z * plane + u.pn * 256;
#pragma unroll
        for (int ai = 0; ai < 2; ++ai)
#pragma unroll
            for (int m = 0; m < 4; ++m) { float* rowp = b0 + (size_t)EPI_ROWS(ai, m) * ld;
#pragma unroll
                for (int bj = 0; bj < 2; ++bj)
#pragma unroll
                    for (int n = 0; n < 2; ++n) *(f32x4*)(rowp + EPI_COL(bj, n)) = acc[ai][bj][m][n]; }
    }
};
struct EpiG {
    static constexpr bool PERM = true;
    float* slab;
    struct State {};
    __device__ __forceinline__ void begin(acc_t& acc, State&, const pg8::Unit&, int, int, int, int) const {
#pragma unroll
        for (int a = 0; a < 2; ++a)
#pragma unroll
            for (int b = 0; b < 2; ++b)
#pragma unroll
                for (int m = 0; m < 4; ++m)
#pragma unroll
                    for (int n = 0; n < 2; ++n) acc[a][b][m][n] = (f32x4){0.f, 0.f, 0.f, 0.f};
    }
    __device__ __forceinline__ void operator()(const acc_t& acc, State&, const pg8::Unit& u, int wr, int wc, int fr, int fq) const {
        if (wc != 0) return;
        float* b0 = slab + (size_t)u.z * MTOK * 36;
#pragma unroll
        for (int ai = 0; ai < 2; ++ai)
#pragma unroll
            for (int m = 0; m < 4; ++m) { float* rowp = b0 + (size_t)EPI_ROWS(ai, m) * 36;
                *(f32x4*)(rowp + 8 * fq) = acc[ai][0][m][0]; *(f32x4*)(rowp + 8 * fq + 4) = acc[ai][0][m][1];
                if (fq == 0) *(f32x4*)(rowp + 32) = acc[ai][1][m][0]; }
    }
};
struct EpiW {
    static constexpr bool PERM = true;
    bf16* w1t;
    struct State {};
    __device__ __forceinline__ void begin(acc_t& acc, State&, const pg8::Unit&, int, int, int, int) const {
#pragma unroll
        for (int a = 0; a < 2; ++a)
#pragma unroll
            for (int b = 0; b < 2; ++b)
#pragma unroll
                for (int m = 0; m < 4; ++m)
#pragma unroll
                    for (int n = 0; n < 2; ++n) acc[a][b][m][n] = (f32x4){0.f, 0.f, 0.f, 0.f};
    }
    __device__ __forceinline__ void operator()(const acc_t& acc, State&, const pg8::Unit& u, int wr, int wc, int fr, int fq) const {
#pragma unroll
        for (int ai = 0; ai < 2; ++ai)
#pragma unroll
            for (int m = 0; m < 4; ++m) { const int d = EPI_ROWS(ai, m);
                if (u.pm == 0 || ai == 0) { bf16* rowp = w1t + (size_t)(u.z * 384 + d) * DM + u.pn * 256;
#pragma unroll
                    for (int bj = 0; bj < 2; ++bj) st_bf8(rowp + EPI_C8(bj), acc[ai][bj][m][0], acc[ai][bj][m][1]); }
                }
    }
};

__device__ __forceinline__ void rinv_pass(Frame& F) {
    unsigned char* ws = F.ptr(IX_WS); const float* SS1 = WSP(float, WS_SS1); float* RINV = WSP(float, WS_RINV1);
    const int gt = F.vcu * NTHREADS + F.tid(), NGT = F.G * NTHREADS;
    for (int i = gt; i < MTOK * 4; i += NGT) { const int row = i >> 2, q = i & 3;
        const f32x4 a = *(const f32x4*)(SS1 + (size_t)row * 32 + q * 8), b = *(const f32x4*)(SS1 + (size_t)row * 32 + q * 8 + 4);
        float s = ((a[0] + a[1]) + (a[2] + a[3])) + ((b[0] + b[1]) + (b[2] + b[3]));
        s += __shfl_xor(s, 1); s += __shfl_xor(s, 2);
        if (q == 0) RINV[row] = 1.0f / sqrtf(s * (1.f / DM) + EPS); }
}
__device__ __forceinline__ void gates_finish(Frame& F) {
    unsigned char* ws = F.ptr(IX_WS); const float* SL = WSP(float, WS_C); const float* RINV = WSP(float, WS_RINV1); float* GATES = WSP(float, WS_GATES);
    const int gt = F.vcu * NTHREADS + F.tid(), NGT = F.G * NTHREADS;
    for (int i = gt; i < MTOK * 9; i += NGT) { const int row = i / 9, c4 = (i - row * 9) * 4;
        const float rinv = RINV[row];
        f32x4 a = *(const f32x4*)(SL + (size_t)row * 36 + c4);
#pragma unroll
        for (int z = 1; z < 4; ++z) a += *(const f32x4*)(SL + (size_t)z * MTOK * 36 + (size_t)row * 36 + c4);
        a = a * rinv;
        *(f32x4*)(GATES + (size_t)row * 36 + c4) = (f32x4){sigmoid_f(a[0]), sigmoid_f(a[1]), sigmoid_f(a[2]), sigmoid_f(a[3])}; }
}
__device__ __forceinline__ void rope_pass(Frame& F) {
    unsigned char* ws = F.ptr(IX_WS); bf16* Q1 = WSP(bf16, WS_Q1); bf16* KV = WSP(bf16, WS_KVB); const float* ROPE = WSP(float, WS_ROPE);
    const int gt = F.vcu * NTHREADS + F.tid(), NGT = F.G * NTHREADS;
    constexpr int NQI = MTOK * NHEAD * 2, NKI = 2 * MTOK * NKVH * 2, NI = NQI + NKI;
    for (int i0 = gt; i0 < NI; i0 += 5 * NGT) {
        bf16* pp[5]; v4u x1[5], x2[5]; f32x4 c0[5], c1[5], s0[5], s1[5];
#pragma unroll
        for (int e = 0; e < 5; ++e) { const int i = i0 + e * NGT; pp[e] = nullptr;
            if (i < NI) { const int q = i & 1; int row; bf16* p;
                if (i < NQI) { const int rh = i >> 1; row = rh / NHEAD; p = Q1 + (size_t)row * NSAW + (rh - row * NHEAD) * 128; }
                else { const int k = (i - NQI) >> 1, t = k & (SEQ - 1), sg = k >> 12, kind = 2 + 2 * (sg >> 4), bg = sg & 15;
                    row = (bg >> 2) * SEQ + t; p = KV + (((size_t)kind * 16 + bg) * SEQ + t) * 128; }
                p += 8 * q; pp[e] = p; const float* rp = ROPE + (size_t)row * 32 + 8 * q;
                x1[e] = *(const v4u*)p; x2[e] = *(const v4u*)(p + 16);
                c0[e] = *(const f32x4*)rp; c1[e] = *(const f32x4*)(rp + 4); s0[e] = *(const f32x4*)(rp + 16); s1[e] = *(const f32x4*)(rp + 20); } }
#pragma unroll
        for (int e = 0; e < 5; ++e) if (pp[e]) {
            const f32x4 a0 = {bflo(x1[e].x), bfhi(x1[e].x), bflo(x1[e].y), bfhi(x1[e].y)}, a1 = {bflo(x1[e].z), bfhi(x1[e].z), bflo(x1[e].w), bfhi(x1[e].w)};
            const f32x4 b0 = {bflo(x2[e].x), bfhi(x2[e].x), bflo(x2[e].y), bfhi(x2[e].y)}, b1 = {bflo(x2[e].z), bfhi(x2[e].z), bflo(x2[e].w), bfhi(x2[e].w)};
            st_bf8(pp[e], a0 * c0[e] - b0 * s0[e], a1 * c1[e] - b1 * s1[e]);
            st_bf8(pp[e] + 16, b0 * c0[e] + a0 * s0[e], b1 * c1[e] + a1 * s1[e]); }
    }
}
__device__ __forceinline__ void p7_cmp2(Frame& F) {
    unsigned char* ws = F.ptr(IX_WS); bf16* KCo = WSP(bf16, WS_KCMP); bf16* VCo = WSP(bf16, WS_VCMP);
    const float* HID = WSP(float, WS_B); const float* CB = WSP(float, WS_CBIASF); const float* ROPEC = WSP(float, WS_ROPEC); const bf16* W2T = WSP(bf16, WS_W2T);
    constexpr int HP = 528;
    LAS unsigned char* hb = F.lds;
    LAS float* os = (LAS float*)(F.lds + 32 * HP);
    for (int unit = F.vcu; unit < 256; unit += F.G) {
        const int tid = F.tid(), lane = tid & 63, wv = __builtin_amdgcn_readfirstlane(tid >> 6), fr = lane & 15, fq = lane >> 4;
        const int kv = unit >> 7, row0 = (unit & 127) * 32;
        {
            const int r = tid >> 4, c16 = (tid & 15) * 16;
            f32x4 a[4] = {{0.f, 0.f, 0.f, 0.f}, {0.f, 0.f, 0.f, 0.f}, {0.f, 0.f, 0.f, 0.f}, {0.f, 0.f, 0.f, 0.f}};
#pragma unroll
            for (int ks = 0; ks < 8; ++ks) { const float* pp = HID + ((size_t)(ks * 2 + kv) * 4096 + row0 + r) * 256 + c16;
#pragma unroll
                for (int e = 0; e < 4; ++e) a[e] += *(const f32x4*)(pp + 4 * e); }
            { const float* cb = CB + kv * 256 + c16;
#pragma unroll
              for (int e = 0; e < 4; ++e) a[e] += *(const f32x4*)(cb + 4 * e); }
            v4u w0, w1;
            w0.x = cvtpk(silu_f(a[0][0]), silu_f(a[0][1])); w0.y = cvtpk(silu_f(a[0][2]), silu_f(a[0][3])); w0.z = cvtpk(silu_f(a[1][0]), silu_f(a[1][1])); w0.w = cvtpk(silu_f(a[1][2]), silu_f(a[1][3]));
            w1.x = cvtpk(silu_f(a[2][0]), silu_f(a[2][1])); w1.y = cvtpk(silu_f(a[2][2]), silu_f(a[2][3])); w1.z = cvtpk(silu_f(a[3][0]), silu_f(a[3][1])); w1.w = cvtpk(silu_f(a[3][2]), silu_f(a[3][3]));
            *(LAS v4u*)(hb + r * HP + c16 * 2) = w0; *(LAS v4u*)(hb + r * HP + c16 * 2 + 16) = w1;
        }
        bf16x8 bfr[8];
        { const bf16* wrow = W2T + ((size_t)kv * 128 + 16 * wv + fr) * 256 + 8 * fq;
#pragma unroll
          for (int ks = 0; ks < 8; ++ks) bfr[ks] = *(const bf16x8*)(wrow + 32 * ks); }
        __syncthreads();
        {
            f32x4 d0 = {0.f, 0.f, 0.f, 0.f}, d1 = {0.f, 0.f, 0.f, 0.f};
#pragma unroll
            for (int ks = 0; ks < 8; ++ks) {
                const bf16x8 a0 = *(const LAS bf16x8*)(hb + fr * HP + (32 * ks + 8 * fq) * 2), a1 = *(const LAS bf16x8*)(hb + (16 + fr) * HP + (32 * ks + 8 * fq) * 2);
                d0 = __builtin_amdgcn_mfma_f32_16x16x32_bf16(a0, bfr[ks], d0, 0, 0, 0);
                d1 = __builtin_amdgcn_mfma_f32_16x16x32_bf16(a1, bfr[ks], d1, 0, 0, 0); }
#pragma unroll
            for (int j = 0; j < 4; ++j) { os[(4 * fq + j) * 128 + 16 * wv + fr] = d0[j]; os[(16 + 4 * fq + j) * 128 + 16 * wv + fr] = d1[j]; }
        }
        __syncthreads();
        {
            const int r = tid >> 4, d8 = (tid & 15) * 8;
            const int row = row0 + r, bg = row >> 8, n = row & 255, b = bg >> 2, g = bg & 3;
            if (n < NCMP) {
                float o[8];
#pragma unroll
                for (int e = 0; e < 8; ++e) { const int d = d8 + e; float v = os[r * 128 + d];
                    if (kv == 0 && d8 < 32) { const int fi = d & 15; const float c = ROPEC[(b * 256 + n) * 32 + fi], s = ROPEC[(b * 256 + n) * 32 + 16 + fi];
                        v = d8 < 16 ? v * c - os[r * 128 + d + 16] * s : v * c + os[r * 128 + d - 16] * s; }
                    o[e] = v; }
                bf16* dst = (kv == 0 ? KCo : VCo) + (size_t)(b * 256 + n) * 512 + g * 128 + d8;
                v4u w; w.x = pk2(o[0], o[1]); w.y = pk2(o[2], o[3]); w.z = pk2(o[4], o[5]); w.w = pk2(o[6], o[7]); *(v4u*)dst = w;
            }
        }
        __syncthreads();
    }
}

__device__ __forceinline__ void p8_select(Frame& F) {
    using namespace att;
    char* lds = F.ldsg; unsigned char* ws = F.ptr(IX_WS);
    const bf16* KC = WSP(bf16, WS_KCMP); const bf16* Q1 = WSP(bf16, WS_Q1); unsigned long long* SEL = WSP(unsigned long long, WS_SEL);
    const int wid = F.wave;
    for (int unit = F.vcu; unit < NB * NKVH * 16; unit += F.G) {
        const int tid = F.tid(), lane = tid & 63, r32 = lane & 31, hi = lane >> 5;
        const int sr = tid >> 4, sc = (tid & 15) * 8;
        const int qt = unit & 15, g = (unit >> 4) & 3, b = unit >> 6;
#pragma unroll
        for (int tt = 0; tt < 4; ++tt)
#pragma unroll
            for (int hf = 0; hf < 2; ++hf) { const int key = tt * 64 + hf * 32 + sr;
                *(bf16x8*)(lds + tt * SHM_K + KSWZ(hf * 32 + sr, sc * 2)) = load8(KC + (size_t)(b * 256 + key) * 512 + g * 128 + sc); }
        __syncthreads();
        const int tw = ((wid < 4) ? qt : 31 - qt) * 128 + (wid & 3) * 32, t = tw + r32, lim = (t - 31) >> 4;
        const int limw = tw >> 4;
        const int limlo = (tw - 31) >> 4;
        float imp[32];
#pragma unroll
        for (int c = 0; c < 32; ++c) imp[c] = 0.f;
        for (int rr = 0; rr < 3; ++rr) {
            const int h = g * 3 + rr; bf16x8 qr[8];
#pragma unroll
            for (int d0 = 0; d0 < 8; ++d0) qr[d0] = load8(Q1 + (size_t)(b * SEQ + t) * NSAW + h * 128 + d0 * 16 + hi * 8);
            f32x16 s[8];
            SBAR(); qkt<0>(s[0], s[1], lds, r32, hi, qr); SBAR();
            if (limw >= 64) { qkt<1>(s[2], s[3], lds, r32, hi, qr); SBAR(); }
            if (limw >= 128) { qkt<2>(s[4], s[5], lds, r32, hi, qr); SBAR(); }
            if (limw >= 192) { qkt<3>(s[6], s[7], lds, r32, hi, qr); SBAR(); }
            constexpr float C2 = LOG2E * ATT_SCALE; const float NEG = -__builtin_inff();
            float mx = -1e30f;
            int lim2 = lim - 4 * hi; asm volatile("" : "+v"(lim2));
#pragma unroll
            for (int i = 0; i < 8; ++i) if (limw >= (i >> 1) * 64) {
                if (limlo >= (i >> 1) * 64 + (i & 1) * 32 + 31) {
#pragma unroll
                    for (int r = 0; r < 16; ++r) mx = fmaxf(mx, s[i][r]);
                } else {
#pragma unroll
                    for (int r = 0; r < 16; ++r) { const int key0 = (i >> 1) * 64 + (i & 1) * 32 + (r & 3) + 8 * (r >> 2); const float v = key0 <= lim2 ? s[i][r] : NEG; s[i][r] = v; mx = fmaxf(mx, v); } } }
            { auto q2 = __builtin_amdgcn_permlane32_swap(__float_as_uint(mx), __float_as_uint(mx), false, false); mx = fmaxf(__uint_as_float(q2[0]), __uint_as_float(q2[1])); }
            float sum = 0.f; const float nmx = -mx * C2;
#pragma unroll
            for (int i = 0; i < 8; ++i) {
                if (limw >= (i >> 1) * 64) {
#pragma unroll
                    for (int r = 0; r < 16; ++r) { const float p = __builtin_amdgcn_exp2f(fmaf(s[i][r], C2, nmx)); s[i][r] = p; sum += p; }
                } else {
#pragma unroll
                    for (int r = 0; r < 16; ++r) s[i][r] = 0.f; } }
            { auto q2 = __builtin_amdgcn_permlane32_swap(__float_as_uint(sum), __float_as_uint(sum), false, false); sum = __uint_as_float(q2[0]) + __uint_as_float(q2[1]); }
            const float inv = sum > 0.f ? 1.0f / sum : 0.f;
            float prev_pt = 0.f;
#pragma unroll
            for (int c = 0; c < 32; ++c) { const int i = c >> 2, a = c & 3; const float tl = 0.5f * s[i][4 * a + 3] * inv;
                auto q2 = __builtin_amdgcn_permlane32_swap(__float_as_uint(tl), __float_as_uint(tl), false, false);
                const float pt = __uint_as_float(hi ? q2[0] : q2[1]);
                imp[c] += (s[i][4 * a] + s[i][4 * a + 1] + s[i][4 * a + 2]) * inv + tl + (hi ? pt : prev_pt);
                prev_pt = pt; }
        }
        const int cur = t >> 6;
        int hi2 = hi; asm volatile("" : "+v"(hi2));
        unsigned key[32];
#pragma unroll
        for (int c = 0; c < 32; ++c) { const int j = 2 * c + hi2; const bool ok = j <= cur, forced = (j == 0) || (j == cur) || (j == cur - 1);
            const float sc_ = forced ? 1e4f : imp[c];
            key[c] = (ok ? (__float_as_uint(sc_) & ~63u) : 0u) | (unsigned)(63 - j); }
        unsigned T = 0u;
#define P8_COUNT(Tc_, cn_) do { cn_ = 0u; _Pragma("unroll") for (int c = 0; c < 32; ++c) cn_ += (key[c] >= (Tc_)) ? 1u : 0u; \
            auto q2 = __builtin_amdgcn_permlane32_swap(cn_, cn_, false, false); cn_ = q2[0] + q2[1]; } while (0)
#pragma unroll 1
        for (int bit = 30; bit >= 6; --bit) { const unsigned Tc = T | (1u << bit); unsigned cn; P8_COUNT(Tc, cn); T = cn >= 16u ? Tc : T; }
        { unsigned cn; P8_COUNT(T, cn);
          if (__any(cn != 16u)) {
#pragma unroll 1
              for (int bit = 5; bit >= 0; --bit) { const unsigned Tc = T | (1u << bit); unsigned c2; P8_COUNT(Tc, c2); T = c2 >= 16u ? Tc : T; } } }
#undef P8_COUNT
        unsigned wlo = 0u, whi = 0u;
#pragma unroll
        for (int c = 0; c < 32; ++c) { const unsigned selbit = (key[c] >= T && (2 * c + hi2) <= cur) ? 1u : 0u;
            if (c < 16) wlo |= selbit << (2 * c); else whi |= selbit << (2 * (c - 16)); }
        wlo <<= hi; whi <<= hi;
        { auto q2 = __builtin_amdgcn_permlane32_swap(wlo, wlo, false, false); wlo = q2[0] | q2[1]; }
        { auto q2 = __builtin_amdgcn_permlane32_swap(whi, whi, false, false); whi = q2[0] | q2[1]; }
        if (hi == 0) SEL[(size_t)(b * NKVH + g) * SEQ + t] = ((unsigned long long)whi << 32) | wlo;
        __syncthreads();
    }
}

typedef att::Ctx AttnCtx;
__device__ __forceinline__ void nsa_blk(const AttnCtx& C, int L, int pass, att::Blk& k) {
    const int qt = 15 - L / 48, bh = L % 48, b = bh / 12, h = bh % 12, g = h / 3;
    const int row0 = b * SEQ + qt * 256;
    k.Q = C.Q1 + (size_t)row0 * NSAW + h * 128; k.ldq = NSAW; k.t0 = qt * 256; k.row0 = row0; k.hcol = h * 128; k.bg = b * NKVH + g;
    if (pass == 0) { k.K = C.KV + (size_t)((2 * 4 + b) * 4 + g) * SEQ * 128; k.voff = 16 * SEQ * 128; k.ldk = 128; k.j_lo = 0; k.j_hi = 4 * qt + 4; k.mode = att::MODE_SEL; k.epi = att::EPI_ACC0; k.gcol = h * 3 + 1; }
    else if (pass == 1) { k.K = C.KV + (size_t)((4 * 4 + b) * 4 + g) * SEQ * 128; k.voff = 16 * SEQ * 128; k.ldk = 128; k.j_lo = qt >= 2 ? 4 * qt - 8 : 0; k.j_hi = 4 * qt + 4; k.mode = att::MODE_WIN; k.epi = att::EPI_ACC1; k.gcol = h * 3 + 2; }
    else { k.K = C.KC + (size_t)b * 256 * 512 + g * 128; k.voff = (int)(C.VC - C.KC); k.ldk = 512; k.j_lo = 0; k.j_hi = (qt >> 2) + 1; k.mode = att::MODE_CMP; k.epi = att::EPI_FIN; k.gcol = h * 3 + 0; }
}
__device__ __forceinline__ void mem_blk(const AttnCtx& C, int X, att::Blk& k) {
    const int qt = X & 15, mh = (X >> 4) & 3, b = X >> 6;
    const int row0 = b * SEQ + qt * 256;
    k.Q = C.QM + (size_t)row0 * C.qm_ld + C.qm_c0 + mh * 128; k.ldq = C.qm_ld; k.t0 = qt * 256; k.row0 = row0; k.hcol = mh * 128; k.bg = 0; k.gcol = 0;
    k.K = C.MKV + (size_t)b * 256 * 1024 + mh * 128; k.voff = 512; k.ldk = 1024; k.j_lo = 0; k.j_hi = 4; k.mode = att::MODE_NONE; k.epi = att::EPI_MEM;
}
struct AttnStream {
    int G, c, n_nsa, n_mem, cnt_nsa, total; bool tab;
    __device__ __forceinline__ void init(int G_, int c_, int n_nsa_, int n_mem_) {
        G = G_; c = c_; n_nsa = n_nsa_; n_mem = n_mem_;
        tab = (G == 256 && n_nsa == 768);
        if (tab) { cnt_nsa = 0;
#pragma unroll
            for (int r = 0; r < 4; ++r) cnt_nsa += NSA_TAB[c * 4 + r] != 0xffff ? 1 : 0; }
        else { const int full = n_nsa / G, rem = n_nsa - full * G, pos = (full & 1) ? G - 1 - c : c; cnt_nsa = full + (pos < rem ? 1 : 0); }
        const int cnt_mem = c < n_mem ? (n_mem - c + G - 1) / G : 0;
        total = 3 * cnt_nsa + cnt_mem;
    }
    __device__ __forceinline__ void get(const AttnCtx& C, int s, att::Blk& k) const {
        if (s < 3 * cnt_nsa) { const int r = s / 3, pass = s - 3 * r; const int L = tab ? (int)NSA_TAB[c * 4 + r] : r * G + ((r & 1) ? G - 1 - c : c); nsa_blk(C, L, pass, k); }
        else { const int sm = s - 3 * cnt_nsa; mem_blk(C, sm * G + c, k); }
    }
};
__device__ __forceinline__ void attn_run(Frame& F, const AttnCtx& C, int n_nsa, int n_mem) {
    AttnStream S; S.init(F.G, F.vcu, n_nsa, n_mem);
    if (S.total > 0) {
        att::Blk cur, nxt; att::Seam seam;
        S.get(C, 0, cur);
        att::attn_prime(F.tid(), cur, F.ldsg, seam);
        for (int s = 0; s < S.total; ++s) {
            const int tid = F.tid();
            S.get(C, s, cur);
            S.get(C, s + 1 < S.total ? s + 1 : s, nxt);
            att::attn_block(tid, C, cur, nxt.Q, nxt.K, nxt.voff, nxt.ldq, nxt.ldk, nxt.j_lo, F.ldsg, seam);
        }
    }
    VM_WAIT(); __syncthreads();
}
__device__ __forceinline__ void attn_run_mem(Frame& F, const AttnCtx& C, int n_mem) {
    const int G = F.G, c = F.vcu, cnt = c < n_mem ? (n_mem - c + G - 1) / G : 0;
    if (cnt > 0) {
        att::Blk cur, nxt; att::Seam seam;
        mem_blk(C, c, cur);
        const int tid = F.tid();
        att::attn_prime(tid, cur, F.ldsg, seam);
        for (int s = 0; s < cnt; ++s) {
            mem_blk(C, s * G + c, cur);
            mem_blk(C, (s + 1 < cnt ? s + 1 : s) * G + c, nxt);
            att::attn_block(tid, C, cur, nxt.Q, nxt.K, nxt.voff, nxt.ldq, nxt.ldk, nxt.j_lo, F.ldsg, seam);
        }
    }
    VM_WAIT(); __syncthreads();
}

__device__ __forceinline__ void p11_final(Frame& F) {
    unsigned char* ws = F.ptr(IX_WS); float* out = (float*)F.ptr(IX_OUT); const float* final_g = F.fin(IX_FINAL_G);
    const float* SS2 = WSP(float, WS_SS2); const bf16* H2B = WSP(bf16, WS_C);
    const int gw = F.vcu * NWAVES + F.wave, NGW = F.G * NWAVES, lane = F.tid() & 63;
    f32x4 g[8];
#pragma unroll
    for (int j = 0; j < 8; ++j) g[j] = ((const f32x4*)final_g)[64 * j + lane];
    for (int m = gw; m < MTOK; m += 4 * NGW) {
        v2u a[4][8]; float rv[4];
#pragma unroll
        for (int q = 0; q < 4; ++q) { const int mm = m + q * NGW < MTOK ? m + q * NGW : m; const v2u* p = (const v2u*)(H2B + (size_t)mm * DM) + lane;
#pragma unroll
            for (int j = 0; j < 8; ++j) a[q][j] = __builtin_nontemporal_load(p + 64 * j);
            rv[q] = lane < 32 ? SS2[(size_t)mm * 32 + lane] : 0.f; }
#pragma unroll
        for (int q = 0; q < 4; ++q) { const int mm = m + q * NGW; if (mm < MTOK) {
            const float rinv = 1.0f / sqrtf(wave_sum(rv[q]) * (1.f / DM) + EPS);
            f32x4* o = (f32x4*)(out + (size_t)mm * DM) + lane;
#pragma unroll
            for (int j = 0; j < 8; ++j) __builtin_nontemporal_store((f32x4){bflo(a[q][j].x), bfhi(a[q][j].x), bflo(a[q][j].y), bfhi(a[q][j].y)} * rinv * g[j], o + 64 * j); } }
    }
}

#ifndef WGM_P1
#define WGM_P1 4
#endif
#ifndef WGM_P3
#define WGM_P3 4
#endif
#ifndef WGM_P4
#define WGM_P4 2
#endif
#ifndef WGM_P5
#define WGM_P5 2
#endif
#ifndef WGM_P10
#define WGM_P10 2
#endif
__global__ void __launch_bounds__(NTHREADS, 2) fwd_kernel(Args args) {
    extern __shared__ __attribute__((aligned(16))) unsigned char lds[];
    Frame F;
    F.lds = (LAS unsigned char*)lds; F.ldsg = (char*)lds;
    F.wave = __builtin_amdgcn_readfirstlane((int)threadIdx.x >> 6);
    F.G = gridDim.x; { const int bx = blockIdx.x; F.vcu = (F.G % 8 == 0) ? (bx % 8) * (F.G / 8) + bx / 8 : bx; }
    if (threadIdx.x < 19) { const unsigned long long v = threadIdx.x < 17 ? (unsigned long long)args.in[threadIdx.x < 17 ? threadIdx.x : 0] : (threadIdx.x == 17 ? (unsigned long long)args.out : (unsigned long long)args.ws);
        ((LAS unsigned long long*)(F.lds + TAB_OFF))[threadIdx.x] = v; }
    if (threadIdx.x == 32) { ((LAS unsigned*)(F.lds + MISC_OFF))[0] = 0u; ((LAS unsigned*)(F.lds + MISC_OFF))[1] = 0u; }
    if (!MK_PER_PHASE && threadIdx.x == 0) (void)xb_add((unsigned*)(args.ws + WS_CTL) + 1024 + XB_XCNT(xb_xcc_id()), 1u);
    __syncthreads();
    const int lo = args.ph_lo, hi = args.ph_hi;
#ifndef PH_MASK
#define PH_MASK 0xfff
#endif
#define IN(k) (((PH_MASK >> (k)) & 1) && lo <= (k) && (k) < hi)
#ifndef REPEAT_MASK
#define REPEAT_MASK 0
#endif
#define REPS(k) (1 + ((REPEAT_MASK >> (k)) & 1))
#define GBAR() xcd_barrier((unsigned*)(F.ptr(IX_WS) + WS_CTL) + 1024, (volatile LAS unsigned*)(F.lds + MISC_OFF), (unsigned)F.G, F.tid())
#define SEAM(k) do { if (IN(k) && IN((k) + 1)) xcd_barrier((unsigned*)(F.ptr(IX_WS) + WS_CTL) + 1024, (volatile LAS unsigned*)(F.lds + MISC_OFF), (unsigned)F.G, F.tid()); } while (0)
#ifdef CLKPROBE_A
#ifndef PROBE_BLK
#define PROBE_BLK 0
#endif
#ifndef CLKPROBE_S
#define CLKPROBE_S (-1)
#endif
#define PROBE_T(k, slot_) do { const int slot = ((slot_) == 0 && (k) == CLKPROBE_S) ? 1 : (slot_); if (((k) == ((slot_) ? CLKPROBE_B : CLKPROBE_A) || ((slot_) == 0 && (k) == CLKPROBE_S)) && blockIdx.x == PROBE_BLK && F.tid() == 0) { volatile unsigned long long* pr_ = (volatile unsigned long long*)(F.ptr(IX_WS) + WS_CTL + 32768); pr_[(slot)] = __builtin_amdgcn_s_memrealtime(); pr_[2 + (slot)] = __builtin_amdgcn_s_memtime(); } } while (0)
#else
#define PROBE_T(k, slot) do { } while (0)
#endif
    const size_t TILE_B = (size_t)256 * DM * 2;

    PROBE_T(0, 0);
#ifdef SKEWPROBE
    if (F.tid() == 0 && blockIdx.x == 0) ((volatile unsigned long long*)(F.ptr(IX_WS) + WS_CTL + 32768))[0] = __builtin_amdgcn_s_memrealtime();
    if (F.tid() == 0 && blockIdx.x == SKEWPROBE) ((volatile unsigned long long*)(F.ptr(IX_WS) + WS_CTL + 32768))[1] = __builtin_amdgcn_s_memrealtime() + 10000ull;
#endif
#ifndef NO_P0A
    if (IN(0)) for (int rep = 0; rep < REPS(0); ++rep) { if (rep) GBAR(); p0_prologue(F); }
#endif
#ifndef NO_P0B
    if (IN(0)) {
        GBAR(); unsigned char* ws = F.ptr(IX_WS);
        int nt6 = 6; asm volatile("" : "+s"(nt6));
        pg8::Geo gw{384, POOLW, nt6, 256};
        SchedW Sw{F.G, (int)blockIdx.x, (const char*)WSP(bf16, WS_WPT), (const char*)WSP(bf16, WS_W1U)};
        EpiW Ew{WSP(bf16, WS_W1T)};
        pg8::gemm_phase<EpiW, SchedW, true, true>(F.lds, F.tid(), gw, Sw, Ew);
    }
#endif
    PROBE_T(0, 1); SEAM(0);
#ifdef DUP0
    GBAR(); p0_prologue(F); GBAR();
#endif

    PROBE_T(1, 0);
    if (IN(1)) for (int rep = 0; rep < REPS(1); ++rep) { if (rep) GBAR(); unsigned char* ws = F.ptr(IX_WS);
        pg8::Geo g{DM, DM, DM / 64, 256};
#ifdef KPROBE
        if (KPROBE_PH == 1 && blockIdx.x == 0) g.probe = (volatile unsigned long long*)(F.ptr(IX_WS) + WS_CTL + 32768);
#endif
        SchedLin S{64, 16, 1, F.G, (int)blockIdx.x, WGM_P1, (const char*)WSP(bf16, WS_XB), (const char*)WSP(bf16, WS_W1T), TILE_B, 0, TILE_B, 0, 0, 0, nullptr, nullptr, 0, 0};
        Epi1 E{WSP(bf16, WS_A), WSP(float, WS_RINV0)};
        pg8::gemm_phase<Epi1, SchedLin, true, true>(F.lds, F.tid(), g, S, E);
        {
            pg8::Geo g2{DM, DM, 4, 256};
            SchedMem S2{F.G, (int)blockIdx.x, (const char*)WSP(bf16, WS_MEMN), (const char*)WSP(bf16, WS_WMT)};
            Epi6 E2{(float*)(ws + WS_D), 1024, (size_t)1024 * 1024};
            pg8::gemm_phase<Epi6, SchedMem, true, true>(F.lds, F.tid(), g2, S2, E2);
        }
    } PROBE_T(1, 1); SEAM(1);

#ifdef DUPBAR
    for (int i = 0; i < 10; ++i) GBAR();
#endif
    PROBE_T(2, 0);
    if (IN(2)) for (int rep = 0; rep < REPS(2); ++rep) { if (rep) GBAR(); p2_pool(F); } PROBE_T(2, 1); SEAM(2);

    PROBE_T(3, 0);
    if (IN(3)) for (int rep = 0; rep < REPS(3); ++rep) { if (rep) GBAR(); unsigned char* ws = F.ptr(IX_WS);
        AttnCtx C{}; C.QM = WSP(bf16, WS_A); C.qm_ld = N1; C.qm_c0 = 2 * POOLW; C.ZM = WSP(bf16, WS_A); C.zm_ld = N1; C.zm_c0 = 2 * POOLW + MEMW;
        C.MKV = WSP(bf16, WS_MKV); C.Y = WSP(bf16, WS_B);
#ifndef NO_ATT3
        PROBE_T(31, 0); attn_run_mem(F, C, NB * 4 * 16); PROBE_T(31, 1);
#ifdef DUP3A
        GBAR(); attn_run_mem(F, C, NB * 4 * 16);
#endif
#endif
    } PROBE_T(3, 1); SEAM(3);

    PROBE_T(4, 0);
    if (IN(4)) for (int rep = 0; rep < REPS(4); ++rep) { if (rep) GBAR(); unsigned char* ws = F.ptr(IX_WS);
        pg8::Geo g{DM, DM, DM / 64, 256};
#ifdef KPROBE
        if (KPROBE_PH == 4 && blockIdx.x == 0) g.probe = (volatile unsigned long long*)(F.ptr(IX_WS) + WS_CTL + 32768);
#endif
        SchedLin S{64, 8, 1, F.G, (int)blockIdx.x, WGM_P4, (const char*)WSP(bf16, WS_B), (const char*)WSP(bf16, WS_WO0T), TILE_B, 0, TILE_B, 0, 0, 0, nullptr, nullptr, 0, 0};
        bf16* h1b = (bf16*)F.ptr(IX_OUT);
        EpiRes<true> E{WSP(bf16, WS_XB), h1b, WSP(float, WS_SS1)};
        pg8::gemm_phase<EpiRes<true>, SchedLin, true, true>(F.lds, F.tid(), g, S, E);
    } PROBE_T(4, 1); SEAM(4);

    PROBE_T(5, 0);
    if (IN(5)) for (int rep = 0; rep < REPS(5); ++rep) { if (rep) GBAR(); unsigned char* ws = F.ptr(IX_WS);
        rinv_pass(F); GBAR();
        pg8::Geo g{DM, DM, DM / 64, 256};
#ifdef KPROBE
        if (KPROBE_PH == 5 && blockIdx.x == 0) g.probe = (volatile unsigned long long*)(F.ptr(IX_WS) + WS_CTL + 32768);
#endif
        SchedLin S{64, 28, 1, F.G, (int)blockIdx.x, WGM_P5, (const char*)F.ptr(IX_OUT), (const char*)WSP(bf16, WS_W4T), TILE_B, 0, TILE_B, 0, 0, 0, nullptr, nullptr, 0, 0};
        Epi5 E{WSP(float, WS_RINV1), WSP(bf16, WS_KVB), WSP(bf16, WS_Q1), WSP(bf16, WS_ZQ), WSP(bf16, WS_QM1), WSP(bf16, WS_ZM1)};
        pg8::gemm_phase<Epi5, SchedLin, true, true>(F.lds, F.tid(), g, S, E);
        {
            pg8::Geo g2{DM, DM, 8, 256};
            SchedGate S2{F.G, (int)blockIdx.x, (const char*)F.ptr(IX_OUT), (const char*)(WSP(bf16, WS_W4T) + (size_t)28 * 256 * DM)};
            EpiG E2{WSP(float, WS_C)};
            pg8::gemm_phase<EpiG, SchedGate, true, true>(F.lds, F.tid(), g2, S2, E2);
        }
    } PROBE_T(5, 1); SEAM(5);

    PROBE_T(6, 0);
    if (IN(6)) for (int rep = 0; rep < REPS(6); ++rep) { if (rep) GBAR(); unsigned char* ws = F.ptr(IX_WS);
        pg8::Geo g{16 * 128, 4096, 8, 256};
        SchedCmp S{F.G, (int)blockIdx.x, (const char*)WSP(bf16, WS_KVB), (const char*)WSP(bf16, WS_WC1T)};
        Epi6 E{WSP(float, WS_B), 256, (size_t)4096 * 256};
        pg8::gemm_phase<Epi6, SchedCmp, true, true>(F.lds, F.tid(), g, S, E);
        PROBE_T(60, 0); gates_finish(F); PROBE_T(60, 1); PROBE_T(61, 0); rope_pass(F); PROBE_T(61, 1);
    } PROBE_T(6, 1); SEAM(6);

    PROBE_T(7, 0);
    if (IN(7)) for (int rep = 0; rep < REPS(7); ++rep) { if (rep) GBAR(); p7_cmp2(F); } PROBE_T(7, 1); SEAM(7);

    PROBE_T(8, 0);
    if (IN(8)) for (int rep = 0; rep < REPS(8); ++rep) { if (rep) GBAR(); p8_select(F); } PROBE_T(8, 1);
#ifdef DUP8
    GBAR(); p8_select(F);
#endif
    SEAM(8);

    PROBE_T(9, 0);
    if (IN(9)) for (int rep = 0; rep < REPS(9); ++rep) { if (rep) GBAR(); unsigned char* ws = F.ptr(IX_WS);
        AttnCtx C{}; C.KV = WSP(bf16, WS_KVB); C.KC = WSP(bf16, WS_KCMP); C.VC = WSP(bf16, WS_VCMP); C.Q1 = WSP(bf16, WS_Q1); C.ZQ = WSP(bf16, WS_ZQ);
        C.QM = WSP(bf16, WS_QM1); C.qm_ld = MEMW; C.qm_c0 = 0; C.ZM = WSP(bf16, WS_ZM1); C.zm_ld = MEMW; C.zm_c0 = 0; C.MKV = WSP(bf16, WS_MKV) + (size_t)1024 * 1024;
        C.gates = WSP(float, WS_GATES); C.SEL = WSP(unsigned long long, WS_SEL); C.YACC = WSP(float, WS_C); C.Y = WSP(bf16, WS_B);
        attn_run(F, C, NB * NHEAD * 16, NB * 4 * 16);
    } PROBE_T(9, 1); SEAM(9);

    PROBE_T(10, 0);
    if (IN(10)) for (int rep = 0; rep < REPS(10); ++rep) { if (rep) GBAR(); unsigned char* ws = F.ptr(IX_WS);
        pg8::Geo g{DM, DM, DM / 64, 256};
#ifdef KPROBE
        if (KPROBE_PH == 10 && blockIdx.x == 0) g.probe = (volatile unsigned long long*)(F.ptr(IX_WS) + WS_CTL + 32768);
#endif
        SchedLin S{64, 8, 1, F.G, (int)blockIdx.x, WGM_P10, (const char*)WSP(bf16, WS_B), (const char*)WSP(bf16, WS_WO1T), TILE_B, 0, TILE_B, 0, 0, 0, nullptr, nullptr, 0, 0};
        EpiRes<true> E{F.ptr(IX_OUT), WSP(bf16, WS_C), WSP(float, WS_SS2)};
        pg8::gemm_phase<EpiRes<true>, SchedLin, true, true>(F.lds, F.tid(), g, S, E);
    } PROBE_T(10, 1); SEAM(10);

    PROBE_T(11, 0);
    if (IN(11)) for (int rep = 0; rep < REPS(11); ++rep) { if (rep) GBAR(); p11_final(F); }
    PROBE_T(11, 1);
#ifdef CLKPROBE_A
    if (blockIdx.x == PROBE_BLK && F.tid() == 0) { volatile unsigned long long* pr_ = (volatile unsigned long long*)(F.ptr(IX_WS) + WS_CTL + 32768);
#ifdef CLKGHZ
        const unsigned long long ticks = (pr_[3] - pr_[2]) * CLKGHZ / (pr_[1] - pr_[0] ? pr_[1] - pr_[0] : 1ull);
#else
        const unsigned long long ticks = (pr_[1] - pr_[0]) * CLKMULT;
#endif
        const unsigned long long t0 = __builtin_amdgcn_s_memrealtime();
        while (__builtin_amdgcn_s_memrealtime() - t0 < ticks) __builtin_amdgcn_s_sleep(8); }
#endif
#undef IN
#undef SEAM
}

extern "C" void kernel_launch(void* const* d_in, const int* in_sizes, int n_in, void* d_out, int out_size, void* d_ws, size_t ws_size, hipStream_t stream) {
    static int grid = 0;
    if (grid == 0) {
        if (n_in != 17 || in_sizes[0] != MTOK * DM || out_size != MTOK * DM || ws_size < WS_END) {
            fprintf(stderr, "kernel_launch: unexpected shapes (n_in %d, in0 %d, out %d, ws %zu < %zu)\n", n_in, n_in > 0 ? in_sizes[0] : -1, out_size, ws_size, (size_t)WS_END); grid = -1; return; }
        int dev = 0, cus = 0, per_cu = 0;
        if (hipGetDevice(&dev) != hipSuccess || hipDeviceGetAttribute(&cus, hipDeviceAttributeMultiprocessorCount, dev) != hipSuccess) { fprintf(stderr, "kernel_launch: device query failed\n"); grid = -1; return; }
        if (hipFuncSetAttribute((const void*)fwd_kernel, hipFuncAttributeMaxDynamicSharedMemorySize, LDS_BYTES) != hipSuccess) { fprintf(stderr, "kernel_launch: hipFuncSetAttribute failed\n"); grid = -1; return; }
        if (hipOccupancyMaxActiveBlocksPerMultiprocessor(&per_cu, (const void*)fwd_kernel, NTHREADS, LDS_BYTES) != hipSuccess || per_cu < 1) {
            fprintf(stderr, "kernel_launch: occupancy query says %d blocks per CU\n", per_cu); (void)hipGetLastError(); per_cu = 1; }
        grid = cus * (per_cu > 1 ? 1 : per_cu);
    }
    if (grid < 0) return;
    (void)hipMemsetAsync((char*)d_ws + WS_CTL, 0, 65536, stream);
    Args a{};
    for (int i = 0; i < 17; ++i) a.in[i] = d_in[i];
    a.out = (float*)d_out; a.ws = (unsigned char*)d_ws;
#if MK_PER_PHASE
    for (int p = 0; p < NPHASE; ++p) { a.ph_lo = p; a.ph_hi = p + 1; hipLaunchKernelGGL(fwd_kernel, dim3(grid), dim3(NTHREADS), LDS_BYTES, stream, a); }
#else
    a.ph_lo = 0; a.ph_hi = NPHASE;
    void* kargs[] = {&a};
    hipError_t e = hipLaunchCooperativeKernel((const void*)fwd_kernel, dim3(grid), dim3(NTHREADS), kargs, LDS_BYTES, stream);
    if (e != hipSuccess) fprintf(stderr, "kernel_launch: cooperative launch failed: %s (grid %d)\n", hipGetErrorString(e), grid);
#endif
}
```
